# Optimizing an MI355X kernel written in HIP

```python
import jax, jax.numpy as jnp
from jax import lax
import numpy as np

D_MODEL = 2048
BATCH = 8
SEQ = 2048
DEPTH = 2

HEAD_DIM = 128
A_HEADS_PER_GROUP = 4
DILATED_GROUPS = ((128, 1), (512, 4), (2048, 16))
A_HEADS = A_HEADS_PER_GROUP * len(DILATED_GROUPS)
A_WIDTH = A_HEADS * HEAD_DIM
A_OUT = A_HEADS_PER_GROUP * HEAD_DIM
ATT_BLOCK = 128
ROPE_THETA = 10000.0
GLA_HEADS = 4
GLA_DK = 128
GLA_DV = 256
GLA_KEY = GLA_HEADS * GLA_DK
GLA_VAL = GLA_HEADS * GLA_DV
GLA_LOWRANK = 16
GLA_TAU = 16.0
GLA_CHUNK = 64
IN_WIDTHS = (A_WIDTH, A_WIDTH, A_WIDTH, GLA_KEY, GLA_KEY, GLA_VAL, GLA_VAL, GLA_LOWRANK, D_MODEL, D_MODEL)
IN_WIDTH = sum(IN_WIDTHS)
N_EXPERTS = 16
N_GROUPS = 4
EXPERTS_PER_GROUP = N_EXPERTS // N_GROUPS
TOPK_GROUPS = 1
TOP_K = 2
D_FF_EXPERT = 1024
EXPERT_BLOCK = 128
NORM_EPS = 1e-6

kernel_name = 'hybrid_dilated_gla_grouped_moe_adaln'


def rms_norm(x, gain):
    x32 = x.astype(jnp.float32)
    y = x32 * lax.rsqrt(jnp.mean(x32 * x32, axis=-1, keepdims=True) + NORM_EPS)
    return (y * gain.astype(jnp.float32)).astype(x.dtype)


def rope_tables(seq):
    pos = jnp.arange(seq, dtype=jnp.float32)
    inv_freq = ROPE_THETA ** (-jnp.arange(0, HEAD_DIM, 2, dtype=jnp.float32) / HEAD_DIM)
    ang = pos[:, None] * inv_freq[None, :]
    return jnp.cos(ang), jnp.sin(ang)


def apply_rope(t, cos, sin):
    t1, t2 = jnp.split(t, 2, axis=-1)
    c = cos[None, :, None, :]
    s = sin[None, :, None, :]
    return jnp.concatenate([t1 * c - t2 * s, t2 * c + t1 * s], axis=-1)


def dilated_window_attention(q, k, v, window, dilation):
    B, S, H, Dh = q.shape
    L = S // dilation
    nb = -(-L // ATT_BLOCK)
    Lp = nb * ATT_BLOCK

    def to_sub(t):
        return t.reshape(B, L, dilation, H, Dh).transpose(0, 2, 3, 1, 4)

    qs = jnp.pad(to_sub(q), ((0, 0), (0, 0), (0, 0), (0, Lp - L), (0, 0)))
    qs = qs.reshape(B, dilation, H, nb, ATT_BLOCK, Dh)
    kp = jnp.pad(to_sub(k), ((0, 0), (0, 0), (0, 0), (ATT_BLOCK, Lp - L), (0, 0)))
    vp = jnp.pad(to_sub(v), ((0, 0), (0, 0), (0, 0), (ATT_BLOCK, Lp - L), (0, 0)))

    def band(t):
        prev = t[:, :, :, :Lp].reshape(B, dilation, H, nb, ATT_BLOCK, Dh)
        cur = t[:, :, :, ATT_BLOCK:].reshape(B, dilation, H, nb, ATT_BLOCK, Dh)
        return jnp.concatenate([prev, cur], axis=-2)

    kb, vb = band(kp), band(vp)
    s = jnp.einsum('brhnid,brhnjd->brhnij', qs, kb) * (Dh ** -0.5)
    i = jnp.arange(ATT_BLOCK)[:, None]
    j = jnp.arange(2 * ATT_BLOCK)[None, :]
    dist = ATT_BLOCK + i - j
    kpos = (jnp.arange(nb)[:, None, None] - 1) * ATT_BLOCK + j[None]
    mask = (dist >= 0) & (dist <= window // dilation) & (kpos >= 0)
    s = jnp.where(mask, s, -jnp.inf)
    m = jnp.max(s, axis=-1, keepdims=True)
    p = jnp.exp(s - m)
    den = jnp.sum(p, axis=-1)
    o = jnp.einsum('brhnij,brhnjd->brhnid', p, vb) / den[..., None]
    lse = m[..., 0] + jnp.log(den)
    o = o.reshape(B, dilation, H, Lp, Dh)[:, :, :, :L].transpose(0, 3, 1, 2, 4).reshape(B, S, H, Dh)
    lse = lse.reshape(B, dilation, H, Lp)[:, :, :, :L].transpose(0, 3, 1, 2).reshape(B, S, H)
    return o, lse


def gated_linear_attention(q, k, v, log_a):
    B, S, H, Dk = q.shape
    Dv = v.shape[-1]
    N = S // GLA_CHUNK

    def to_chunks(t):
        return t.reshape(B, N, GLA_CHUNK, H, t.shape[-1]).transpose(0, 3, 1, 2, 4)

    q, k, v, log_a = to_chunks(q), to_chunks(k), to_chunks(v), to_chunks(log_a)
    q = q * (Dk ** -0.5)
    b = jnp.cumsum(log_a, axis=-2)
    q_dec = q * jnp.exp(b)
    k_inv = k * jnp.exp(-b)
    causal = jnp.tril(jnp.ones((GLA_CHUNK, GLA_CHUNK), dtype=bool))
    attn = jnp.where(causal, jnp.einsum('bhnid,bhnjd->bhnij', q_dec, k_inv), 0.0)
    o_intra = jnp.einsum('bhnij,bhnjv->bhniv', attn, v)
    b_end = b[..., -1, :]
    k_end = k * jnp.exp(b_end[..., None, :] - b)
    d_state = jnp.einsum('bhncd,bhncv->bhndv', k_end, v)

    def step(state, inp):
        decay, ds = inp
        return decay[..., None] * state + ds, state

    _, s_prev = lax.scan(step, jnp.zeros((B, H, Dk, Dv), jnp.float32),
                         (jnp.moveaxis(jnp.exp(b_end), 2, 0), jnp.moveaxis(d_state, 2, 0)))
    s_prev = jnp.moveaxis(s_prev, 0, 2)
    o = o_intra + jnp.einsum('bhnid,bhndv->bhniv', q_dec, s_prev)
    return o.transpose(0, 2, 3, 1, 4).reshape(B, S, H, Dv)


def token_mixer(h, w_in, w_alpha2, b_alpha2, gla_gain, w_out_a, w_out_b, w_out, cos, sin):
    B, S, _ = h.shape
    f32 = jnp.float32
    proj = h @ w_in
    splits = np.cumsum(IN_WIDTHS)[:-1].tolist()
    q_a, k_a, v_a, q_b, k_b, v_b, r_b, a_low, g_a, g_b = jnp.split(proj, splits, axis=-1)

    q_a = apply_rope(q_a.astype(f32).reshape(B, S, A_HEADS, HEAD_DIM), cos, sin)
    k_a = apply_rope(k_a.astype(f32).reshape(B, S, A_HEADS, HEAD_DIM), cos, sin)
    v_a = v_a.astype(f32).reshape(B, S, A_HEADS, HEAD_DIM)
    outs, lses = [], []
    for gi, (window, dilation) in enumerate(DILATED_GROUPS):
        hs = slice(gi * A_HEADS_PER_GROUP, (gi + 1) * A_HEADS_PER_GROUP)
        o, lse = dilated_window_attention(q_a[:, :, hs], k_a[:, :, hs], v_a[:, :, hs], window, dilation)
        outs.append(o)
        lses.append(lse)
    wts = jax.nn.softmax(jnp.stack(lses), axis=0)
    y_a = jnp.einsum('gbsh,gbshd->bshd', wts, jnp.stack(outs)).reshape(B, S, A_OUT).astype(h.dtype)

    log_a = jax.nn.log_sigmoid((a_low @ w_alpha2 + b_alpha2).astype(f32)) / GLA_TAU
    o_b = gated_linear_attention(q_b.astype(f32).reshape(B, S, GLA_HEADS, GLA_DK),
                                 k_b.astype(f32).reshape(B, S, GLA_HEADS, GLA_DK),
                                 v_b.astype(f32).reshape(B, S, GLA_HEADS, GLA_DV),
                                 log_a.reshape(B, S, GLA_HEADS, GLA_DK))
    o_b = o_b * lax.rsqrt(jnp.mean(o_b * o_b, axis=-1, keepdims=True) + NORM_EPS)
    o_b = o_b * gla_gain.astype(f32).reshape(GLA_HEADS, GLA_DV)
    y_b = (o_b.reshape(B, S, GLA_VAL) * jax.nn.silu(r_b.astype(f32))).astype(h.dtype)

    merged = jax.nn.sigmoid(g_a) * (y_a @ w_out_a) + jax.nn.sigmoid(g_b) * (y_b @ w_out_b)
    return merged @ w_out


def route(h, w_router, b_router):
    T = h.shape[0]
    aff = jax.nn.sigmoid(h.astype(jnp.float32) @ w_router.astype(jnp.float32))
    sel = aff + b_router.astype(jnp.float32)
    grp_score = lax.top_k(sel.reshape(T, N_GROUPS, EXPERTS_PER_GROUP), 2)[0].sum(-1)
    _, top_grp = lax.top_k(grp_score, TOPK_GROUPS)
    grp_mask = jnp.sum(jax.nn.one_hot(top_grp, N_GROUPS, dtype=jnp.float32), axis=1) > 0
    expert_mask = jnp.repeat(grp_mask, EXPERTS_PER_GROUP, axis=1)
    _, idx = lax.top_k(jnp.where(expert_mask, sel, -jnp.inf), TOP_K)
    w = jnp.take_along_axis(aff, idx, axis=1)
    return w / jnp.sum(w, axis=-1, keepdims=True), idx


def moe_ffn(h, w_router, b_router, w_gate_e, w_up_e, w_down_e):
    T, D = h.shape
    gate, eidx = route(h, w_router, b_router)
    TK = T * TOP_K
    flat_e = eidx.reshape(-1)
    flat_g = gate.reshape(-1)
    order = jnp.argsort(flat_e)
    se = flat_e[order]
    tok = order // TOP_K
    counts = jnp.bincount(flat_e, length=N_EXPERTS)
    pcounts = (counts + EXPERT_BLOCK - 1) // EXPERT_BLOCK * EXPERT_BLOCK
    pend = jnp.cumsum(pcounts)
    pstart = pend - pcounts
    start = jnp.cumsum(counts) - counts
    dest = pstart[se] + jnp.arange(TK) - start[se]
    n_blk = TK // EXPERT_BLOCK + N_EXPERTS
    buf = jnp.zeros((n_blk * EXPERT_BLOCK, D), h.dtype).at[dest].set(h[tok])
    blk_e = jnp.minimum(jnp.searchsorted(pend, jnp.arange(n_blk) * EXPERT_BLOCK, side='right'),
                        N_EXPERTS - 1)

    def expert_block(args):
        xb, e = args
        return (jax.nn.silu(xb @ w_gate_e[e]) * (xb @ w_up_e[e])) @ w_down_e[e]

    ybuf = lax.map(expert_block, (buf.reshape(n_blk, EXPERT_BLOCK, D), blk_e)).reshape(-1, D)
    y = ybuf[dest] * flat_g[order][:, None].astype(h.dtype)
    return jnp.zeros_like(h).at[tok].add(y)


def setup_inputs(seed: int = 0) -> dict:
    key = jax.random.key(seed)
    ks = jax.random.split(key, 20)
    f32 = jnp.float32
    D = D_MODEL

    def nrm(k, shape, scale):
        return jax.random.normal(k, shape, f32) * scale

    return {
        'x': nrm(ks[0], (BATCH, SEQ, D), 1.0),
        'c': nrm(ks[1], (BATCH, D), 1.0),
        'w_ada': nrm(ks[2], (DEPTH, D, 6 * D), 0.5 * D ** -0.5),
        'b_ada': nrm(ks[3], (DEPTH, 6 * D), 0.02),
        'norm_mix': 1.0 + nrm(ks[4], (DEPTH, D), 0.02),
        'norm_ffn': 1.0 + nrm(ks[5], (DEPTH, D), 0.02),
        'w_in': nrm(ks[6], (DEPTH, D, IN_WIDTH), D ** -0.5),
        'w_alpha2': nrm(ks[7], (DEPTH, GLA_LOWRANK, GLA_KEY), GLA_LOWRANK ** -0.5),
        'b_alpha2': nrm(ks[8], (DEPTH, GLA_KEY), 0.1),
        'gla_gain': 1.0 + nrm(ks[9], (DEPTH, GLA_VAL), 0.02),
        'w_out_a': nrm(ks[10], (DEPTH, A_OUT, D), A_OUT ** -0.5),
        'w_out_b': nrm(ks[11], (DEPTH, GLA_VAL, D), GLA_VAL ** -0.5),
        'w_out': nrm(ks[12], (DEPTH, D, D), D ** -0.5),
        'w_router': nrm(ks[13], (D, N_EXPERTS), D ** -0.5),
        'b_router': nrm(ks[14], (N_EXPERTS,), 0.01),
        'w_gate_e': nrm(ks[15], (DEPTH, N_EXPERTS, D, D_FF_EXPERT), D ** -0.5),
        'w_up_e': nrm(ks[16], (DEPTH, N_EXPERTS, D, D_FF_EXPERT), D ** -0.5),
        'w_down_e': nrm(ks[17], (DEPTH, N_EXPERTS, D_FF_EXPERT, D), D_FF_EXPERT ** -0.5),
        'final_norm': 1.0 + nrm(ks[18], (D,), 0.02),
    }


def reference(x, c, w_ada, b_ada, norm_mix, norm_ffn, w_in, w_alpha2, b_alpha2, gla_gain,
              w_out_a, w_out_b, w_out, w_router, b_router, w_gate_e, w_up_e, w_down_e, final_norm):
    B, S, D = x.shape
    cos, sin = rope_tables(S)
    c_act = jax.nn.silu(c)
    for layer in range(DEPTH):
        ada = c_act @ w_ada[layer] + b_ada[layer]
        shift1, scale1, gate1, shift2, scale2, gate2 = jnp.split(ada[:, None, :], 6, axis=-1)
        h = rms_norm(x, norm_mix[layer]) * (1 + scale1) + shift1
        x = x + gate1 * token_mixer(h, w_in[layer], w_alpha2[layer], b_alpha2[layer], gla_gain[layer],
                                    w_out_a[layer], w_out_b[layer], w_out[layer], cos, sin)
        h = rms_norm(x, norm_ffn[layer]) * (1 + scale2) + shift2
        y = moe_ffn(h.reshape(B * S, D), w_router, b_router,
                    w_gate_e[layer], w_up_e[layer], w_down_e[layer]).reshape(B, S, D)
        x = x + gate2 * y
    return rms_norm(x, final_norm)
```

```cpp
#include <hip/hip_runtime.h>
#include <cstdio>
#include <cstdint>

#ifndef MK_PER_PHASE
#define MK_PER_PHASE 0
#endif

#define LAS __attribute__((address_space(3)))
#define GAS __attribute__((address_space(1)))
typedef unsigned short bf16_t;
typedef short bf16x8 __attribute__((ext_vector_type(8)));
typedef short s16x4 __attribute__((ext_vector_type(4)));
typedef float f32x4 __attribute__((ext_vector_type(4)));
typedef float f32x2 __attribute__((ext_vector_type(2)));
typedef unsigned u32x4 __attribute__((ext_vector_type(4)));
typedef unsigned u32x2 __attribute__((ext_vector_type(2)));
typedef GAS unsigned gu32;

constexpr int NB = 8, SEQ = 2048, T = NB * SEQ, D = 2048, DEPTH = 2;
constexpr int NIN = 11792;
constexpr int NP = 12032;
constexpr int QA = 0, KA = 1536, VA = 3072, QB = 4608, KB = 5120, VB = 5632, RB = 6656, GA = 7680, GB = 9728, AL = 11776;
constexpr int NE = 16, FF = 1024;
constexpr int MAXTILES = 144, MAXROWS = MAXTILES * 256;
constexpr float NORM_EPS = 1e-6f;
constexpr int NWAVES = 8, NTHREADS = 512;

constexpr size_t MiB = 1u << 20;
constexpr size_t WS_CTL = 0, CTL_ZERO_BYTES = 1 * MiB;
constexpr size_t WS_ADA = 1 * MiB;
constexpr size_t WS_ROPE = 2 * MiB;
constexpr size_t WS_ALOW = 3 * MiB;
constexpr size_t WS_LSE = 4 * MiB;
constexpr size_t WS_SSQ = 5 * MiB;
constexpr size_t WS_RLIST = 9 * MiB;
constexpr size_t WS_TSLOT = 10 * MiB;
constexpr size_t WS_TW = 10 * MiB + 512 * 1024;
constexpr size_t WS_WIN = 12 * MiB;
constexpr size_t WS_WOA = 106 * MiB;
constexpr size_t WS_WOB = 110 * MiB;
constexpr size_t WS_WO = 118 * MiB;
constexpr size_t WS_WGU = 134 * MiB;
constexpr size_t WS_WDN = 390 * MiB;
constexpr size_t WS_H = 518 * MiB;
constexpr size_t WS_YA = 582 * MiB;
constexpr size_t WS_YB = 598 * MiB;
constexpr size_t WS_MRG = 630 * MiB;
constexpr size_t WS_ATTO = 694 * MiB;
constexpr size_t WS_OB = 742 * MiB;
constexpr size_t WS_PROJ = 774 * MiB;
constexpr size_t WS_ACT = WS_PROJ;
constexpr size_t WS_Y = WS_PROJ + 72 * MiB;
constexpr size_t WS_END = 1150 * MiB;
constexpr int CW_BAR = 4096;
constexpr int CW_CNT = 16384;

constexpr int RING_BYTES = 131072;
constexpr int MISC_OFF = RING_BYTES;
constexpr int LDS_BYTES = 147456;

#define LDS_WAIT() asm volatile("s_waitcnt lgkmcnt(0)" ::: "memory")
#define VM_WAIT() asm volatile("s_waitcnt vmcnt(0)" ::: "memory")
#define RLX_AGENT __ATOMIC_RELAXED, __HIP_MEMORY_SCOPE_AGENT
__device__ __forceinline__ unsigned f2bf(float f) { unsigned u = __builtin_bit_cast(unsigned, f); return (u + 0x7fffu + ((u >> 16) & 1u)) >> 16; }
__device__ __forceinline__ unsigned pk2(float lo, float hi) { return f2bf(lo) | (f2bf(hi) << 16); }
__device__ __forceinline__ float bflo(unsigned u) { return __builtin_bit_cast(float, u << 16); }
__device__ __forceinline__ float bfhi(unsigned u) { return __builtin_bit_cast(float, u & 0xffff0000u); }
__device__ __forceinline__ float bf2f(bf16_t h) { return __builtin_bit_cast(float, (unsigned)h << 16); }
__device__ __forceinline__ float wave_sum(float v) {
#pragma unroll
    for (int o = 1; o < 64; o <<= 1) v += __shfl_xor(v, o);
    return v;
}
__device__ __forceinline__ float sigmoidf_(float x) { return 1.0f / (1.0f + __expf(-x)); }
__device__ __forceinline__ float siluf_(float x) { return x / (1.0f + __expf(-x)); }

#define XB_TMO      128
#define XB_XCNT(j)  (256  + 64 * (j))
#define XB_XSUB(j)  (1280 + 64 * (j))
#define XB_XGEN(j)  (2304 + 64 * (j))
#define XB_TOP      3328
#define XB_TOPGEN   3392
#define XCD_BAR_WORDS 3456
#define XB_SPIN_CAP (1u << 18)
__device__ __forceinline__ unsigned xb_ld(unsigned* p)              { return __hip_atomic_load(p, __ATOMIC_RELAXED, __HIP_MEMORY_SCOPE_AGENT); }
__device__ __forceinline__ unsigned xb_add(unsigned* p, unsigned v) { return __hip_atomic_fetch_add(p, v, __ATOMIC_RELAXED, __HIP_MEMORY_SCOPE_AGENT); }
__device__ __forceinline__ unsigned xb_xcc_id() { return (unsigned)__builtin_amdgcn_s_getreg((3 << 11) | 20) & 0xFu; }
#define XB_SPIN(cond, bar) do { unsigned _sp = 0; while (cond) { __builtin_amdgcn_s_sleep(1); \
    if ((++_sp & 255u) == 0u) { if (xb_ld(&(bar)[XB_TMO])) break; if (_sp > XB_SPIN_CAP) { atomicAdd(&(bar)[XB_TMO], 1u); break; } } } } while (0)
struct XcdBarrier { unsigned* bar; unsigned x; volatile LAS unsigned* st; };
__device__ __forceinline__ XcdBarrier xcd_barrier_post(unsigned* bar, volatile LAS unsigned* st) {
    XcdBarrier b; b.bar = bar; b.x = xb_xcc_id(); b.st = st;
    if (threadIdx.x == 0) (void)xb_add(&bar[XB_XCNT(b.x)], 1u);
    return b;
}
__device__ __forceinline__ void xcd_barrier_complete(unsigned* bar, unsigned x, unsigned& nloc, unsigned& nx) {
    const unsigned G = gridDim.x * gridDim.y * gridDim.z;
    unsigned sum, cnt, mine, sp = 0u;
    for (;;) {
        sum = 0u; cnt = 0u; mine = 0u;
#pragma unroll
        for (unsigned j = 0; j < 16; ++j) { const unsigned c = xb_ld(&bar[XB_XCNT(j)]); sum += c; cnt += (c > 0u) ? 1u : 0u; mine = (j == x) ? c : mine; }
        if (sum == G) break;
        __builtin_amdgcn_s_sleep(1);
        if ((++sp & 255u) == 0u) { if (xb_ld(&bar[XB_TMO])) break; if (sp > XB_SPIN_CAP) { atomicAdd(&bar[XB_TMO], 1u); break; } }
    }
    nloc = mine > 0u ? mine : 1u; nx = cnt > 0u ? cnt : 1u;
}
__device__ __forceinline__ void xcd_barrier(const XcdBarrier& b) {
    asm volatile("s_waitcnt vmcnt(0)" ::: "memory");
    __syncthreads();
    if (threadIdx.x == 0) {
        unsigned* bar = b.bar;
        __builtin_amdgcn_s_waitcnt(0);
        unsigned nloc = b.st[0], nx = b.st[1];
        if (nloc == 0u) { xcd_barrier_complete(bar, b.x, nloc, nx); b.st[0] = nloc; b.st[1] = nx; }
        const unsigned old = xb_add(&bar[XB_XSUB(b.x)], 1u);
        const unsigned gen = old / nloc;
        if (old + 1u == (gen + 1u) * nloc) {
            __builtin_amdgcn_fence(__ATOMIC_RELEASE, "agent");
            asm volatile("s_waitcnt vmcnt(0)" ::: "memory");
            const unsigned og = xb_add(&bar[XB_TOP], 1u);
            const unsigned tg = og / nx;
            if (og + 1u == (tg + 1u) * nx) xb_add(&bar[XB_TOPGEN], 1u);
            else XB_SPIN(xb_ld(&bar[XB_TOPGEN]) == tg, bar);
            __builtin_amdgcn_fence(__ATOMIC_ACQUIRE, "agent");
            xb_add(&bar[XB_XGEN(b.x)], 1u);
            asm volatile("s_waitcnt vmcnt(0)" ::: "memory");
        } else {
            XB_SPIN(xb_ld(&bar[XB_XGEN(b.x)]) == gen, bar);
            __builtin_amdgcn_fence(__ATOMIC_ACQUIRE, "agent");
            asm volatile("s_waitcnt vmcnt(0)" ::: "memory");
        }
    }
    __syncthreads();
}

namespace pg8 {
constexpr int BM = 256, BK = 64, HALF = 128, HTB = HALF * BK * 2, NXCD = 8, WGM = 8;
__device__ __forceinline__ int lds_byte(int r, int c) { const int st = (r >> 4) * 2 + (c >> 5), rr = r & 15, cc = c & 31, ob = rr * 64 + cc * 2; return st * 1024 + (ob ^ (((ob >> 9) & 1) << 5)); }
__device__ __forceinline__ void stage_rc(int b, int& R, int& C) { const int st = b / 1024, sb = b % 1024, swz = sb ^ (((sb >> 9) & 1) << 5); R = (st >> 1) * 16 + swz / 64; C = (st & 1) * 32 + (swz % 64) / 2; }
__device__ __forceinline__ int perm32(int rho) { const int n = rho >> 4, i = rho & 15; return 8 * (i >> 2) + 4 * n + (i & 3); }

struct Unit { int pm, pn, e, ti; };

__device__ __forceinline__ bool grid_order(int nM, int nN, int G, int c, int i, int& pm, int& pn) {
    const int nwg = nM * nN; const long L = (long)i * G + c; if (L >= nwg) return false;
    int wgid = (int)L; { const int q = nwg / NXCD, r = nwg % NXCD, xcd = wgid % NXCD, off = wgid / NXCD; wgid = (xcd < r ? xcd * (q + 1) : r * (q + 1) + (xcd - r) * q) + off; }
    const int nig = WGM * nN, gid = wgid / nig, fm = gid * WGM, gsz = (nM - fm) < WGM ? (nM - fm) : WGM;
    pm = fm + ((wgid % nig) % gsz); pn = (wgid % nig) / gsz; return true;
}
struct StaticOrder {
    int nM, nN, G, c;
    __device__ __forceinline__ bool next(int i, Unit& u) const { u.e = 0; u.ti = 0; return grid_order(nM, nN, G, c, i, u.pm, u.pn); }
};
struct MoeOrder {
    int tend[NE]; int NT, nN, G, c;
    __device__ __forceinline__ void init(const unsigned* cnt, int nN_, int G_, int c_) {
        int acc = 0;
#pragma unroll
        for (int e = 0; e < NE; ++e) { const int n = (int)__hip_atomic_load(cnt + 64 * e, RLX_AGENT); acc += (n + 255) >> 8; tend[e] = acc; }
        NT = acc; nN = nN_; G = G_; c = c_;
    }
    __device__ __forceinline__ bool next(int i, Unit& u) const {
        if (!grid_order(NT, nN, G, c, i, u.pm, u.pn)) return false;
        int e = 0, ts = 0;
#pragma unroll
        for (int j = 0; j < NE; ++j) { const bool ge = u.pm >= tend[j]; e += ge ? 1 : 0; ts = ge ? tend[j] : ts; }
        u.e = e; u.ti = u.pm - ts; return true;
    }
};
struct RowsContig { static constexpr bool GATHER = false; __device__ __forceinline__ unsigned row(const Unit& u, int rr) const { return (unsigned)(u.pm * 256 + rr); } };
struct RowsGather {
    static constexpr bool GATHER = true;
    const int* rlist; const unsigned* cnt;
    __device__ __forceinline__ unsigned row(const Unit& u, int rr) const {
        const int n = (int)__hip_atomic_load(cnt + 64 * u.e, RLX_AGENT); const int rank = u.ti * 256 + rr;
        return rank < n ? (unsigned)rlist[(size_t)u.e * T + rank] : 0u;
    }
};

template <class Epi, class Sched, class AMap, bool ALIGN_EPI>
__device__ __forceinline__ void gemm_phase(LAS unsigned char* lds, const int tid, const bf16_t* A, const bf16_t* Bt, size_t bstride, int K, const Sched& S, const AMap& AM, const Epi& E) {
    const int wid = __builtin_amdgcn_readfirstlane(tid >> 6), lane = tid & 63, wr = wid >> 2, wc = wid & 3, fr = lane & 15, fq = lane >> 4;
    const int nt = K / BK;
    unsigned voffA[2], voffB[2];
#pragma unroll
    for (int i = 0; i < 2; ++i) { int R, C; stage_rc(tid * 16 + i * 8192, R, C); const int Rb = Epi::PERM ? ((R & ~31) + perm32(R & 31)) : R; voffA[i] = (unsigned)(R * K + C) * 2u; voffB[i] = (unsigned)(Rb * K + C) * 2u; }
    const size_t kstep = (size_t)(BK * 2);
    const size_t hstep = (size_t)HALF * K * 2;
    const size_t tstep = 2 * hstep;
    const unsigned ldsw = (unsigned)wid * 1024u;
    const int aoff = lds_byte(wr * 64 + fr, fq * 8), boff = lds_byte(wc * 32 + fr, fq * 8);
#define PG8_SA(b, h) (((b) * 2 + (h)) * HTB)
#define PG8_SB(b, h) ((4 + (b) * 2 + (h)) * HTB)
#define PG8_STAGE(bufoff, gbase, voff) do { _Pragma("unroll") for (int _i = 0; _i < 2; ++_i) \
        __builtin_amdgcn_global_load_lds((const unsigned*)((const char*)(gbase) + (voff)[_i]), (LAS unsigned*)(lds + (bufoff) + ldsw + _i * 8192), 16, 0, 0); } while (0)
#define PG8_LDA(dst, b, h) do { _Pragma("unroll") for (int m = 0; m < 4; ++m) _Pragma("unroll") for (int k = 0; k < 2; ++k) dst[m][k] = *(const LAS bf16x8*)(lds + PG8_SA(b, h) + aoff + m * 2048 + k * 1024); } while (0)
#define PG8_LDB(dst, b, h) do { _Pragma("unroll") for (int n = 0; n < 2; ++n) _Pragma("unroll") for (int k = 0; k < 2; ++k) dst[n][k] = *(const LAS bf16x8*)(lds + PG8_SB(b, h) + boff + n * 2048 + k * 1024); } while (0)
#define PG8_MMA(ai, bj, At, Bt_) do { __builtin_amdgcn_s_setprio(1); _Pragma("unroll") for (int m = 0; m < 4; ++m) _Pragma("unroll") for (int n = 0; n < 2; ++n) _Pragma("unroll") for (int k = 0; k < 2; ++k) \
        acc[ai][bj][m][n] = __builtin_amdgcn_mfma_f32_16x16x32_bf16(Bt_[n][k], At[m][k], acc[ai][bj][m][n], 0, 0, 0); __builtin_amdgcn_s_setprio(0); } while (0)
#define PG8_WAIT_V(n) asm volatile("s_waitcnt vmcnt(" #n ")" ::: "memory")
#define PG8_WAIT_L(n) asm volatile("s_waitcnt lgkmcnt(" #n ")" ::: "memory")
#define PG8_BAR __builtin_amdgcn_s_barrier()
#define PG8_SCHED __builtin_amdgcn_sched_barrier(0)
#define PG8_OFFS(dst, u) do { _Pragma("unroll") for (int _h = 0; _h < 2; ++_h) _Pragma("unroll") for (int _i = 0; _i < 2; ++_i) { int _R, _C; stage_rc(tid * 16 + _i * 8192, _R, _C); \
        dst[_h][_i] = (AM.row(u, _h * HALF + _R) * (unsigned)K + (unsigned)_C) * 2u; } } while (0)
#define PG8_STAGE_A(bufoff, h, kb, NXT) do { if constexpr (AMap::GATHER) { _Pragma("unroll") for (int _i = 0; _i < 2; ++_i) { const unsigned _o = (NXT) ? offN[h][_i] : offC[h][_i]; \
            __builtin_amdgcn_global_load_lds((const unsigned*)((const char*)A + (kb) + _o), (LAS unsigned*)(lds + (bufoff) + ldsw + _i * 8192), 16, 0, 0); } } \
        else { const char* _g = ((NXT) ? nA : cA) + (h) * hstep + (kb); PG8_STAGE(bufoff, _g, voffA); } } while (0)
    Unit cur, nxt; int ui = 0;
    if (!S.next(0, cur)) return;
    f32x4 acc[2][2][4][2];
#pragma unroll
    for (int a = 0; a < 2; ++a)
#pragma unroll
        for (int b = 0; b < 2; ++b)
#pragma unroll
            for (int m = 0; m < 4; ++m)
#pragma unroll
                for (int n = 0; n < 2; ++n) acc[a][b][m][n] = (f32x4){0.f, 0.f, 0.f, 0.f};
    bf16x8 At[4][2], B0[2][2], B1[2][2];
    unsigned offC[2][2], offN[2][2];
    if constexpr (AMap::GATHER) { PG8_OFFS(offC, cur); }
    const char* cA = (const char*)A + (AMap::GATHER ? (size_t)0 : (size_t)cur.pm * tstep); const char* nA = cA;
    const char* cB = (const char*)Bt + ((size_t)cur.e * bstride) * 2 + (size_t)cur.pn * tstep;
    PG8_STAGE(PG8_SB(0, 0), cB, voffB); PG8_STAGE(PG8_SB(0, 1), cB + hstep, voffB); PG8_STAGE_A(PG8_SA(0, 0), 0, 0, false); PG8_STAGE_A(PG8_SA(0, 1), 1, 0, false);
    if (wr == 1) PG8_BAR;
    PG8_WAIT_V(2); PG8_BAR;
    PG8_STAGE(PG8_SB(1, 0), cB + kstep, voffB); PG8_STAGE_A(PG8_SA(1, 0), 0, kstep, false); PG8_STAGE(PG8_SB(1, 1), cB + hstep + kstep, voffB);
    PG8_WAIT_V(6); PG8_BAR;
    for (;;) {
        const bool has_next = S.next(ui + 1, nxt);
        if constexpr (AMap::GATHER) {
            if (has_next) { PG8_OFFS(offN, nxt); }
            else {
#pragma unroll
                for (int h = 0; h < 2; ++h)
#pragma unroll
                    for (int i = 0; i < 2; ++i) offN[h][i] = offC[h][i];
            }
        } else { nA = has_next ? (const char*)A + (size_t)nxt.pm * tstep : cA; }
        const char* nB = has_next ? (const char*)Bt + ((size_t)nxt.e * bstride) * 2 + (size_t)nxt.pn * tstep : cB;
        for (int t = 0; t < nt; t += 2) {
            const bool last = (t == nt - 2);
            const size_t k1 = (size_t)(t + 1) * kstep, k2 = last ? (size_t)0 : (size_t)(t + 2) * kstep, k3 = k2 + kstep;
            const char* b2 = last ? nB : cB + (size_t)(t + 2) * kstep; const char* b3 = b2 + kstep;
            PG8_LDB(B0, 0, 0); PG8_LDB(B1, 0, 1); PG8_SCHED; PG8_LDA(At, 0, 0); PG8_STAGE_A(PG8_SA(1, 1), 1, k1, false);
            PG8_WAIT_V(8); PG8_WAIT_L(0); PG8_BAR; PG8_MMA(0, 0, At, B0); PG8_MMA(0, 1, At, B1); PG8_BAR; PG8_SCHED;
            PG8_LDA(At, 0, 1); PG8_STAGE(PG8_SB(0, 0), b2, voffB); PG8_STAGE(PG8_SB(0, 1), b2 + hstep, voffB); PG8_STAGE_A(PG8_SA(0, 0), 0, k2, last);
            PG8_WAIT_V(8); PG8_WAIT_L(0); PG8_BAR; PG8_MMA(1, 0, At, B0); PG8_MMA(1, 1, At, B1); PG8_BAR; PG8_SCHED;
            PG8_LDB(B0, 1, 0); PG8_LDB(B1, 1, 1); PG8_SCHED; PG8_LDA(At, 1, 0); PG8_STAGE_A(PG8_SA(0, 1), 1, k2, last);
            PG8_WAIT_V(8); PG8_WAIT_L(0); PG8_BAR; PG8_MMA(0, 0, At, B0); PG8_MMA(0, 1, At, B1); PG8_BAR; PG8_SCHED;
            PG8_LDA(At, 1, 1); PG8_STAGE(PG8_SB(1, 0), b3, voffB); PG8_STAGE(PG8_SB(1, 1), b3 + hstep, voffB); PG8_STAGE_A(PG8_SA(1, 0), 0, k3, last);
            PG8_WAIT_V(8); PG8_WAIT_L(0); PG8_BAR; PG8_MMA(1, 0, At, B0); PG8_MMA(1, 1, At, B1); PG8_BAR; PG8_SCHED;
        }
        if constexpr (ALIGN_EPI) { if (wr == 0) PG8_BAR; }
        E(acc, cur, wr, wc, fr, fq);
        if (!has_next) break;
#pragma unroll
        for (int a = 0; a < 2; ++a)
#pragma unroll
            for (int b = 0; b < 2; ++b)
#pragma unroll
                for (int m = 0; m < 4; ++m)
#pragma unroll
                    for (int n = 0; n < 2; ++n) acc[a][b][m][n] = (f32x4){0.f, 0.f, 0.f, 0.f};
        cur = nxt; cB = nB; cA = nA; ++ui;
        if constexpr (AMap::GATHER) {
#pragma unroll
            for (int h = 0; h < 2; ++h)
#pragma unroll
                for (int i = 0; i < 2; ++i) offC[h][i] = offN[h][i];
        }
        if constexpr (ALIGN_EPI) { if (wr == 1) PG8_BAR; }
    }
    PG8_WAIT_V(0);
    if constexpr (!ALIGN_EPI) { if (wr == 0) PG8_BAR; }
    PG8_BAR;
#undef PG8_STAGE_A
#undef PG8_SA
#undef PG8_SB
#undef PG8_STAGE
#undef PG8_LDA
#undef PG8_LDB
#undef PG8_MMA
#undef PG8_WAIT_V
#undef PG8_WAIT_L
#undef PG8_BAR
#undef PG8_SCHED
#undef PG8_OFFS
}

#define EPI_PIN(x) asm volatile("" : "+v"(x))
#define EPI_ROWSTEP(m) (((m) == 3) ? 80 : 16)
struct EpiProj {
    static constexpr bool PERM = true;
    bf16_t* O; const float* cs; const float* sn; float* alow;
    __device__ __forceinline__ void operator()(const f32x4 (&acc)[2][2][4][2], const Unit& u, int wr, int wc, int fr, int fq) const {
        const int row0 = u.pm * BM + wr * 64 + fr, col0 = u.pn * BM + wc * 32 + 8 * fq;
        unsigned off = (unsigned)(row0 * NP + col0) * 2u;
        if (u.pn < 12) {
            unsigned toff = (unsigned)((row0 & (SEQ - 1)) * 64 + wc * 16 + fq * 4) * 4u;
#pragma unroll
            for (int ai = 0; ai < 2; ++ai)
#pragma unroll
                for (int m = 0; m < 4; ++m) {
                    const f32x4 c4 = *(const f32x4*)((const char*)cs + toff), s4 = *(const f32x4*)((const char*)sn + toff);
#pragma unroll
                    for (int bj = 0; bj < 2; ++bj) { const f32x4 v0 = acc[ai][bj][m][0], v1 = acc[ai][bj][m][1]; u32x4 w;
                        w.x = pk2(v0[0] * c4[0] - v0[1] * s4[0], v0[1] * c4[0] + v0[0] * s4[0]);
                        w.y = pk2(v0[2] * c4[1] - v0[3] * s4[1], v0[3] * c4[1] + v0[2] * s4[1]);
                        w.z = pk2(v1[0] * c4[2] - v1[1] * s4[2], v1[1] * c4[2] + v1[0] * s4[2]);
                        w.w = pk2(v1[2] * c4[3] - v1[3] * s4[3], v1[3] * c4[3] + v1[2] * s4[3]);
                        *(u32x4*)((char*)O + off + bj * HALF * 2) = w; }
                    off += EPI_ROWSTEP(m) * NP * 2; toff += EPI_ROWSTEP(m) * 64 * 4; EPI_PIN(off); EPI_PIN(toff);
                }
        } else if (u.pn < 46) {
#pragma unroll
            for (int ai = 0; ai < 2; ++ai)
#pragma unroll
                for (int m = 0; m < 4; ++m) {
#pragma unroll
                    for (int bj = 0; bj < 2; ++bj) { const f32x4 v0 = acc[ai][bj][m][0], v1 = acc[ai][bj][m][1]; u32x4 w;
                        w.x = pk2(v0[0], v0[1]); w.y = pk2(v0[2], v0[3]); w.z = pk2(v1[0], v1[1]); w.w = pk2(v1[2], v1[3]);
                        *(u32x4*)((char*)O + off + bj * HALF * 2) = w; }
                    off += EPI_ROWSTEP(m) * NP * 2; EPI_PIN(off); }
        } else {
            if (wc == 0 && fq < 2) {
                unsigned aoff_ = (unsigned)(row0 * 16 + 8 * fq) * 4u;
#pragma unroll
                for (int ai = 0; ai < 2; ++ai)
#pragma unroll
                    for (int m = 0; m < 4; ++m) { float* rp = (float*)((char*)alow + aoff_);
                        *(f32x4*)rp = acc[ai][0][m][0]; *(f32x4*)(rp + 4) = acc[ai][0][m][1];
                        aoff_ += EPI_ROWSTEP(m) * 16 * 4; EPI_PIN(aoff_); }
            }
        }
    }
};
template <bool FIRST> struct EpiGate {
    static constexpr bool PERM = true;
    bf16_t* O; const bf16_t* proj; int goff;
    __device__ __forceinline__ void operator()(const f32x4 (&acc)[2][2][4][2], const Unit& u, int wr, int wc, int fr, int fq) const {
        const int row0 = u.pm * BM + wr * 64 + fr, col0 = u.pn * BM + wc * 32 + 8 * fq;
        unsigned goffb = (unsigned)(row0 * NP + goff + col0) * 2u, ooff = (unsigned)(row0 * D + col0) * 2u;
#pragma unroll
        for (int ai = 0; ai < 2; ++ai)
#pragma unroll
            for (int m = 0; m < 4; ++m) {
#pragma unroll
                for (int bj = 0; bj < 2; ++bj) {
                    const u32x4 g = *(const u32x4*)((const char*)proj + goffb + bj * HALF * 2);
                    const f32x4 v0 = acc[ai][bj][m][0], v1 = acc[ai][bj][m][1];
                    float r[8];
                    r[0] = sigmoidf_(bflo(g.x)) * v0[0]; r[1] = sigmoidf_(bfhi(g.x)) * v0[1]; r[2] = sigmoidf_(bflo(g.y)) * v0[2]; r[3] = sigmoidf_(bfhi(g.y)) * v0[3];
                    r[4] = sigmoidf_(bflo(g.z)) * v1[0]; r[5] = sigmoidf_(bfhi(g.z)) * v1[1]; r[6] = sigmoidf_(bflo(g.w)) * v1[2]; r[7] = sigmoidf_(bfhi(g.w)) * v1[3];
                    u32x4* op = (u32x4*)((char*)O + ooff + bj * HALF * 2);
                    if (!FIRST) { const u32x4 p = *op;
                        r[0] += bflo(p.x); r[1] += bfhi(p.x); r[2] += bflo(p.y); r[3] += bfhi(p.y); r[4] += bflo(p.z); r[5] += bfhi(p.z); r[6] += bflo(p.w); r[7] += bfhi(p.w); }
                    u32x4 w; w.x = pk2(r[0], r[1]); w.y = pk2(r[2], r[3]); w.z = pk2(r[4], r[5]); w.w = pk2(r[6], r[7]);
                    *op = w; }
                goffb += EPI_ROWSTEP(m) * NP * 2; ooff += EPI_ROWSTEP(m) * D * 2; EPI_PIN(goffb); EPI_PIN(ooff); asm volatile("" ::: "memory"); }
    }
};
struct EpiResid {
    static constexpr bool PERM = false;
    const float* xi; float* xo; const float* gate;
    __device__ __forceinline__ void operator()(const f32x4 (&acc)[2][2][4][2], const Unit& u, int wr, int wc, int fr, int fq) const {
        const int row0 = u.pm * BM + wr * 64 + fr, col0 = u.pn * BM + wc * 32 + 4 * fq;
        const int b = (u.pm * BM) / SEQ;
        f32x4 gt[2][2];
#pragma unroll
        for (int bj = 0; bj < 2; ++bj)
#pragma unroll
            for (int n = 0; n < 2; ++n) gt[bj][n] = *(const f32x4*)(gate + (size_t)b * 12288 + col0 + bj * HALF + 16 * n);
        unsigned off = (unsigned)(row0 * D + col0) * 4u;
#pragma unroll
        for (int ai = 0; ai < 2; ++ai)
#pragma unroll
            for (int m = 0; m < 4; ++m) {
#pragma unroll
                for (int bj = 0; bj < 2; ++bj)
#pragma unroll
                    for (int n = 0; n < 2; ++n) { const unsigned o = off + (bj * HALF + 16 * n) * 4;
                        const f32x4 xv = *(const f32x4*)((const char*)xi + o); *(f32x4*)((char*)xo + o) = xv + gt[bj][n] * acc[ai][bj][m][n]; }
                off += EPI_ROWSTEP(m) * D * 4; EPI_PIN(off); asm volatile("" ::: "memory"); }
    }
};
struct EpiSwiGLU {
    static constexpr bool PERM = true;
    bf16_t* O;
    __device__ __forceinline__ void operator()(const f32x4 (&acc)[2][2][4][2], const Unit& u, int wr, int wc, int fr, int fq) const {
        const int row0 = u.pm * BM + wr * 64 + fr, col0 = u.pn * HALF + wc * 32 + 8 * fq;
        unsigned off = (unsigned)(row0 * FF + col0) * 2u;
#pragma unroll
        for (int ai = 0; ai < 2; ++ai)
#pragma unroll
            for (int m = 0; m < 4; ++m) { const f32x4 g0 = acc[ai][0][m][0], g1 = acc[ai][0][m][1], u0 = acc[ai][1][m][0], u1 = acc[ai][1][m][1]; u32x4 w;
                w.x = pk2(siluf_(g0[0]) * u0[0], siluf_(g0[1]) * u0[1]); w.y = pk2(siluf_(g0[2]) * u0[2], siluf_(g0[3]) * u0[3]);
                w.z = pk2(siluf_(g1[0]) * u1[0], siluf_(g1[1]) * u1[1]); w.w = pk2(siluf_(g1[2]) * u1[2], siluf_(g1[3]) * u1[3]);
                *(u32x4*)((char*)O + off) = w;
                off += EPI_ROWSTEP(m) * FF * 2; EPI_PIN(off); }
    }
};
struct EpiPlain {
    static constexpr bool PERM = true;
    bf16_t* O;
    __device__ __forceinline__ void operator()(const f32x4 (&acc)[2][2][4][2], const Unit& u, int wr, int wc, int fr, int fq) const {
        const int row0 = u.pm * BM + wr * 64 + fr, col0 = u.pn * BM + wc * 32 + 8 * fq;
        unsigned off = (unsigned)(row0 * D + col0) * 2u;
#pragma unroll
        for (int ai = 0; ai < 2; ++ai)
#pragma unroll
            for (int m = 0; m < 4; ++m) {
#pragma unroll
                for (int bj = 0; bj < 2; ++bj) { const f32x4 v0 = acc[ai][bj][m][0], v1 = acc[ai][bj][m][1]; u32x4 w;
                    w.x = pk2(v0[0], v0[1]); w.y = pk2(v0[2], v0[3]); w.z = pk2(v1[0], v1[1]); w.w = pk2(v1[2], v1[3]);
                    *(u32x4*)((char*)O + off + bj * HALF * 2) = w; }
                off += EPI_ROWSTEP(m) * D * 2; EPI_PIN(off); }
    }
};
}

struct Args {
    const float* x; const float* c; const float* w_ada; const float* b_ada; const float* norm_mix; const float* norm_ffn; const float* w_in;
    const float* w_alpha2; const float* b_alpha2; const float* gla_gain; const float* w_out_a; const float* w_out_b; const float* w_out;
    const float* w_router; const float* b_router; const float* w_gate_e; const float* w_up_e; const float* w_down_e; const float* final_norm;
    float* out; unsigned char* ws; int ph_lo, ph_hi;
};

__device__ __forceinline__ int proj_src_col(int n) {
    if (n < 3072) { const int blk = n >> 7, w = n & 127; return (blk << 7) + (w >> 1) + ((w & 1) << 6); }
    if (n < 7680) return n;
    if (n < 11776) return n + 16;
    if (n < 11792) return n - 4096;
    return -1;
}
__device__ __forceinline__ void tr_item(const float* W, int ldw, bf16_t* WT, int K, int k0, int n0, int sc, LAS float* scr, int lane) {
#pragma unroll 8
    for (int i = 0; i < 32; ++i) { const int kk = 2 * i + (lane >> 5); float v = 0.f; if (sc >= 0) v = W[(size_t)(k0 + kk) * ldw + sc]; scr[kk * 33 + (lane & 31)] = v; }
    LDS_WAIT(); asm volatile("" ::: "memory");
    const int c = lane & 7;
#pragma unroll
    for (int j = 0; j < 4; ++j) { const int n = (lane >> 3) + 8 * j; const LAS float* s = scr + (8 * c) * 33 + n;
        u32x4 o; o.x = pk2(s[0 * 33], s[1 * 33]); o.y = pk2(s[2 * 33], s[3 * 33]); o.z = pk2(s[4 * 33], s[5 * 33]); o.w = pk2(s[6 * 33], s[7 * 33]);
        *(GAS u32x4*)(WT + (size_t)(n0 + n) * K + k0 + 8 * c) = o; }
    LDS_WAIT(); asm volatile("" ::: "memory");
}

typedef const __attribute__((address_space(4))) Args CArgsP;
__device__ __forceinline__ void prologue_phase(CArgsP* ap_, LAS unsigned char* lds, int vcu, int G, int tid, int wave, int lane) {
#define a (*ap_)
    unsigned char* ws = a.ws;
    {
        LAS float* cact = (LAS float*)lds;
        LAS float* red = (LAS float*)(lds + 65536);
        for (int i = tid; i < NB * D; i += NTHREADS) { const int b = i >> 11, k = i & 2047; cact[k * 8 + b] = siluf_(a.c[i]); }
        __syncthreads();
        float* ada = (float*)(ws + WS_ADA);
        const int q = tid & 7, kg = tid >> 3;
        for (int u = vcu; u < DEPTH * 384; u += G) {
            const int l = u / 384, n0 = (u % 384) * 32;
            const float* W = a.w_ada + (size_t)l * D * 12288 + n0 + 4 * q;
            f32x4 acc[8];
#pragma unroll
            for (int b = 0; b < 8; ++b) acc[b] = (f32x4){0.f, 0.f, 0.f, 0.f};
#pragma unroll 4
            for (int kk = 0; kk < 32; ++kk) { const int k = kg * 32 + kk; const f32x4 w = *(const f32x4*)(W + (size_t)k * 12288);
                const f32x4 c0 = *(const LAS f32x4*)(cact + k * 8), c1 = *(const LAS f32x4*)(cact + k * 8 + 4);
                acc[0] += w * c0[0]; acc[1] += w * c0[1]; acc[2] += w * c0[2]; acc[3] += w * c0[3];
                acc[4] += w * c1[0]; acc[5] += w * c1[1]; acc[6] += w * c1[2]; acc[7] += w * c1[3]; }
#pragma unroll
            for (int b = 0; b < 8; ++b) *(LAS f32x4*)(red + (kg * 8 + b) * 32 + 4 * q) = acc[b];
            __syncthreads();
            if (tid < 256) { const int b = tid >> 5, col = tid & 31; float s = a.b_ada[(size_t)l * 12288 + n0 + col];
                for (int g = 0; g < 64; ++g) s += red[(g * 8 + b) * 32 + col];
                ada[((size_t)l * NB + b) * 12288 + n0 + col] = s; }
            __syncthreads();
        }
    }
    {
        float* cs = (float*)(ws + WS_ROPE); float* sn = cs + SEQ * 64;
        for (int i = vcu * NTHREADS + tid; i < SEQ * 64; i += G * NTHREADS) {
            const int pos = i >> 6, fi = i & 63;
            double f = 1.0;
            if (fi & 1) f *= 0.8659643233600653; if (fi & 2) f *= 0.7498942093324558; if (fi & 4) f *= 0.5623413251903491;
            if (fi & 8) f *= 0.31622776601683794; if (fi & 16) f *= 0.09999999999999999; if (fi & 32) f *= 0.009999999999999998;
            double rev = (double)pos * f * 0.15915494309189535; rev -= __builtin_floor(rev);
            const float rv = (float)rev;
            cs[i] = __builtin_amdgcn_cosf(rv); sn[i] = __builtin_amdgcn_sinf(rv);
        }
    }
    {
        LAS float* scr = (LAS float*)(lds + wave * 16384);
        const int gw = vcu * NWAVES + wave, NGW = G * NWAVES;
        constexpr int C_IN = 32 * 376, C_OA = 8 * 64, C_OB = 16 * 64, C_O = 32 * 64, C_GU = 16 * 2048, C_DN = 16 * 1024, C_L = C_IN + C_OA + C_OB + C_O + C_GU + C_DN;
        const int nn = lane & 31;
        for (int it = gw; it < DEPTH * C_L; it += NGW) {
            const int l = it / C_L; int r = it % C_L;
            if (r < C_IN) { const int kb = r / 376, nb = r % 376;
                tr_item(a.w_in + (size_t)l * D * NIN, NIN, (bf16_t*)(ws + WS_WIN) + (size_t)l * NP * D, D, 64 * kb, 32 * nb, proj_src_col(32 * nb + nn), scr, lane); continue; }
            r -= C_IN;
            if (r < C_OA) { const int kb = r / 64, nb = r % 64;
                tr_item(a.w_out_a + (size_t)l * 512 * D, D, (bf16_t*)(ws + WS_WOA) + (size_t)l * D * 512, 512, 64 * kb, 32 * nb, 32 * nb + nn, scr, lane); continue; }
            r -= C_OA;
            if (r < C_OB) { const int kb = r / 64, nb = r % 64;
                tr_item(a.w_out_b + (size_t)l * 1024 * D, D, (bf16_t*)(ws + WS_WOB) + (size_t)l * D * 1024, 1024, 64 * kb, 32 * nb, 32 * nb + nn, scr, lane); continue; }
            r -= C_OB;
            if (r < C_O) { const int kb = r / 64, nb = r % 64;
                tr_item(a.w_out + (size_t)l * D * D, D, (bf16_t*)(ws + WS_WO) + (size_t)l * D * D, D, 64 * kb, 32 * nb, 32 * nb + nn, scr, lane); continue; }
            r -= C_O;
            if (r < C_GU) { const int e = r / 2048, r2 = r % 2048, kb = r2 / 64, nb = r2 % 64, pn = nb >> 3, s = (nb >> 2) & 1, c0 = 32 * (nb & 3);
                const float* W = (s ? a.w_up_e : a.w_gate_e) + (size_t)(l * NE + e) * D * FF;
                tr_item(W, FF, (bf16_t*)(ws + WS_WGU) + (size_t)(l * NE + e) * 2048 * D, D, 64 * kb, 32 * nb, 128 * pn + c0 + nn, scr, lane); continue; }
            r -= C_GU;
            { const int e = r / 1024, r2 = r % 1024, kb = r2 / 64, nb = r2 % 64;
                tr_item(a.w_down_e + (size_t)(l * NE + e) * FF * D, D, (bf16_t*)(ws + WS_WDN) + (size_t)(l * NE + e) * D * FF, FF, 64 * kb, 32 * nb, 32 * nb + nn, scr, lane); }
        }
    }
}

#undef a

struct MoeStarts {
    int ts[NE];
    __device__ __forceinline__ void init(const unsigned* cnt) { int acc = 0;
#pragma unroll
        for (int e = 0; e < NE; ++e) { ts[e] = acc; acc += ((int)__hip_atomic_load(cnt + 64 * e, RLX_AGENT) + 255) >> 8; } }
    __device__ __forceinline__ int row(int slot) const { const int e = slot >> 16; int t0 = 0;
#pragma unroll
        for (int j = 0; j < NE; ++j) t0 = (e == j) ? ts[j] : t0;
        return t0 * 256 + (slot & 0xffff); }
};

template <int MODE>
__device__ __forceinline__ void norm_phase(const float* xs, float* xd, bf16_t* hout, const float* gain, const float* ada_scale, const float* ada_shift, const float* ada_gate2,
                                           const bf16_t* Y, const int* tslot, const float* tw, const unsigned* cnt, int vcu, int G, int wave, int lane) {
    const int gw = vcu * NWAVES + wave, NGW = G * NWAVES, rpw = T / NGW;
    MoeStarts ms; if (MODE != 0) ms.init(cnt);
    for (int k = 0; k < rpw; ++k) {
        const int row = gw * rpw + k, b = row >> 11;
        const GAS f32x4* xr = (const GAS f32x4*)(xs + (size_t)row * D) + lane;
        f32x4 v[8];
#pragma unroll
        for (int j = 0; j < 8; ++j) v[j] = xr[64 * j];
        if (MODE != 0) {
            const int s0 = tslot[row * 2], s1 = tslot[row * 2 + 1]; const float w0 = tw[row * 2], w1 = tw[row * 2 + 1];
            const GAS u32x2* y0 = (const GAS u32x2*)(Y + (size_t)ms.row(s0) * D) + lane; const GAS u32x2* y1 = (const GAS u32x2*)(Y + (size_t)ms.row(s1) * D) + lane;
            const GAS f32x4* gt = (const GAS f32x4*)(ada_gate2 + (size_t)b * 12288) + lane;
#pragma unroll
            for (int j = 0; j < 8; ++j) { const u32x2 a0 = y0[64 * j], a1 = y1[64 * j]; const f32x4 g = gt[64 * j];
                f32x4 m; m[0] = w0 * bflo(a0.x) + w1 * bflo(a1.x); m[1] = w0 * bfhi(a0.x) + w1 * bfhi(a1.x); m[2] = w0 * bflo(a0.y) + w1 * bflo(a1.y); m[3] = w0 * bfhi(a0.y) + w1 * bfhi(a1.y);
                v[j] = v[j] + g * m; }
            if (MODE == 1) { GAS f32x4* xw = (GAS f32x4*)(xd + (size_t)row * D) + lane;
#pragma unroll
                for (int j = 0; j < 8; ++j) xw[64 * j] = v[j]; }
        }
        float s = 0.f;
#pragma unroll
        for (int j = 0; j < 8; ++j) s += (v[j][0] * v[j][0] + v[j][1] * v[j][1]) + (v[j][2] * v[j][2] + v[j][3] * v[j][3]);
        const float rstd = 1.0f / sqrtf(wave_sum(s) * (1.0f / D) + NORM_EPS);
        const GAS f32x4* gn = (const GAS f32x4*)gain + lane;
        if (MODE == 2) { GAS f32x4* o = (GAS f32x4*)(xd + (size_t)row * D) + lane;
#pragma unroll
            for (int j = 0; j < 8; ++j) o[64 * j] = v[j] * rstd * gn[64 * j];
        } else {
            const GAS f32x4* sc = (const GAS f32x4*)(ada_scale + (size_t)b * 12288) + lane; const GAS f32x4* sh = (const GAS f32x4*)(ada_shift + (size_t)b * 12288) + lane;
            GAS u32x2* o = (GAS u32x2*)(hout + (size_t)row * D) + lane;
#pragma unroll
            for (int j = 0; j < 8; ++j) { const f32x4 hh = v[j] * rstd * gn[64 * j] * (sc[64 * j] + 1.0f) + sh[64 * j]; u32x2 w; w.x = pk2(hh[0], hh[1]); w.y = pk2(hh[2], hh[3]); o[64 * j] = w; }
        }
    }
}

__device__ __forceinline__ void router_phase(const float* xs, bf16_t* hout, const float* gain, const float* ada_scale, const float* ada_shift, const float* w_router, const float* b_router,
                                             unsigned* cnt, int* rlist, int* tslot, float* tw, LAS unsigned char* lds, int vcu, int G, int tid, int wave, int lane) {
    LAS float* wrT = (LAS float*)lds;
    LAS int* misc = (LAS int*)(lds + MISC_OFF + 64);
    LAS int* lcnt = misc; LAS int* lbase = misc + 16; LAS int* rinfo = misc + 32;
    for (int i = tid; i < D * NE; i += NTHREADS) { const int c = i >> 4, e = i & 15; wrT[e * D + c] = w_router[i]; }
    const int rows_per_blk = T / G;
    for (int base = vcu * rows_per_blk; base < T; base += G * rows_per_blk) {
        if (tid < 16) lcnt[tid] = 0;
        __syncthreads();
        const int rpw = rows_per_blk / NWAVES;
        for (int k = 0; k < rpw; ++k) {
            const int lr = wave * rpw + k, row = base + lr, b = row >> 11;
            const GAS f32x4* xr = (const GAS f32x4*)(xs + (size_t)row * D) + lane;
            f32x4 v[8];
#pragma unroll
            for (int j = 0; j < 8; ++j) v[j] = xr[64 * j];
            float s = 0.f;
#pragma unroll
            for (int j = 0; j < 8; ++j) s += (v[j][0] * v[j][0] + v[j][1] * v[j][1]) + (v[j][2] * v[j][2] + v[j][3] * v[j][3]);
            const float rstd = 1.0f / sqrtf(wave_sum(s) * (1.0f / D) + NORM_EPS);
            const GAS f32x4* gn = (const GAS f32x4*)gain + lane;
            const GAS f32x4* sc = (const GAS f32x4*)(ada_scale + (size_t)b * 12288) + lane; const GAS f32x4* sh = (const GAS f32x4*)(ada_shift + (size_t)b * 12288) + lane;
            GAS u32x2* o = (GAS u32x2*)(hout + (size_t)row * D) + lane;
#pragma unroll
            for (int j = 0; j < 8; ++j) { v[j] = v[j] * rstd * gn[64 * j] * (sc[64 * j] + 1.0f) + sh[64 * j]; u32x2 w; w.x = pk2(v[j][0], v[j][1]); w.y = pk2(v[j][2], v[j][3]); o[64 * j] = w; }
            float lg[NE];
#pragma unroll
            for (int e = 0; e < NE; ++e) { float p = 0.f;
#pragma unroll
                for (int j = 0; j < 8; ++j) { const f32x4 w = *(const LAS f32x4*)(wrT + e * D + 4 * lane + 256 * j); p += (v[j][0] * w[0] + v[j][1] * w[1]) + (v[j][2] * w[2] + v[j][3] * w[3]); }
                lg[e] = wave_sum(p); }
            float aff[NE], sel[NE];
#pragma unroll
            for (int e = 0; e < NE; ++e) { aff[e] = sigmoidf_(lg[e]); sel[e] = aff[e] + b_router[e]; }
            int bg = 0; float bgs = -3.0e38f;
#pragma unroll
            for (int g = 0; g < 4; ++g) { float m1 = -3.0e38f, m2 = -3.0e38f;
#pragma unroll
                for (int j = 0; j < 4; ++j) { const float sv = sel[4 * g + j]; if (sv > m1) { m2 = m1; m1 = sv; } else if (sv > m2) m2 = sv; }
                const float gs = m1 + m2; if (gs > bgs) { bgs = gs; bg = g; } }
            int i0 = 0, i1 = 0; float s0 = -3.0e38f, s1 = -3.0e38f, a0 = 0.f, a1 = 0.f;
#pragma unroll
            for (int e = 0; e < NE; ++e) { if ((e >> 2) == bg) { const float sv = sel[e];
                if (sv > s0) { s1 = s0; i1 = i0; a1 = a0; s0 = sv; i0 = e; a0 = aff[e]; } else if (sv > s1) { s1 = sv; i1 = e; a1 = aff[e]; } } }
            if (lane == 0) { const int r0 = atomicAdd((int*)lcnt + i0, 1), r1 = atomicAdd((int*)lcnt + i1, 1);
                rinfo[lr * 4 + 0] = (i0 << 16) | r0; rinfo[lr * 4 + 1] = (i1 << 16) | r1;
                const float inv = 1.0f / (a0 + a1); tw[row * 2] = a0 * inv; tw[row * 2 + 1] = a1 * inv; }
        }
        __syncthreads();
        if (tid < 16) lbase[tid] = (int)__hip_atomic_fetch_add(cnt + 64 * tid, (unsigned)lcnt[tid], RLX_AGENT);
        __syncthreads();
        if (tid < rows_per_blk * 2) { const int lr = tid >> 1, kk = tid & 1, info = rinfo[lr * 4 + kk], e = info >> 16, rank = lbase[e] + (info & 0xffff);
            rlist[(size_t)e * T + rank] = base + lr; tslot[(base + lr) * 2 + kk] = (e << 16) | rank; }
        __syncthreads();
    }
}

__device__ __forceinline__ int swz256(int row, int ch) { return 256 * row + 16 * (ch ^ (((row & 3) << 2) | ((row >> 2) & 3))); }
typedef short v4i16_t __attribute__((ext_vector_type(4)));
__device__ __forceinline__ s16x4 vtr(const LAS unsigned char* p) { return __builtin_bit_cast(s16x4, __builtin_amdgcn_ds_read_tr16_b64_v4i16((LAS v4i16_t*)p)); }

__device__ __forceinline__ void attn_unit(LAS unsigned char* lds, const bf16_t* proj, bf16_t* atto, float* lse, int a, int tid, int wave, int lane) {
    const int sub = a & 15, bh = a >> 4, head = bh % 12, b = bh / 12, g = head >> 2, hj = head & 3;
    const int dsh = 2 * g, nbsh = 4 - 2 * g;
    const int nblk = sub & ((1 << nbsh) - 1), r = sub >> nbsh;
    const size_t tb = (size_t)b * SEQ;
    const int p0 = 128 * (nblk - 1);
    LAS unsigned char* Kl = lds; LAS unsigned char* Vl = lds + 65536;
    {
        u32x4 kv[8], vv[8];
#pragma unroll
        for (int it = 0; it < 8; ++it) { const int id = tid + NTHREADS * it, row = id >> 4, ch = id & 15, p = p0 + row;
            kv[it] = (u32x4){0u, 0u, 0u, 0u}; vv[it] = kv[it];
            if (p >= 0) { const size_t t = tb + ((size_t)p << dsh) + r; const bf16_t* src = proj + t * NP + head * 128 + ch * 8; kv[it] = *(const u32x4*)(src + KA); vv[it] = *(const u32x4*)(src + VA); } }
#pragma unroll
        for (int it = 0; it < 8; ++it) { const int id = tid + NTHREADS * it, row = id >> 4, ch = id & 15; const int off = swz256(row, ch);
            *(LAS u32x4*)(Kl + off) = kv[it]; *(LAS u32x4*)(Vl + off) = vv[it]; }
    }
    const int fr = lane & 15, fq = lane >> 4;
    const int qi = 16 * wave + fr;
    const size_t tq = tb + ((size_t)(128 * nblk + qi) << dsh) + r;
    bf16x8 qf[4];
    { const bf16_t* qsrc = proj + tq * NP + QA + head * 128 + fq * 8;
#pragma unroll
        for (int ks = 0; ks < 4; ++ks) qf[ks] = *(const bf16x8*)(qsrc + 32 * ks); }
    __syncthreads();
    f32x4 sacc[9];
#pragma unroll
    for (int kt = 0; kt < 9; ++kt) { f32x4 acc = (f32x4){0.f, 0.f, 0.f, 0.f}; const int key = 16 * (wave + kt) + fr;
#pragma unroll
        for (int ks = 0; ks < 4; ++ks) { const bf16x8 kf = *(const LAS bf16x8*)(Kl + swz256(key, 4 * ks + fq)); acc = __builtin_amdgcn_mfma_f32_16x16x32_bf16(kf, qf[ks], acc, 0, 0, 0); }
        sacc[kt] = acc; }
    const float sc = 0.12751743082459868f;
    float mx = -3.0e38f;
#pragma unroll
    for (int kt = 0; kt < 9; ++kt)
#pragma unroll
        for (int rg = 0; rg < 4; ++rg) { const int jk = 16 * (wave + kt) + 4 * fq + rg; const bool valid = (jk >= qi) && (jk <= qi + 128) && (p0 + jk >= 0);
            const float s = valid ? sacc[kt][rg] * sc : -3.0e38f; sacc[kt][rg] = s; mx = fmaxf(mx, s); }
    mx = fmaxf(mx, __shfl_xor(mx, 16)); mx = fmaxf(mx, __shfl_xor(mx, 32));
    float sum = 0.f;
#pragma unroll
    for (int kt = 0; kt < 9; ++kt)
#pragma unroll
        for (int rg = 0; rg < 4; ++rg) { const float p = __builtin_amdgcn_exp2f(sacc[kt][rg] - mx); sacc[kt][rg] = p; sum += p; }
    sum += __shfl_xor(sum, 16); sum += __shfl_xor(sum, 32);
    f32x4 oacc[8];
#pragma unroll
    for (int dt = 0; dt < 8; ++dt) oacc[dt] = (f32x4){0.f, 0.f, 0.f, 0.f};
    const int li = lane & 15, qq = li >> 2, pp = li & 3;
#pragma unroll
    for (int s5 = 0; s5 < 5; ++s5) {
        const int t0 = 2 * s5, t1 = (2 * s5 + 1 < 9) ? 2 * s5 + 1 : 2 * s5;
        u32x4 pw; pw.x = pk2(sacc[t0][0], sacc[t0][1]); pw.y = pk2(sacc[t0][2], sacc[t0][3]);
        if (2 * s5 + 1 < 9) { pw.z = pk2(sacc[t1][0], sacc[t1][1]); pw.w = pk2(sacc[t1][2], sacc[t1][3]); } else { pw.z = 0u; pw.w = 0u; }
        const bf16x8 pf = __builtin_bit_cast(bf16x8, pw);
        const int key0 = 16 * (wave + t0) + 4 * fq + qq, key1 = 16 * (wave + t1) + 4 * fq + qq;
#pragma unroll
        for (int dt = 0; dt < 8; ++dt) {
            const s16x4 v0 = vtr(Vl + swz256(key0, 2 * dt + (pp >> 1)) + 8 * (pp & 1));
            const s16x4 v1 = vtr(Vl + swz256(key1, 2 * dt + (pp >> 1)) + 8 * (pp & 1));
            bf16x8 vf; vf[0] = v0[0]; vf[1] = v0[1]; vf[2] = v0[2]; vf[3] = v0[3]; vf[4] = v1[0]; vf[5] = v1[1]; vf[6] = v1[2]; vf[7] = v1[3];
            oacc[dt] = __builtin_amdgcn_mfma_f32_16x16x32_bf16(vf, pf, oacc[dt], 0, 0, 0);
        }
    }
    const float inv = 1.0f / sum;
    bf16_t* op = atto + ((size_t)g * T + tq) * 512 + hj * 128 + 4 * fq;
#pragma unroll
    for (int dt = 0; dt < 8; ++dt) { u32x2 w; w.x = pk2(oacc[dt][0] * inv, oacc[dt][1] * inv); w.y = pk2(oacc[dt][2] * inv, oacc[dt][3] * inv); *(u32x2*)(op + 16 * dt) = w; }
    if (fq == 0) lse[((size_t)g * T + tq) * 4 + hj] = mx * 0.6931471805599453f + __logf(sum);
    __syncthreads();
}

__device__ __forceinline__ void gla_unit(LAS unsigned char* lds, const bf16_t* proj, const float* alow, const float* w_alpha2, const float* b_alpha2, bf16_t* ob, float* ssq,
                                         int u, int tid, int wave, int lane) {
    const int vs = u & 7, h = (u >> 3) & 3, b = u >> 5;
    const int d = tid & 127, ig = tid >> 7;
    const int fr = lane & 15, fq = lane >> 4;
    LAS unsigned char* QD = lds; LAS unsigned char* KI = lds + 16384; LAS unsigned char* KET = lds + 32768; LAS unsigned char* VT = lds + 49152; LAS unsigned char* AT = lds + 53248;
    LAS unsigned char* STb = lds + 61440;
    LAS float* CS = (LAS float*)(lds + 77824); LAS float* DC = (LAS float*)(lds + 79872); LAS float* ALs = (LAS float*)(lds + 80384);
    float w2[16];
#pragma unroll
    for (int r = 0; r < 16; ++r) w2[r] = w_alpha2[r * 512 + h * 128 + d];
    const float bias = b_alpha2[h * 128 + d];
    f32x4 sst[2]; sst[0] = (f32x4){0.f, 0.f, 0.f, 0.f}; sst[1] = sst[0];
    { unsigned z0 = 0u; asm volatile("" : "+v"(z0)); *(LAS u32x4*)(STb + tid * 16) = (u32x4){z0, z0, z0, z0}; }
    const float qscale = 0.08838834764831845f;
    for (int n = 0; n < 32; ++n) {
        const size_t t0 = (size_t)b * SEQ + 64 * n;
        LAS unsigned char* STc = STb + (n & 1) * 8192; LAS unsigned char* STn = STb + ((n + 1) & 1) * 8192;
        const float al0 = alow[t0 * 16 + tid], al1 = alow[t0 * 16 + 512 + tid];
        bf16_t qv[16], kv[16];
        { const bf16_t* src = proj + (t0 + 16 * ig) * NP + h * 128 + d;
#pragma unroll
            for (int ii = 0; ii < 16; ++ii) { qv[ii] = src[(size_t)ii * NP + QB]; kv[ii] = src[(size_t)ii * NP + KB]; } }
        const int vi = tid >> 3, c4 = (tid & 7) * 4;
        const u32x2 vraw = *(const u32x2*)(proj + (t0 + vi) * NP + VB + h * 256 + 32 * vs + c4);
        ALs[tid] = al0; ALs[512 + tid] = al1;
        __syncthreads();
        float bl[16]; float run = 0.f;
#pragma unroll
        for (int ii = 0; ii < 16; ++ii) { float z = bias; const LAS f32x4* ap = (const LAS f32x4*)(ALs + (16 * ig + ii) * 16);
#pragma unroll
            for (int r4 = 0; r4 < 4; ++r4) { const f32x4 av = ap[r4]; z += av[0] * w2[4 * r4] + av[1] * w2[4 * r4 + 1] + av[2] * w2[4 * r4 + 2] + av[3] * w2[4 * r4 + 3]; }
            const float la = (fminf(z, 0.f) - __logf(1.0f + __expf(-fabsf(z)))) * 0.0625f; run += la; bl[ii] = run; }
        CS[ig * 128 + d] = run;
        __syncthreads();
        float pre = 0.f, tot = 0.f;
#pragma unroll
        for (int g2 = 0; g2 < 4; ++g2) { const float cv = CS[g2 * 128 + d]; tot += cv; pre += (g2 < ig) ? cv : 0.f; }
        unsigned ke[8];
#pragma unroll
        for (int ii = 0; ii < 16; ++ii) { const float bb = pre + bl[ii]; const float qf_ = bf2f(qv[ii]), kf_ = bf2f(kv[ii]);
            const float qd = qf_ * qscale * __expf(bb), ki = kf_ * __expf(-bb), kend = kf_ * __expf(tot - bb);
            *(LAS bf16_t*)(QD + (16 * ig + ii) * 256 + 2 * d) = (bf16_t)f2bf(qd); *(LAS bf16_t*)(KI + (16 * ig + ii) * 256 + 2 * d) = (bf16_t)f2bf(ki);
            if (ii & 1) ke[ii >> 1] |= f2bf(kend) << 16; else ke[ii >> 1] = f2bf(kend); }
        *(LAS u32x4*)(KET + d * 128 + 32 * ig) = (u32x4){ke[0], ke[1], ke[2], ke[3]}; *(LAS u32x4*)(KET + d * 128 + 32 * ig + 16) = (u32x4){ke[4], ke[5], ke[6], ke[7]};
        if (ig == 0) DC[d] = __expf(tot);
        *(LAS bf16_t*)(VT + (c4 + 0) * 128 + 2 * vi) = (bf16_t)(vraw.x & 0xffffu); *(LAS bf16_t*)(VT + (c4 + 1) * 128 + 2 * vi) = (bf16_t)(vraw.x >> 16);
        *(LAS bf16_t*)(VT + (c4 + 2) * 128 + 2 * vi) = (bf16_t)(vraw.y & 0xffffu); *(LAS bf16_t*)(VT + (c4 + 3) * 128 + 2 * vi) = (bf16_t)(vraw.y >> 16);
        __syncthreads();
#pragma unroll
        for (int x = 0; x < 2; ++x) { const int id = 2 * wave + x, ti = id >> 2, tj = id & 3; f32x4 acc = (f32x4){0.f, 0.f, 0.f, 0.f};
            if (tj <= ti) {
#pragma unroll
                for (int ks = 0; ks < 4; ++ks) { const bf16x8 af = *(const LAS bf16x8*)(QD + (16 * ti + fr) * 256 + (32 * ks + 8 * fq) * 2); const bf16x8 bfr = *(const LAS bf16x8*)(KI + (16 * tj + fr) * 256 + (32 * ks + 8 * fq) * 2);
                    acc = __builtin_amdgcn_mfma_f32_16x16x32_bf16(af, bfr, acc, 0, 0, 0); } }
#pragma unroll
            for (int rg = 0; rg < 4; ++rg) { const int i = 16 * ti + 4 * fq + rg, j = 16 * tj + fr; const float vv = (i >= j) ? acc[rg] : 0.f; *(LAS bf16_t*)(AT + i * 128 + 2 * j) = (bf16_t)f2bf(vv); } }
        __syncthreads();
        { const int ti = wave >> 1, tv = wave & 1; f32x4 acc = (f32x4){0.f, 0.f, 0.f, 0.f};
#pragma unroll
            for (int ks = 0; ks < 2; ++ks) { const bf16x8 af = *(const LAS bf16x8*)(AT + (16 * ti + fr) * 128 + (32 * ks + 8 * fq) * 2); const bf16x8 bfr = *(const LAS bf16x8*)(VT + (16 * tv + fr) * 128 + (32 * ks + 8 * fq) * 2);
                acc = __builtin_amdgcn_mfma_f32_16x16x32_bf16(af, bfr, acc, 0, 0, 0); }
#pragma unroll
            for (int ks = 0; ks < 4; ++ks) { const bf16x8 af = *(const LAS bf16x8*)(QD + (16 * ti + fr) * 256 + (32 * ks + 8 * fq) * 2); const bf16x8 bfr = *(const LAS bf16x8*)(STc + (16 * tv + fr) * 256 + (32 * ks + 8 * fq) * 2);
                acc = __builtin_amdgcn_mfma_f32_16x16x32_bf16(af, bfr, acc, 0, 0, 0); }
#pragma unroll
            for (int rg = 0; rg < 4; ++rg) { const size_t t = t0 + 16 * ti + 4 * fq + rg; const float ov = acc[rg];
                ob[t * 1024 + h * 256 + 32 * vs + 16 * tv + fr] = (bf16_t)f2bf(ov);
                float q2 = ov * ov; q2 += __shfl_xor(q2, 1); q2 += __shfl_xor(q2, 2); q2 += __shfl_xor(q2, 4); q2 += __shfl_xor(q2, 8);
                if (fr == 0) ssq[(t * 4 + h) * 16 + vs * 2 + tv] = q2; } }
#pragma unroll
        for (int tv = 0; tv < 2; ++tv) {
#pragma unroll
            for (int rg = 0; rg < 4; ++rg) sst[tv][rg] *= DC[16 * wave + 4 * fq + rg];
#pragma unroll
            for (int ks = 0; ks < 2; ++ks) { const bf16x8 af = *(const LAS bf16x8*)(KET + (16 * wave + fr) * 128 + (32 * ks + 8 * fq) * 2); const bf16x8 bfr = *(const LAS bf16x8*)(VT + (16 * tv + fr) * 128 + (32 * ks + 8 * fq) * 2);
                sst[tv] = __builtin_amdgcn_mfma_f32_16x16x32_bf16(af, bfr, sst[tv], 0, 0, 0); }
            u32x2 w; w.x = pk2(sst[tv][0], sst[tv][1]); w.y = pk2(sst[tv][2], sst[tv][3]);
            *(LAS u32x2*)(STn + (16 * tv + fr) * 256 + (16 * wave + 4 * fq) * 2) = w; }
        __syncthreads();
    }
}

__device__ __forceinline__ void merge_phase(const bf16_t* atto, const float* lse, const bf16_t* ob, const float* ssq, const bf16_t* proj, const float* gla_gain, bf16_t* ya, bf16_t* yb,
                                            int vcu, int G, int wave, int lane) {
    const int gw = vcu * NWAVES + wave, NGW = G * NWAVES;
    for (int row = gw; row < T; row += NGW) {
        { const int hj = lane >> 4;
            const float l0 = lse[((size_t)0 * T + row) * 4 + hj], l1 = lse[((size_t)1 * T + row) * 4 + hj], l2 = lse[((size_t)2 * T + row) * 4 + hj];
            const float m = fmaxf(l0, fmaxf(l1, l2)); float e0 = __expf(l0 - m), e1 = __expf(l1 - m), e2 = __expf(l2 - m); const float inv = 1.0f / (e0 + e1 + e2); e0 *= inv; e1 *= inv; e2 *= inv;
            const u32x4 a0 = *(const u32x4*)(atto + ((size_t)0 * T + row) * 512 + 8 * lane), a1 = *(const u32x4*)(atto + ((size_t)1 * T + row) * 512 + 8 * lane), a2 = *(const u32x4*)(atto + ((size_t)2 * T + row) * 512 + 8 * lane);
            u32x4 w;
            w.x = pk2(e0 * bflo(a0.x) + e1 * bflo(a1.x) + e2 * bflo(a2.x), e0 * bfhi(a0.x) + e1 * bfhi(a1.x) + e2 * bfhi(a2.x));
            w.y = pk2(e0 * bflo(a0.y) + e1 * bflo(a1.y) + e2 * bflo(a2.y), e0 * bfhi(a0.y) + e1 * bfhi(a1.y) + e2 * bfhi(a2.y));
            w.z = pk2(e0 * bflo(a0.z) + e1 * bflo(a1.z) + e2 * bflo(a2.z), e0 * bfhi(a0.z) + e1 * bfhi(a1.z) + e2 * bfhi(a2.z));
            w.w = pk2(e0 * bflo(a0.w) + e1 * bflo(a1.w) + e2 * bflo(a2.w), e0 * bfhi(a0.w) + e1 * bfhi(a1.w) + e2 * bfhi(a2.w));
            *(u32x4*)(ya + (size_t)row * 512 + 8 * lane) = w; }
#pragma unroll
        for (int c = 0; c < 2; ++c) { const int col = 8 * lane + 512 * c, hh = col >> 8;
            const f32x4* sp = (const f32x4*)(ssq + ((size_t)row * 4 + hh) * 16); const f32x4 s0 = sp[0], s1 = sp[1], s2 = sp[2], s3 = sp[3];
            const float tot = ((s0[0] + s0[1]) + (s0[2] + s0[3])) + ((s1[0] + s1[1]) + (s1[2] + s1[3])) + ((s2[0] + s2[1]) + (s2[2] + s2[3])) + ((s3[0] + s3[1]) + (s3[2] + s3[3]));
            const float rstd = 1.0f / sqrtf(tot * (1.0f / 256.0f) + NORM_EPS);
            const u32x4 o = *(const u32x4*)(ob + (size_t)row * 1024 + col), rr = *(const u32x4*)(proj + (size_t)row * NP + RB + col);
            const f32x4 g0 = *(const f32x4*)(gla_gain + col), g1 = *(const f32x4*)(gla_gain + col + 4);
            u32x4 w;
            w.x = pk2(bflo(o.x) * rstd * g0[0] * siluf_(bflo(rr.x)), bfhi(o.x) * rstd * g0[1] * siluf_(bfhi(rr.x)));
            w.y = pk2(bflo(o.y) * rstd * g0[2] * siluf_(bflo(rr.y)), bfhi(o.y) * rstd * g0[3] * siluf_(bfhi(rr.y)));
            w.z = pk2(bflo(o.z) * rstd * g1[0] * siluf_(bflo(rr.z)), bfhi(o.z) * rstd * g1[1] * siluf_(bfhi(rr.z)));
            w.w = pk2(bflo(o.w) * rstd * g1[2] * siluf_(bflo(rr.w)), bfhi(o.w) * rstd * g1[3] * siluf_(bfhi(rr.w)));
            *(u32x4*)(yb + (size_t)row * 1024 + col) = w; }
    }
}

constexpr int N_PHASES = 20;
typedef const __attribute__((address_space(4))) Args CArgs;
__device__ __forceinline__ CArgs* fresh_args() {
    unsigned long long v = (unsigned long long)__builtin_amdgcn_kernarg_segment_ptr();
    unsigned lo = (unsigned)v, hi = (unsigned)(v >> 32);
    asm volatile("" : "+s"(lo), "+s"(hi));
    lo = __builtin_amdgcn_readfirstlane(lo); hi = __builtin_amdgcn_readfirstlane(hi);
    return (CArgs*)(((unsigned long long)hi << 32) | lo);
}
template <unsigned MASK, bool ONE>
__global__ void __launch_bounds__(NTHREADS, 2) fwd_kernel(Args a_unused) {
    extern __shared__ __attribute__((aligned(16))) unsigned char lds_raw[];
    LAS unsigned char* lds = (LAS unsigned char*)lds_raw;
    int tid = threadIdx.x, lane = tid & 63, wave = __builtin_amdgcn_readfirstlane(tid >> 6);
    CArgs* ap = fresh_args();
    unsigned char* ws = ap->ws;
#define a (*ap)
#define FRESH_TID() do { ap = fresh_args(); ws = ap->ws; tid = threadIdx.x; asm volatile("" : "+v"(tid)); lane = tid & 63; wave = __builtin_amdgcn_readfirstlane(tid >> 6); } while (0)
    const int G = gridDim.x; const int bx = blockIdx.x; const int vcu = (G % 8 == 0) ? (bx % 8) * (G / 8) + bx / 8 : bx;
    volatile LAS unsigned* MISC = (volatile LAS unsigned*)(lds + MISC_OFF);
    for (int u = tid; u < (LDS_BYTES - MISC_OFF) / 4; u += NTHREADS) ((LAS unsigned*)(lds + MISC_OFF))[u] = 0u;
    __syncthreads();
    if (ONE) (void)xcd_barrier_post((unsigned*)(ws + WS_CTL) + CW_BAR, MISC + 8);
    const int lo = ONE ? 0 : a.ph_lo, hi = ONE ? N_PHASES : a.ph_hi;
#define IN(k) (((MASK >> ((k) > 9 ? (k) - 9 : (k))) & 1u) && (ONE || (lo <= (k) && (k) < hi)))
#define SEAM(k) do { if (ONE && IN(k) && IN((k) + 1)) { XcdBarrier bar_; bar_.bar = (unsigned*)(((CArgs*)fresh_args())->ws + WS_CTL) + CW_BAR; bar_.x = xb_xcc_id(); bar_.st = (volatile LAS unsigned*)(lds + MISC_OFF) + 8; xcd_barrier(bar_); } } while (0)

#define ada ((float*)(ws + WS_ADA))
#define ropec ((const float*)(ws + WS_ROPE))
#define ropes (((const float*)(ws + WS_ROPE)) + SEQ * 64)
#define alow ((float*)(ws + WS_ALOW))
#define lse ((float*)(ws + WS_LSE))
#define ssq ((float*)(ws + WS_SSQ))
#define rlist ((int*)(ws + WS_RLIST))
#define tslot ((int*)(ws + WS_TSLOT))
#define tw ((float*)(ws + WS_TW))
#define hbuf ((bf16_t*)(ws + WS_H))
#define ya ((bf16_t*)(ws + WS_YA))
#define yb ((bf16_t*)(ws + WS_YB))
#define mrg ((bf16_t*)(ws + WS_MRG))
#define atto ((bf16_t*)(ws + WS_ATTO))
#define obuf ((bf16_t*)(ws + WS_OB))
#define proj ((bf16_t*)(ws + WS_PROJ))
#define act ((bf16_t*)(ws + WS_ACT))
#define Y ((bf16_t*)(ws + WS_Y))
#define ctl ((unsigned*)(ws + WS_CTL))

    if (IN(0)) { FRESH_TID(); prologue_phase(ap, lds, vcu, G, tid, wave, lane); }
    SEAM(0);

    for (int l = 0; l < DEPTH; ++l) {
        const int P = 1 + 9 * l;
#define adal (ada + (size_t)l * NB * 12288)
#define cntl (ctl + CW_CNT + l * 1024)
#define cntp (ctl + CW_CNT + (l > 0 ? (l - 1) * 1024 : 0))
#define xsrc ((l == 0) ? a.x : a.out)
        if (IN(P)) { FRESH_TID();
            if (l == 0) norm_phase<0>(xsrc, nullptr, hbuf, a.norm_mix, adal + 2048, adal, nullptr, nullptr, nullptr, nullptr, nullptr, vcu, G, wave, lane);
            else norm_phase<1>(xsrc, a.out, hbuf, a.norm_mix + (size_t)l * D, adal + 2048, adal, ada + (size_t)(l - 1) * NB * 12288 + 10240, Y, tslot, tw, cntp, vcu, G, wave, lane);
        }
        SEAM(P);
        if (IN(P + 1)) { FRESH_TID();
            pg8::StaticOrder S{T / 256, NP / 256, G, bx}; pg8::RowsContig AM; pg8::EpiProj E{proj, ropec, ropes, alow};
            pg8::gemm_phase<pg8::EpiProj, pg8::StaticOrder, pg8::RowsContig, true>(lds, tid, hbuf, (const bf16_t*)(ws + WS_WIN) + (size_t)l * NP * D, 0, D, S, AM, E);
        }
        SEAM(P + 1);
        if (IN(P + 2)) { FRESH_TID();
            for (int u = vcu; u < 256; u += G) { gla_unit(lds, proj, alow, a.w_alpha2 + (size_t)l * 16 * 512, a.b_alpha2 + (size_t)l * 512, obuf, ssq, u, tid, wave, lane); }
            __syncthreads();
            for (int u = vcu; u < NB * 12 * 16; u += G) attn_unit(lds, proj, atto, lse, u, tid, wave, lane);
        }
        SEAM(P + 2);
        if (IN(P + 3)) { FRESH_TID(); merge_phase(atto, lse, obuf, ssq, proj, a.gla_gain + (size_t)l * 1024, ya, yb, vcu, G, wave, lane); }
        SEAM(P + 3);
        if (IN(P + 4)) { FRESH_TID();
            pg8::StaticOrder S{T / 256, D / 256, G, bx}; pg8::RowsContig AM;
            { pg8::EpiGate<true> E{mrg, proj, GA}; pg8::gemm_phase<pg8::EpiGate<true>, pg8::StaticOrder, pg8::RowsContig, true>(lds, tid, ya, (const bf16_t*)(ws + WS_WOA) + (size_t)l * D * 512, 0, 512, S, AM, E); }
            FRESH_TID();
            { pg8::EpiGate<false> E{mrg, proj, GB}; pg8::gemm_phase<pg8::EpiGate<false>, pg8::StaticOrder, pg8::RowsContig, true>(lds, tid, yb, (const bf16_t*)(ws + WS_WOB) + (size_t)l * D * 1024, 0, 1024, S, AM, E); }
        }
        SEAM(P + 4);
        if (IN(P + 5)) { FRESH_TID();
            pg8::StaticOrder S{T / 256, D / 256, G, bx}; pg8::RowsContig AM; pg8::EpiResid E{xsrc, a.out, adal + 4096};
            pg8::gemm_phase<pg8::EpiResid, pg8::StaticOrder, pg8::RowsContig, true>(lds, tid, mrg, (const bf16_t*)(ws + WS_WO) + (size_t)l * D * D, 0, D, S, AM, E);
        }
        SEAM(P + 5);
        if (IN(P + 6)) { FRESH_TID(); router_phase(a.out, hbuf, a.norm_ffn + (size_t)l * D, adal + 8192, adal + 6144, a.w_router, a.b_router, cntl, rlist, tslot, tw, lds, vcu, G, tid, wave, lane); }
        SEAM(P + 6);
        if (IN(P + 7)) { FRESH_TID();
            pg8::MoeOrder S; S.init(cntl, 8, G, bx); pg8::RowsGather AM{rlist, cntl}; pg8::EpiSwiGLU E{act};
            pg8::gemm_phase<pg8::EpiSwiGLU, pg8::MoeOrder, pg8::RowsGather, true>(lds, tid, hbuf, (const bf16_t*)(ws + WS_WGU) + (size_t)l * NE * 2048 * D, (size_t)2048 * D, D, S, AM, E);
        }
        SEAM(P + 7);
        if (IN(P + 8)) { FRESH_TID();
            pg8::MoeOrder S; S.init(cntl, 8, G, bx); pg8::RowsContig AM; pg8::EpiPlain E{Y};
            pg8::gemm_phase<pg8::EpiPlain, pg8::MoeOrder, pg8::RowsContig, true>(lds, tid, act, (const bf16_t*)(ws + WS_WDN) + (size_t)l * NE * D * FF, (size_t)D * FF, FF, S, AM, E);
        }
        SEAM(P + 8);
    }
    if (IN(19)) { FRESH_TID(); norm_phase<2>(a.out, a.out, nullptr, a.final_norm, nullptr, nullptr, ada + (size_t)(DEPTH - 1) * NB * 12288 + 10240, Y, tslot, tw, ctl + CW_CNT + (DEPTH - 1) * 1024, vcu, G, wave, lane); }
#undef a
#undef IN
#undef SEAM
}

template <unsigned MASK, bool ONE>
static void launch_one(const Args& a, int grid, hipStream_t stream) {
    static bool attr_done = false;
    if (!attr_done) { (void)hipFuncSetAttribute((const void*)fwd_kernel<MASK, ONE>, hipFuncAttributeMaxDynamicSharedMemorySize, LDS_BYTES); attr_done = true; }
    hipLaunchKernelGGL((fwd_kernel<MASK, ONE>), dim3(grid), dim3(NTHREADS), LDS_BYTES, stream, a);
}
extern "C" void kernel_launch(void* const* d_in, const int* in_sizes, int n_in, void* d_out, int out_size, void* d_ws, size_t ws_size, hipStream_t stream) {
    static int grid = 0;
    if (grid == 0) {
        if (n_in != 19 || out_size != T * D || ws_size < WS_END) { fprintf(stderr, "kernel_launch: unexpected shapes (n_in %d, out %d, ws %zu < %zu); nothing launched\n", n_in, out_size, ws_size, (size_t)WS_END); grid = -1; return; }
        int dev = 0, cus = 0;
        if (hipGetDevice(&dev) != hipSuccess || hipDeviceGetAttribute(&cus, hipDeviceAttributeMultiprocessorCount, dev) != hipSuccess) { grid = -1; return; }
        grid = cus;
        if (grid != 256) fprintf(stderr, "kernel_launch: note: %d CUs (built for 256)\n", grid);
    }
    if (grid < 0) return;
    (void)hipMemsetAsync((char*)d_ws + WS_CTL, 0, CTL_ZERO_BYTES, stream);
    Args a{};
    a.x = (const float*)d_in[0]; a.c = (const float*)d_in[1]; a.w_ada = (const float*)d_in[2]; a.b_ada = (const float*)d_in[3]; a.norm_mix = (const float*)d_in[4]; a.norm_ffn = (const float*)d_in[5];
    a.w_in = (const float*)d_in[6]; a.w_alpha2 = (const float*)d_in[7]; a.b_alpha2 = (const float*)d_in[8]; a.gla_gain = (const float*)d_in[9]; a.w_out_a = (const float*)d_in[10];
    a.w_out_b = (const float*)d_in[11]; a.w_out = (const float*)d_in[12]; a.w_router = (const float*)d_in[13]; a.b_router = (const float*)d_in[14]; a.w_gate_e = (const float*)d_in[15];
    a.w_up_e = (const float*)d_in[16]; a.w_down_e = (const float*)d_in[17]; a.final_norm = (const float*)d_in[18];
    a.out = (float*)d_out; a.ws = (unsigned char*)d_ws;
#if MK_PER_PHASE
    for (int p = 0; p < N_PHASES; ++p) { a.ph_lo = p; a.ph_hi = p + 1;
        const int kind = p > 9 ? p - 9 : p;
        switch (kind) {
            case 0: launch_one<1u << 0, false>(a, grid, stream); break; case 1: launch_one<1u << 1, false>(a, grid, stream); break;
            case 2: launch_one<1u << 2, false>(a, grid, stream); break; case 3: launch_one<1u << 3, false>(a, grid, stream); break;
            case 4: launch_one<1u << 4, false>(a, grid, stream); break; case 5: launch_one<1u << 5, false>(a, grid, stream); break;
            case 6: launch_one<1u << 6, false>(a, grid, stream); break; case 7: launch_one<1u << 7, false>(a, grid, stream); break;
            case 8: launch_one<1u << 8, false>(a, grid, stream); break; case 9: launch_one<1u << 9, false>(a, grid, stream); break;
            default: launch_one<1u << 10, false>(a, grid, stream); break; } }
#else
    a.ph_lo = 0; a.ph_hi = N_PHASES; launch_one<0xFFFFFu, true>(a, grid, stream);
#endif
    const hipError_t le = hipPeekAtLastError();
    if (le != hipSuccess) fprintf(stderr, "kernel_launch: launch failed: %s\n", hipGetErrorName(le));
}
```

```cpp
#include <hip/hip_runtime.h>
#include <cstdio>
#include <cstdint>

#ifndef PROJ_F8
#define PROJ_F8 1
#endif
#ifndef MIX_F8
#define MIX_F8 1
#endif
#ifndef GATE_F8
#define GATE_F8 1
#endif
#ifndef Y_F8
#define Y_F8 1
#endif
#ifndef BR_FUSE
#define BR_FUSE 1
#endif
#ifndef MK_PER_PHASE
#define MK_PER_PHASE 0
#endif

#define LAS __attribute__((address_space(3)))
#define GAS __attribute__((address_space(1)))
typedef unsigned short bf16_t;
typedef short bf16x8 __attribute__((ext_vector_type(8)));
typedef short s16x4 __attribute__((ext_vector_type(4)));
typedef float f32x4 __attribute__((ext_vector_type(4)));
typedef float f32x2 __attribute__((ext_vector_type(2)));
typedef unsigned u32x4 __attribute__((ext_vector_type(4)));
typedef unsigned u32x2 __attribute__((ext_vector_type(2)));
typedef GAS unsigned gu32;

constexpr int NB = 8, SEQ = 2048, T = NB * SEQ, D = 2048, DEPTH = 2;
constexpr int NIN = 11792;
constexpr int NP = 12032;
constexpr int QA = 0, KA = 1536, VA = 3072, QB = 4608, KB = 5120, VB = 5632, RB = 6656, GA = 7680, GB = 9728, AL = 11776;
constexpr int NE = 16, FF = 1024;
constexpr int MAXTILES = 144, MAXROWS = MAXTILES * 256;
constexpr float NORM_EPS = 1e-6f;
constexpr int NWAVES = 8, NTHREADS = 512;

constexpr size_t MiB = 1u << 20;
constexpr size_t WS_CTL = 0, CTL_ZERO_BYTES = 80 * 1024;
constexpr size_t WS_ADA = 1 * MiB;
constexpr size_t WS_ROPE = 2 * MiB;
constexpr size_t WS_ALOW = 3 * MiB;
constexpr size_t WS_LSE = 4 * MiB;
constexpr size_t WS_SSQ = 5 * MiB;
constexpr size_t WS_RLIST = 9 * MiB;
constexpr size_t WS_TSLOT = 10 * MiB;
constexpr size_t WS_TW = 10 * MiB + 512 * 1024;
constexpr size_t WS_WIN = 12 * MiB;
constexpr size_t WS_MRG8 = 60 * MiB;
constexpr size_t WS_WOA = 106 * MiB;
constexpr size_t WS_WOB = 110 * MiB;
constexpr size_t WS_WO = 118 * MiB;
constexpr size_t WS_WGU = 134 * MiB;
constexpr size_t WS_XB = 262 * MiB;
constexpr size_t WS_WDN = 390 * MiB;
constexpr size_t WS_H = 518 * MiB;
constexpr size_t WS_YA = 582 * MiB;
constexpr size_t WS_YB = 598 * MiB;
constexpr size_t WS_MRG = 630 * MiB;
constexpr size_t WS_ATTO = 694 * MiB;
constexpr size_t WS_OB = 742 * MiB;
constexpr size_t WS_PROJ = 774 * MiB;
constexpr size_t WS_ACT = WS_PROJ;
constexpr size_t WS_Y = WS_PROJ + 72 * MiB;
constexpr size_t WS_QD = 1150 * MiB;
constexpr size_t WS_OI = 1166 * MiB;
constexpr size_t WS_DST = 1198 * MiB;
constexpr size_t WS_DEC = 1262 * MiB;
constexpr size_t WS_END = 1263 * MiB;
constexpr int CW_BAR = 4096;
constexpr int CW_CNT = 16384;

constexpr int RING_BYTES = 131072;
constexpr int MISC_OFF = 135168;
constexpr int LDS_BYTES = 151552;

#define LDS_WAIT() asm volatile("s_waitcnt lgkmcnt(0)" ::: "memory")
#define VM_WAIT() asm volatile("s_waitcnt vmcnt(0)" ::: "memory")
#define RLX_AGENT __ATOMIC_RELAXED, __HIP_MEMORY_SCOPE_AGENT
__device__ __forceinline__ unsigned f2bf(float f) { unsigned u = __builtin_bit_cast(unsigned, f); return (u + 0x7fffu + ((u >> 16) & 1u)) >> 16; }
typedef float f32x2_t __attribute__((ext_vector_type(2)));
typedef __bf16 bf16x2_t __attribute__((ext_vector_type(2)));
__device__ __forceinline__ unsigned pk2(float lo, float hi) { const f32x2_t v = {lo, hi}; const bf16x2_t b = __builtin_convertvector(v, bf16x2_t); return __builtin_bit_cast(unsigned, b); }
__device__ __forceinline__ float sat8(float x) { return __builtin_amdgcn_fmed3f(x, -448.0f, 448.0f); }
__device__ __forceinline__ unsigned pk_fp8x4(float a, float b, float c, float d) { int p = __builtin_amdgcn_cvt_pk_fp8_f32(sat8(a), sat8(b), 0, false); p = __builtin_amdgcn_cvt_pk_fp8_f32(sat8(c), sat8(d), p, true); return (unsigned)p; }
constexpr int G8_BYTE0 = RB * 2;
__device__ __forceinline__ void unpack_fp8x8(u32x2 v, float (&f)[8]) { const f32x2_t a = __builtin_amdgcn_cvt_pk_f32_fp8((int)v.x, false), b = __builtin_amdgcn_cvt_pk_f32_fp8((int)v.x, true), c = __builtin_amdgcn_cvt_pk_f32_fp8((int)v.y, false), d = __builtin_amdgcn_cvt_pk_f32_fp8((int)v.y, true);
    f[0] = a[0]; f[1] = a[1]; f[2] = b[0]; f[3] = b[1]; f[4] = c[0]; f[5] = c[1]; f[6] = d[0]; f[7] = d[1]; }
__device__ __forceinline__ unsigned pk_fp8x4_ns(float a, float b, float c, float d) { int p = __builtin_amdgcn_cvt_pk_fp8_f32(a, b, 0, false); p = __builtin_amdgcn_cvt_pk_fp8_f32(c, d, p, true); return (unsigned)p; }
__device__ __forceinline__ float bflo(unsigned u) { return __builtin_bit_cast(float, u << 16); }
__device__ __forceinline__ float bfhi(unsigned u) { return __builtin_bit_cast(float, u & 0xffff0000u); }
__device__ __forceinline__ float bf2f(bf16_t h) { return __builtin_bit_cast(float, (unsigned)h << 16); }
template <int M> __device__ __forceinline__ float sx(float v, int lane) {
    if constexpr (M < 32) return __builtin_bit_cast(float, __builtin_amdgcn_ds_swizzle(__builtin_bit_cast(int, v), (M << 10) | 0x1F));
    else return __builtin_bit_cast(float, __builtin_amdgcn_ds_bpermute((lane ^ 32) << 2, __builtin_bit_cast(int, v)));
}
__device__ __forceinline__ float wave_sum(float v, int lane) {
    v += sx<1>(v, lane); v += sx<2>(v, lane); v += sx<4>(v, lane); v += sx<8>(v, lane); v += sx<16>(v, lane); v += sx<32>(v, lane);
    return v;
}
__device__ __forceinline__ float sigmoidf_(float x) { return __builtin_amdgcn_rcpf(1.0f + __expf(-x)); }
__device__ __forceinline__ float siluf_(float x) { return x * __builtin_amdgcn_rcpf(1.0f + __expf(-x)); }

#define XB_TMO      128
#define XB_XCNT(j)  (256  + 64 * (j))
#define XB_XSUB(j)  (1280 + 64 * (j))
#define XB_XGEN(j)  (2304 + 64 * (j))
#define XB_TOP      3328
#define XB_TOPGEN   3392
#define XCD_BAR_WORDS 3456
#define XB_SPIN_CAP (1u << 18)
__device__ __forceinline__ unsigned xb_ld(unsigned* p)              { return __hip_atomic_load(p, __ATOMIC_RELAXED, __HIP_MEMORY_SCOPE_AGENT); }
__device__ __forceinline__ unsigned xb_add(unsigned* p, unsigned v) { return __hip_atomic_fetch_add(p, v, __ATOMIC_RELAXED, __HIP_MEMORY_SCOPE_AGENT); }
__device__ __forceinline__ unsigned xb_xcc_id() { return (unsigned)__builtin_amdgcn_s_getreg((3 << 11) | 20) & 0xFu; }
#define XB_SPIN(cond, bar) do { unsigned _sp = 0; while (cond) { __builtin_amdgcn_s_sleep(1); \
    if ((++_sp & 255u) == 0u) { if (xb_ld(&(bar)[XB_TMO])) break; if (_sp > XB_SPIN_CAP) { atomicAdd(&(bar)[XB_TMO], 1u); break; } } } } while (0)
struct XcdBarrier { unsigned* bar; unsigned x; volatile LAS unsigned* st; };
__device__ __forceinline__ XcdBarrier xcd_barrier_post(unsigned* bar, volatile LAS unsigned* st) {
    XcdBarrier b; b.bar = bar; b.x = xb_xcc_id(); b.st = st;
    if (threadIdx.x == 0) (void)xb_add(&bar[XB_XCNT(b.x)], 1u);
    return b;
}
__device__ __forceinline__ void xcd_barrier_complete(unsigned* bar, unsigned x, unsigned& nloc, unsigned& nx) {
    const unsigned G = gridDim.x * gridDim.y * gridDim.z;
    unsigned sum, cnt, mine, sp = 0u;
    for (;;) {
        sum = 0u; cnt = 0u; mine = 0u;
#pragma unroll
        for (unsigned j = 0; j < 16; ++j) { const unsigned c = xb_ld(&bar[XB_XCNT(j)]); sum += c; cnt += (c > 0u) ? 1u : 0u; mine = (j == x) ? c : mine; }
        if (sum == G) break;
        __builtin_amdgcn_s_sleep(1);
        if ((++sp & 255u) == 0u) { if (xb_ld(&bar[XB_TMO])) break; if (sp > XB_SPIN_CAP) { atomicAdd(&bar[XB_TMO], 1u); break; } }
    }
    nloc = mine > 0u ? mine : 1u; nx = cnt > 0u ? cnt : 1u;
}
__device__ __forceinline__ void xcd_barrier(const XcdBarrier& b) {
    asm volatile("s_waitcnt vmcnt(0)" ::: "memory");
    __syncthreads();
    if (threadIdx.x == 0) {
        unsigned* bar = b.bar;
        __builtin_amdgcn_s_waitcnt(0);
        unsigned nloc = b.st[0], nx = b.st[1];
        if (nloc == 0u) { xcd_barrier_complete(bar, b.x, nloc, nx); b.st[0] = nloc; b.st[1] = nx; }
        const unsigned old = xb_add(&bar[XB_XSUB(b.x)], 1u);
        const unsigned gen = old / nloc;
        if (old + 1u == (gen + 1u) * nloc) {
            __builtin_amdgcn_fence(__ATOMIC_RELEASE, "agent");
            asm volatile("s_waitcnt vmcnt(0)" ::: "memory");
            const unsigned og = xb_add(&bar[XB_TOP], 1u);
            const unsigned tg = og / nx;
            if (og + 1u == (tg + 1u) * nx) xb_add(&bar[XB_TOPGEN], 1u);
            else XB_SPIN(xb_ld(&bar[XB_TOPGEN]) == tg, bar);
            __builtin_amdgcn_fence(__ATOMIC_ACQUIRE, "agent");
            xb_add(&bar[XB_XGEN(b.x)], 1u);
            asm volatile("s_waitcnt vmcnt(0)" ::: "memory");
        } else {
            XB_SPIN(xb_ld(&bar[XB_XGEN(b.x)]) == gen, bar);
            __builtin_amdgcn_fence(__ATOMIC_ACQUIRE, "agent");
            asm volatile("s_waitcnt vmcnt(0)" ::: "memory");
        }
    }
    __syncthreads();
}

namespace pg8 {
constexpr int BM = 256, BK = 64, HALF = 128, HTB = HALF * BK * 2, NXCD = 8, WGM = 8;
__device__ __forceinline__ int lds_byte(int r, int c) { const int st = (r >> 4) * 2 + (c >> 5), rr = r & 15, cc = c & 31, ob = rr * 64 + cc * 2; return st * 1024 + (ob ^ (((ob >> 9) & 1) << 5)); }
__device__ __forceinline__ void stage_rc(int b, int& R, int& C) { const int st = b / 1024, sb = b % 1024, swz = sb ^ (((sb >> 9) & 1) << 5); R = (st >> 1) * 16 + swz / 64; C = (st & 1) * 32 + (swz % 64) / 2; }
__device__ __forceinline__ int perm32(int rho) { const int n = rho >> 4, i = rho & 15; return 8 * (i >> 2) + 4 * n + (i & 3); }

struct Unit { int pm, pn, e, ti; };

__device__ __forceinline__ bool grid_order(int nM, int nN, int G, int c, int i, int& pm, int& pn) {
    const int nwg = nM * nN; const long L = (long)i * G + c; if (L >= nwg) return false;
    int wgid = (int)L; { const int q = nwg / NXCD, r = nwg % NXCD, xcd = wgid % NXCD, off = wgid / NXCD; wgid = (xcd < r ? xcd * (q + 1) : r * (q + 1) + (xcd - r) * q) + off; }
    const int nig = WGM * nN, gid = wgid / nig, fm = gid * WGM, gsz = (nM - fm) < WGM ? (nM - fm) : WGM;
    pm = fm + ((wgid % nig) % gsz); pn = (wgid % nig) / gsz; return true;
}
struct StaticOrder {
    int nM, nN, G, c;
    __device__ __forceinline__ bool next(int i, Unit& u) const { u.e = 0; u.ti = 0; return grid_order(nM, nN, G, c, i, u.pm, u.pn); }
};
struct SegOrder {
    int nM, nN, G, c;
    __device__ __forceinline__ bool next(int i, Unit& u) const { u.e = i & 1; u.ti = 0; return grid_order(nM, nN, G, c, i >> 1, u.pm, u.pn); }
};
constexpr int MOE_TAB_OFF = MISC_OFF + 4096;
__device__ __forceinline__ void moe_table_build(LAS unsigned char* lds, const unsigned* cnt, int tid) {
    if (tid < NE) { const int n = (int)__hip_atomic_load(cnt + 64 * tid, RLX_AGENT); ((LAS int*)(lds + MOE_TAB_OFF))[16 + tid] = n; }
    __syncthreads();
    if (tid == 0) { int acc = 0; for (int e = 0; e < NE; ++e) { acc += (((LAS int*)(lds + MOE_TAB_OFF))[16 + e] + 255) >> 8; ((LAS int*)(lds + MOE_TAB_OFF))[e] = acc; } }
    __syncthreads();
}
typedef int i32x4 __attribute__((ext_vector_type(4)));
struct MoeOrder {
    LAS unsigned char* lds; int NT, nN, G, c;
    __device__ __forceinline__ void init(LAS unsigned char* lds_, int nN_, int G_, int c_) {
        lds = lds_; NT = __builtin_amdgcn_readfirstlane(((LAS int*)(lds + MOE_TAB_OFF))[15]); nN = nN_; G = G_; c = c_; }
    __device__ __forceinline__ bool next(int i, Unit& u) const {
        if (!grid_order(NT, nN, G, c, i, u.pm, u.pn)) return false;
        int e = 0, ts = 0;
#pragma unroll
        for (int q = 0; q < 4; ++q) { const i32x4 t = ((const LAS i32x4*)(lds + MOE_TAB_OFF))[q];
#pragma unroll
            for (int j = 0; j < 4; ++j) { const bool ge = u.pm >= t[j]; e += ge ? 1 : 0; ts = ge ? t[j] : ts; } }
        u.e = __builtin_amdgcn_readfirstlane(e); u.ti = u.pm - __builtin_amdgcn_readfirstlane(ts); return true;
    }
};
struct RowsContig { static constexpr bool GATHER = false; __device__ __forceinline__ unsigned row(const Unit& u, int rr) const { return (unsigned)(u.pm * 256 + rr); } };
struct RowsGather {
    static constexpr bool GATHER = true;
    const int* rlist; LAS unsigned char* lds;
    __device__ __forceinline__ unsigned row(const Unit& u, int rr) const {
        const int n = ((LAS int*)(lds + MOE_TAB_OFF))[16 + u.e]; const int rank = u.ti * 256 + rr; const bool ok = rank < n;
        return (unsigned)rlist[(size_t)u.e * T + (ok ? rank : 0)];
    }
};

typedef int i32x4v __attribute__((ext_vector_type(4)));
typedef int i32x8 __attribute__((ext_vector_type(8)));
template <class Epi, class Sched, class AMap, bool ALIGN_EPI, bool F8 = false, bool SEG2 = false>
__device__ __forceinline__ void gemm_phase(LAS unsigned char* lds, const int tid, const bf16_t* A, const bf16_t* Bt, size_t bstride, int K, const Sched& S, const AMap& AM, const Epi& E) {
    const int wid = __builtin_amdgcn_readfirstlane(tid >> 6), lane = tid & 63, wr = wid >> 2, wc = wid & 3, fr = lane & 15, fq = lane >> 4;
    const int nt = K / BK;
    unsigned voffA[2], voffB[2];
#pragma unroll
    for (int i = 0; i < 2; ++i) { int R, C; stage_rc(tid * 16 + i * 8192, R, C); const int Rb = Epi::PERM ? ((R & ~31) + perm32(R & 31)) : R; voffA[i] = (unsigned)(R * K + C) * 2u; voffB[i] = (unsigned)(Rb * K + C) * 2u; }
    const unsigned kstep = (unsigned)(BK * 2);
    const unsigned hstep = (unsigned)HALF * (unsigned)K * 2u;
    const unsigned tstep = 2u * hstep;
    const __amdgpu_buffer_rsrc_t rsA = __builtin_amdgcn_make_buffer_rsrc((void*)A, 0, -1, 0x00020000), rsB = __builtin_amdgcn_make_buffer_rsrc((void*)Bt, 0, -1, 0x00020000);
    const unsigned ldsw = (unsigned)wid * 1024u;
    const int aoff = lds_byte(wr * 64 + fr, fq * 8), boff = lds_byte(wc * 32 + fr, fq * 8);
#define PG8_SA(b, h) (((b) * 2 + (h)) * HTB)
#define PG8_SB(b, h) ((4 + (b) * 2 + (h)) * HTB)
#define PG8_STAGE(bufoff, soffB, voff) do { _Pragma("unroll") for (int _i = 0; _i < 2; ++_i) \
        __builtin_amdgcn_raw_ptr_buffer_load_lds(rsB, (LAS unsigned*)(lds + (bufoff) + ldsw + _i * 8192), 16, (int)(voff)[_i], (int)(soffB), 0, 0); } while (0)
#define PG8_LDA(dst, b, h) do { _Pragma("unroll") for (int m = 0; m < 4; ++m) _Pragma("unroll") for (int k = 0; k < 2; ++k) dst[m][k] = *(const LAS bf16x8*)(lds + PG8_SA(b, h) + aoff + m * 2048 + k * 1024); } while (0)
#define PG8_LDB(dst, b, h) do { _Pragma("unroll") for (int n = 0; n < 2; ++n) _Pragma("unroll") for (int k = 0; k < 2; ++k) dst[n][k] = *(const LAS bf16x8*)(lds + PG8_SB(b, h) + boff + n * 2048 + k * 1024); } while (0)
#define PG8_MMA(ai, bj, At, Bt_) do { __builtin_amdgcn_s_setprio(1); _Pragma("unroll") for (int m = 0; m < 4; ++m) _Pragma("unroll") for (int n = 0; n < 2; ++n) _Pragma("unroll") for (int k = 0; k < 2; ++k) \
        acc[ai][bj][m][n] = __builtin_amdgcn_mfma_f32_16x16x32_bf16(Bt_[n][k], At[m][k], acc[ai][bj][m][n], 0, 0, 0); __builtin_amdgcn_s_setprio(0); } while (0)
#define PG8_LD8(dst, base) do { const i32x4v lo_ = *(const LAS i32x4v*)(lds + (base)); const i32x4v hi_ = *(const LAS i32x4v*)(lds + (base) + 1024); dst = __builtin_shufflevector(lo_, hi_, 0, 1, 2, 3, 4, 5, 6, 7); } while (0)
#define PG8_LDA8(dst, b, h) do { _Pragma("unroll") for (int m = 0; m < 4; ++m) PG8_LD8(dst[m], PG8_SA(b, h) + aoff + m * 2048); } while (0)
#define PG8_LDB8(dst, b, h) do { _Pragma("unroll") for (int n = 0; n < 2; ++n) PG8_LD8(dst[n], PG8_SB(b, h) + boff + n * 2048); } while (0)
#define PG8_MMA8(ai, bj, At, Bt_) do { __builtin_amdgcn_s_setprio(1); _Pragma("unroll") for (int m = 0; m < 4; ++m) _Pragma("unroll") for (int n = 0; n < 2; ++n) \
        asm volatile("v_mfma_f32_16x16x128_f8f6f4 %0, %1, %2, %0" : "+v"(acc[ai][bj][m][n]) : "v"(Bt_[n]), "v"(At[m])); __builtin_amdgcn_s_setprio(0); } while (0)
#define PG8_XLDA(b, h) do { if constexpr (F8) PG8_LDA8(At8, b, h); else PG8_LDA(At, b, h); } while (0)
#define PG8_XLDB(w, b, h) do { if constexpr (F8) { if (w == 0) PG8_LDB8(B08, b, h); else PG8_LDB8(B18, b, h); } else { if (w == 0) PG8_LDB(B0, b, h); else PG8_LDB(B1, b, h); } } while (0)
#define PG8_XMMA(ai, bj, w) do { if constexpr (F8) { if (w == 0) PG8_MMA8(ai, bj, At8, B08); else PG8_MMA8(ai, bj, At8, B18); } else { if (w == 0) PG8_MMA(ai, bj, At, B0); else PG8_MMA(ai, bj, At, B1); } } while (0)
#define PG8_WAIT_V(n) asm volatile("s_waitcnt vmcnt(" #n ")" ::: "memory")
#define PG8_WAIT_L(n) asm volatile("s_waitcnt lgkmcnt(" #n ")" ::: "memory")
#define PG8_BAR __builtin_amdgcn_s_barrier()
#define PG8_SCHED __builtin_amdgcn_sched_barrier(0)
#define PG8_OFFS(dst, u) do { _Pragma("unroll") for (int _h = 0; _h < 2; ++_h) _Pragma("unroll") for (int _i = 0; _i < 2; ++_i) { int _R, _C; stage_rc(tid * 16 + _i * 8192, _R, _C); \
        dst[_h][_i] = (AM.row(u, _h * HALF + _R) * (unsigned)K + (unsigned)_C) * 2u; } } while (0)
#define PG8_STAGE_A(bufoff, h, kb, NXT) do { if constexpr (AMap::GATHER) { _Pragma("unroll") for (int _i = 0; _i < 2; ++_i) { const unsigned _o = (NXT) ? offN[h][_i] : offC[h][_i]; \
            __builtin_amdgcn_raw_ptr_buffer_load_lds(rsA, (LAS unsigned*)(lds + (bufoff) + ldsw + _i * 8192), 16, (int)_o, (int)(kb), 0, 0); } } \
        else { const unsigned _g = ((NXT) ? nA : cA) + (h) * hstep + (kb); _Pragma("unroll") for (int _i = 0; _i < 2; ++_i) \
            __builtin_amdgcn_raw_ptr_buffer_load_lds(rsA, (LAS unsigned*)(lds + (bufoff) + ldsw + _i * 8192), 16, (int)voffA[_i], (int)_g, 0, 0); } } while (0)
    Unit cur, nxt, nn; int ui = 0; bool has_next = false, has_nn = false;
    if (!S.next(0, cur)) return;
    f32x4 acc[2][2][4][2];
#pragma unroll
    for (int a = 0; a < 2; ++a)
#pragma unroll
        for (int b = 0; b < 2; ++b)
#pragma unroll
            for (int m = 0; m < 4; ++m)
#pragma unroll
                for (int n = 0; n < 2; ++n) acc[a][b][m][n] = (f32x4){0.f, 0.f, 0.f, 0.f};
    bf16x8 At[4][2], B0[2][2], B1[2][2]; i32x8 At8[4], B08[2], B18[2];
    int sc8 = 0x7F7F7F7F; if constexpr (F8) asm volatile("" : "+v"(sc8));
#define PG8_RAW(dst, u) do { _Pragma("unroll") for (int _h = 0; _h < 2; ++_h) _Pragma("unroll") for (int _i = 0; _i < 2; ++_i) { int _R, _C; stage_rc(tid * 16 + _i * 8192, _R, _C); dst[_h][_i] = AM.row(u, _h * HALF + _R); } } while (0)
#define PG8_CONV(dst, raw) do { _Pragma("unroll") for (int _h = 0; _h < 2; ++_h) _Pragma("unroll") for (int _i = 0; _i < 2; ++_i) { int _R, _C; stage_rc(tid * 16 + _i * 8192, _R, _C); dst[_h][_i] = (raw[_h][_i] * (unsigned)K + (unsigned)_C) * 2u; } } while (0)
    unsigned offC[2][2], offN[2][2], rawN[2][2];
    if constexpr (AMap::GATHER) { PG8_OFFS(offC, cur); has_next = S.next(1, nxt);
        if (has_next) { PG8_RAW(rawN, nxt); } else {
#pragma unroll
            for (int h = 0; h < 2; ++h)
#pragma unroll
                for (int i = 0; i < 2; ++i) rawN[h][i] = 0u; } }
    unsigned cA = AMap::GATHER ? 0u : (unsigned)cur.pm * tstep + (SEG2 ? (unsigned)cur.e * 1024u : 0u), nA = cA;
    unsigned cB = (unsigned)cur.e * (SEG2 ? 1024u : (unsigned)(bstride * 2)) + (unsigned)cur.pn * tstep;
    PG8_STAGE(PG8_SB(0, 0), cB, voffB); PG8_STAGE(PG8_SB(0, 1), cB + hstep, voffB); PG8_STAGE_A(PG8_SA(0, 0), 0, 0, false); PG8_STAGE_A(PG8_SA(0, 1), 1, 0, false);
    if (wr == 1) PG8_BAR;
    PG8_WAIT_V(2); PG8_BAR;
    PG8_STAGE(PG8_SB(1, 0), cB + kstep, voffB); PG8_STAGE_A(PG8_SA(1, 0), 0, kstep, false); PG8_STAGE(PG8_SB(1, 1), cB + hstep + kstep, voffB);
    PG8_WAIT_V(6); PG8_BAR;
    for (;;) {
        if constexpr (!AMap::GATHER) has_next = S.next(ui + 1, nxt);
        if constexpr (AMap::GATHER) {
            if (has_next) { PG8_CONV(offN, rawN); }
            else {
#pragma unroll
                for (int h = 0; h < 2; ++h)
#pragma unroll
                    for (int i = 0; i < 2; ++i) offN[h][i] = offC[h][i];
            }
            has_nn = has_next && S.next(ui + 2, nn);
            if (has_nn) { PG8_RAW(rawN, nn); }
        } else { nA = has_next ? (unsigned)nxt.pm * tstep + (SEG2 ? (unsigned)nxt.e * 1024u : 0u) : cA; }
        const unsigned nB = has_next ? (unsigned)nxt.e * (SEG2 ? 1024u : (unsigned)(bstride * 2)) + (unsigned)nxt.pn * tstep : cB;
        const int ntc = SEG2 ? (cur.e ? 4 : 8) : nt;
#pragma nounroll
        for (int t = 0; t < ntc; t += 2) {
            const bool last = (t == ntc - 2);
            const unsigned k1 = (unsigned)(t + 1) * kstep, k2 = last ? 0u : (unsigned)(t + 2) * kstep, k3 = k2 + kstep;
            const unsigned b2 = last ? nB : cB + (unsigned)(t + 2) * kstep, b3 = b2 + kstep;
            PG8_XLDB(0, 0, 0); PG8_XLDB(1, 0, 1); PG8_SCHED; PG8_XLDA(0, 0); PG8_STAGE_A(PG8_SA(1, 1), 1, k1, false);
            PG8_WAIT_V(8); PG8_WAIT_L(0); PG8_BAR; PG8_XMMA(0, 0, 0); PG8_XMMA(0, 1, 1); PG8_BAR; PG8_SCHED;
            PG8_XLDA(0, 1); PG8_STAGE(PG8_SB(0, 0), b2, voffB); PG8_STAGE(PG8_SB(0, 1), b2 + hstep, voffB); PG8_STAGE_A(PG8_SA(0, 0), 0, k2, last);
            PG8_WAIT_V(8); PG8_WAIT_L(0); PG8_BAR; PG8_XMMA(1, 0, 0); PG8_XMMA(1, 1, 1); PG8_BAR; PG8_SCHED;
            PG8_XLDB(0, 1, 0); PG8_XLDB(1, 1, 1); PG8_SCHED; PG8_XLDA(1, 0); PG8_STAGE_A(PG8_SA(0, 1), 1, k2, last);
            PG8_WAIT_V(8); PG8_WAIT_L(0); PG8_BAR; PG8_XMMA(0, 0, 0); PG8_XMMA(0, 1, 1); PG8_BAR; PG8_SCHED;
            PG8_XLDA(1, 1); PG8_STAGE(PG8_SB(1, 0), b3, voffB); PG8_STAGE(PG8_SB(1, 1), b3 + hstep, voffB); PG8_STAGE_A(PG8_SA(1, 0), 0, k3, last);
            PG8_WAIT_V(8); PG8_WAIT_L(0); PG8_BAR; PG8_XMMA(1, 0, 0); PG8_XMMA(1, 1, 1); PG8_BAR; PG8_SCHED;
        }
#ifdef PROBE_EPI
        unsigned long long pe_t0 = 0; if (tid == 0) pe_t0 = __builtin_amdgcn_s_memrealtime();
#endif
        if constexpr (ALIGN_EPI) { if (wr == 0) PG8_BAR; }
        if constexpr (F8) asm volatile("s_nop 15\n\ts_nop 15" ::: "memory");
        E(acc, cur, wr, wc, fr, fq);
#ifdef PROBE_EPI
        if (tid == 0) { asm volatile("s_waitcnt vmcnt(0)" ::: "memory"); volatile LAS unsigned long long* pb_ = (volatile LAS unsigned long long*)(lds + MISC_OFF + 8192); pb_[1] = pb_[1] + (__builtin_amdgcn_s_memrealtime() - pe_t0); }
#endif
        if (!has_next) break;
        if (!(SEG2 && cur.e == 0))
#pragma unroll
        for (int a = 0; a < 2; ++a)
#pragma unroll
            for (int b = 0; b < 2; ++b)
#pragma unroll
                for (int m = 0; m < 4; ++m)
#pragma unroll
                    for (int n = 0; n < 2; ++n) acc[a][b][m][n] = (f32x4){0.f, 0.f, 0.f, 0.f};
        cur = nxt; cB = nB; cA = nA; ++ui;
        if constexpr (AMap::GATHER) { nxt = nn; has_next = has_nn;
#pragma unroll
            for (int h = 0; h < 2; ++h)
#pragma unroll
                for (int i = 0; i < 2; ++i) offC[h][i] = offN[h][i];
        }
        if constexpr (ALIGN_EPI) { if (wr == 1) PG8_BAR; }
    }
    PG8_WAIT_V(0);
    if constexpr (!ALIGN_EPI) { if (wr == 0) PG8_BAR; }
    PG8_BAR;
#undef PG8_STAGE_A
#undef PG8_LD8
#undef PG8_LDA8
#undef PG8_LDB8
#undef PG8_MMA8
#undef PG8_XLDA
#undef PG8_XLDB
#undef PG8_XMMA
#undef PG8_SA
#undef PG8_SB
#undef PG8_STAGE
#undef PG8_LDA
#undef PG8_LDB
#undef PG8_MMA
#undef PG8_WAIT_V
#undef PG8_WAIT_L
#undef PG8_BAR
#undef PG8_SCHED
#undef PG8_OFFS
#undef PG8_RAW
#undef PG8_CONV
}

#define EPI_PIN(x) asm volatile("" : "+v"(x))
#define LPIN(x) asm volatile("" : "+v"(x))
#define EPI_ROWSTEP(m) (((m) == 3) ? 80 : 16)
struct EpiProj {
    static constexpr bool PERM = true;
    bf16_t* O; const float* cs; const float* sn; float* alow; float scale;
    __device__ __forceinline__ void operator()(const f32x4 (&acc)[2][2][4][2], const Unit& u, int wr, int wc, int fr, int fq) const {
        const int row0 = u.pm * BM + wr * 64 + fr, col0 = u.pn * BM + wc * 32 + 8 * fq;
        unsigned off = (unsigned)(row0 * NP + col0) * 2u;
        if (u.pn < 12) {
            unsigned toff = (unsigned)((row0 & (SEQ - 1)) * 64 + wc * 16 + fq * 4) * 4u;
            f32x4 ct[2][4], st[2][4];
#pragma unroll
            for (int ai = 0; ai < 2; ++ai)
#pragma unroll
                for (int m = 0; m < 4; ++m) { ct[ai][m] = *(const f32x4*)((const char*)cs + toff + (ai * HALF + m * 16) * 64 * 4); st[ai][m] = *(const f32x4*)((const char*)sn + toff + (ai * HALF + m * 16) * 64 * 4); }
#pragma unroll
            for (int ai = 0; ai < 2; ++ai)
#pragma unroll
                for (int m = 0; m < 4; ++m) {
                    const f32x4 c4 = ct[ai][m], s4 = st[ai][m];
#pragma unroll
                    for (int bj = 0; bj < 2; ++bj) { const f32x4 v0 = acc[ai][bj][m][0] * scale, v1 = acc[ai][bj][m][1] * scale; u32x4 w;
                        w.x = pk2(v0[0] * c4[0] - v0[1] * s4[0], v0[1] * c4[0] + v0[0] * s4[0]);
                        w.y = pk2(v0[2] * c4[1] - v0[3] * s4[1], v0[3] * c4[1] + v0[2] * s4[1]);
                        w.z = pk2(v1[0] * c4[2] - v1[1] * s4[2], v1[1] * c4[2] + v1[0] * s4[2]);
                        w.w = pk2(v1[2] * c4[3] - v1[3] * s4[3], v1[3] * c4[3] + v1[2] * s4[3]);
                        *(u32x4*)((char*)O + off + bj * HALF * 2) = w; }
                    off += EPI_ROWSTEP(m) * NP * 2; EPI_PIN(off);
                }
        } else if (GATE_F8 && u.pn >= RB / 256 && u.pn < 46) {
            unsigned off8 = (unsigned)(row0 * NP) * 2u + (unsigned)(G8_BYTE0 + col0 - RB);
#pragma unroll
            for (int ai = 0; ai < 2; ++ai)
#pragma unroll
                for (int m = 0; m < 4; ++m) {
#pragma unroll
                    for (int bj = 0; bj < 2; ++bj) { const f32x4 v0 = acc[ai][bj][m][0] * scale, v1 = acc[ai][bj][m][1] * scale; u32x2 w;
                        w.x = pk_fp8x4(v0[0], v0[1], v0[2], v0[3]); w.y = pk_fp8x4(v1[0], v1[1], v1[2], v1[3]);
                        *(u32x2*)((char*)O + off8 + bj * HALF) = w; }
                    off8 += EPI_ROWSTEP(m) * NP * 2; EPI_PIN(off8); }
        } else if (u.pn < 46) {
#pragma unroll
            for (int ai = 0; ai < 2; ++ai)
#pragma unroll
                for (int m = 0; m < 4; ++m) {
#pragma unroll
                    for (int bj = 0; bj < 2; ++bj) { const f32x4 v0 = acc[ai][bj][m][0] * scale, v1 = acc[ai][bj][m][1] * scale; u32x4 w;
                        w.x = pk2(v0[0], v0[1]); w.y = pk2(v0[2], v0[3]); w.z = pk2(v1[0], v1[1]); w.w = pk2(v1[2], v1[3]);
                        *(u32x4*)((char*)O + off + bj * HALF * 2) = w; }
                    off += EPI_ROWSTEP(m) * NP * 2; EPI_PIN(off); }
        } else {
            if (wc == 0 && fq < 2) {
                unsigned aoff_ = (unsigned)(row0 * 16 + 8 * fq) * 4u;
#pragma unroll
                for (int ai = 0; ai < 2; ++ai)
#pragma unroll
                    for (int m = 0; m < 4; ++m) { float* rp = (float*)((char*)alow + aoff_);
                        *(f32x4*)rp = acc[ai][0][m][0] * scale; *(f32x4*)(rp + 4) = acc[ai][0][m][1] * scale;
                        aoff_ += EPI_ROWSTEP(m) * 16 * 4; EPI_PIN(aoff_); }
            }
        }
    }
};
template <bool FIRST> struct EpiGate {
    static constexpr bool PERM = true;
    bf16_t* O; const bf16_t* proj; int goff; float scale; unsigned char* O8;
    __device__ __forceinline__ void operator()(const f32x4 (&acc)[2][2][4][2], const Unit& u, int wr, int wc, int fr, int fq) const {
        const int row0 = u.pm * BM + wr * 64 + fr, col0 = u.pn * BM + wc * 32 + 8 * fq;
        const unsigned goffb = GATE_F8 ? (unsigned)(row0 * NP) * 2u + (unsigned)(G8_BYTE0 + goff - RB + col0) : (unsigned)(row0 * NP + goff + col0) * 2u, ooff = (unsigned)(row0 * D + col0) * 2u;
        u32x4 gA[2][2], gB[2][2], pA[2][2], pB[2][2];
#define EG_ROW(r) ((((r) >> 2) * 128) + (((r) & 3) * 16))
#define EG_LOAD(G, P, b) do { _Pragma("unroll") for (int rr = 0; rr < 2; ++rr) { const unsigned ro = EG_ROW(2 * (b) + rr); _Pragma("unroll") for (int bj = 0; bj < 2; ++bj) { \
            if (GATE_F8) { const u32x2 g8 = *(const u32x2*)((const char*)proj + goffb + ro * NP * 2 + bj * HALF); G[rr][bj] = (u32x4){g8.x, g8.y, 0u, 0u}; } \
            else G[rr][bj] = *(const u32x4*)((const char*)proj + goffb + ro * NP * 2 + bj * HALF * 2); \
            if (!FIRST) P[rr][bj] = *(const u32x4*)((const char*)O + ooff + ro * D * 2 + bj * HALF * 2); } } asm volatile("" ::: "memory"); } while (0)
#define EG_COMP(G, P, b) do { _Pragma("unroll") for (int rr = 0; rr < 2; ++rr) { const int r = 2 * (b) + rr, ai = r >> 2, m = r & 3; const unsigned ro = EG_ROW(r); _Pragma("unroll") for (int bj = 0; bj < 2; ++bj) { \
            const u32x4 gg = G[rr][bj]; const f32x4 v0 = acc[ai][bj][m][0] * scale, v1 = acc[ai][bj][m][1] * scale; float gf[8], r8[8]; \
            if (GATE_F8) unpack_fp8x8((u32x2){gg.x, gg.y}, gf); else { gf[0] = bflo(gg.x); gf[1] = bfhi(gg.x); gf[2] = bflo(gg.y); gf[3] = bfhi(gg.y); gf[4] = bflo(gg.z); gf[5] = bfhi(gg.z); gf[6] = bflo(gg.w); gf[7] = bfhi(gg.w); } \
            r8[0] = sigmoidf_(gf[0]) * v0[0]; r8[1] = sigmoidf_(gf[1]) * v0[1]; r8[2] = sigmoidf_(gf[2]) * v0[2]; r8[3] = sigmoidf_(gf[3]) * v0[3]; \
            r8[4] = sigmoidf_(gf[4]) * v1[0]; r8[5] = sigmoidf_(gf[5]) * v1[1]; r8[6] = sigmoidf_(gf[6]) * v1[2]; r8[7] = sigmoidf_(gf[7]) * v1[3]; \
            if (!FIRST) { const u32x4 pq = P[rr][bj]; r8[0] += bflo(pq.x); r8[1] += bfhi(pq.x); r8[2] += bflo(pq.y); r8[3] += bfhi(pq.y); r8[4] += bflo(pq.z); r8[5] += bfhi(pq.z); r8[6] += bflo(pq.w); r8[7] += bfhi(pq.w); } \
            if (!FIRST && O8) { u32x2 w8; w8.x = pk_fp8x4(r8[0], r8[1], r8[2], r8[3]); w8.y = pk_fp8x4(r8[4], r8[5], r8[6], r8[7]); *(u32x2*)(O8 + (ooff >> 1) + ro * D + bj * HALF) = w8; } \
            else { u32x4 w; w.x = pk2(r8[0], r8[1]); w.y = pk2(r8[2], r8[3]); w.z = pk2(r8[4], r8[5]); w.w = pk2(r8[6], r8[7]); *(u32x4*)((char*)O + ooff + ro * D * 2 + bj * HALF * 2) = w; } } } asm volatile("" ::: "memory"); } while (0)
        EG_LOAD(gA, pA, 0); EG_LOAD(gB, pB, 1); EG_COMP(gA, pA, 0); EG_LOAD(gA, pA, 2); EG_COMP(gB, pB, 1); EG_LOAD(gB, pB, 3); EG_COMP(gA, pA, 2); EG_COMP(gB, pB, 3);
#undef EG_LOAD
#undef EG_COMP
    }
};
struct EpiGate2 {
    static constexpr bool PERM = true;
    const bf16_t* proj; float scale; unsigned char* O8;
    __device__ __forceinline__ void operator()(f32x4 (&acc)[2][2][4][2], const Unit& u, int wr, int wc, int fr, int fq) const {
        const int row0 = u.pm * BM + wr * 64 + fr, col0 = u.pn * BM + wc * 32 + 8 * fq;
        const unsigned goffa = (unsigned)(row0 * NP) * 2u + (unsigned)(G8_BYTE0 + GA - RB + col0), ooff = (unsigned)(row0 * D + col0);
        u32x4 gA[2][2], gB[2][2];
#define EG_ROW(r) ((((r) >> 2) * 128) + (((r) & 3) * 16))
        if (u.e == 0) {
#define E2_LOAD(G, b) do { _Pragma("unroll") for (int rr = 0; rr < 2; ++rr) { const unsigned ro = EG_ROW(2 * (b) + rr); _Pragma("unroll") for (int bj = 0; bj < 2; ++bj) { \
            const u32x2 ga8 = *(const u32x2*)((const char*)proj + goffa + ro * NP * 2 + bj * HALF), gb8 = *(const u32x2*)((const char*)proj + goffa + (GB - GA) + ro * NP * 2 + bj * HALF); \
            G[rr][bj] = (u32x4){ga8.x, ga8.y, gb8.x, gb8.y}; } } asm volatile("" ::: "memory"); } while (0)
#define E2_COMP(G, b) do { _Pragma("unroll") for (int rr = 0; rr < 2; ++rr) { const int r = 2 * (b) + rr, ai = r >> 2, m = r & 3; _Pragma("unroll") for (int bj = 0; bj < 2; ++bj) { \
            const u32x4 gg = G[rr][bj]; float fa[8], fb[8]; unpack_fp8x8((u32x2){gg.x, gg.y}, fa); unpack_fp8x8((u32x2){gg.z, gg.w}, fb); \
            _Pragma("unroll") for (int j = 0; j < 8; ++j) { const float q = (1.0f + __expf(-fmaxf(fa[j], -30.0f))) * sigmoidf_(fb[j]); acc[ai][bj][m][j >> 2][j & 3] *= q; } } } } while (0)
            E2_LOAD(gA, 0); E2_LOAD(gB, 1); E2_COMP(gA, 0); E2_LOAD(gA, 2); E2_COMP(gB, 1); E2_LOAD(gB, 3); E2_COMP(gA, 2); E2_COMP(gB, 3);
#undef E2_LOAD
#undef E2_COMP
        } else {
#define E2_LOAD(G, b) do { _Pragma("unroll") for (int rr = 0; rr < 2; ++rr) { const unsigned ro = EG_ROW(2 * (b) + rr); _Pragma("unroll") for (int bj = 0; bj < 2; ++bj) { \
            const u32x2 ga8 = *(const u32x2*)((const char*)proj + goffa + ro * NP * 2 + bj * HALF); G[rr][bj] = (u32x4){ga8.x, ga8.y, 0u, 0u}; } } asm volatile("" ::: "memory"); } while (0)
#define E2_COMP(G, b) do { _Pragma("unroll") for (int rr = 0; rr < 2; ++rr) { const int r = 2 * (b) + rr, ai = r >> 2, m = r & 3; const unsigned ro = EG_ROW(r); _Pragma("unroll") for (int bj = 0; bj < 2; ++bj) { \
            const u32x4 gg = G[rr][bj]; float fa[8], r8[8]; unpack_fp8x8((u32x2){gg.x, gg.y}, fa); \
            _Pragma("unroll") for (int j = 0; j < 8; ++j) r8[j] = sigmoidf_(fmaxf(fa[j], -30.0f)) * (acc[ai][bj][m][j >> 2][j & 3] * scale); \
            u32x2 w8; w8.x = pk_fp8x4(r8[0], r8[1], r8[2], r8[3]); w8.y = pk_fp8x4(r8[4], r8[5], r8[6], r8[7]); *(u32x2*)(O8 + ooff + ro * D + bj * HALF) = w8; } } asm volatile("" ::: "memory"); } while (0)
            E2_LOAD(gA, 0); E2_LOAD(gB, 1); E2_COMP(gA, 0); E2_LOAD(gA, 2); E2_COMP(gB, 1); E2_LOAD(gB, 3); E2_COMP(gA, 2); E2_COMP(gB, 3);
#undef E2_LOAD
#undef E2_COMP
        }
#undef EG_ROW
    }
};
#define EG_ROW(r) ((((r) >> 2) * 128) + (((r) & 3) * 16))
template <bool XF32> struct EpiResid {
    static constexpr bool PERM = true;
    const void* xi; bf16_t* xo; const float* gate; float scale;
    __device__ __forceinline__ void operator()(const f32x4 (&acc)[2][2][4][2], const Unit& u, int wr, int wc, int fr, int fq) const {
        const int row0 = u.pm * BM + wr * 64 + fr, col0 = u.pn * BM + wc * 32 + 8 * fq;
        const int b = (u.pm * BM) / SEQ;
        f32x4 gt[2][2];
#pragma unroll
        for (int bj = 0; bj < 2; ++bj)
#pragma unroll
            for (int n = 0; n < 2; ++n) gt[bj][n] = *(const f32x4*)(gate + (size_t)b * 12288 + col0 + bj * HALF + 4 * n) * scale;
        const unsigned off = (unsigned)(row0 * D + col0);
        constexpr int RB_ = XF32 ? 1 : 2, NBAT = 8 / RB_;
        f32x4 xA[RB_][2][2], xB[RB_][2][2];
#define ER_LOAD(X, bb) do { _Pragma("unroll") for (int rr = 0; rr < RB_; ++rr) { const unsigned ro = EG_ROW(RB_ * (bb) + rr); _Pragma("unroll") for (int bj = 0; bj < 2; ++bj) { const unsigned o = off + ro * D + bj * HALF; \
            if (XF32) { X[rr][bj][0] = *(const f32x4*)((const float*)xi + o); X[rr][bj][1] = *(const f32x4*)((const float*)xi + o + 4); } \
            else { const u32x4 rw = *(const u32x4*)((const bf16_t*)xi + o); X[rr][bj][0] = (f32x4){bflo(rw.x), bfhi(rw.x), bflo(rw.y), bfhi(rw.y)}; X[rr][bj][1] = (f32x4){bflo(rw.z), bfhi(rw.z), bflo(rw.w), bfhi(rw.w)}; } } } asm volatile("" ::: "memory"); } while (0)
#define ER_COMP(X, bb) do { _Pragma("unroll") for (int rr = 0; rr < RB_; ++rr) { const int r = RB_ * (bb) + rr, ai = r >> 2, m = r & 3; const unsigned ro = EG_ROW(r); _Pragma("unroll") for (int bj = 0; bj < 2; ++bj) { const unsigned o = off + ro * D + bj * HALF; \
            const f32x4 v0 = X[rr][bj][0] + gt[bj][0] * acc[ai][bj][m][0], v1 = X[rr][bj][1] + gt[bj][1] * acc[ai][bj][m][1]; \
            u32x4 w; w.x = pk2(v0[0], v0[1]); w.y = pk2(v0[2], v0[3]); w.z = pk2(v1[0], v1[1]); w.w = pk2(v1[2], v1[3]); *(u32x4*)(xo + o) = w; } } asm volatile("" ::: "memory"); } while (0)
        ER_LOAD(xA, 0);
#pragma unroll
        for (int bb = 0; bb < NBAT; bb += 2) {
            ER_LOAD(xB, bb + 1); ER_COMP(xA, bb);
            if (bb + 2 < NBAT) ER_LOAD(xA, bb + 2);
            ER_COMP(xB, bb + 1); }
#undef ER_LOAD
#undef ER_COMP
#undef EG_ROW
    }
};
struct EpiSwiGLU {
    static constexpr bool PERM = true;
    bf16_t* O;
    __device__ __forceinline__ void operator()(const f32x4 (&acc)[2][2][4][2], const Unit& u, int wr, int wc, int fr, int fq) const {
        const int row0 = u.pm * BM + wr * 64 + fr, col0 = u.pn * HALF + wc * 32 + 8 * fq;
        unsigned off = (unsigned)(row0 * FF + col0) * 2u;
#pragma unroll
        for (int ai = 0; ai < 2; ++ai)
#pragma unroll
            for (int m = 0; m < 4; ++m) { const f32x4 g0 = acc[ai][0][m][0], g1 = acc[ai][0][m][1], u0 = acc[ai][1][m][0], u1 = acc[ai][1][m][1]; u32x4 w;
                w.x = pk2(siluf_(g0[0]) * u0[0], siluf_(g0[1]) * u0[1]); w.y = pk2(siluf_(g0[2]) * u0[2], siluf_(g0[3]) * u0[3]);
                w.z = pk2(siluf_(g1[0]) * u1[0], siluf_(g1[1]) * u1[1]); w.w = pk2(siluf_(g1[2]) * u1[2], siluf_(g1[3]) * u1[3]);
                *(u32x4*)((char*)O + off) = w;
                off += EPI_ROWSTEP(m) * FF * 2; EPI_PIN(off); }
    }
};
struct EpiPlain {
    static constexpr bool PERM = true;
    bf16_t* O;
    __device__ __forceinline__ void operator()(const f32x4 (&acc)[2][2][4][2], const Unit& u, int wr, int wc, int fr, int fq) const {
        const int row0 = u.pm * BM + wr * 64 + fr, col0 = u.pn * BM + wc * 32 + 8 * fq;
        unsigned off = (unsigned)(row0 * D + col0) * 2u;
#pragma unroll
        for (int ai = 0; ai < 2; ++ai)
#pragma unroll
            for (int m = 0; m < 4; ++m) {
#pragma unroll
                for (int bj = 0; bj < 2; ++bj) { const f32x4 v0 = acc[ai][bj][m][0], v1 = acc[ai][bj][m][1]; u32x4 w;
                    w.x = pk2(v0[0], v0[1]); w.y = pk2(v0[2], v0[3]); w.z = pk2(v1[0], v1[1]); w.w = pk2(v1[2], v1[3]);
                    *(u32x4*)((char*)O + off + bj * HALF * 2) = w; }
                off += EPI_ROWSTEP(m) * D * 2; EPI_PIN(off); }
    }
};
constexpr float W8_SCALE = 32.0f, W8_INV = 1.0f / 32.0f;
struct EpiSwiGLU8 {
    static constexpr bool PERM = true;
    unsigned char* O;
    __device__ __forceinline__ void operator()(const f32x4 (&acc)[2][2][4][2], const Unit& u, int wr, int wc, int fr, int fq) const {
        const int row0 = u.pm * BM + wr * 64 + fr, col0 = u.pn * HALF + wc * 32 + 8 * fq;
        unsigned off = (unsigned)(row0 * FF + col0);
#pragma unroll
        for (int ai = 0; ai < 2; ++ai)
#pragma unroll
            for (int m = 0; m < 4; ++m) { const f32x4 g0 = acc[ai][0][m][0] * W8_INV, g1 = acc[ai][0][m][1] * W8_INV, u0 = acc[ai][1][m][0] * W8_INV, u1 = acc[ai][1][m][1] * W8_INV; u32x2 w;
                w.x = pk_fp8x4(siluf_(g0[0]) * u0[0], siluf_(g0[1]) * u0[1], siluf_(g0[2]) * u0[2], siluf_(g0[3]) * u0[3]);
                w.y = pk_fp8x4(siluf_(g1[0]) * u1[0], siluf_(g1[1]) * u1[1], siluf_(g1[2]) * u1[2], siluf_(g1[3]) * u1[3]);
                *(u32x2*)(O + off) = w;
                off += EPI_ROWSTEP(m) * FF; EPI_PIN(off); }
    }
};
struct EpiPlainS {
    static constexpr bool PERM = true;
    bf16_t* O; float scale;
    __device__ __forceinline__ void operator()(const f32x4 (&acc)[2][2][4][2], const Unit& u, int wr, int wc, int fr, int fq) const {
        const int row0 = u.pm * BM + wr * 64 + fr, col0 = u.pn * BM + wc * 32 + 8 * fq;
        unsigned off = (unsigned)(row0 * D + col0) * (Y_F8 ? 1u : 2u);
#pragma unroll
        for (int ai = 0; ai < 2; ++ai)
#pragma unroll
            for (int m = 0; m < 4; ++m) {
#pragma unroll
                for (int bj = 0; bj < 2; ++bj) { const f32x4 v0 = acc[ai][bj][m][0] * scale, v1 = acc[ai][bj][m][1] * scale;
#if Y_F8
                    u32x2 w; w.x = pk_fp8x4(v0[0], v0[1], v0[2], v0[3]); w.y = pk_fp8x4(v1[0], v1[1], v1[2], v1[3]);
                    *(u32x2*)((char*)O + off + bj * HALF) = w;
#else
                    u32x4 w; w.x = pk2(v0[0], v0[1]); w.y = pk2(v0[2], v0[3]); w.z = pk2(v1[0], v1[1]); w.w = pk2(v1[2], v1[3]);
                    *(u32x4*)((char*)O + off + bj * HALF * 2) = w;
#endif
                }
                off += EPI_ROWSTEP(m) * D * (Y_F8 ? 1 : 2); EPI_PIN(off); }
    }
};
}

struct Args {
    const float* x; const float* c; const float* w_ada; const float* b_ada; const float* norm_mix; const float* norm_ffn; const float* w_in;
    const float* w_alpha2; const float* b_alpha2; const float* gla_gain; const float* w_out_a; const float* w_out_b; const float* w_out;
    const float* w_router; const float* b_router; const float* w_gate_e; const float* w_up_e; const float* w_down_e; const float* final_norm;
    float* out; unsigned char* ws; int ph_lo, ph_hi;
};

__device__ __forceinline__ int proj_src_col(int n) {
    if (n < 3072) { const int blk = n >> 7, w = n & 127; return (blk << 7) + (w >> 1) + ((w & 1) << 6); }
    if (n < 7680) return n;
    if (n < 11776) return n + 16;
    if (n < 11792) return n - 4096;
    return -1;
}
struct TrDesc { const float* src; unsigned char* dst; int ldw, K, zero, rope, f8; };
__device__ __forceinline__ void tr_load(const TrDesc& d, f32x4 (&v)[16]) {
#pragma unroll
    for (int i = 0; i < 16; ++i) v[i] = *(const f32x4*)(d.src + (size_t)(4 * i) * d.ldw);
}
__device__ __forceinline__ void tr_finish(const TrDesc& d, f32x4 (&v)[16], LAS float* scr, int lane) {
    const int kk = lane >> 4, q4 = lane & 15;
    if (d.zero) {
#pragma unroll
        for (int i = 0; i < 16; ++i) v[i] = (f32x4){0.f, 0.f, 0.f, 0.f}; }
    const int d0 = d.rope ? 8 * (q4 & 7) + (q4 >> 3) : 4 * q4, ds = d.rope ? 2 : 1;
    { LAS float* rp = scr + kk * 65 + d0;
#pragma unroll
        for (int i = 0; i < 16; ++i) { rp[4 * i * 65] = v[i][0]; rp[4 * i * 65 + ds] = v[i][1]; rp[4 * i * 65 + 2 * ds] = v[i][2]; rp[4 * i * 65 + 3 * ds] = v[i][3]; } }
    LDS_WAIT(); asm volatile("" ::: "memory");
    if (d.f8) {
        const int c = lane & 3, nl = lane >> 2; const LAS float* sp = scr + (16 * c) * 65 + nl; unsigned char* dp = d.dst + (size_t)nl * d.K + 16 * c;
#pragma unroll
        for (int j = 0; j < 4; ++j) { u32x4 o;
            o.x = pk_fp8x4(sp[0 * 65 + 16 * j] * 32.0f, sp[1 * 65 + 16 * j] * 32.0f, sp[2 * 65 + 16 * j] * 32.0f, sp[3 * 65 + 16 * j] * 32.0f);
            o.y = pk_fp8x4(sp[4 * 65 + 16 * j] * 32.0f, sp[5 * 65 + 16 * j] * 32.0f, sp[6 * 65 + 16 * j] * 32.0f, sp[7 * 65 + 16 * j] * 32.0f);
            o.z = pk_fp8x4(sp[8 * 65 + 16 * j] * 32.0f, sp[9 * 65 + 16 * j] * 32.0f, sp[10 * 65 + 16 * j] * 32.0f, sp[11 * 65 + 16 * j] * 32.0f);
            o.w = pk_fp8x4(sp[12 * 65 + 16 * j] * 32.0f, sp[13 * 65 + 16 * j] * 32.0f, sp[14 * 65 + 16 * j] * 32.0f, sp[15 * 65 + 16 * j] * 32.0f);
            *(GAS u32x4*)(dp + (size_t)(16 * j) * d.K) = o; }
    } else {
        const int c = lane & 7, nl = lane >> 3; const LAS float* sp = scr + (8 * c) * 65 + nl; unsigned char* dp = d.dst + ((size_t)nl * d.K + 8 * c) * 2;
#pragma unroll
        for (int j = 0; j < 8; ++j) { u32x4 o;
            o.x = pk2(sp[0 * 65 + 8 * j], sp[1 * 65 + 8 * j]); o.y = pk2(sp[2 * 65 + 8 * j], sp[3 * 65 + 8 * j]); o.z = pk2(sp[4 * 65 + 8 * j], sp[5 * 65 + 8 * j]); o.w = pk2(sp[6 * 65 + 8 * j], sp[7 * 65 + 8 * j]);
            *(GAS u32x4*)(dp + (size_t)(8 * j) * d.K * 2) = o; }
    }
    LDS_WAIT(); asm volatile("" ::: "memory");
}

typedef const __attribute__((address_space(4))) Args CArgsP;
__device__ __forceinline__ void prologue_phase(CArgsP* ap_, LAS unsigned char* lds, int vcu, int G, int tid, int wave, int lane, int parts = 7) {
#define a (*ap_)
    unsigned char* ws = a.ws;
    if (parts & 1) {
        LAS float* cact = (LAS float*)lds;
        LAS float* red = (LAS float*)(lds + 65536);
        for (int i = tid; i < NB * D; i += NTHREADS) { const int b = i >> 11, k = i & 2047; cact[k * 8 + b] = siluf_(a.c[i]); }
        __syncthreads();
        float* ada = (float*)(ws + WS_ADA);
        const int q = tid & 7, kg = tid >> 3;
        for (int u = vcu; u < DEPTH * 384; u += G) {
            const int l = u / 384, n0 = (u % 384) * 32;
            const float* W = a.w_ada + (size_t)l * D * 12288 + n0 + 4 * q;
            f32x4 acc[8];
#pragma unroll
            for (int b = 0; b < 8; ++b) acc[b] = (f32x4){0.f, 0.f, 0.f, 0.f};
            f32x4 wv[32];
#pragma unroll
            for (int kk = 0; kk < 32; ++kk) wv[kk] = *(const f32x4*)(W + (size_t)(kg * 32 + kk) * 12288);
            asm volatile("" ::: "memory");
#pragma unroll
            for (int kk = 0; kk < 32; ++kk) { const int k = kg * 32 + kk; const f32x4 w = wv[kk];
                const f32x4 c0 = *(const LAS f32x4*)(cact + k * 8), c1 = *(const LAS f32x4*)(cact + k * 8 + 4);
                acc[0] += w * c0[0]; acc[1] += w * c0[1]; acc[2] += w * c0[2]; acc[3] += w * c0[3];
                acc[4] += w * c1[0]; acc[5] += w * c1[1]; acc[6] += w * c1[2]; acc[7] += w * c1[3]; }
#pragma unroll
            for (int b = 0; b < 8; ++b) *(LAS f32x4*)(red + (kg * 8 + b) * 32 + 4 * q) = acc[b];
            __syncthreads();
            if (tid < 256) { const int b = tid >> 5, col = tid & 31; float s = a.b_ada[(size_t)l * 12288 + n0 + col];
                for (int g = 0; g < 64; ++g) s += red[(g * 8 + b) * 32 + col];
                const int n = n0 + col;
                if (n >= 2048 && n < 4096) s = (1.0f + s) * a.norm_mix[(size_t)l * D + n - 2048]; else if (n >= 8192 && n < 10240) s = (1.0f + s) * a.norm_ffn[(size_t)l * D + n - 8192];
                ada[((size_t)l * NB + b) * 12288 + n] = s; }
            __syncthreads();
        }
    }
    if (parts & 2) {
        float* cs = (float*)(ws + WS_ROPE); float* sn = cs + SEQ * 64;
        for (int i = vcu * NTHREADS + tid; i < SEQ * 64; i += G * NTHREADS) {
            const int pos = i >> 6, fi = i & 63;
            double f = 1.0;
            if (fi & 1) f *= 0.8659643233600653; if (fi & 2) f *= 0.7498942093324558; if (fi & 4) f *= 0.5623413251903491;
            if (fi & 8) f *= 0.31622776601683794; if (fi & 16) f *= 0.09999999999999999; if (fi & 32) f *= 0.009999999999999998;
            double rev = (double)pos * f * 0.15915494309189535; rev -= __builtin_floor(rev);
            const float rv = (float)rev;
            cs[i] = __builtin_amdgcn_cosf(rv); sn[i] = __builtin_amdgcn_sinf(rv);
        }
    }
    if (parts & 4) {
        LAS float* scr = (LAS float*)(lds + wave * 16640);
        const int gw = vcu * NWAVES + wave, NGW = G * NWAVES;
        constexpr int C_IN = 32 * 188, C_OA = 8 * 32, C_OB = 16 * 32, C_O = 32 * 32, C_GU = 16 * 32 * 32, C_DN = 16 * 16 * 32, C_L = C_IN + C_OA + C_OB + C_O + C_GU + C_DN, NIT = DEPTH * C_L;
        const int q4 = lane & 15, kk = lane >> 4;
        auto decode = [&](int it) -> TrDesc {
            TrDesc d; d.zero = 0; d.rope = 0; d.f8 = 0;
            const int l = it / C_L; int r = it % C_L;
            const float* W; unsigned char* WT; int ldw, K, k0, n0, scol, esz = 2;
            if (r < C_IN) { const int kb = r / 188, nb = r % 188; n0 = 64 * nb; k0 = 64 * kb; ldw = NIN; K = D; W = a.w_in + (size_t)l * D * NIN;
                if (n0 < 3072) { d.rope = 1; scol = (n0 >> 7) * 128 + 32 * ((n0 >> 6) & 1) + 64 * (q4 >> 3) + 4 * (q4 & 7); }
                else if (n0 < 7680) scol = n0 + 4 * q4;
                else if (n0 < 11776) scol = n0 + 16 + 4 * q4;
                else if (n0 == 11776) { scol = (q4 < 4) ? 7680 + 4 * q4 : 0; d.zero = (q4 < 4) ? 0 : 1; }
                else { scol = 0; d.zero = 1; }
#if PROJ_F8
                d.f8 = 1; esz = 1; WT = ws + WS_WIN + (size_t)l * NP * D;
#else
                WT = ws + WS_WIN + (size_t)l * NP * D * 2;
#endif
            } else if ((r -= C_IN) < C_OA) { const int kb = r / 32, nb = r % 32; n0 = 64 * nb; k0 = 64 * kb; ldw = D; K = 512; scol = n0 + 4 * q4; W = a.w_out_a + (size_t)l * 512 * D; WT = ws + WS_WOA + (size_t)l * D * 512 * (MIX_F8 ? 1 : 2); if (MIX_F8) { d.f8 = 1; esz = 1; }
                if (BR_FUSE) { K = 1536; WT = ws + WS_WOA + (size_t)l * D * 1536 + 1024; }
            } else if ((r -= C_OA) < C_OB) { const int kb = r / 32, nb = r % 32; n0 = 64 * nb; k0 = 64 * kb; ldw = D; K = 1024; scol = n0 + 4 * q4; W = a.w_out_b + (size_t)l * 1024 * D; WT = ws + WS_WOB + (size_t)l * D * 1024 * (MIX_F8 ? 1 : 2); if (MIX_F8) { d.f8 = 1; esz = 1; }
                if (BR_FUSE) { K = 1536; WT = ws + WS_WOA + (size_t)l * D * 1536; }
            } else if ((r -= C_OB) < C_O) { const int kb = r / 32, nb = r % 32; n0 = 64 * nb; k0 = 64 * kb; ldw = D; K = D; scol = n0 + 4 * q4; W = a.w_out + (size_t)l * D * D; WT = ws + WS_WO + (size_t)l * D * D * (MIX_F8 ? 1 : 2); if (MIX_F8) { d.f8 = 1; esz = 1; }
            } else if ((r -= C_O) < C_GU) { const int e = r / 1024, r2 = r % 1024, kb = r2 / 32, nb = r2 % 32, pn = nb >> 2, sgu = (nb >> 1) & 1, c0 = 64 * (nb & 1);
                n0 = 64 * nb; k0 = 64 * kb; ldw = FF; K = D; scol = 128 * pn + c0 + 4 * q4; W = (sgu ? a.w_up_e : a.w_gate_e) + (size_t)(l * NE + e) * D * FF; WT = ws + WS_WGU + (size_t)(l * NE + e) * 2048 * D; d.f8 = 1; esz = 1;
            } else { r -= C_GU; const int e = r / 512, r2 = r % 512, kb = r2 / 32, nb = r2 % 32;
                n0 = 64 * nb; k0 = 64 * kb; ldw = D; K = FF; scol = n0 + 4 * q4; W = a.w_down_e + (size_t)(l * NE + e) * FF * D; WT = ws + WS_WDN + (size_t)(l * NE + e) * D * FF; d.f8 = 1; esz = 1; }
            d.src = W + (size_t)(k0 + kk) * ldw + scol; d.ldw = ldw; d.K = K; d.dst = WT + ((size_t)n0 * K + k0) * esz;
            return d; };
        int it = gw; TrDesc dA, dB; f32x4 vA[16], vB[16];
        if (it < NIT) {
            dA = decode(it); tr_load(dA, vA);
            for (;;) {
                const int itB = it + NGW; const bool hB = itB < NIT;
                dB = decode(hB ? itB : it); tr_load(dB, vB);
                tr_finish(dA, vA, scr, lane);
                if (!hB) break;
                const int itA = itB + NGW; const bool hA = itA < NIT;
                dA = decode(hA ? itA : itB); tr_load(dA, vA);
                tr_finish(dB, vB, scr, lane);
                if (!hA) break;
                it = itA;
            }
        }
    }
}
#undef a

struct MoeStarts {
    int ts[NE];
    __device__ __forceinline__ void init(const unsigned* cnt) { int acc = 0;
#pragma unroll
        for (int e = 0; e < NE; ++e) { ts[e] = acc; acc += ((int)__hip_atomic_load(cnt + 64 * e, RLX_AGENT) + 255) >> 8; } }
    __device__ __forceinline__ int row(int slot) const { const int e = slot >> 16; int t0 = 0;
#pragma unroll
        for (int j = 0; j < NE; ++j) t0 = (e == j) ? ts[j] : t0;
        return t0 * 256 + (slot & 0xffff); }
};

template <int MODE>
__device__ __forceinline__ void norm_phase(const void* xs, void* xd, bf16_t* hout, const float* gain, const float* ada_scale, const float* ada_shift, const float* ada_gate2,
                                           const bf16_t* Y, const int* tslot, const float* tw, const unsigned* cnt, int vcu, int G, int wave, int lane) {
    const int gw = vcu * NWAVES + wave, NGW = G * NWAVES, rpw = T / NGW;
    MoeStarts ms; if (MODE != 0) ms.init(cnt);
    int tsl = 0; float twl = 0.f;
    if (MODE != 0) { const int i0 = gw * rpw * 2, ii = (i0 + lane < 2 * T) ? i0 + lane : 2 * T - 1; tsl = tslot[ii]; twl = tw[ii]; }
    for (int k = 0; k < rpw; k += 2) {
        const int row = gw * rpw + k, b = row >> 11;
        f32x4 v[2][8]; u32x2 xraw[2][8];
        int s0[2], s1[2]; float w0[2], w1[2];
        if (MODE != 0) {
#pragma unroll
            for (int rr = 0; rr < 2; ++rr) { s0[rr] = __builtin_amdgcn_readlane(tsl, (k + rr) * 2); s1[rr] = __builtin_amdgcn_readlane(tsl, (k + rr) * 2 + 1);
                w0[rr] = __builtin_bit_cast(float, __builtin_amdgcn_readlane(__builtin_bit_cast(int, twl), (k + rr) * 2)); w1[rr] = __builtin_bit_cast(float, __builtin_amdgcn_readlane(__builtin_bit_cast(int, twl), (k + rr) * 2 + 1)); } }
#pragma unroll
        for (int rr = 0; rr < 2; ++rr) {
            if (MODE == 0) { const GAS f32x4* xr = (const GAS f32x4*)((const float*)xs + (size_t)(row + rr) * D) + lane;
#pragma unroll
                for (int j = 0; j < 8; ++j) v[rr][j] = xr[64 * j];
            } else { const GAS u32x2* xr = (const GAS u32x2*)((const bf16_t*)xs + (size_t)(row + rr) * D) + lane;
#pragma unroll
                for (int j = 0; j < 8; ++j) xraw[rr][j] = xr[64 * j]; } }
        f32x4 ggv[8], ssv[8], scv[8];
#define GSS_LOAD() do { const GAS f32x4* gn_ = (const GAS f32x4*)gain + lane; \
            if (MODE == 2) { _Pragma("unroll") for (int j = 0; j < 8; ++j) { ggv[j] = gn_[64 * j]; scv[j] = (f32x4){0.f, 0.f, 0.f, 0.f}; ssv[j] = (f32x4){0.f, 0.f, 0.f, 0.f}; } } \
            else { const GAS f32x4* sc_ = (const GAS f32x4*)(ada_scale + (size_t)b * 12288) + lane; const GAS f32x4* sh_ = (const GAS f32x4*)(ada_shift + (size_t)b * 12288) + lane; \
                _Pragma("unroll") for (int j = 0; j < 8; ++j) { ggv[j] = sc_[64 * j]; scv[j] = (f32x4){0.f, 0.f, 0.f, 0.f}; ssv[j] = sh_[64 * j]; } } asm volatile("" ::: "memory"); } while (0)
        if (MODE == 0) GSS_LOAD();
        if (MODE != 0) {
            const GAS f32x4* gt = (const GAS f32x4*)(ada_gate2 + (size_t)b * 12288) + lane;
#if Y_F8
            unsigned ya[2][8], yb[2][8];
#pragma unroll
            for (int rr = 0; rr < 2; ++rr) { const GAS unsigned* y0 = (const GAS unsigned*)((const unsigned char*)Y + (size_t)ms.row(s0[rr]) * D) + lane; const GAS unsigned* y1 = (const GAS unsigned*)((const unsigned char*)Y + (size_t)ms.row(s1[rr]) * D) + lane;
#pragma unroll
                for (int j = 0; j < 8; ++j) { ya[rr][j] = y0[64 * j]; yb[rr][j] = y1[64 * j]; } }
            f32x4 gtv[8];
#pragma unroll
            for (int j = 0; j < 8; ++j) gtv[j] = gt[64 * j];
            asm volatile("" ::: "memory");
#pragma unroll
            for (int rr = 0; rr < 2; ++rr)
#pragma unroll
                for (int j = 0; j < 8; ++j) { LPIN(xraw[rr][j]); LPIN(ya[rr][j]); LPIN(yb[rr][j]); }
#pragma unroll
            for (int j = 0; j < 8; ++j) LPIN(gtv[j]);
#pragma unroll
            for (int rr = 0; rr < 2; ++rr)
#pragma unroll
                for (int j = 0; j < 8; ++j) { const u32x2 r = xraw[rr][j]; v[rr][j] = (f32x4){bflo(r.x), bfhi(r.x), bflo(r.y), bfhi(r.y)}; }
#pragma unroll
            for (int j = 0; j < 8; ++j) { const f32x4 g = gtv[j];
#pragma unroll
                for (int rr = 0; rr < 2; ++rr) {
                    const f32x2_t a0l = __builtin_amdgcn_cvt_pk_f32_fp8((int)ya[rr][j], false), a0h = __builtin_amdgcn_cvt_pk_f32_fp8((int)ya[rr][j], true), a1l = __builtin_amdgcn_cvt_pk_f32_fp8((int)yb[rr][j], false), a1h = __builtin_amdgcn_cvt_pk_f32_fp8((int)yb[rr][j], true);
                    f32x4 m; m[0] = w0[rr] * a0l[0] + w1[rr] * a1l[0]; m[1] = w0[rr] * a0l[1] + w1[rr] * a1l[1]; m[2] = w0[rr] * a0h[0] + w1[rr] * a1h[0]; m[3] = w0[rr] * a0h[1] + w1[rr] * a1h[1];
                    v[rr][j] = v[rr][j] + g * m; } }
#else
            u32x2 ya[2][8], yb[2][8];
#pragma unroll
            for (int rr = 0; rr < 2; ++rr) { const GAS u32x2* y0 = (const GAS u32x2*)(Y + (size_t)ms.row(s0[rr]) * D) + lane; const GAS u32x2* y1 = (const GAS u32x2*)(Y + (size_t)ms.row(s1[rr]) * D) + lane;
#pragma unroll
                for (int j = 0; j < 8; ++j) { ya[rr][j] = y0[64 * j]; yb[rr][j] = y1[64 * j]; } }
#pragma unroll
            for (int j = 0; j < 8; ++j) { const f32x4 g = gt[64 * j];
#pragma unroll
                for (int rr = 0; rr < 2; ++rr) { const u32x2 a0 = ya[rr][j], a1 = yb[rr][j];
                    f32x4 m; m[0] = w0[rr] * bflo(a0.x) + w1[rr] * bflo(a1.x); m[1] = w0[rr] * bfhi(a0.x) + w1[rr] * bfhi(a1.x); m[2] = w0[rr] * bflo(a0.y) + w1[rr] * bflo(a1.y); m[3] = w0[rr] * bfhi(a0.y) + w1[rr] * bfhi(a1.y);
                    v[rr][j] = v[rr][j] + g * m; } }
#endif
            GSS_LOAD();
            if (MODE == 1) {
#pragma unroll
                for (int rr = 0; rr < 2; ++rr) { GAS u32x2* xw = (GAS u32x2*)((bf16_t*)xd + (size_t)(row + rr) * D) + lane;
#pragma unroll
                    for (int j = 0; j < 8; ++j) { u32x2 w; w.x = pk2(v[rr][j][0], v[rr][j][1]); w.y = pk2(v[rr][j][2], v[rr][j][3]); xw[64 * j] = w; } } }
        }
        float rstd[2];
#pragma unroll
        for (int rr = 0; rr < 2; ++rr) { float s = 0.f;
#pragma unroll
            for (int j = 0; j < 8; ++j) s += (v[rr][j][0] * v[rr][j][0] + v[rr][j][1] * v[rr][j][1]) + (v[rr][j][2] * v[rr][j][2] + v[rr][j][3] * v[rr][j][3]);
            rstd[rr] = 1.0f / sqrtf(wave_sum(s, lane) * (1.0f / D) + NORM_EPS); }
        if (MODE == 2) {
#pragma unroll
            for (int j = 0; j < 8; ++j) { const f32x4 gg = ggv[j];
#pragma unroll
                for (int rr = 0; rr < 2; ++rr) ((GAS f32x4*)((float*)xd + (size_t)(row + rr) * D) + lane)[64 * j] = v[rr][j] * rstd[rr] * gg; }
        } else {
#pragma unroll
            for (int j = 0; j < 8; ++j) { const f32x4 gg = ggv[j] * (scv[j] + 1.0f), ss = ssv[j];
#pragma unroll
                for (int rr = 0; rr < 2; ++rr) { const f32x4 hh = v[rr][j] * rstd[rr] * gg + ss;
#if PROJ_F8
                    ((GAS unsigned*)((unsigned char*)hout + (size_t)(row + rr) * D) + lane)[64 * j] = pk_fp8x4_ns(hh[0], hh[1], hh[2], hh[3]);
#else
                    u32x2 w; w.x = pk2(hh[0], hh[1]); w.y = pk2(hh[2], hh[3]); ((GAS u32x2*)(hout + (size_t)(row + rr) * D) + lane)[64 * j] = w;
#endif
                } }
        }
    }
}

__device__ __forceinline__ float reduce16(const float (&p)[NE], int lane) {
    float q[8], r[4], s2[2];
    const bool h5 = (lane & 32) != 0, h4 = (lane & 16) != 0, h3 = (lane & 8) != 0, h2 = (lane & 4) != 0;
#pragma unroll
    for (int i = 0; i < 8; ++i) q[i] = (h5 ? p[i + 8] : p[i]) + sx<32>(h5 ? p[i] : p[i + 8], lane);
#pragma unroll
    for (int i = 0; i < 4; ++i) r[i] = (h4 ? q[i + 4] : q[i]) + sx<16>(h4 ? q[i] : q[i + 4], lane);
#pragma unroll
    for (int i = 0; i < 2; ++i) s2[i] = (h3 ? r[i + 2] : r[i]) + sx<8>(h3 ? r[i] : r[i + 2], lane);
    float t = (h2 ? s2[1] : s2[0]) + sx<4>(h2 ? s2[0] : s2[1], lane);
    t += sx<2>(t, lane); t += sx<1>(t, lane);
    return t;
}
__device__ __forceinline__ void route_token(float affl, float sell, int& i0, int& i1, float& w0, float& w1) {
    float aff[NE], sel[NE];
#pragma unroll
    for (int e = 0; e < NE; ++e) { aff[e] = __builtin_bit_cast(float, __builtin_amdgcn_readlane(__builtin_bit_cast(int, affl), 4 * e)); sel[e] = __builtin_bit_cast(float, __builtin_amdgcn_readlane(__builtin_bit_cast(int, sell), 4 * e)); }
    float gs[4];
#pragma unroll
    for (int g = 0; g < 4; ++g) { const float a = sel[4 * g], b = sel[4 * g + 1], c = sel[4 * g + 2], d = sel[4 * g + 3];
        const float h1 = fmaxf(a, b), l1 = fminf(a, b), h2 = fmaxf(c, d), l2 = fminf(c, d);
        gs[g] = fmaxf(h1, h2) + fmaxf(fminf(h1, h2), fmaxf(l1, l2)); }
    int bg = 0; float best = gs[0];
#pragma unroll
    for (int g = 1; g < 4; ++g) { const bool c = gs[g] > best; best = c ? gs[g] : best; bg = c ? g : bg; }
    float s0 = -3.0e38f, s1 = -3.0e38f, a0 = 0.f, a1 = 0.f; int j0 = 0, j1 = 0;
#pragma unroll
    for (int j = 0; j < 4; ++j) {
        const float v = bg == 0 ? sel[j] : (bg == 1 ? sel[4 + j] : (bg == 2 ? sel[8 + j] : sel[12 + j]));
        const float af = bg == 0 ? aff[j] : (bg == 1 ? aff[4 + j] : (bg == 2 ? aff[8 + j] : aff[12 + j]));
        const bool gt0 = v > s0, gt1 = v > s1;
        s1 = gt0 ? s0 : (gt1 ? v : s1); j1 = gt0 ? j0 : (gt1 ? j : j1); a1 = gt0 ? a0 : (gt1 ? af : a1);
        s0 = gt0 ? v : s0; j0 = gt0 ? j : j0; a0 = gt0 ? af : a0; }
    i0 = 4 * bg + j0; i1 = 4 * bg + j1;
    const float inv = 1.0f / (a0 + a1); w0 = a0 * inv; w1 = a1 * inv;
}
__device__ __forceinline__ void router_phase(const bf16_t* xs, bf16_t* hout, const float* gain, const float* ada_scale, const float* ada_shift, const float* w_router, const float* b_router,
                                             unsigned* cnt, int* rlist, int* tslot, float* tw, LAS unsigned char* lds, int vcu, int G, int tid, int wave, int lane) {
    LAS float* wrT = (LAS float*)lds;
    LAS int* misc = (LAS int*)(lds + MISC_OFF + 64);
    LAS int* lcnt = misc; LAS int* lbase = misc + 16; LAS int* rinfo = misc + 32;
    {
        f32x4 wq[4][4];
#pragma unroll
        for (int i = 0; i < 4; ++i) { const int c = tid + i * NTHREADS;
#pragma unroll
            for (int q = 0; q < 4; ++q) wq[i][q] = *(const f32x4*)(w_router + c * 16 + 4 * q); }
        asm volatile("" ::: "memory");
#pragma unroll
        for (int i = 0; i < 4; ++i) { const int c = tid + i * NTHREADS;
#pragma unroll
            for (int q = 0; q < 4; ++q)
#pragma unroll
                for (int e = 0; e < 4; ++e) wrT[(4 * q + e) * D + c] = wq[i][q][e]; } }
    const int rows_per_blk = T / G;
    for (int base = vcu * rows_per_blk; base < T; base += G * rows_per_blk) {
        if (tid < 16) lcnt[tid] = 0;
        __syncthreads();
        const int rpw = rows_per_blk / NWAVES;
        for (int k = 0; k < rpw; k += 2) {
            const int lr = wave * rpw + k, row = base + lr, b = row >> 11;
            f32x4 v[2][8]; float rstd[2];
#pragma unroll
            for (int rr = 0; rr < 2; ++rr) { const GAS u32x2* xr = (const GAS u32x2*)(xs + (size_t)(row + rr) * D) + lane;
#pragma unroll
                for (int j = 0; j < 8; ++j) { const u32x2 r = xr[64 * j]; v[rr][j] = (f32x4){bflo(r.x), bfhi(r.x), bflo(r.y), bfhi(r.y)}; } }
            f32x4 ggv[8], ssv[8];
            { const GAS f32x4* sc = (const GAS f32x4*)(ada_scale + (size_t)b * 12288) + lane; const GAS f32x4* sh = (const GAS f32x4*)(ada_shift + (size_t)b * 12288) + lane;
#pragma unroll
              for (int j = 0; j < 8; ++j) { ggv[j] = sc[64 * j]; ssv[j] = sh[64 * j]; }
              asm volatile("" ::: "memory"); }
#pragma unroll
            for (int rr = 0; rr < 2; ++rr) { float s = 0.f;
#pragma unroll
                for (int j = 0; j < 8; ++j) s += (v[rr][j][0] * v[rr][j][0] + v[rr][j][1] * v[rr][j][1]) + (v[rr][j][2] * v[rr][j][2] + v[rr][j][3] * v[rr][j][3]);
                rstd[rr] = 1.0f / sqrtf(wave_sum(s, lane) * (1.0f / D) + NORM_EPS); }
#pragma unroll
            for (int jb = 0; jb < 8; jb += 4) {
#pragma unroll
                for (int jj = 0; jj < 4; ++jj) { const int j = jb + jj; const f32x4 gg = ggv[j], ss = ssv[j];
#pragma unroll
                    for (int rr = 0; rr < 2; ++rr) { v[rr][j] = v[rr][j] * rstd[rr] * gg + ss;
                        ((GAS unsigned*)((unsigned char*)hout + (size_t)(row + rr) * D) + lane)[64 * j] = pk_fp8x4_ns(v[rr][j][0], v[rr][j][1], v[rr][j][2], v[rr][j][3]); } }
                asm volatile("" ::: "memory"); }
            float p0[NE], p1[NE];
            f32x4 wA[8], wB[8];
#define RT_RD(W, e) do { _Pragma("unroll") for (int j = 0; j < 8; ++j) W[j] = *(const LAS f32x4*)(wrT + (e) * D + 4 * lane + 256 * j); asm volatile("" ::: "memory"); } while (0)
#define RT_FMA(W, e) do { f32x2 a0 = {0.f, 0.f}, a1 = {0.f, 0.f}; _Pragma("unroll") for (int j = 0; j < 8; ++j) { LPIN(W[j]); const f32x2 wl = {W[j][0], W[j][1]}, wh = {W[j][2], W[j][3]}; \
                a0 = __builtin_elementwise_fma((f32x2){v[0][j][0], v[0][j][1]}, wl, a0); a0 = __builtin_elementwise_fma((f32x2){v[0][j][2], v[0][j][3]}, wh, a0); \
                a1 = __builtin_elementwise_fma((f32x2){v[1][j][0], v[1][j][1]}, wl, a1); a1 = __builtin_elementwise_fma((f32x2){v[1][j][2], v[1][j][3]}, wh, a1); } \
                p0[e] = a0[0] + a0[1]; p1[e] = a1[0] + a1[1]; } while (0)
            RT_RD(wA, 0);
#pragma unroll
            for (int e = 0; e < NE; e += 2) { RT_RD(wB, e + 1); RT_FMA(wA, e); if (e + 2 < NE) RT_RD(wA, e + 2); RT_FMA(wB, e + 1); }
#undef RT_RD
#undef RT_FMA
            const float t0 = reduce16(p0, lane), t1 = reduce16(p1, lane);
            const float bre = b_router[lane >> 2];
#pragma unroll
            for (int rr = 0; rr < 2; ++rr) {
                const float affl = sigmoidf_(rr ? t1 : t0), sell = affl + bre;
                int i0, i1; float w0, w1; route_token(affl, sell, i0, i1, w0, w1);
                if (lane == 0) { const int r0 = atomicAdd((int*)lcnt + i0, 1), r1 = atomicAdd((int*)lcnt + i1, 1);
                    rinfo[(lr + rr) * 4 + 0] = (i0 << 16) | r0; rinfo[(lr + rr) * 4 + 1] = (i1 << 16) | r1;
                    tw[(row + rr) * 2] = w0; tw[(row + rr) * 2 + 1] = w1; } }
        }
        __syncthreads();
        if (tid < 16) lbase[tid] = (int)__hip_atomic_fetch_add(cnt + 64 * tid, (unsigned)lcnt[tid], RLX_AGENT);
        __syncthreads();
        if (tid < rows_per_blk * 2) { const int lr = tid >> 1, kk = tid & 1, info = rinfo[lr * 4 + kk], e = info >> 16, rank = lbase[e] + (info & 0xffff);
            rlist[(size_t)e * T + rank] = base + lr; tslot[(base + lr) * 2 + kk] = (e << 16) | rank; }
        __syncthreads();
    }
}

__device__ __forceinline__ int swz256(int row, int ch) { return 256 * row + 16 * (ch ^ (((row & 3) << 2) | ((row >> 2) & 3))); }
typedef short v4i16_t __attribute__((ext_vector_type(4)));
__device__ __forceinline__ s16x4 vtr(const LAS unsigned char* p) { return __builtin_bit_cast(s16x4, __builtin_amdgcn_ds_read_tr16_b64_v4i16((LAS v4i16_t*)p)); }

struct AttnPre { u32x4 kv[8]; bf16x8 qf[4]; };
__device__ __forceinline__ void attn_issue(AttnPre& R, const bf16_t* proj, int a, int tid, int wave, int lane) {
    const int sub = a & 15, bh = a >> 4, head = bh % 12, b = bh / 12, g = head >> 2;
    const int dsh = 2 * g, nbsh = 4 - 2 * g;
    const int nblk = sub & ((1 << nbsh) - 1), r = sub >> nbsh;
    const size_t tb = (size_t)b * SEQ;
    const int p0 = 128 * (nblk - 1);
#pragma unroll
    for (int it = 0; it < 8; ++it) { const int id = tid + NTHREADS * it, row = id >> 4, ch = id & 15, p = p0 + row;
        const int pc = p < 0 ? 0 : p;
        const size_t t = tb + ((size_t)pc << dsh) + r; R.kv[it] = *(const u32x4*)(proj + t * NP + KA + head * 128 + ch * 8); }
    const int fr = lane & 15, fq = lane >> 4, qi = 16 * wave + fr;
    const size_t tq = tb + ((size_t)(128 * nblk + qi) << dsh) + r;
    const bf16_t* qsrc = proj + tq * NP + QA + head * 128 + fq * 8;
#pragma unroll
    for (int ks = 0; ks < 4; ++ks) R.qf[ks] = *(const bf16x8*)(qsrc + 32 * ks);
}
__device__ __forceinline__ void attn_unit(LAS unsigned char* lds, AttnPre& R, const bf16_t* proj, bf16_t* atto, float* lse, int a, int a_next, int tid, int wave, int lane) {
    const int sub = a & 15, bh = a >> 4, head = bh % 12, b = bh / 12, g = head >> 2, hj = head & 3;
    const int dsh = 2 * g, nbsh = 4 - 2 * g;
    const int nblk = sub & ((1 << nbsh) - 1), r = sub >> nbsh;
    const size_t tb = (size_t)b * SEQ;
    const int p0 = 128 * (nblk - 1);
    LAS unsigned char* Kl = lds; LAS unsigned char* Vl = lds + 65536;
#pragma unroll
    for (int it = 0; it < 8; ++it) { const int id = tid + NTHREADS * it, row = id >> 4, ch = id & 15; *(LAS u32x4*)(Kl + swz256(row, ch)) = R.kv[it]; }
    u32x4 vv[8];
#pragma unroll
    for (int it = 0; it < 8; ++it) { const int id = tid + NTHREADS * it, row = id >> 4, ch = id & 15, p = p0 + row;
        const int pc = p < 0 ? 0 : p;
        const size_t t = tb + ((size_t)pc << dsh) + r; vv[it] = *(const u32x4*)(proj + t * NP + VA + head * 128 + ch * 8); }
    const int fr = lane & 15, fq = lane >> 4;
    const int qi = 16 * wave + fr;
    const size_t tq = tb + ((size_t)(128 * nblk + qi) << dsh) + r;
    bf16x8 qf[4];
#pragma unroll
    for (int ks = 0; ks < 4; ++ks) qf[ks] = R.qf[ks];
    __syncthreads();
    f32x4 sacc[9];
    unsigned kbase[4];
    { const int fK = ((fr & 3) << 2) | ((fr >> 2) & 3);
#pragma unroll
        for (int ks = 0; ks < 4; ++ks) kbase[ks] = (unsigned)(256 * (16 * wave + fr) + 16 * ((4 * ks + fq) ^ fK)); }
#pragma unroll
    for (int kt = 0; kt < 9; ++kt) { f32x4 acc = (f32x4){0.f, 0.f, 0.f, 0.f};
#pragma unroll
        for (int ks = 0; ks < 4; ++ks) { const bf16x8 kf = *(const LAS bf16x8*)(Kl + kbase[ks] + 4096 * kt); acc = __builtin_amdgcn_mfma_f32_16x16x32_bf16(kf, qf[ks], acc, 0, 0, 0); }
        sacc[kt] = acc; }
    const float sc = 0.12751743082459868f;
    float mx = -3.0e38f;
#pragma unroll
    for (int kt = 0; kt < 9; ++kt)
#pragma unroll
        for (int rg = 0; rg < 4; ++rg) { const int jk = 16 * (wave + kt) + 4 * fq + rg; const bool valid = (jk >= qi) && (jk <= qi + 128) && (p0 + jk >= 0);
            const float s = valid ? sacc[kt][rg] * sc : -3.0e38f; sacc[kt][rg] = s; mx = fmaxf(mx, s); }
    mx = fmaxf(mx, sx<16>(mx, lane)); mx = fmaxf(mx, sx<32>(mx, lane));
    float sum = 0.f;
#pragma unroll
    for (int kt = 0; kt < 9; ++kt)
#pragma unroll
        for (int rg = 0; rg < 4; ++rg) { const float p = __builtin_amdgcn_exp2f(sacc[kt][rg] - mx); sacc[kt][rg] = p; sum += p; }
    sum += sx<16>(sum, lane); sum += sx<32>(sum, lane);
#pragma unroll
    for (int it = 0; it < 8; ++it) { const int id = tid + NTHREADS * it, row = id >> 4, ch = id & 15; *(LAS u32x4*)(Vl + swz256(row, ch)) = vv[it]; }
    __syncthreads();
    if (a_next >= 0) attn_issue(R, proj, a_next, tid, wave, lane);
    f32x4 oacc[8];
#pragma unroll
    for (int dt = 0; dt < 8; ++dt) oacc[dt] = (f32x4){0.f, 0.f, 0.f, 0.f};
    const int li = lane & 15, qq = li >> 2, pp = li & 3;
    unsigned vbase[8];
    { const int fV = (qq << 2) | fq;
#pragma unroll
        for (int dt = 0; dt < 8; ++dt) vbase[dt] = (unsigned)(256 * (16 * wave + 4 * fq + qq) + 16 * ((2 * dt + (pp >> 1)) ^ fV) + 8 * (pp & 1)); }
#pragma unroll
    for (int s5 = 0; s5 < 5; ++s5) {
        const int t0 = 2 * s5, t1 = (2 * s5 + 1 < 9) ? 2 * s5 + 1 : 2 * s5;
        u32x4 pw; pw.x = pk2(sacc[t0][0], sacc[t0][1]); pw.y = pk2(sacc[t0][2], sacc[t0][3]);
        if (2 * s5 + 1 < 9) { pw.z = pk2(sacc[t1][0], sacc[t1][1]); pw.w = pk2(sacc[t1][2], sacc[t1][3]); } else { pw.z = 0u; pw.w = 0u; }
        const bf16x8 pf = __builtin_bit_cast(bf16x8, pw);
#pragma unroll
        for (int dt = 0; dt < 8; ++dt) {
            const s16x4 v0 = vtr(Vl + vbase[dt] + 4096 * t0);
            const s16x4 v1 = vtr(Vl + vbase[dt] + 4096 * t1);
            bf16x8 vf; vf[0] = v0[0]; vf[1] = v0[1]; vf[2] = v0[2]; vf[3] = v0[3]; vf[4] = v1[0]; vf[5] = v1[1]; vf[6] = v1[2]; vf[7] = v1[3];
            oacc[dt] = __builtin_amdgcn_mfma_f32_16x16x32_bf16(vf, pf, oacc[dt], 0, 0, 0);
        }
    }
    const float inv = 1.0f / sum;
    bf16_t* op = atto + ((size_t)g * T + tq) * 512 + hj * 128 + 4 * fq;
#pragma unroll
    for (int dt = 0; dt < 8; ++dt) { u32x2 w; w.x = pk2(oacc[dt][0] * inv, oacc[dt][1] * inv); w.y = pk2(oacc[dt][2] * inv, oacc[dt][3] * inv); *(u32x2*)(op + 16 * dt) = w; }
    if (fq == 0) lse[((size_t)g * T + tq) * 4 + hj] = mx * 0.6931471805599453f + __logf(sum);
    __syncthreads();
}

__device__ __forceinline__ int swz512(int row, int ch) { return 512 * row + 16 * (ch ^ (((row & 3) << 2) | ((row >> 2) & 3))); }

struct GlaPre { float al0, al1; u32x4 q[2], k[2], v[4]; };
__device__ __forceinline__ void gla_local_issue(GlaPre& R, const bf16_t* proj, const float* alow, int u, int tid) {
    const int n = u & 31, h = (u >> 5) & 3, b = u >> 7;
    const size_t t0 = (size_t)b * SEQ + 64 * n;
    R.al0 = alow[t0 * 16 + tid]; R.al1 = alow[t0 * 16 + 512 + tid];
#pragma unroll
    for (int it = 0; it < 2; ++it) { const int id = tid + NTHREADS * it, row = id >> 4, ch = id & 15; const bf16_t* src = proj + (t0 + row) * NP + h * 128 + ch * 8; R.q[it] = *(const u32x4*)(src + QB); R.k[it] = *(const u32x4*)(src + KB); }
#pragma unroll
    for (int it = 0; it < 4; ++it) { const int id = tid + NTHREADS * it, row = id >> 5, ch = id & 31; R.v[it] = *(const u32x4*)(proj + (t0 + row) * NP + VB + h * 256 + ch * 8); }
}
__device__ __forceinline__ void gla_local_unit(LAS unsigned char* lds, GlaPre& R, const bf16_t* proj, const float* alow, const float (&w2)[16], const float bias,
                                               bf16_t* qdg, bf16_t* oig, bf16_t* dstg, float* decg, int u, int u_next, int tid, int wave, int lane) {
    const int n = u & 31, h = (u >> 5) & 3, b = u >> 7;
    const int d = tid & 127, ig = tid >> 7;
    const int fr = lane & 15, fq = lane >> 4;
    LAS unsigned char* QD = lds; LAS unsigned char* KI = lds + 17408; LAS unsigned char* KET = lds + 34816; LAS unsigned char* VL = lds + 53248;
    LAS unsigned char* AT = lds + 86016;
    LAS float* CS = (LAS float*)(lds + 95232); LAS float* ALs = (LAS float*)(lds + 97280);
    const size_t t0 = (size_t)b * SEQ + 64 * n;
#pragma unroll
    for (int it = 0; it < 2; ++it) { const int id = tid + NTHREADS * it, row = id >> 4, ch = id & 15; *(LAS u32x4*)(QD + row * 272 + ch * 16) = R.q[it]; *(LAS u32x4*)(KI + row * 272 + ch * 16) = R.k[it]; }
    ALs[tid] = R.al0; ALs[512 + tid] = R.al1;
#pragma unroll
    for (int it = 0; it < 4; ++it) { const int id = tid + NTHREADS * it, row = id >> 5, ch = id & 31; *(LAS u32x4*)(VL + swz512(row, ch)) = R.v[it]; }
    __syncthreads();
    if (u_next >= 0) gla_local_issue(R, proj, alow, u_next, tid);
    float bl[16]; float run = 0.f;
#pragma unroll
    for (int ii = 0; ii < 16; ++ii) { float z = bias; const LAS f32x4* ap = (const LAS f32x4*)(ALs + (16 * ig + ii) * 16);
#pragma unroll
        for (int r4 = 0; r4 < 4; ++r4) { const f32x4 av = ap[r4]; z = fmaf(av[0], w2[4 * r4], z); z = fmaf(av[1], w2[4 * r4 + 1], z); z = fmaf(av[2], w2[4 * r4 + 2], z); z = fmaf(av[3], w2[4 * r4 + 3], z); }
        const float la = (fminf(z, 0.f) - __logf(1.0f + __expf(-fabsf(z)))) * 0.0625f; run += la; bl[ii] = run; }
    CS[ig * 128 + d] = run;
    __syncthreads();
    float pre = 0.f, tot = 0.f;
#pragma unroll
    for (int g2 = 0; g2 < 4; ++g2) { const float cv = CS[g2 * 128 + d]; tot += cv; pre += (g2 < ig) ? cv : 0.f; }
    const float qscale = 0.08838834764831845f; const float etot = __expf(tot);
    unsigned ke[8];
#pragma unroll
    for (int ii = 0; ii < 16; ++ii) { const float bb = pre + bl[ii];
        LAS bf16_t* qp = (LAS bf16_t*)(QD + (16 * ig + ii) * 272 + 2 * d); LAS bf16_t* kp = (LAS bf16_t*)(KI + (16 * ig + ii) * 272 + 2 * d);
        const float qf_ = bf2f(*qp), kf_ = bf2f(*kp);
        const float eb = __expf(bb), einv = __builtin_amdgcn_rcpf(eb);
        const float qd = qf_ * qscale * eb, ki = kf_ * einv, kend = kf_ * (etot * einv);
        *qp = (bf16_t)f2bf(qd); *kp = (bf16_t)f2bf(ki);
        if (ii & 1) ke[ii >> 1] |= f2bf(kend) << 16; else ke[ii >> 1] = f2bf(kend); }
    *(LAS u32x4*)(KET + d * 144 + 32 * ig) = (u32x4){ke[0], ke[1], ke[2], ke[3]}; *(LAS u32x4*)(KET + d * 144 + 32 * ig + 16) = (u32x4){ke[4], ke[5], ke[6], ke[7]};
    if (ig == 0) decg[(size_t)u * 128 + d] = etot;
    __syncthreads();
#pragma unroll
    for (int it = 0; it < 2; ++it) { const int id = tid + NTHREADS * it, row = id >> 4, ch = id & 15; *(u32x4*)(qdg + ((size_t)(b * 4 + h) * 32 + n) * 8192 + (size_t)((((row >> 4) * 4 + (ch >> 2)) * 64 + (row & 15) * 4 + (ch & 3)) * 8)) = *(const LAS u32x4*)(QD + row * 272 + ch * 16); }
#pragma unroll
    for (int x = 0; x < 2; ++x) { const int id = 2 * wave + x, ti = id >> 2, tj = id & 3; f32x4 acc = (f32x4){0.f, 0.f, 0.f, 0.f};
        if (tj <= ti) {
#pragma unroll
            for (int ks = 0; ks < 4; ++ks) { const bf16x8 af = *(const LAS bf16x8*)(QD + (16 * ti + fr) * 272 + (32 * ks + 8 * fq) * 2); const bf16x8 bfr = *(const LAS bf16x8*)(KI + (16 * tj + fr) * 272 + (32 * ks + 8 * fq) * 2);
                acc = __builtin_amdgcn_mfma_f32_16x16x32_bf16(af, bfr, acc, 0, 0, 0); } }
#pragma unroll
        for (int rg = 0; rg < 4; ++rg) { const int i = 16 * ti + 4 * fq + rg, j = 16 * tj + fr; const float vv = (i >= j) ? acc[rg] : 0.f; *(LAS bf16_t*)(AT + i * 144 + 2 * j) = (bf16_t)f2bf(vv); } }
    bf16x8 vfr[2][2];
    { const int li = lane & 15, qq = li >> 2, pp = li & 3;
#pragma unroll
        for (int tv = 0; tv < 2; ++tv)
#pragma unroll
            for (int ks = 0; ks < 2; ++ks) { const int vt = 2 * wave + tv;
                const int r0 = 32 * ks + 8 * fq + qq, r1 = r0 + 4;
                const s16x4 a0 = vtr(VL + swz512(r0, 2 * vt + (pp >> 1)) + 8 * (pp & 1)), a1 = vtr(VL + swz512(r1, 2 * vt + (pp >> 1)) + 8 * (pp & 1));
                bf16x8 f; f[0] = a0[0]; f[1] = a0[1]; f[2] = a0[2]; f[3] = a0[3]; f[4] = a1[0]; f[5] = a1[1]; f[6] = a1[2]; f[7] = a1[3]; vfr[tv][ks] = f; } }
#pragma unroll
    for (int dt = 0; dt < 8; ++dt) {
        bf16x8 kf[2];
#pragma unroll
        for (int ks = 0; ks < 2; ++ks) kf[ks] = *(const LAS bf16x8*)(KET + (16 * dt + fr) * 144 + (32 * ks + 8 * fq) * 2);
#pragma unroll
        for (int tv = 0; tv < 2; ++tv) { f32x4 acc = (f32x4){0.f, 0.f, 0.f, 0.f};
#pragma unroll
            for (int ks = 0; ks < 2; ++ks) acc = __builtin_amdgcn_mfma_f32_16x16x32_bf16(kf[ks], vfr[tv][ks], acc, 0, 0, 0);
            u32x2 w; w.x = pk2(acc[0], acc[1]); w.y = pk2(acc[2], acc[3]);
            *(u32x2*)(dstg + (((size_t)(b * 4 + h) * 8 + wave) * 32 + n) * 4096 + (size_t)(((dt * 2 + tv) * 64 + fr * 4 + fq) * 4)) = w; } }
    __syncthreads();
#pragma unroll
    for (int ti = 0; ti < 4; ++ti) {
        bf16x8 af[2];
#pragma unroll
        for (int ks = 0; ks < 2; ++ks) af[ks] = *(const LAS bf16x8*)(AT + (16 * ti + fr) * 144 + (32 * ks + 8 * fq) * 2);
#pragma unroll
        for (int tv = 0; tv < 2; ++tv) { f32x4 acc = (f32x4){0.f, 0.f, 0.f, 0.f};
#pragma unroll
            for (int ks = 0; ks < 2; ++ks) acc = __builtin_amdgcn_mfma_f32_16x16x32_bf16(vfr[tv][ks], af[ks], acc, 0, 0, 0);
            u32x2 w; w.x = pk2(acc[0], acc[1]); w.y = pk2(acc[2], acc[3]);
            *(u32x2*)(oig + (((size_t)(b * 4 + h) * 8 + wave) * 32 + n) * 2048 + (size_t)(((ti * 2 + tv) * 64 + fr * 4 + fq) * 4)) = w; } }
    __syncthreads();
}

template <bool FAKE>
__device__ __forceinline__ void gla_scan_unit(LAS unsigned char* lds, const bf16_t* qdg, const bf16_t* oig, const bf16_t* dstg, const float* decg, bf16_t* ob, float* ssq,
                                              int u, int tid, int wave, int lane) {
    const int vs = u & 7, h = (u >> 3) & 3, b = u >> 5;
    const int fr = lane & 15, fq = lane >> 4;
    const int ti = wave >> 1, tv = wave & 1;
    LAS unsigned char* STb = lds;
    LAS unsigned char* OBL = lds + 20480;
    LAS float* SQL = (LAS float*)(lds + 53248);
    f32x4 sst[2]; sst[0] = (f32x4){0.f, 0.f, 0.f, 0.f}; sst[1] = sst[0];
    { unsigned z0 = 0u; asm volatile("" : "+v"(z0)); *(LAS u32x4*)(STb + tid * 16) = (u32x4){z0, z0, z0, z0}; if (tid < 32) *(LAS u32x4*)(STb + 8192 + tid * 16) = (u32x4){z0, z0, z0, z0}; }
    const int ub = (b * 4 + h) * 32;
    struct StepOps { bf16x8 q[4]; u32x2 o; u32x2 ds[2]; f32x4 dc; };
    const unsigned qoff = (unsigned)((ti * 4 * 64 + fr * 4 + fq) * 16), ooff = (unsigned)(((ti * 2 + tv) * 64 + fr * 4 + fq) * 8);
    const unsigned dsoff = (unsigned)(((wave * 2) * 64 + fr * 4 + fq) * 8), dcoff = (unsigned)(16 * wave + 4 * fq) * 4u;
    const char* qbase = (const char*)(qdg + (size_t)(b * 4 + h) * SEQ * 128);
    const char* obase = (const char*)(oig + ((size_t)(b * 4 + h) * 8 + vs) * SEQ * 32);
    const char* dsbase = (const char*)(dstg + ((size_t)(b * 4 + h) * 8 + vs) * 32 * 32 * 128);
    const char* dcbase = (const char*)(decg + (size_t)ub * 128);
#define GLA_LOAD(R, nn_) do { const int nn = FAKE ? 0 : ((nn_) < 32 ? (nn_) : 31); \
        const char* qs_ = qbase + (size_t)nn * 16384; _Pragma("unroll") for (int ks = 0; ks < 4; ++ks) R.q[ks] = *(const bf16x8*)(qs_ + qoff + 1024 * ks); \
        R.o = *(const u32x2*)(obase + (size_t)nn * 4096 + ooff); \
        _Pragma("unroll") for (int t2 = 0; t2 < 2; ++t2) R.ds[t2] = *(const u32x2*)(dsbase + (size_t)nn * 8192 + 512 * t2 + dsoff); \
        R.dc = *(const f32x4*)(dcbase + (size_t)nn * 512 + dcoff); } while (0)
#define GLA_STEP(R, n_) do { const int n = (n_); const size_t t0 = (size_t)b * SEQ + 64 * n; \
        LAS unsigned char* STc = STb + (n & 1) * 8704; LAS unsigned char* STn = STb + ((n + 1) & 1) * 8704; \
        f32x4 acc; acc[0] = bflo(R.o.x); acc[1] = bfhi(R.o.x); acc[2] = bflo(R.o.y); acc[3] = bfhi(R.o.y); \
        _Pragma("unroll") for (int ks = 0; ks < 4; ++ks) { const bf16x8 sfr = *(const LAS bf16x8*)(STc + (16 * tv + fr) * 272 + (32 * ks + 8 * fq) * 2); acc = __builtin_amdgcn_mfma_f32_16x16x32_bf16(sfr, R.q[ks], acc, 0, 0, 0); } \
        { u32x2 w; w.x = pk2(acc[0], acc[1]); w.y = pk2(acc[2], acc[3]);              \
            *(LAS u32x2*)(OBL + (n & 7) * 4096 + (16 * ti + fr) * 64 + (16 * tv + 4 * fq) * 2) = w; \
            float q2 = (acc[0] * acc[0] + acc[1] * acc[1]) + (acc[2] * acc[2] + acc[3] * acc[3]); q2 += sx<16>(q2, lane); q2 += sx<32>(q2, lane); \
            if (fq == 0) SQL[(n & 7) * 128 + (16 * ti + fr) * 2 + tv] = q2; } \
        _Pragma("unroll") for (int t2 = 0; t2 < 2; ++t2) { \
            sst[t2][0] = sst[t2][0] * R.dc[0] + bflo(R.ds[t2].x); sst[t2][1] = sst[t2][1] * R.dc[1] + bfhi(R.ds[t2].x); \
            sst[t2][2] = sst[t2][2] * R.dc[2] + bflo(R.ds[t2].y); sst[t2][3] = sst[t2][3] * R.dc[3] + bfhi(R.ds[t2].y); \
            u32x2 w; w.x = pk2(sst[t2][0], sst[t2][1]); w.y = pk2(sst[t2][2], sst[t2][3]); \
            *(LAS u32x2*)(STn + (16 * t2 + fr) * 272 + (16 * wave + 4 * fq) * 2) = w; } \
        __syncthreads(); \
        if (!FAKE && (n & 7) == 7) { const size_t tf = (size_t)b * SEQ + 64 * (n - 7); \
            _Pragma("unroll") for (int it = 0; it < 4; ++it) { const int id = tid + NTHREADS * it, sf = id >> 8, row = (id >> 2) & 63, c = id & 3; \
                *(u32x4*)(ob + (tf + 64 * sf + row) * 1024 + h * 256 + 32 * vs + 8 * c) = *(const LAS u32x4*)(OBL + id * 16); } \
            _Pragma("unroll") for (int it = 0; it < 2; ++it) { const int id = tid + NTHREADS * it, sf = id >> 7, row = (id >> 1) & 63, tq = id & 1; \
                ssq[((tf + 64 * sf + row) * 4 + h) * 16 + vs * 2 + tq] = SQL[id]; } \
            __syncthreads(); } } while (0)
    StepOps r0, r1, r2, r3;
    GLA_LOAD(r0, 0); GLA_LOAD(r1, 1); GLA_LOAD(r2, 2);
    __syncthreads();
    for (int n4 = 0; n4 < 32; n4 += 4) {
        GLA_LOAD(r3, n4 + 3); GLA_STEP(r0, n4);
        GLA_LOAD(r0, n4 + 4); GLA_STEP(r1, n4 + 1);
        GLA_LOAD(r1, n4 + 5); GLA_STEP(r2, n4 + 2);
        GLA_LOAD(r2, n4 + 6); GLA_STEP(r3, n4 + 3);
    }
#undef GLA_STEP
#undef GLA_LOAD
}

__device__ __forceinline__ void merge_phase(const bf16_t* atto, const float* lse, const bf16_t* ob, const float* ssq, const bf16_t* proj, const float* gla_gain, bf16_t* ya, bf16_t* yb,
                                            int vcu, int G, int wave, int lane) {
    const int gw = vcu * NWAVES + wave, NGW = G * NWAVES;
    const int hj = lane >> 4;
    f32x4 g0[2], g1[2];
#pragma unroll
    for (int c = 0; c < 2; ++c) { const int col = 8 * lane + 512 * c; g0[c] = *(const f32x4*)(gla_gain + col); g1[c] = *(const f32x4*)(gla_gain + col + 4); }
    for (int row0 = 2 * gw; row0 < T; row0 += 2 * NGW) {
        float l0[2], l1[2], l2[2]; u32x4 a0[2], a1[2], a2[2], o[2][2], rr_[2][2]; f32x4 sq[2][2][4];
#pragma unroll
        for (int r = 0; r < 2; ++r) { const int row = row0 + r;
            l0[r] = lse[((size_t)0 * T + row) * 4 + hj]; l1[r] = lse[((size_t)1 * T + row) * 4 + hj]; l2[r] = lse[((size_t)2 * T + row) * 4 + hj];
            a0[r] = *(const u32x4*)(atto + ((size_t)0 * T + row) * 512 + 8 * lane); a1[r] = *(const u32x4*)(atto + ((size_t)1 * T + row) * 512 + 8 * lane); a2[r] = *(const u32x4*)(atto + ((size_t)2 * T + row) * 512 + 8 * lane);
#pragma unroll
            for (int c = 0; c < 2; ++c) { const int col = 8 * lane + 512 * c, hh = col >> 8;
                const f32x4* sp = (const f32x4*)(ssq + ((size_t)row * 4 + hh) * 16); sq[r][c][0] = sp[0]; sq[r][c][1] = sp[1]; sq[r][c][2] = sp[2]; sq[r][c][3] = sp[3];
                o[r][c] = *(const u32x4*)(ob + (size_t)row * 1024 + col);
#if GATE_F8
                { const u32x2 r8 = *(const u32x2*)((const unsigned char*)proj + (size_t)row * NP * 2 + G8_BYTE0 + col); rr_[r][c] = (u32x4){r8.x, r8.y, 0u, 0u}; }
#else
                rr_[r][c] = *(const u32x4*)(proj + (size_t)row * NP + RB + col);
#endif
            } }
#pragma unroll
        for (int r = 0; r < 2; ++r) { const int row = row0 + r;
            const float m = fmaxf(l0[r], fmaxf(l1[r], l2[r])); float e0 = __expf(l0[r] - m), e1 = __expf(l1[r] - m), e2 = __expf(l2[r] - m); const float inv = 1.0f / (e0 + e1 + e2); e0 *= inv; e1 *= inv; e2 *= inv;
            u32x4 w;
            w.x = pk2(e0 * bflo(a0[r].x) + e1 * bflo(a1[r].x) + e2 * bflo(a2[r].x), e0 * bfhi(a0[r].x) + e1 * bfhi(a1[r].x) + e2 * bfhi(a2[r].x));
            w.y = pk2(e0 * bflo(a0[r].y) + e1 * bflo(a1[r].y) + e2 * bflo(a2[r].y), e0 * bfhi(a0[r].y) + e1 * bfhi(a1[r].y) + e2 * bfhi(a2[r].y));
            w.z = pk2(e0 * bflo(a0[r].z) + e1 * bflo(a1[r].z) + e2 * bflo(a2[r].z), e0 * bfhi(a0[r].z) + e1 * bfhi(a1[r].z) + e2 * bfhi(a2[r].z));
            w.w = pk2(e0 * bflo(a0[r].w) + e1 * bflo(a1[r].w) + e2 * bflo(a2[r].w), e0 * bfhi(a0[r].w) + e1 * bfhi(a1[r].w) + e2 * bfhi(a2[r].w));
#if MIX_F8
            { u32x2 w8; w8.x = pk_fp8x4(bflo(w.x), bfhi(w.x), bflo(w.y), bfhi(w.y)); w8.y = pk_fp8x4(bflo(w.z), bfhi(w.z), bflo(w.w), bfhi(w.w)); *(u32x2*)((unsigned char*)ya + (BR_FUSE ? (size_t)row * 1536 + 1024 : (size_t)row * 512) + 8 * lane) = w8; }
#else
            *(u32x4*)(ya + (size_t)row * 512 + 8 * lane) = w;
#endif
#pragma unroll
            for (int c = 0; c < 2; ++c) { const int col = 8 * lane + 512 * c;
                const f32x4 s0 = sq[r][c][0], s1 = sq[r][c][1], s2 = sq[r][c][2], s3 = sq[r][c][3];
                const float tot = ((s0[0] + s0[1]) + (s0[2] + s0[3])) + ((s1[0] + s1[1]) + (s1[2] + s1[3])) + ((s2[0] + s2[1]) + (s2[2] + s2[3])) + ((s3[0] + s3[1]) + (s3[2] + s3[3]));
                const float rstd = 1.0f / sqrtf(tot * (1.0f / 256.0f) + NORM_EPS);
                const u32x4 ov = o[r][c], rv = rr_[r][c]; u32x4 y; float rf[8];
#if GATE_F8
                unpack_fp8x8((u32x2){rv.x, rv.y}, rf);
#else
                rf[0] = bflo(rv.x); rf[1] = bfhi(rv.x); rf[2] = bflo(rv.y); rf[3] = bfhi(rv.y); rf[4] = bflo(rv.z); rf[5] = bfhi(rv.z); rf[6] = bflo(rv.w); rf[7] = bfhi(rv.w);
#endif
                y.x = pk2(bflo(ov.x) * rstd * g0[c][0] * siluf_(rf[0]), bfhi(ov.x) * rstd * g0[c][1] * siluf_(rf[1]));
                y.y = pk2(bflo(ov.y) * rstd * g0[c][2] * siluf_(rf[2]), bfhi(ov.y) * rstd * g0[c][3] * siluf_(rf[3]));
                y.z = pk2(bflo(ov.z) * rstd * g1[c][0] * siluf_(rf[4]), bfhi(ov.z) * rstd * g1[c][1] * siluf_(rf[5]));
                y.w = pk2(bflo(ov.w) * rstd * g1[c][2] * siluf_(rf[6]), bfhi(ov.w) * rstd * g1[c][3] * siluf_(rf[7]));
#if MIX_F8
                { u32x2 y8; y8.x = pk_fp8x4(bflo(y.x), bfhi(y.x), bflo(y.y), bfhi(y.y)); y8.y = pk_fp8x4(bflo(y.z), bfhi(y.z), bflo(y.w), bfhi(y.w)); *(u32x2*)((unsigned char*)(BR_FUSE ? ya : yb) + (size_t)row * (BR_FUSE ? 1536 : 1024) + col) = y8; }
#else
                *(u32x4*)(yb + (size_t)row * 1024 + col) = y;
#endif
            } }
    }
}

constexpr int LS = 10;
__host__ __device__ constexpr int phase_kind(int k) { return k == 0 ? 0 : (k == 1 + DEPTH * LS ? LS + 1 : ((k - 1) % LS) + 1); }
constexpr int N_PHASES = 2 + DEPTH * LS;
typedef const __attribute__((address_space(4))) Args CArgs;
__device__ __forceinline__ CArgs* fresh_args() {
    unsigned long long v = (unsigned long long)__builtin_amdgcn_kernarg_segment_ptr();
    unsigned lo = (unsigned)v, hi = (unsigned)(v >> 32);
    asm volatile("" : "+s"(lo), "+s"(hi));
    lo = __builtin_amdgcn_readfirstlane(lo); hi = __builtin_amdgcn_readfirstlane(hi);
    return (CArgs*)(((unsigned long long)hi << 32) | lo);
}
template <unsigned MASK, bool ONE>
__global__ void __launch_bounds__(NTHREADS, 2) fwd_kernel(Args a_unused) {
    extern __shared__ __attribute__((aligned(16))) unsigned char lds_raw[];
    LAS unsigned char* lds = (LAS unsigned char*)lds_raw;
    const int wave0 = __builtin_amdgcn_readfirstlane((int)threadIdx.x >> 6);
    int lane = (int)__builtin_amdgcn_mbcnt_hi(~0u, __builtin_amdgcn_mbcnt_lo(~0u, 0u)), wave = wave0, tid = wave0 * 64 + lane;
    CArgs* ap = fresh_args();
    unsigned char* ws = ap->ws;
#define a (*ap)
#define FRESH_TID() do { ap = fresh_args(); ws = ap->ws; unsigned m1_ = ~0u; asm volatile("" : "+s"(m1_)); lane = (int)__builtin_amdgcn_mbcnt_hi(m1_, __builtin_amdgcn_mbcnt_lo(m1_, 0u)); asm volatile("" : "+v"(lane)); wave = wave0; tid = wave0 * 64 + lane; } while (0)
    const int G = gridDim.x; const int bx = blockIdx.x; const int vcu = (G % 8 == 0) ? (bx % 8) * (G / 8) + bx / 8 : bx;
    volatile LAS unsigned* MISC = (volatile LAS unsigned*)(lds + MISC_OFF);
    for (int u = tid; u < (LDS_BYTES - MISC_OFF) / 4; u += NTHREADS) ((LAS unsigned*)(lds + MISC_OFF))[u] = 0u;
    __syncthreads();
    if (ONE) (void)xcd_barrier_post((unsigned*)(ws + WS_CTL) + CW_BAR, MISC + 8);
    const int lo = ONE ? 0 : a.ph_lo, hi = ONE ? N_PHASES : a.ph_hi;
#define IN(k, kind) (((MASK >> (kind)) & 1u) && (ONE || (lo <= (k) && (k) < hi)))
#if defined(PROBE_EPI) && !defined(PROBE_MASK)
#endif
#ifdef PROBE_MASK
#define PB_ON(k) ((PROBE_MASK >> phase_kind(k)) & 1u)
#define PB_START(k) do { if (PB_ON(k) && threadIdx.x == 0) *(volatile LAS unsigned long long*)(lds + MISC_OFF + 8192) = __builtin_amdgcn_s_memrealtime(); } while (0)
#define PB_END(k) do { if (PB_ON(k) && threadIdx.x == 0) { volatile LAS unsigned long long* pb_ = (volatile LAS unsigned long long*)(lds + MISC_OFF + 8192); pb_[1] = pb_[1] + (__builtin_amdgcn_s_memrealtime() - pb_[0]); } } while (0)
#else
#define PB_START(k) do { } while (0)
#define PB_END(k) do { } while (0)
#endif
#define SEAM(k) do { if (ONE) { XcdBarrier bar_; bar_.bar = (unsigned*)(((CArgs*)fresh_args())->ws + WS_CTL) + CW_BAR; bar_.x = xb_xcc_id(); bar_.st = (volatile LAS unsigned*)(lds + MISC_OFF) + 8; xcd_barrier(bar_); } } while (0)

#define ada ((float*)(ws + WS_ADA))
#define ropec ((const float*)(ws + WS_ROPE))
#define ropes (((const float*)(ws + WS_ROPE)) + SEQ * 64)
#define alow ((float*)(ws + WS_ALOW))
#define lse ((float*)(ws + WS_LSE))
#define ssq ((float*)(ws + WS_SSQ))
#define rlist ((int*)(ws + WS_RLIST))
#define tslot ((int*)(ws + WS_TSLOT))
#define tw ((float*)(ws + WS_TW))
#define hbuf ((bf16_t*)(ws + WS_H))
#define ya ((bf16_t*)(ws + WS_YA))
#define yb ((bf16_t*)(ws + WS_YB))
#define mrg ((bf16_t*)(ws + WS_MRG))
#define atto ((bf16_t*)(ws + WS_ATTO))
#define obuf ((bf16_t*)(ws + WS_OB))
#define proj ((bf16_t*)(ws + WS_PROJ))
#define act ((bf16_t*)(ws + WS_ACT))
#define Y ((bf16_t*)(ws + WS_Y))
#define ctl ((unsigned*)(ws + WS_CTL))
#define xb_ ((bf16_t*)(ws + WS_XB))
#define qdb_ ((bf16_t*)(ws + WS_QD))
#define oib_ ((bf16_t*)(ws + WS_OI))
#define dstb_ ((bf16_t*)(ws + WS_DST))
#define decb_ ((float*)(ws + WS_DEC))

    PB_START(0);
    if (IN(0, 0)) { FRESH_TID(); prologue_phase(ap, lds, vcu, G, tid, wave, lane); }
#ifdef PROBE_DUP_PRO
    __syncthreads(); if (IN(0, 0)) { FRESH_TID(); prologue_phase(ap, lds, vcu, G, tid, wave, lane, PROBE_DUP_PRO); }
#endif
    SEAM(0); PB_END(0);

    for (int l = 0; l < DEPTH; ++l) {
        const int P = 1 + LS * l;
#define adal (ada + (size_t)l * NB * 12288)
#define cntl (ctl + CW_CNT + l * 1024)
#define cntp (ctl + CW_CNT + (l > 0 ? (l - 1) * 1024 : 0))
#define xsrc ((l == 0) ? a.x : a.out)
        PB_START(P);
        if (IN(P, 1)) { FRESH_TID();
            if (l == 0) norm_phase<0>(xsrc, nullptr, hbuf, a.norm_mix, adal + 2048, adal, nullptr, nullptr, nullptr, nullptr, nullptr, vcu, G, wave, lane);
            else norm_phase<1>(xb_, xb_, hbuf, a.norm_mix + (size_t)l * D, adal + 2048, adal, ada + (size_t)(l - 1) * NB * 12288 + 10240, Y, tslot, tw, cntp, vcu, G, wave, lane);
        }
        SEAM(P); PB_END(P); PB_START(P + 1);
        if (IN(P + 1, 2)) { FRESH_TID();
#if PROJ_F8
            pg8::StaticOrder S{T / 256, NP / 256, G, bx}; pg8::RowsContig AM; pg8::EpiProj E{proj, ropec, ropes, alow, pg8::W8_INV};
            pg8::gemm_phase<pg8::EpiProj, pg8::StaticOrder, pg8::RowsContig, true, true>(lds, tid, hbuf, (const bf16_t*)(ws + WS_WIN + (size_t)l * NP * D), 0, D / 2, S, AM, E);
#else
            pg8::StaticOrder S{T / 256, NP / 256, G, bx}; pg8::RowsContig AM; pg8::EpiProj E{proj, ropec, ropes, alow, 1.0f};
            pg8::gemm_phase<pg8::EpiProj, pg8::StaticOrder, pg8::RowsContig, true>(lds, tid, hbuf, (const bf16_t*)(ws + WS_WIN) + (size_t)l * NP * D, 0, D, S, AM, E);
#endif
        }
        SEAM(P + 1); PB_END(P + 1); PB_START(P + 2);
        if (IN(P + 2, 3)) { FRESH_TID();
            {
                const int hw = (vcu >> 5) & 3, dw = tid & 127; float w2[16];
#pragma unroll
                for (int r = 0; r < 16; ++r) w2[r] = (a.w_alpha2 + (size_t)l * 16 * 512)[r * 512 + hw * 128 + dw];
                const float bias = (a.b_alpha2 + (size_t)l * 512)[hw * 128 + dw];
                for (int u = vcu; u < NB * 4 * 32; u += G) { GlaPre R; gla_local_issue(R, proj, alow, u, tid);
                    gla_local_unit(lds, R, proj, alow, w2, bias, qdb_, oib_, dstb_, decb_, u, -1, tid, wave, lane); } }
            FRESH_TID();
            for (int u = vcu; u < NB * 12 * 16; u += G) { AttnPre R; attn_issue(R, proj, u, tid, wave, lane); attn_unit(lds, R, proj, atto, lse, u, -1, tid, wave, lane); }
#ifdef PROBE_DUP_ATTN
            for (int u = vcu; u < NB * 12 * 16; u += G) { AttnPre R; attn_issue(R, proj, u, tid, wave, lane); attn_unit(lds, R, proj, atto, lse, u, -1, tid, wave, lane); }
#endif
        }
        SEAM(P + 2); PB_END(P + 2); PB_START(P + 3);
        if (IN(P + 3, 4)) { FRESH_TID();
            for (int u = vcu; u < 256; u += G) gla_scan_unit<false>(lds, qdb_, oib_, dstb_, decb_, obuf, ssq, u, tid, wave, lane);
#ifdef PROBE_FAKESCAN
            __syncthreads(); for (int u = vcu; u < 256; u += G) gla_scan_unit<true>(lds, qdb_, oib_, dstb_, decb_, obuf, ssq, u, tid, wave, lane);
#endif
        }
        SEAM(P + 3); PB_END(P + 3); PB_START(P + 4);
        if (IN(P + 4, 5)) { FRESH_TID(); merge_phase(atto, lse, obuf, ssq, proj, a.gla_gain + (size_t)l * 1024, ya, yb, vcu, G, wave, lane); }
        SEAM(P + 4); PB_END(P + 4); PB_START(P + 5);
        if (IN(P + 5, 6)) { FRESH_TID();
#if BR_FUSE
            { pg8::SegOrder S2{T / 256, D / 256, G, bx}; pg8::RowsContig AM2; pg8::EpiGate2 E{proj, pg8::W8_INV, ws + WS_MRG8};
              pg8::gemm_phase<pg8::EpiGate2, pg8::SegOrder, pg8::RowsContig, true, true, true>(lds, tid, ya, (const bf16_t*)(ws + WS_WOA + (size_t)l * D * 1536), 0, 768, S2, AM2, E); }
#else
            pg8::StaticOrder S{T / 256, D / 256, G, bx}; pg8::RowsContig AM;
#if MIX_F8
            { pg8::EpiGate<true> E{mrg, proj, GA, pg8::W8_INV, nullptr}; pg8::gemm_phase<pg8::EpiGate<true>, pg8::StaticOrder, pg8::RowsContig, true, true>(lds, tid, ya, (const bf16_t*)(ws + WS_WOA + (size_t)l * D * 512), 0, 256, S, AM, E); }
#else
            { pg8::EpiGate<true> E{mrg, proj, GA, 1.0f, nullptr}; pg8::gemm_phase<pg8::EpiGate<true>, pg8::StaticOrder, pg8::RowsContig, true>(lds, tid, ya, (const bf16_t*)(ws + WS_WOA) + (size_t)l * D * 512, 0, 512, S, AM, E); }
#endif
            FRESH_TID();
#if MIX_F8
            { pg8::EpiGate<false> E{mrg, proj, GB, pg8::W8_INV, ws + WS_MRG8}; pg8::gemm_phase<pg8::EpiGate<false>, pg8::StaticOrder, pg8::RowsContig, true, true>(lds, tid, yb, (const bf16_t*)(ws + WS_WOB + (size_t)l * D * 1024), 0, 512, S, AM, E); }
#else
            { pg8::EpiGate<false> E{mrg, proj, GB, 1.0f, nullptr}; pg8::gemm_phase<pg8::EpiGate<false>, pg8::StaticOrder, pg8::RowsContig, true>(lds, tid, yb, (const bf16_t*)(ws + WS_WOB) + (size_t)l * D * 1024, 0, 1024, S, AM, E); }
#endif
#endif
        }
        SEAM(P + 5); PB_END(P + 5); PB_START(P + 6);
        if (IN(P + 6, 7)) { FRESH_TID();
            pg8::StaticOrder S{T / 256, D / 256, G, bx}; pg8::RowsContig AM;
#if MIX_F8
            if (l == 0) { pg8::EpiResid<true> E{a.x, xb_, adal + 4096, pg8::W8_INV}; pg8::gemm_phase<pg8::EpiResid<true>, pg8::StaticOrder, pg8::RowsContig, true, true>(lds, tid, (const bf16_t*)(ws + WS_MRG8), (const bf16_t*)(ws + WS_WO + (size_t)l * D * D), 0, D / 2, S, AM, E); }
            else { pg8::EpiResid<false> E{xb_, xb_, adal + 4096, pg8::W8_INV}; pg8::gemm_phase<pg8::EpiResid<false>, pg8::StaticOrder, pg8::RowsContig, true, true>(lds, tid, (const bf16_t*)(ws + WS_MRG8), (const bf16_t*)(ws + WS_WO + (size_t)l * D * D), 0, D / 2, S, AM, E); }
#else
            if (l == 0) { pg8::EpiResid<true> E{a.x, xb_, adal + 4096, 1.0f}; pg8::gemm_phase<pg8::EpiResid<true>, pg8::StaticOrder, pg8::RowsContig, true>(lds, tid, mrg, (const bf16_t*)(ws + WS_WO) + (size_t)l * D * D, 0, D, S, AM, E); }
            else { pg8::EpiResid<false> E{xb_, xb_, adal + 4096, 1.0f}; pg8::gemm_phase<pg8::EpiResid<false>, pg8::StaticOrder, pg8::RowsContig, true>(lds, tid, mrg, (const bf16_t*)(ws + WS_WO) + (size_t)l * D * D, 0, D, S, AM, E); }
#endif
        }
        SEAM(P + 6); PB_END(P + 6); PB_START(P + 7);
        if (IN(P + 7, 8)) { FRESH_TID(); router_phase(xb_, hbuf, a.norm_ffn + (size_t)l * D, adal + 8192, adal + 6144, a.w_router, a.b_router, cntl, rlist, tslot, tw, lds, vcu, G, tid, wave, lane); }
        SEAM(P + 7); PB_END(P + 7); PB_START(P + 8);
        if (IN(P + 8, 9)) { FRESH_TID();
            pg8::moe_table_build(lds, cntl, tid);
            pg8::MoeOrder S; S.init(lds, 8, G, bx); pg8::RowsGather AM{rlist, lds}; pg8::EpiSwiGLU8 E{(unsigned char*)act};
            pg8::gemm_phase<pg8::EpiSwiGLU8, pg8::MoeOrder, pg8::RowsGather, true, true>(lds, tid, hbuf, (const bf16_t*)(ws + WS_WGU + (size_t)l * NE * 2048 * D), (size_t)2048 * D / 2, D / 2, S, AM, E);
        }
        SEAM(P + 8); PB_END(P + 8); PB_START(P + 9);
        if (IN(P + 9, 10)) { FRESH_TID();
            pg8::moe_table_build(lds, cntl, tid);
            pg8::MoeOrder S; S.init(lds, 8, G, bx); pg8::RowsContig AM; pg8::EpiPlainS E{Y, pg8::W8_INV};
            pg8::gemm_phase<pg8::EpiPlainS, pg8::MoeOrder, pg8::RowsContig, true, true>(lds, tid, act, (const bf16_t*)(ws + WS_WDN + (size_t)l * NE * D * FF), (size_t)D * FF / 2, FF / 2, S, AM, E);
        }
        SEAM(P + 9); PB_END(P + 9);
    }
    PB_START(1 + DEPTH * LS);
    if (IN(1 + DEPTH * LS, LS + 1)) { FRESH_TID(); norm_phase<2>(xb_, a.out, nullptr, a.final_norm, nullptr, nullptr, ada + (size_t)(DEPTH - 1) * NB * 12288 + 10240, Y, tslot, tw, ctl + CW_CNT + (DEPTH - 1) * 1024, vcu, G, wave, lane); }
#ifdef PROBE_MASK
    __syncthreads(); PB_END(1 + DEPTH * LS);
    if (threadIdx.x == 0) { const unsigned long long t0_ = __builtin_amdgcn_s_memrealtime(), d_ = ((volatile LAS unsigned long long*)(lds + MISC_OFF + 8192))[1];
        while (__builtin_amdgcn_s_memrealtime() - t0_ < d_) __builtin_amdgcn_s_sleep(8); }
    __syncthreads();
#endif
#undef a
#undef IN
#undef SEAM
}

template <unsigned MASK, bool ONE>
static void launch_one(const Args& a, int grid, hipStream_t stream) {
    static bool attr_done = false;
    if (!attr_done) { (void)hipFuncSetAttribute((const void*)fwd_kernel<MASK, ONE>, hipFuncAttributeMaxDynamicSharedMemorySize, LDS_BYTES); attr_done = true; }
    hipLaunchKernelGGL((fwd_kernel<MASK, ONE>), dim3(grid), dim3(NTHREADS), LDS_BYTES, stream, a);
}
extern "C" void kernel_launch(void* const* d_in, const int* in_sizes, int n_in, void* d_out, int out_size, void* d_ws, size_t ws_size, hipStream_t stream) {
    static int grid = 0;
    if (grid == 0) {
        if (n_in != 19 || out_size != T * D || ws_size < WS_END) { fprintf(stderr, "kernel_launch: unexpected shapes (n_in %d, out %d, ws %zu < %zu); nothing launched\n", n_in, out_size, ws_size, (size_t)WS_END); grid = -1; return; }
        int dev = 0, cus = 0;
        if (hipGetDevice(&dev) != hipSuccess || hipDeviceGetAttribute(&cus, hipDeviceAttributeMultiprocessorCount, dev) != hipSuccess) { grid = -1; return; }
        grid = cus;
        if (grid != 256) fprintf(stderr, "kernel_launch: note: %d CUs (built for 256)\n", grid);
    }
    if (grid < 0) return;
    (void)hipMemsetAsync((char*)d_ws + WS_CTL, 0, CTL_ZERO_BYTES, stream);
    Args a{};
    a.x = (const float*)d_in[0]; a.c = (const float*)d_in[1]; a.w_ada = (const float*)d_in[2]; a.b_ada = (const float*)d_in[3]; a.norm_mix = (const float*)d_in[4]; a.norm_ffn = (const float*)d_in[5];
    a.w_in = (const float*)d_in[6]; a.w_alpha2 = (const float*)d_in[7]; a.b_alpha2 = (const float*)d_in[8]; a.gla_gain = (const float*)d_in[9]; a.w_out_a = (const float*)d_in[10];
    a.w_out_b = (const float*)d_in[11]; a.w_out = (const float*)d_in[12]; a.w_router = (const float*)d_in[13]; a.b_router = (const float*)d_in[14]; a.w_gate_e = (const float*)d_in[15];
    a.w_up_e = (const float*)d_in[16]; a.w_down_e = (const float*)d_in[17]; a.final_norm = (const float*)d_in[18];
    a.out = (float*)d_out; a.ws = (unsigned char*)d_ws;
#if MK_PER_PHASE
    for (int p = 0; p < N_PHASES; ++p) { a.ph_lo = p; a.ph_hi = p + 1;
        const int kind = phase_kind(p);
        switch (kind) {
            case 0: launch_one<1u << 0, false>(a, grid, stream); break; case 1: launch_one<1u << 1, false>(a, grid, stream); break;
            case 2: launch_one<1u << 2, false>(a, grid, stream); break; case 3: launch_one<1u << 3, false>(a, grid, stream); break;
            case 4: launch_one<1u << 4, false>(a, grid, stream); break; case 5: launch_one<1u << 5, false>(a, grid, stream); break;
            case 6: launch_one<1u << 6, false>(a, grid, stream); break; case 7: launch_one<1u << 7, false>(a, grid, stream); break;
            case 8: launch_one<1u << 8, false>(a, grid, stream); break; case 9: launch_one<1u << 9, false>(a, grid, stream); break;
            case 10: launch_one<1u << 10, false>(a, grid, stream); break;
            default: launch_one<1u << 11, false>(a, grid, stream); break; } }
#else
    a.ph_lo = 0; a.ph_hi = N_PHASES; launch_one<0xFFFFFu, true>(a, grid, stream);
#endif
    const hipError_t le = hipPeekAtLastError();
    if (le != hipSuccess) fprintf(stderr, "kernel_launch: launch failed: %s\n", hipGetErrorName(le));
}
```

```cpp
#include <hip/hip_runtime.h>
#include <cstdio>
#include <cstdint>

#ifndef PROJ_F8
#define PROJ_F8 1
#endif
#ifndef MIX_F8
#define MIX_F8 1
#endif
#ifndef GATE_F8
#define GATE_F8 1
#endif
#ifndef Y_F8
#define Y_F8 1
#endif
#ifndef BR_FUSE
#define BR_FUSE 1
#endif
#ifndef MK_PER_PHASE
#define MK_PER_PHASE 0
#endif

#define LAS __attribute__((address_space(3)))
#define GAS __attribute__((address_space(1)))
typedef unsigned short bf16_t;
typedef short bf16x8 __attribute__((ext_vector_type(8)));
typedef short s16x4 __attribute__((ext_vector_type(4)));
typedef float f32x4 __attribute__((ext_vector_type(4)));
typedef float f32x2 __attribute__((ext_vector_type(2)));
typedef unsigned u32x4 __attribute__((ext_vector_type(4)));
typedef unsigned u32x2 __attribute__((ext_vector_type(2)));
typedef GAS unsigned gu32;

constexpr int NB = 8, SEQ = 2048, T = NB * SEQ, D = 2048, DEPTH = 2;
constexpr int NIN = 11792;
constexpr int NP = 12032;
constexpr int QA = 0, KA = 1536, VA = 3072, QB = 4608, KB = 5120, VB = 5632, RB = 6656, GA = 7680, GB = 9728, AL = 11776;
constexpr int NE = 16, FF = 1024;
constexpr int MAXTILES = 144, MAXROWS = MAXTILES * 256;
constexpr float NORM_EPS = 1e-6f;
constexpr int NWAVES = 8, NTHREADS = 512;

constexpr size_t MiB = 1u << 20;
constexpr size_t WS_CTL = 0, CTL_ZERO_BYTES = 80 * 1024;
constexpr size_t WS_ADA = 1 * MiB;
constexpr size_t WS_ROPE = 2 * MiB;
constexpr size_t WS_ALOW = 3 * MiB;
constexpr size_t WS_LSE = 4 * MiB;
constexpr size_t WS_SSQ = 5 * MiB;
constexpr size_t WS_RLIST = 9 * MiB;
constexpr size_t WS_TSLOT = 10 * MiB;
constexpr size_t WS_TW = 10 * MiB + 512 * 1024;
constexpr size_t WS_WIN = 12 * MiB;
constexpr size_t WS_MRG8 = 60 * MiB;
constexpr size_t WS_WOA = 106 * MiB;
constexpr size_t WS_WOB = 110 * MiB;
constexpr size_t WS_WO = 118 * MiB;
constexpr size_t WS_WGU = 134 * MiB;
constexpr size_t WS_XB = 262 * MiB;
constexpr size_t WS_WDN = 390 * MiB;
constexpr size_t WS_H = 518 * MiB;
constexpr size_t WS_YA = 582 * MiB;
constexpr size_t WS_YB = 598 * MiB;
constexpr size_t WS_MRG = 630 * MiB;
constexpr size_t WS_ATTO = 694 * MiB;
constexpr size_t WS_OB = 742 * MiB;
constexpr size_t WS_PROJ = 774 * MiB;
constexpr size_t WS_ACT = WS_PROJ;
constexpr size_t WS_Y = WS_PROJ + 72 * MiB;
constexpr size_t WS_QD = 1150 * MiB;
constexpr size_t WS_OI = 1166 * MiB;
constexpr size_t WS_DST = 1198 * MiB;
constexpr size_t WS_DEC = 1262 * MiB;
constexpr size_t WS_END = 1263 * MiB;
constexpr int CW_BAR = 4096;
constexpr int CW_CNT = 16384;

constexpr int RING_BYTES = 131072;
constexpr int MISC_OFF = 135168;
constexpr int LDS_BYTES = 151552;

#define LDS_WAIT() asm volatile("s_waitcnt lgkmcnt(0)" ::: "memory")
#define VM_WAIT() asm volatile("s_waitcnt vmcnt(0)" ::: "memory")
#define RLX_AGENT __ATOMIC_RELAXED, __HIP_MEMORY_SCOPE_AGENT
__device__ __forceinline__ unsigned f2bf(float f) { unsigned u = __builtin_bit_cast(unsigned, f); return (u + 0x7fffu + ((u >> 16) & 1u)) >> 16; }
typedef float f32x2_t __attribute__((ext_vector_type(2)));
typedef __bf16 bf16x2_t __attribute__((ext_vector_type(2)));
__device__ __forceinline__ unsigned pk2(float lo, float hi) { const f32x2_t v = {lo, hi}; const bf16x2_t b = __builtin_convertvector(v, bf16x2_t); return __builtin_bit_cast(unsigned, b); }
__device__ __forceinline__ float sat8(float x) { return __builtin_amdgcn_fmed3f(x, -448.0f, 448.0f); }
__device__ __forceinline__ unsigned pk_fp8x4(float a, float b, float c, float d) { int p = __builtin_amdgcn_cvt_pk_fp8_f32(sat8(a), sat8(b), 0, false); p = __builtin_amdgcn_cvt_pk_fp8_f32(sat8(c), sat8(d), p, true); return (unsigned)p; }
constexpr int G8_BYTE0 = RB * 2;
__device__ __forceinline__ void unpack_fp8x8(u32x2 v, float (&f)[8]) { const f32x2_t a = __builtin_amdgcn_cvt_pk_f32_fp8((int)v.x, false), b = __builtin_amdgcn_cvt_pk_f32_fp8((int)v.x, true), c = __builtin_amdgcn_cvt_pk_f32_fp8((int)v.y, false), d = __builtin_amdgcn_cvt_pk_f32_fp8((int)v.y, true);
    f[0] = a[0]; f[1] = a[1]; f[2] = b[0]; f[3] = b[1]; f[4] = c[0]; f[5] = c[1]; f[6] = d[0]; f[7] = d[1]; }
__device__ __forceinline__ unsigned pk_fp8x4_ns(float a, float b, float c, float d) { int p = __builtin_amdgcn_cvt_pk_fp8_f32(a, b, 0, false); p = __builtin_amdgcn_cvt_pk_fp8_f32(c, d, p, true); return (unsigned)p; }
__device__ __forceinline__ float bflo(unsigned u) { return __builtin_bit_cast(float, u << 16); }
__device__ __forceinline__ float bfhi(unsigned u) { return __builtin_bit_cast(float, u & 0xffff0000u); }
__device__ __forceinline__ float bf2f(bf16_t h) { return __builtin_bit_cast(float, (unsigned)h << 16); }
template <int M> __device__ __forceinline__ float sx(float v, int lane) {
    if constexpr (M < 32) return __builtin_bit_cast(float, __builtin_amdgcn_ds_swizzle(__builtin_bit_cast(int, v), (M << 10) | 0x1F));
    else return __builtin_bit_cast(float, __builtin_amdgcn_ds_bpermute((lane ^ 32) << 2, __builtin_bit_cast(int, v)));
}
__device__ __forceinline__ float wave_sum(float v, int lane) {
    v += sx<1>(v, lane); v += sx<2>(v, lane); v += sx<4>(v, lane); v += sx<8>(v, lane); v += sx<16>(v, lane); v += sx<32>(v, lane);
    return v;
}
__device__ __forceinline__ float sigmoidf_(float x) { return __builtin_amdgcn_rcpf(1.0f + __expf(-x)); }
__device__ __forceinline__ float siluf_(float x) { return x * __builtin_amdgcn_rcpf(1.0f + __expf(-x)); }

#define XB_TMO      128
#define XB_XCNT(j)  (256  + 64 * (j))
#define XB_XSUB(j)  (1280 + 64 * (j))
#define XB_XGEN(j)  (2304 + 64 * (j))
#define XB_TOP      3328
#define XB_TOPGEN   3392
#define XCD_BAR_WORDS 3456
#define XB_SPIN_CAP (1u << 18)
__device__ __forceinline__ unsigned xb_ld(unsigned* p)              { return __hip_atomic_load(p, __ATOMIC_RELAXED, __HIP_MEMORY_SCOPE_AGENT); }
__device__ __forceinline__ unsigned xb_add(unsigned* p, unsigned v) { return __hip_atomic_fetch_add(p, v, __ATOMIC_RELAXED, __HIP_MEMORY_SCOPE_AGENT); }
__device__ __forceinline__ unsigned xb_xcc_id() { return (unsigned)__builtin_amdgcn_s_getreg((3 << 11) | 20) & 0xFu; }
#define XB_SPIN(cond, bar) do { unsigned _sp = 0; while (cond) { __builtin_amdgcn_s_sleep(1); \
    if ((++_sp & 255u) == 0u) { if (xb_ld(&(bar)[XB_TMO])) break; if (_sp > XB_SPIN_CAP) { atomicAdd(&(bar)[XB_TMO], 1u); break; } } } } while (0)
struct XcdBarrier { unsigned* bar; unsigned x; volatile LAS unsigned* st; };
__device__ __forceinline__ XcdBarrier xcd_barrier_post(unsigned* bar, volatile LAS unsigned* st) {
    XcdBarrier b; b.bar = bar; b.x = xb_xcc_id(); b.st = st;
    if (threadIdx.x == 0) (void)xb_add(&bar[XB_XCNT(b.x)], 1u);
    return b;
}
__device__ __forceinline__ void xcd_barrier_complete(unsigned* bar, unsigned x, unsigned& nloc, unsigned& nx) {
    const unsigned G = gridDim.x * gridDim.y * gridDim.z;
    unsigned sum, cnt, mine, sp = 0u;
    for (;;) {
        sum = 0u; cnt = 0u; mine = 0u;
#pragma unroll
        for (unsigned j = 0; j < 16; ++j) { const unsigned c = xb_ld(&bar[XB_XCNT(j)]); sum += c; cnt += (c > 0u) ? 1u : 0u; mine = (j == x) ? c : mine; }
        if (sum == G) break;
        __builtin_amdgcn_s_sleep(1);
        if ((++sp & 255u) == 0u) { if (xb_ld(&bar[XB_TMO])) break; if (sp > XB_SPIN_CAP) { atomicAdd(&bar[XB_TMO], 1u); break; } }
    }
    nloc = mine > 0u ? mine : 1u; nx = cnt > 0u ? cnt : 1u;
}
__device__ __forceinline__ void xcd_barrier(const XcdBarrier& b) {
    asm volatile("s_waitcnt vmcnt(0)" ::: "memory");
    __syncthreads();
    if (threadIdx.x == 0) {
        unsigned* bar = b.bar;
        __builtin_amdgcn_s_waitcnt(0);
        unsigned nloc = b.st[0], nx = b.st[1];
        if (nloc == 0u) { xcd_barrier_complete(bar, b.x, nloc, nx); b.st[0] = nloc; b.st[1] = nx; }
        const unsigned old = xb_add(&bar[XB_XSUB(b.x)], 1u);
        const unsigned gen = old / nloc;
        if (old + 1u == (gen + 1u) * nloc) {
            __builtin_amdgcn_fence(__ATOMIC_RELEASE, "agent");
            asm volatile("s_waitcnt vmcnt(0)" ::: "memory");
            const unsigned og = xb_add(&bar[XB_TOP], 1u);
            const unsigned tg = og / nx;
            if (og + 1u == (tg + 1u) * nx) xb_add(&bar[XB_TOPGEN], 1u);
            else XB_SPIN(xb_ld(&bar[XB_TOPGEN]) == tg, bar);
            __builtin_amdgcn_fence(__ATOMIC_ACQUIRE, "agent");
            xb_add(&bar[XB_XGEN(b.x)], 1u);
            asm volatile("s_waitcnt vmcnt(0)" ::: "memory");
        } else {
            XB_SPIN(xb_ld(&bar[XB_XGEN(b.x)]) == gen, bar);
            __builtin_amdgcn_fence(__ATOMIC_ACQUIRE, "agent");
            asm volatile("s_waitcnt vmcnt(0)" ::: "memory");
        }
    }
    __syncthreads();
}

namespace pg8 {
constexpr int BM = 256, BK = 64, HALF = 128, HTB = HALF * BK * 2, NXCD = 8, WGM = 4;
__device__ __forceinline__ int lds_byte(int r, int c) { const int st = (r >> 4) * 2 + (c >> 5), rr = r & 15, cc = c & 31, ob = rr * 64 + cc * 2; return st * 1024 + (ob ^ (((ob >> 9) & 1) << 5)); }
__device__ __forceinline__ void stage_rc(int b, int& R, int& C) { const int st = b / 1024, sb = b % 1024, swz = sb ^ (((sb >> 9) & 1) << 5); R = (st >> 1) * 16 + swz / 64; C = (st & 1) * 32 + (swz % 64) / 2; }
__device__ __forceinline__ int perm32(int rho) { const int n = rho >> 4, i = rho & 15; return 8 * (i >> 2) + 4 * n + (i & 3); }

struct Unit { int pm, pn, e, ti; };

__device__ __forceinline__ bool grid_order(int nM, int nN, int G, int c, int i, int& pm, int& pn) {
    const int nwg = nM * nN; const long L = (long)i * G + c; if (L >= nwg) return false;
    int wgid = (int)L; { const int q = nwg / NXCD, r = nwg % NXCD, xcd = wgid % NXCD, off = wgid / NXCD; wgid = (xcd < r ? xcd * (q + 1) : r * (q + 1) + (xcd - r) * q) + off; }
    const int nig = WGM * nN, gid = wgid / nig, fm = gid * WGM, gsz = (nM - fm) < WGM ? (nM - fm) : WGM;
    pm = fm + ((wgid % nig) % gsz); pn = (wgid % nig) / gsz; return true;
}
struct StaticOrder {
    int nM, nN, G, c;
    __device__ __forceinline__ bool next(int i, Unit& u) const { u.e = 0; u.ti = 0; return grid_order(nM, nN, G, c, i, u.pm, u.pn); }
};
struct SegOrder {
    int nM, nN, G, c;
    __device__ __forceinline__ bool next(int i, Unit& u) const { u.e = i & 1; u.ti = 0; return grid_order(nM, nN, G, c, i >> 1, u.pm, u.pn); }
};
constexpr int MOE_TAB_OFF = MISC_OFF + 4096;
__device__ __forceinline__ void moe_table_build(LAS unsigned char* lds, const unsigned* cnt, int tid) {
    if (tid < NE) { const int n = (int)__hip_atomic_load(cnt + 64 * tid, RLX_AGENT); ((LAS int*)(lds + MOE_TAB_OFF))[16 + tid] = n; }
    __syncthreads();
    if (tid == 0) { int acc = 0; for (int e = 0; e < NE; ++e) { acc += (((LAS int*)(lds + MOE_TAB_OFF))[16 + e] + 255) >> 8; ((LAS int*)(lds + MOE_TAB_OFF))[e] = acc; } }
    __syncthreads();
}
typedef int i32x4 __attribute__((ext_vector_type(4)));
struct MoeOrder {
    LAS unsigned char* lds; int NT, nN, G, c;
    __device__ __forceinline__ void init(LAS unsigned char* lds_, int nN_, int G_, int c_) {
        lds = lds_; NT = __builtin_amdgcn_readfirstlane(((LAS int*)(lds + MOE_TAB_OFF))[15]); nN = nN_; G = G_; c = c_; }
    __device__ __forceinline__ bool next(int i, Unit& u) const {
        if (!grid_order(NT, nN, G, c, i, u.pm, u.pn)) return false;
        int e = 0, ts = 0;
#pragma unroll
        for (int q = 0; q < 4; ++q) { const i32x4 t = ((const LAS i32x4*)(lds + MOE_TAB_OFF))[q];
#pragma unroll
            for (int j = 0; j < 4; ++j) { const bool ge = u.pm >= t[j]; e += ge ? 1 : 0; ts = ge ? t[j] : ts; } }
        u.e = __builtin_amdgcn_readfirstlane(e); u.ti = u.pm - __builtin_amdgcn_readfirstlane(ts); return true;
    }
};
struct RowsContig { static constexpr bool GATHER = false; __device__ __forceinline__ unsigned row(const Unit& u, int rr) const { return (unsigned)(u.pm * 256 + rr); } };
struct RowsGather {
    static constexpr bool GATHER = true;
    const int* rlist; LAS unsigned char* lds;
    __device__ __forceinline__ unsigned row(const Unit& u, int rr) const {
        const int n = ((LAS int*)(lds + MOE_TAB_OFF))[16 + u.e]; const int rank = u.ti * 256 + rr; const bool ok = rank < n;
        return (unsigned)rlist[(size_t)u.e * T + (ok ? rank : 0)];
    }
};

typedef int i32x4v __attribute__((ext_vector_type(4)));
typedef int i32x8 __attribute__((ext_vector_type(8)));
template <class Epi, class Sched, class AMap, bool ALIGN_EPI, bool F8 = false, bool SEG2 = false>
__device__ __forceinline__ void gemm_phase(LAS unsigned char* lds, const int tid, const bf16_t* A, const bf16_t* Bt, size_t bstride, int K, const Sched& S, const AMap& AM, const Epi& E) {
    const int wid = __builtin_amdgcn_readfirstlane(tid >> 6), lane = tid & 63, wr = wid >> 2, wc = wid & 3, fr = lane & 15, fq = lane >> 4;
    const int nt = K / BK;
    unsigned voffA[2], voffB[2];
#pragma unroll
    for (int i = 0; i < 2; ++i) { int R, C; stage_rc(tid * 16 + i * 8192, R, C); const int Rb = Epi::PERM ? ((R & ~31) + perm32(R & 31)) : R; voffA[i] = (unsigned)(R * K + C) * 2u; voffB[i] = (unsigned)(Rb * K + C) * 2u; }
    const unsigned kstep = (unsigned)(BK * 2);
    const unsigned hstep = (unsigned)HALF * (unsigned)K * 2u;
    const unsigned tstep = 2u * hstep;
    const __amdgpu_buffer_rsrc_t rsA = __builtin_amdgcn_make_buffer_rsrc((void*)A, 0, -1, 0x00020000), rsB = __builtin_amdgcn_make_buffer_rsrc((void*)Bt, 0, -1, 0x00020000);
    const unsigned ldsw = (unsigned)wid * 1024u;
    const int aoff = lds_byte(wr * 64 + fr, fq * 8), boff = lds_byte(wc * 32 + fr, fq * 8);
#define PG8_SA(b, h) (((b) * 2 + (h)) * HTB)
#define PG8_SB(b, h) ((4 + (b) * 2 + (h)) * HTB)
#define PG8_STAGE(bufoff, soffB, voff) do { _Pragma("unroll") for (int _i = 0; _i < 2; ++_i) \
        __builtin_amdgcn_raw_ptr_buffer_load_lds(rsB, (LAS unsigned*)(lds + (bufoff) + ldsw + _i * 8192), 16, (int)(voff)[_i], (int)(soffB), 0, 0); } while (0)
#define PG8_LDA(dst, b, h) do { _Pragma("unroll") for (int m = 0; m < 4; ++m) _Pragma("unroll") for (int k = 0; k < 2; ++k) dst[m][k] = *(const LAS bf16x8*)(lds + PG8_SA(b, h) + aoff + m * 2048 + k * 1024); } while (0)
#define PG8_LDB(dst, b, h) do { _Pragma("unroll") for (int n = 0; n < 2; ++n) _Pragma("unroll") for (int k = 0; k < 2; ++k) dst[n][k] = *(const LAS bf16x8*)(lds + PG8_SB(b, h) + boff + n * 2048 + k * 1024); } while (0)
#define PG8_MMA(ai, bj, At, Bt_) do { __builtin_amdgcn_s_setprio(1); _Pragma("unroll") for (int m = 0; m < 4; ++m) _Pragma("unroll") for (int n = 0; n < 2; ++n) _Pragma("unroll") for (int k = 0; k < 2; ++k) \
        acc[ai][bj][m][n] = __builtin_amdgcn_mfma_f32_16x16x32_bf16(Bt_[n][k], At[m][k], acc[ai][bj][m][n], 0, 0, 0); __builtin_amdgcn_s_setprio(0); } while (0)
#define PG8_LD8(dst, base) do { const i32x4v lo_ = *(const LAS i32x4v*)(lds + (base)); const i32x4v hi_ = *(const LAS i32x4v*)(lds + (base) + 1024); dst = __builtin_shufflevector(lo_, hi_, 0, 1, 2, 3, 4, 5, 6, 7); } while (0)
#define PG8_LDA8(dst, b, h) do { _Pragma("unroll") for (int m = 0; m < 4; ++m) PG8_LD8(dst[m], PG8_SA(b, h) + aoff + m * 2048); } while (0)
#define PG8_LDB8(dst, b, h) do { _Pragma("unroll") for (int n = 0; n < 2; ++n) PG8_LD8(dst[n], PG8_SB(b, h) + boff + n * 2048); } while (0)
#define PG8_MMA8(ai, bj, At, Bt_) do { __builtin_amdgcn_s_setprio(1); _Pragma("unroll") for (int m = 0; m < 4; ++m) _Pragma("unroll") for (int n = 0; n < 2; ++n) \
        asm volatile("v_mfma_f32_16x16x128_f8f6f4 %0, %1, %2, %0" : "+v"(acc[ai][bj][m][n]) : "v"(Bt_[n]), "v"(At[m])); __builtin_amdgcn_s_setprio(0); } while (0)
#define PG8_XLDA(b, h) do { if constexpr (F8) PG8_LDA8(At8, b, h); else PG8_LDA(At, b, h); } while (0)
#define PG8_XLDB(w, b, h) do { if constexpr (F8) { if (w == 0) PG8_LDB8(B08, b, h); else PG8_LDB8(B18, b, h); } else { if (w == 0) PG8_LDB(B0, b, h); else PG8_LDB(B1, b, h); } } while (0)
#define PG8_XMMA(ai, bj, w) do { if constexpr (F8) { if (w == 0) PG8_MMA8(ai, bj, At8, B08); else PG8_MMA8(ai, bj, At8, B18); } else { if (w == 0) PG8_MMA(ai, bj, At, B0); else PG8_MMA(ai, bj, At, B1); } } while (0)
#define PG8_WAIT_V(n) asm volatile("s_waitcnt vmcnt(" #n ")" ::: "memory")
#define PG8_WAIT_L(n) asm volatile("s_waitcnt lgkmcnt(" #n ")" ::: "memory")
#define PG8_BAR __builtin_amdgcn_s_barrier()
#define PG8_SCHED __builtin_amdgcn_sched_barrier(0)
#define PG8_OFFS(dst, u) do { _Pragma("unroll") for (int _h = 0; _h < 2; ++_h) _Pragma("unroll") for (int _i = 0; _i < 2; ++_i) { int _R, _C; stage_rc(tid * 16 + _i * 8192, _R, _C); \
        dst[_h][_i] = (AM.row(u, _h * HALF + _R) * (unsigned)K + (unsigned)_C) * 2u; } } while (0)
#define PG8_STAGE_A(bufoff, h, kb, NXT) do { if constexpr (AMap::GATHER) { _Pragma("unroll") for (int _i = 0; _i < 2; ++_i) { const unsigned _o = (NXT) ? offN[h][_i] : offC[h][_i]; \
            __builtin_amdgcn_raw_ptr_buffer_load_lds(rsA, (LAS unsigned*)(lds + (bufoff) + ldsw + _i * 8192), 16, (int)_o, (int)(kb), 0, 0); } } \
        else { const unsigned _g = ((NXT) ? nA : cA) + (h) * hstep + (kb); _Pragma("unroll") for (int _i = 0; _i < 2; ++_i) \
            __builtin_amdgcn_raw_ptr_buffer_load_lds(rsA, (LAS unsigned*)(lds + (bufoff) + ldsw + _i * 8192), 16, (int)voffA[_i], (int)_g, 0, 0); } } while (0)
    Unit cur, nxt, nn; int ui = 0; bool has_next = false, has_nn = false;
    if (!S.next(0, cur)) return;
    f32x4 acc[2][2][4][2];
#pragma unroll
    for (int a = 0; a < 2; ++a)
#pragma unroll
        for (int b = 0; b < 2; ++b)
#pragma unroll
            for (int m = 0; m < 4; ++m)
#pragma unroll
                for (int n = 0; n < 2; ++n) acc[a][b][m][n] = (f32x4){0.f, 0.f, 0.f, 0.f};
    bf16x8 At[4][2], B0[2][2], B1[2][2]; i32x8 At8[4], B08[2], B18[2];
    int sc8 = 0x7F7F7F7F; if constexpr (F8) asm volatile("" : "+v"(sc8));
#define PG8_RAW(dst, u) do { _Pragma("unroll") for (int _h = 0; _h < 2; ++_h) _Pragma("unroll") for (int _i = 0; _i < 2; ++_i) { int _R, _C; stage_rc(tid * 16 + _i * 8192, _R, _C); dst[_h][_i] = AM.row(u, _h * HALF + _R); } } while (0)
#define PG8_CONV(dst, raw) do { _Pragma("unroll") for (int _h = 0; _h < 2; ++_h) _Pragma("unroll") for (int _i = 0; _i < 2; ++_i) { int _R, _C; stage_rc(tid * 16 + _i * 8192, _R, _C); dst[_h][_i] = (raw[_h][_i] * (unsigned)K + (unsigned)_C) * 2u; } } while (0)
    unsigned offC[2][2], offN[2][2], rawN[2][2];
    if constexpr (AMap::GATHER) { PG8_OFFS(offC, cur); has_next = S.next(1, nxt);
        if (has_next) { PG8_RAW(rawN, nxt); } else {
#pragma unroll
            for (int h = 0; h < 2; ++h)
#pragma unroll
                for (int i = 0; i < 2; ++i) rawN[h][i] = 0u; } }
    unsigned cA = AMap::GATHER ? 0u : (unsigned)cur.pm * tstep + (SEG2 ? (unsigned)cur.e * 1024u : 0u), nA = cA;
    unsigned cB = (unsigned)cur.e * (SEG2 ? 1024u : (unsigned)(bstride * 2)) + (unsigned)cur.pn * tstep;
    PG8_STAGE(PG8_SB(0, 0), cB, voffB); PG8_STAGE(PG8_SB(0, 1), cB + hstep, voffB); PG8_STAGE_A(PG8_SA(0, 0), 0, 0, false); PG8_STAGE_A(PG8_SA(0, 1), 1, 0, false);
    if (wr == 1) PG8_BAR;
    PG8_WAIT_V(2); PG8_BAR;
    PG8_STAGE(PG8_SB(1, 0), cB + kstep, voffB); PG8_STAGE_A(PG8_SA(1, 0), 0, kstep, false); PG8_STAGE(PG8_SB(1, 1), cB + hstep + kstep, voffB);
    PG8_WAIT_V(6); PG8_BAR;
    for (;;) {
        if constexpr (!AMap::GATHER) has_next = S.next(ui + 1, nxt);
        if constexpr (AMap::GATHER) {
            if (has_next) { PG8_CONV(offN, rawN); }
            else {
#pragma unroll
                for (int h = 0; h < 2; ++h)
#pragma unroll
                    for (int i = 0; i < 2; ++i) offN[h][i] = offC[h][i];
            }
            has_nn = has_next && S.next(ui + 2, nn);
            if (has_nn) { PG8_RAW(rawN, nn); }
        } else { nA = has_next ? (unsigned)nxt.pm * tstep + (SEG2 ? (unsigned)nxt.e * 1024u : 0u) : cA; }
        const unsigned nB = has_next ? (unsigned)nxt.e * (SEG2 ? 1024u : (unsigned)(bstride * 2)) + (unsigned)nxt.pn * tstep : cB;
        const int ntc = SEG2 ? (cur.e ? 4 : 8) : nt;
#pragma nounroll
        for (int t = 0; t < ntc; t += 2) {
            const bool last = (t == ntc - 2);
            const unsigned k1 = (unsigned)(t + 1) * kstep, k2 = last ? 0u : (unsigned)(t + 2) * kstep, k3 = k2 + kstep;
            const unsigned b2 = last ? nB : cB + (unsigned)(t + 2) * kstep, b3 = b2 + kstep;
            PG8_XLDB(0, 0, 0); PG8_XLDB(1, 0, 1); PG8_SCHED; PG8_XLDA(0, 0); PG8_STAGE_A(PG8_SA(1, 1), 1, k1, false);
            PG8_WAIT_V(8); PG8_WAIT_L(0); PG8_BAR; PG8_XMMA(0, 0, 0); PG8_XMMA(0, 1, 1); PG8_BAR; PG8_SCHED;
            PG8_XLDA(0, 1); PG8_STAGE(PG8_SB(0, 0), b2, voffB); PG8_STAGE(PG8_SB(0, 1), b2 + hstep, voffB); PG8_STAGE_A(PG8_SA(0, 0), 0, k2, last);
            PG8_WAIT_V(8); PG8_WAIT_L(0); PG8_BAR; PG8_XMMA(1, 0, 0); PG8_XMMA(1, 1, 1); PG8_BAR; PG8_SCHED;
            PG8_XLDB(0, 1, 0); PG8_XLDB(1, 1, 1); PG8_SCHED; PG8_XLDA(1, 0); PG8_STAGE_A(PG8_SA(0, 1), 1, k2, last);
            PG8_WAIT_V(8); PG8_WAIT_L(0); PG8_BAR; PG8_XMMA(0, 0, 0); PG8_XMMA(0, 1, 1); PG8_BAR; PG8_SCHED;
            PG8_XLDA(1, 1); PG8_STAGE(PG8_SB(1, 0), b3, voffB); PG8_STAGE(PG8_SB(1, 1), b3 + hstep, voffB); PG8_STAGE_A(PG8_SA(1, 0), 0, k3, last);
            PG8_WAIT_V(8); PG8_WAIT_L(0); PG8_BAR; PG8_XMMA(1, 0, 0); PG8_XMMA(1, 1, 1); PG8_BAR; PG8_SCHED;
        }
#ifdef PROBE_EPI
        unsigned long long pe_t0 = 0; if (tid == 0) pe_t0 = __builtin_amdgcn_s_memrealtime();
#endif
        if constexpr (ALIGN_EPI) { if (wr == 0) PG8_BAR; }
        if constexpr (F8) asm volatile("s_nop 15\n\ts_nop 15" ::: "memory");
        E(acc, cur, wr, wc, fr, fq);
#ifdef PROBE_EPI
        if (tid == 0) { asm volatile("s_waitcnt vmcnt(0)" ::: "memory"); volatile LAS unsigned long long* pb_ = (volatile LAS unsigned long long*)(lds + MISC_OFF + 8192); pb_[1] = pb_[1] + (__builtin_amdgcn_s_memrealtime() - pe_t0); }
#endif
        if (!has_next) break;
        if (!(SEG2 && cur.e == 0))
#pragma unroll
        for (int a = 0; a < 2; ++a)
#pragma unroll
            for (int b = 0; b < 2; ++b)
#pragma unroll
                for (int m = 0; m < 4; ++m)
#pragma unroll
                    for (int n = 0; n < 2; ++n) acc[a][b][m][n] = (f32x4){0.f, 0.f, 0.f, 0.f};
        cur = nxt; cB = nB; cA = nA; ++ui;
        if constexpr (AMap::GATHER) { nxt = nn; has_next = has_nn;
#pragma unroll
            for (int h = 0; h < 2; ++h)
#pragma unroll
                for (int i = 0; i < 2; ++i) offC[h][i] = offN[h][i];
        }
        if constexpr (ALIGN_EPI) { if (wr == 1) PG8_BAR; }
    }
    PG8_WAIT_V(0);
    if constexpr (!ALIGN_EPI) { if (wr == 0) PG8_BAR; }
    PG8_BAR;
#undef PG8_STAGE_A
#undef PG8_LD8
#undef PG8_LDA8
#undef PG8_LDB8
#undef PG8_MMA8
#undef PG8_XLDA
#undef PG8_XLDB
#undef PG8_XMMA
#undef PG8_SA
#undef PG8_SB
#undef PG8_STAGE
#undef PG8_LDA
#undef PG8_LDB
#undef PG8_MMA
#undef PG8_WAIT_V
#undef PG8_WAIT_L
#undef PG8_BAR
#undef PG8_SCHED
#undef PG8_OFFS
#undef PG8_RAW
#undef PG8_CONV
}

#define EPI_PIN(x) asm volatile("" : "+v"(x))
#define LPIN(x) asm volatile("" : "+v"(x))
#define EPI_ROWSTEP(m) (((m) == 3) ? 80 : 16)
struct EpiProj {
    static constexpr bool PERM = true;
    bf16_t* O; const float* cs; const float* sn; float* alow; float scale;
    __device__ __forceinline__ void operator()(const f32x4 (&acc)[2][2][4][2], const Unit& u, int wr, int wc, int fr, int fq) const {
        const int row0 = u.pm * BM + wr * 64 + fr, col0 = u.pn * BM + wc * 32 + 8 * fq;
        unsigned off = (unsigned)(row0 * NP + col0) * 2u;
        if (u.pn < 12) {
            unsigned toff = (unsigned)((row0 & (SEQ - 1)) * 64 + wc * 16 + fq * 4) * 4u;
            f32x4 ct[2][4], st[2][4];
#pragma unroll
            for (int ai = 0; ai < 2; ++ai)
#pragma unroll
                for (int m = 0; m < 4; ++m) { ct[ai][m] = *(const f32x4*)((const char*)cs + toff + (ai * HALF + m * 16) * 64 * 4); st[ai][m] = *(const f32x4*)((const char*)sn + toff + (ai * HALF + m * 16) * 64 * 4); }
#pragma unroll
            for (int ai = 0; ai < 2; ++ai)
#pragma unroll
                for (int m = 0; m < 4; ++m) {
                    const f32x4 c4 = ct[ai][m], s4 = st[ai][m];
#pragma unroll
                    for (int bj = 0; bj < 2; ++bj) { const f32x4 v0 = acc[ai][bj][m][0] * scale, v1 = acc[ai][bj][m][1] * scale; u32x4 w;
                        w.x = pk2(v0[0] * c4[0] - v0[1] * s4[0], v0[1] * c4[0] + v0[0] * s4[0]);
                        w.y = pk2(v0[2] * c4[1] - v0[3] * s4[1], v0[3] * c4[1] + v0[2] * s4[1]);
                        w.z = pk2(v1[0] * c4[2] - v1[1] * s4[2], v1[1] * c4[2] + v1[0] * s4[2]);
                        w.w = pk2(v1[2] * c4[3] - v1[3] * s4[3], v1[3] * c4[3] + v1[2] * s4[3]);
                        *(u32x4*)((char*)O + off + bj * HALF * 2) = w; }
                    off += EPI_ROWSTEP(m) * NP * 2; EPI_PIN(off);
                }
        } else if (GATE_F8 && u.pn >= RB / 256 && u.pn < 46) {
            unsigned off8 = (unsigned)(row0 * NP) * 2u + (unsigned)(G8_BYTE0 + col0 - RB);
#pragma unroll
            for (int ai = 0; ai < 2; ++ai)
#pragma unroll
                for (int m = 0; m < 4; ++m) {
#pragma unroll
                    for (int bj = 0; bj < 2; ++bj) { const f32x4 v0 = acc[ai][bj][m][0] * scale, v1 = acc[ai][bj][m][1] * scale; u32x2 w;
                        w.x = pk_fp8x4(v0[0], v0[1], v0[2], v0[3]); w.y = pk_fp8x4(v1[0], v1[1], v1[2], v1[3]);
                        *(u32x2*)((char*)O + off8 + bj * HALF) = w; }
                    off8 += EPI_ROWSTEP(m) * NP * 2; EPI_PIN(off8); }
        } else if (u.pn < 46) {
#pragma unroll
            for (int ai = 0; ai < 2; ++ai)
#pragma unroll
                for (int m = 0; m < 4; ++m) {
#pragma unroll
                    for (int bj = 0; bj < 2; ++bj) { const f32x4 v0 = acc[ai][bj][m][0] * scale, v1 = acc[ai][bj][m][1] * scale; u32x4 w;
                        w.x = pk2(v0[0], v0[1]); w.y = pk2(v0[2], v0[3]); w.z = pk2(v1[0], v1[1]); w.w = pk2(v1[2], v1[3]);
                        *(u32x4*)((char*)O + off + bj * HALF * 2) = w; }
                    off += EPI_ROWSTEP(m) * NP * 2; EPI_PIN(off); }
        } else {
            if (wc == 0 && fq < 2) {
                unsigned aoff_ = (unsigned)(row0 * 16 + 8 * fq) * 4u;
#pragma unroll
                for (int ai = 0; ai < 2; ++ai)
#pragma unroll
                    for (int m = 0; m < 4; ++m) { float* rp = (float*)((char*)alow + aoff_);
                        *(f32x4*)rp = acc[ai][0][m][0] * scale; *(f32x4*)(rp + 4) = acc[ai][0][m][1] * scale;
                        aoff_ += EPI_ROWSTEP(m) * 16 * 4; EPI_PIN(aoff_); }
            }
        }
    }
};
template <bool FIRST> struct EpiGate {
    static constexpr bool PERM = true;
    bf16_t* O; const bf16_t* proj; int goff; float scale; unsigned char* O8;
    __device__ __forceinline__ void operator()(const f32x4 (&acc)[2][2][4][2], const Unit& u, int wr, int wc, int fr, int fq) const {
        const int row0 = u.pm * BM + wr * 64 + fr, col0 = u.pn * BM + wc * 32 + 8 * fq;
        const unsigned goffb = GATE_F8 ? (unsigned)(row0 * NP) * 2u + (unsigned)(G8_BYTE0 + goff - RB + col0) : (unsigned)(row0 * NP + goff + col0) * 2u, ooff = (unsigned)(row0 * D + col0) * 2u;
        u32x4 gA[2][2], gB[2][2], pA[2][2], pB[2][2];
#define EG_ROW(r) ((((r) >> 2) * 128) + (((r) & 3) * 16))
#define EG_LOAD(G, P, b) do { _Pragma("unroll") for (int rr = 0; rr < 2; ++rr) { const unsigned ro = EG_ROW(2 * (b) + rr); _Pragma("unroll") for (int bj = 0; bj < 2; ++bj) { \
            if (GATE_F8) { const u32x2 g8 = *(const u32x2*)((const char*)proj + goffb + ro * NP * 2 + bj * HALF); G[rr][bj] = (u32x4){g8.x, g8.y, 0u, 0u}; } \
            else G[rr][bj] = *(const u32x4*)((const char*)proj + goffb + ro * NP * 2 + bj * HALF * 2); \
            if (!FIRST) P[rr][bj] = *(const u32x4*)((const char*)O + ooff + ro * D * 2 + bj * HALF * 2); } } asm volatile("" ::: "memory"); } while (0)
#define EG_COMP(G, P, b) do { _Pragma("unroll") for (int rr = 0; rr < 2; ++rr) { const int r = 2 * (b) + rr, ai = r >> 2, m = r & 3; const unsigned ro = EG_ROW(r); _Pragma("unroll") for (int bj = 0; bj < 2; ++bj) { \
            const u32x4 gg = G[rr][bj]; const f32x4 v0 = acc[ai][bj][m][0] * scale, v1 = acc[ai][bj][m][1] * scale; float gf[8], r8[8]; \
            if (GATE_F8) unpack_fp8x8((u32x2){gg.x, gg.y}, gf); else { gf[0] = bflo(gg.x); gf[1] = bfhi(gg.x); gf[2] = bflo(gg.y); gf[3] = bfhi(gg.y); gf[4] = bflo(gg.z); gf[5] = bfhi(gg.z); gf[6] = bflo(gg.w); gf[7] = bfhi(gg.w); } \
            r8[0] = sigmoidf_(gf[0]) * v0[0]; r8[1] = sigmoidf_(gf[1]) * v0[1]; r8[2] = sigmoidf_(gf[2]) * v0[2]; r8[3] = sigmoidf_(gf[3]) * v0[3]; \
            r8[4] = sigmoidf_(gf[4]) * v1[0]; r8[5] = sigmoidf_(gf[5]) * v1[1]; r8[6] = sigmoidf_(gf[6]) * v1[2]; r8[7] = sigmoidf_(gf[7]) * v1[3]; \
            if (!FIRST) { const u32x4 pq = P[rr][bj]; r8[0] += bflo(pq.x); r8[1] += bfhi(pq.x); r8[2] += bflo(pq.y); r8[3] += bfhi(pq.y); r8[4] += bflo(pq.z); r8[5] += bfhi(pq.z); r8[6] += bflo(pq.w); r8[7] += bfhi(pq.w); } \
            if (!FIRST && O8) { u32x2 w8; w8.x = pk_fp8x4(r8[0], r8[1], r8[2], r8[3]); w8.y = pk_fp8x4(r8[4], r8[5], r8[6], r8[7]); *(u32x2*)(O8 + (ooff >> 1) + ro * D + bj * HALF) = w8; } \
            else { u32x4 w; w.x = pk2(r8[0], r8[1]); w.y = pk2(r8[2], r8[3]); w.z = pk2(r8[4], r8[5]); w.w = pk2(r8[6], r8[7]); *(u32x4*)((char*)O + ooff + ro * D * 2 + bj * HALF * 2) = w; } } } asm volatile("" ::: "memory"); } while (0)
        EG_LOAD(gA, pA, 0); EG_LOAD(gB, pB, 1); EG_COMP(gA, pA, 0); EG_LOAD(gA, pA, 2); EG_COMP(gB, pB, 1); EG_LOAD(gB, pB, 3); EG_COMP(gA, pA, 2); EG_COMP(gB, pB, 3);
#undef EG_LOAD
#undef EG_COMP
    }
};
struct EpiGate2 {
    static constexpr bool PERM = true;
    const bf16_t* proj; float scale; unsigned char* O8;
    __device__ __forceinline__ void operator()(f32x4 (&acc)[2][2][4][2], const Unit& u, int wr, int wc, int fr, int fq) const {
        const int row0 = u.pm * BM + wr * 64 + fr, col0 = u.pn * BM + wc * 32 + 8 * fq;
        const unsigned goffa = (unsigned)(row0 * NP) * 2u + (unsigned)(G8_BYTE0 + GA - RB + col0), ooff = (unsigned)(row0 * D + col0);
        u32x4 gA[2][2], gB[2][2];
#define EG_ROW(r) ((((r) >> 2) * 128) + (((r) & 3) * 16))
        if (u.e == 0) {
#define E2_LOAD(G, b) do { _Pragma("unroll") for (int rr = 0; rr < 2; ++rr) { const unsigned ro = EG_ROW(2 * (b) + rr); _Pragma("unroll") for (int bj = 0; bj < 2; ++bj) { \
            const u32x2 ga8 = *(const u32x2*)((const char*)proj + goffa + ro * NP * 2 + bj * HALF), gb8 = *(const u32x2*)((const char*)proj + goffa + (GB - GA) + ro * NP * 2 + bj * HALF); \
            G[rr][bj] = (u32x4){ga8.x, ga8.y, gb8.x, gb8.y}; } } asm volatile("" ::: "memory"); } while (0)
#define E2_COMP(G, b) do { _Pragma("unroll") for (int rr = 0; rr < 2; ++rr) { const int r = 2 * (b) + rr, ai = r >> 2, m = r & 3; _Pragma("unroll") for (int bj = 0; bj < 2; ++bj) { \
            const u32x4 gg = G[rr][bj]; float fa[8], fb[8]; unpack_fp8x8((u32x2){gg.x, gg.y}, fa); unpack_fp8x8((u32x2){gg.z, gg.w}, fb); \
            _Pragma("unroll") for (int j = 0; j < 8; ++j) { const float q = (1.0f + __expf(-fmaxf(fa[j], -30.0f))) * sigmoidf_(fb[j]); acc[ai][bj][m][j >> 2][j & 3] *= q; } } } } while (0)
            E2_LOAD(gA, 0); E2_LOAD(gB, 1); E2_COMP(gA, 0); E2_LOAD(gA, 2); E2_COMP(gB, 1); E2_LOAD(gB, 3); E2_COMP(gA, 2); E2_COMP(gB, 3);
#undef E2_LOAD
#undef E2_COMP
        } else {
#define E2_LOAD(G, b) do { _Pragma("unroll") for (int rr = 0; rr < 2; ++rr) { const unsigned ro = EG_ROW(2 * (b) + rr); _Pragma("unroll") for (int bj = 0; bj < 2; ++bj) { \
            const u32x2 ga8 = *(const u32x2*)((const char*)proj + goffa + ro * NP * 2 + bj * HALF); G[rr][bj] = (u32x4){ga8.x, ga8.y, 0u, 0u}; } } asm volatile("" ::: "memory"); } while (0)
#define E2_COMP(G, b) do { _Pragma("unroll") for (int rr = 0; rr < 2; ++rr) { const int r = 2 * (b) + rr, ai = r >> 2, m = r & 3; const unsigned ro = EG_ROW(r); _Pragma("unroll") for (int bj = 0; bj < 2; ++bj) { \
            const u32x4 gg = G[rr][bj]; float fa[8], r8[8]; unpack_fp8x8((u32x2){gg.x, gg.y}, fa); \
            _Pragma("unroll") for (int j = 0; j < 8; ++j) r8[j] = sigmoidf_(fmaxf(fa[j], -30.0f)) * (acc[ai][bj][m][j >> 2][j & 3] * scale); \
            u32x2 w8; w8.x = pk_fp8x4(r8[0], r8[1], r8[2], r8[3]); w8.y = pk_fp8x4(r8[4], r8[5], r8[6], r8[7]); *(u32x2*)(O8 + ooff + ro * D + bj * HALF) = w8; } } asm volatile("" ::: "memory"); } while (0)
            E2_LOAD(gA, 0); E2_LOAD(gB, 1); E2_COMP(gA, 0); E2_LOAD(gA, 2); E2_COMP(gB, 1); E2_LOAD(gB, 3); E2_COMP(gA, 2); E2_COMP(gB, 3);
#undef E2_LOAD
#undef E2_COMP
        }
#undef EG_ROW
    }
};
#define EG_ROW(r) ((((r) >> 2) * 128) + (((r) & 3) * 16))
template <bool XF32> struct EpiResid {
    static constexpr bool PERM = true;
    const void* xi; bf16_t* xo; const float* gate; float scale;
    __device__ __forceinline__ void operator()(const f32x4 (&acc)[2][2][4][2], const Unit& u, int wr, int wc, int fr, int fq) const {
        const int row0 = u.pm * BM + wr * 64 + fr, col0 = u.pn * BM + wc * 32 + 8 * fq;
        const int b = (u.pm * BM) / SEQ;
        f32x4 gt[2][2];
#pragma unroll
        for (int bj = 0; bj < 2; ++bj)
#pragma unroll
            for (int n = 0; n < 2; ++n) gt[bj][n] = *(const f32x4*)(gate + (size_t)b * 12288 + col0 + bj * HALF + 4 * n) * scale;
        const unsigned off = (unsigned)(row0 * D + col0);
        constexpr int RB_ = XF32 ? 1 : 2, NBAT = 8 / RB_;
        f32x4 xA[RB_][2][2], xB[RB_][2][2];
#define ER_LOAD(X, bb) do { _Pragma("unroll") for (int rr = 0; rr < RB_; ++rr) { const unsigned ro = EG_ROW(RB_ * (bb) + rr); _Pragma("unroll") for (int bj = 0; bj < 2; ++bj) { const unsigned o = off + ro * D + bj * HALF; \
            if (XF32) { X[rr][bj][0] = *(const f32x4*)((const float*)xi + o); X[rr][bj][1] = *(const f32x4*)((const float*)xi + o + 4); } \
            else { const u32x4 rw = *(const u32x4*)((const bf16_t*)xi + o); X[rr][bj][0] = (f32x4){bflo(rw.x), bfhi(rw.x), bflo(rw.y), bfhi(rw.y)}; X[rr][bj][1] = (f32x4){bflo(rw.z), bfhi(rw.z), bflo(rw.w), bfhi(rw.w)}; } } } asm volatile("" ::: "memory"); } while (0)
#define ER_COMP(X, bb) do { _Pragma("unroll") for (int rr = 0; rr < RB_; ++rr) { const int r = RB_ * (bb) + rr, ai = r >> 2, m = r & 3; const unsigned ro = EG_ROW(r); _Pragma("unroll") for (int bj = 0; bj < 2; ++bj) { const unsigned o = off + ro * D + bj * HALF; \
            const f32x4 v0 = X[rr][bj][0] + gt[bj][0] * acc[ai][bj][m][0], v1 = X[rr][bj][1] + gt[bj][1] * acc[ai][bj][m][1]; \
            u32x4 w; w.x = pk2(v0[0], v0[1]); w.y = pk2(v0[2], v0[3]); w.z = pk2(v1[0], v1[1]); w.w = pk2(v1[2], v1[3]); *(u32x4*)(xo + o) = w; } } asm volatile("" ::: "memory"); } while (0)
        ER_LOAD(xA, 0);
#pragma unroll
        for (int bb = 0; bb < NBAT; bb += 2) {
            ER_LOAD(xB, bb + 1); ER_COMP(xA, bb);
            if (bb + 2 < NBAT) ER_LOAD(xA, bb + 2);
            ER_COMP(xB, bb + 1); }
#undef ER_LOAD
#undef ER_COMP
#undef EG_ROW
    }
};
struct EpiSwiGLU {
    static constexpr bool PERM = true;
    bf16_t* O;
    __device__ __forceinline__ void operator()(const f32x4 (&acc)[2][2][4][2], const Unit& u, int wr, int wc, int fr, int fq) const {
        const int row0 = u.pm * BM + wr * 64 + fr, col0 = u.pn * HALF + wc * 32 + 8 * fq;
        unsigned off = (unsigned)(row0 * FF + col0) * 2u;
#pragma unroll
        for (int ai = 0; ai < 2; ++ai)
#pragma unroll
            for (int m = 0; m < 4; ++m) { const f32x4 g0 = acc[ai][0][m][0], g1 = acc[ai][0][m][1], u0 = acc[ai][1][m][0], u1 = acc[ai][1][m][1]; u32x4 w;
                w.x = pk2(siluf_(g0[0]) * u0[0], siluf_(g0[1]) * u0[1]); w.y = pk2(siluf_(g0[2]) * u0[2], siluf_(g0[3]) * u0[3]);
                w.z = pk2(siluf_(g1[0]) * u1[0], siluf_(g1[1]) * u1[1]); w.w = pk2(siluf_(g1[2]) * u1[2], siluf_(g1[3]) * u1[3]);
                *(u32x4*)((char*)O + off) = w;
                off += EPI_ROWSTEP(m) * FF * 2; EPI_PIN(off); }
    }
};
struct EpiPlain {
    static constexpr bool PERM = true;
    bf16_t* O;
    __device__ __forceinline__ void operator()(const f32x4 (&acc)[2][2][4][2], const Unit& u, int wr, int wc, int fr, int fq) const {
        const int row0 = u.pm * BM + wr * 64 + fr, col0 = u.pn * BM + wc * 32 + 8 * fq;
        unsigned off = (unsigned)(row0 * D + col0) * 2u;
#pragma unroll
        for (int ai = 0; ai < 2; ++ai)
#pragma unroll
            for (int m = 0; m < 4; ++m) {
#pragma unroll
                for (int bj = 0; bj < 2; ++bj) { const f32x4 v0 = acc[ai][bj][m][0], v1 = acc[ai][bj][m][1]; u32x4 w;
                    w.x = pk2(v0[0], v0[1]); w.y = pk2(v0[2], v0[3]); w.z = pk2(v1[0], v1[1]); w.w = pk2(v1[2], v1[3]);
                    *(u32x4*)((char*)O + off + bj * HALF * 2) = w; }
                off += EPI_ROWSTEP(m) * D * 2; EPI_PIN(off); }
    }
};
constexpr float W8_SCALE = 32.0f, W8_INV = 1.0f / 32.0f;
struct EpiSwiGLU8 {
    static constexpr bool PERM = true;
    unsigned char* O;
    __device__ __forceinline__ void operator()(const f32x4 (&acc)[2][2][4][2], const Unit& u, int wr, int wc, int fr, int fq) const {
        const int row0 = u.pm * BM + wr * 64 + fr, col0 = u.pn * HALF + wc * 32 + 8 * fq;
        unsigned off = (unsigned)(row0 * FF + col0);
#pragma unroll
        for (int ai = 0; ai < 2; ++ai)
#pragma unroll
            for (int m = 0; m < 4; ++m) { const f32x4 g0 = acc[ai][0][m][0] * W8_INV, g1 = acc[ai][0][m][1] * W8_INV, u0 = acc[ai][1][m][0] * W8_INV, u1 = acc[ai][1][m][1] * W8_INV; u32x2 w;
                w.x = pk_fp8x4(siluf_(g0[0]) * u0[0], siluf_(g0[1]) * u0[1], siluf_(g0[2]) * u0[2], siluf_(g0[3]) * u0[3]);
                w.y = pk_fp8x4(siluf_(g1[0]) * u1[0], siluf_(g1[1]) * u1[1], siluf_(g1[2]) * u1[2], siluf_(g1[3]) * u1[3]);
                *(u32x2*)(O + off) = w;
                off += EPI_ROWSTEP(m) * FF; EPI_PIN(off); }
    }
};
struct EpiPlainS {
    static constexpr bool PERM = true;
    bf16_t* O; float scale;
    __device__ __forceinline__ void operator()(const f32x4 (&acc)[2][2][4][2], const Unit& u, int wr, int wc, int fr, int fq) const {
        const int row0 = u.pm * BM + wr * 64 + fr, col0 = u.pn * BM + wc * 32 + 8 * fq;
        unsigned off = (unsigned)(row0 * D + col0) * (Y_F8 ? 1u : 2u);
#pragma unroll
        for (int ai = 0; ai < 2; ++ai)
#pragma unroll
            for (int m = 0; m < 4; ++m) {
#pragma unroll
                for (int bj = 0; bj < 2; ++bj) { const f32x4 v0 = acc[ai][bj][m][0] * scale, v1 = acc[ai][bj][m][1] * scale;
#if Y_F8
                    u32x2 w; w.x = pk_fp8x4(v0[0], v0[1], v0[2], v0[3]); w.y = pk_fp8x4(v1[0], v1[1], v1[2], v1[3]);
                    *(u32x2*)((char*)O + off + bj * HALF) = w;
#else
                    u32x4 w; w.x = pk2(v0[0], v0[1]); w.y = pk2(v0[2], v0[3]); w.z = pk2(v1[0], v1[1]); w.w = pk2(v1[2], v1[3]);
                    *(u32x4*)((char*)O + off + bj * HALF * 2) = w;
#endif
                }
                off += EPI_ROWSTEP(m) * D * (Y_F8 ? 1 : 2); EPI_PIN(off); }
    }
};
}

struct Args {
    const float* x; const float* c; const float* w_ada; const float* b_ada; const float* norm_mix; const float* norm_ffn; const float* w_in;
    const float* w_alpha2; const float* b_alpha2; const float* gla_gain; const float* w_out_a; const float* w_out_b; const float* w_out;
    const float* w_router; const float* b_router; const float* w_gate_e; const float* w_up_e; const float* w_down_e; const float* final_norm;
    float* out; unsigned char* ws; int ph_lo, ph_hi;
};

__device__ __forceinline__ int proj_src_col(int n) {
    if (n < 3072) { const int blk = n >> 7, w = n & 127; return (blk << 7) + (w >> 1) + ((w & 1) << 6); }
    if (n < 7680) return n;
    if (n < 11776) return n + 16;
    if (n < 11792) return n - 4096;
    return -1;
}
struct TrDesc { const float* src; unsigned char* dst; int ldw, K, zero, rope, f8; };
__device__ __forceinline__ void tr_load(const TrDesc& d, f32x4 (&v)[16]) {
#pragma unroll
    for (int i = 0; i < 16; ++i) v[i] = *(const f32x4*)(d.src + (size_t)(4 * i) * d.ldw);
}
__device__ __forceinline__ void tr_finish(const TrDesc& d, f32x4 (&v)[16], LAS float* scr, int lane) {
    const int kk = lane >> 4, q4 = lane & 15;
    if (d.zero) {
#pragma unroll
        for (int i = 0; i < 16; ++i) v[i] = (f32x4){0.f, 0.f, 0.f, 0.f}; }
    const int d0 = d.rope ? 8 * (q4 & 7) + (q4 >> 3) : 4 * q4, ds = d.rope ? 2 : 1;
    { LAS float* rp = scr + kk * 65 + d0;
#pragma unroll
        for (int i = 0; i < 16; ++i) { rp[4 * i * 65] = v[i][0]; rp[4 * i * 65 + ds] = v[i][1]; rp[4 * i * 65 + 2 * ds] = v[i][2]; rp[4 * i * 65 + 3 * ds] = v[i][3]; } }
    LDS_WAIT(); asm volatile("" ::: "memory");
    if (d.f8) {
        const int c = lane & 3, nl = lane >> 2; const LAS float* sp = scr + (16 * c) * 65 + nl; unsigned char* dp = d.dst + (size_t)nl * d.K + 16 * c;
#pragma unroll
        for (int j = 0; j < 4; ++j) { u32x4 o;
            o.x = pk_fp8x4(sp[0 * 65 + 16 * j] * 32.0f, sp[1 * 65 + 16 * j] * 32.0f, sp[2 * 65 + 16 * j] * 32.0f, sp[3 * 65 + 16 * j] * 32.0f);
            o.y = pk_fp8x4(sp[4 * 65 + 16 * j] * 32.0f, sp[5 * 65 + 16 * j] * 32.0f, sp[6 * 65 + 16 * j] * 32.0f, sp[7 * 65 + 16 * j] * 32.0f);
            o.z = pk_fp8x4(sp[8 * 65 + 16 * j] * 32.0f, sp[9 * 65 + 16 * j] * 32.0f, sp[10 * 65 + 16 * j] * 32.0f, sp[11 * 65 + 16 * j] * 32.0f);
            o.w = pk_fp8x4(sp[12 * 65 + 16 * j] * 32.0f, sp[13 * 65 + 16 * j] * 32.0f, sp[14 * 65 + 16 * j] * 32.0f, sp[15 * 65 + 16 * j] * 32.0f);
            *(GAS u32x4*)(dp + (size_t)(16 * j) * d.K) = o; }
    } else {
        const int c = lane & 7, nl = lane >> 3; const LAS float* sp = scr + (8 * c) * 65 + nl; unsigned char* dp = d.dst + ((size_t)nl * d.K + 8 * c) * 2;
#pragma unroll
        for (int j = 0; j < 8; ++j) { u32x4 o;
            o.x = pk2(sp[0 * 65 + 8 * j], sp[1 * 65 + 8 * j]); o.y = pk2(sp[2 * 65 + 8 * j], sp[3 * 65 + 8 * j]); o.z = pk2(sp[4 * 65 + 8 * j], sp[5 * 65 + 8 * j]); o.w = pk2(sp[6 * 65 + 8 * j], sp[7 * 65 + 8 * j]);
            *(GAS u32x4*)(dp + (size_t)(8 * j) * d.K * 2) = o; }
    }
    LDS_WAIT(); asm volatile("" ::: "memory");
}

typedef const __attribute__((address_space(4))) Args CArgsP;
__device__ __forceinline__ void prologue_phase(CArgsP* ap_, LAS unsigned char* lds, int vcu, int G, int tid, int wave, int lane, int parts = 7) {
#define a (*ap_)
    unsigned char* ws = a.ws;
    if (parts & 1) {
        LAS float* cact = (LAS float*)lds;
        LAS float* red = (LAS float*)(lds + 65536);
        for (int i = tid; i < NB * D; i += NTHREADS) { const int b = i >> 11, k = i & 2047; cact[k * 8 + b] = siluf_(a.c[i]); }
        __syncthreads();
        float* ada = (float*)(ws + WS_ADA);
        const int q = tid & 7, kg = tid >> 3;
        for (int u = vcu; u < DEPTH * 384; u += G) {
            const int l = u / 384, n0 = (u % 384) * 32;
            const float* W = a.w_ada + (size_t)l * D * 12288 + n0 + 4 * q;
            f32x4 acc[8];
#pragma unroll
            for (int b = 0; b < 8; ++b) acc[b] = (f32x4){0.f, 0.f, 0.f, 0.f};
#pragma unroll 8
            for (int kk = 0; kk < 32; ++kk) { const int k = kg * 32 + kk; const f32x4 w = *(const f32x4*)(W + (size_t)k * 12288);
                const f32x4 c0 = *(const LAS f32x4*)(cact + k * 8), c1 = *(const LAS f32x4*)(cact + k * 8 + 4);
                acc[0] += w * c0[0]; acc[1] += w * c0[1]; acc[2] += w * c0[2]; acc[3] += w * c0[3];
                acc[4] += w * c1[0]; acc[5] += w * c1[1]; acc[6] += w * c1[2]; acc[7] += w * c1[3]; }
#pragma unroll
            for (int b = 0; b < 8; ++b) *(LAS f32x4*)(red + (kg * 8 + b) * 32 + 4 * q) = acc[b];
            __syncthreads();
            if (tid < 256) { const int b = tid >> 5, col = tid & 31; float s = a.b_ada[(size_t)l * 12288 + n0 + col];
                for (int g = 0; g < 64; ++g) s += red[(g * 8 + b) * 32 + col];
                const int n = n0 + col;
                if (n >= 2048 && n < 4096) s = (1.0f + s) * a.norm_mix[(size_t)l * D + n - 2048]; else if (n >= 8192 && n < 10240) s = (1.0f + s) * a.norm_ffn[(size_t)l * D + n - 8192];
                ada[((size_t)l * NB + b) * 12288 + n] = s; }
            __syncthreads();
        }
    }
    if (parts & 2) {
        float* cs = (float*)(ws + WS_ROPE); float* sn = cs + SEQ * 64;
        for (int i = vcu * NTHREADS + tid; i < SEQ * 64; i += G * NTHREADS) {
            const int pos = i >> 6, fi = i & 63;
            double f = 1.0;
            if (fi & 1) f *= 0.8659643233600653; if (fi & 2) f *= 0.7498942093324558; if (fi & 4) f *= 0.5623413251903491;
            if (fi & 8) f *= 0.31622776601683794; if (fi & 16) f *= 0.09999999999999999; if (fi & 32) f *= 0.009999999999999998;
            double rev = (double)pos * f * 0.15915494309189535; rev -= __builtin_floor(rev);
            const float rv = (float)rev;
            cs[i] = __builtin_amdgcn_cosf(rv); sn[i] = __builtin_amdgcn_sinf(rv);
        }
    }
    if (parts & 4) {
        LAS float* scr = (LAS float*)(lds + wave * 16640);
        const int gw = vcu * NWAVES + wave, NGW = G * NWAVES;
        constexpr int C_IN = 32 * 188, C_OA = 8 * 32, C_OB = 16 * 32, C_O = 32 * 32, C_GU = 16 * 32 * 32, C_DN = 16 * 16 * 32, C_L = C_IN + C_OA + C_OB + C_O + C_GU + C_DN, NIT = DEPTH * C_L;
        const int q4 = lane & 15, kk = lane >> 4;
        auto decode = [&](int it) -> TrDesc {
            TrDesc d; d.zero = 0; d.rope = 0; d.f8 = 0;
            const int l = it / C_L; int r = it % C_L;
            const float* W; unsigned char* WT; int ldw, K, k0, n0, scol, esz = 2;
            if (r < C_IN) { const int kb = r / 188, nb = r % 188; n0 = 64 * nb; k0 = 64 * kb; ldw = NIN; K = D; W = a.w_in + (size_t)l * D * NIN;
                if (n0 < 3072) { d.rope = 1; scol = (n0 >> 7) * 128 + 32 * ((n0 >> 6) & 1) + 64 * (q4 >> 3) + 4 * (q4 & 7); }
                else if (n0 < 7680) scol = n0 + 4 * q4;
                else if (n0 < 11776) scol = n0 + 16 + 4 * q4;
                else if (n0 == 11776) { scol = (q4 < 4) ? 7680 + 4 * q4 : 0; d.zero = (q4 < 4) ? 0 : 1; }
                else { scol = 0; d.zero = 1; }
#if PROJ_F8
                d.f8 = 1; esz = 1; WT = ws + WS_WIN + (size_t)l * NP * D;
#else
                WT = ws + WS_WIN + (size_t)l * NP * D * 2;
#endif
            } else if ((r -= C_IN) < C_OA) { const int kb = r / 32, nb = r % 32; n0 = 64 * nb; k0 = 64 * kb; ldw = D; K = 512; scol = n0 + 4 * q4; W = a.w_out_a + (size_t)l * 512 * D; WT = ws + WS_WOA + (size_t)l * D * 512 * (MIX_F8 ? 1 : 2); if (MIX_F8) { d.f8 = 1; esz = 1; }
                if (BR_FUSE) { K = 1536; WT = ws + WS_WOA + (size_t)l * D * 1536 + 1024; }
            } else if ((r -= C_OA) < C_OB) { const int kb = r / 32, nb = r % 32; n0 = 64 * nb; k0 = 64 * kb; ldw = D; K = 1024; scol = n0 + 4 * q4; W = a.w_out_b + (size_t)l * 1024 * D; WT = ws + WS_WOB + (size_t)l * D * 1024 * (MIX_F8 ? 1 : 2); if (MIX_F8) { d.f8 = 1; esz = 1; }
                if (BR_FUSE) { K = 1536; WT = ws + WS_WOA + (size_t)l * D * 1536; }
            } else if ((r -= C_OB) < C_O) { const int kb = r / 32, nb = r % 32; n0 = 64 * nb; k0 = 64 * kb; ldw = D; K = D; scol = n0 + 4 * q4; W = a.w_out + (size_t)l * D * D; WT = ws + WS_WO + (size_t)l * D * D * (MIX_F8 ? 1 : 2); if (MIX_F8) { d.f8 = 1; esz = 1; }
            } else if ((r -= C_O) < C_GU) { const int e = r / 1024, r2 = r % 1024, kb = r2 / 32, nb = r2 % 32, pn = nb >> 2, sgu = (nb >> 1) & 1, c0 = 64 * (nb & 1);
                n0 = 64 * nb; k0 = 64 * kb; ldw = FF; K = D; scol = 128 * pn + c0 + 4 * q4; W = (sgu ? a.w_up_e : a.w_gate_e) + (size_t)(l * NE + e) * D * FF; WT = ws + WS_WGU + (size_t)(l * NE + e) * 2048 * D; d.f8 = 1; esz = 1;
            } else { r -= C_GU; const int e = r / 512, r2 = r % 512, kb = r2 / 32, nb = r2 % 32;
                n0 = 64 * nb; k0 = 64 * kb; ldw = D; K = FF; scol = n0 + 4 * q4; W = a.w_down_e + (size_t)(l * NE + e) * FF * D; WT = ws + WS_WDN + (size_t)(l * NE + e) * D * FF; d.f8 = 1; esz = 1; }
            d.src = W + (size_t)(k0 + kk) * ldw + scol; d.ldw = ldw; d.K = K; d.dst = WT + ((size_t)n0 * K + k0) * esz;
            return d; };
        int it = gw; TrDesc dA, dB; f32x4 vA[16], vB[16];
        if (it < NIT) { dA = decode(it); tr_load(dA, vA); }
        while (it < NIT) {
            const int itB = it + NGW;
            if (itB < NIT) { dB = decode(itB); tr_load(dB, vB); }
            tr_finish(dA, vA, scr, lane);
            if (itB >= NIT) break;
            const int itA = itB + NGW;
            if (itA < NIT) { dA = decode(itA); tr_load(dA, vA); }
            tr_finish(dB, vB, scr, lane);
            it = itA;
        }
    }
}
#undef a

struct MoeStarts {
    int ts[NE];
    __device__ __forceinline__ void init(const unsigned* cnt) { int acc = 0;
#pragma unroll
        for (int e = 0; e < NE; ++e) { ts[e] = acc; acc += ((int)__hip_atomic_load(cnt + 64 * e, RLX_AGENT) + 255) >> 8; } }
    __device__ __forceinline__ int row(int slot) const { const int e = slot >> 16; int t0 = 0;
#pragma unroll
        for (int j = 0; j < NE; ++j) t0 = (e == j) ? ts[j] : t0;
        return t0 * 256 + (slot & 0xffff); }
};

template <int MODE>
__device__ __forceinline__ void norm_phase(const void* xs, void* xd, bf16_t* hout, const float* gain, const float* ada_scale, const float* ada_shift, const float* ada_gate2,
                                           const bf16_t* Y, const int* tslot, const float* tw, const unsigned* cnt, int vcu, int G, int wave, int lane) {
    const int gw = vcu * NWAVES + wave, NGW = G * NWAVES, rpw = T / NGW;
    MoeStarts ms; if (MODE != 0) ms.init(cnt);
    int tsl = 0; float twl = 0.f;
    if (MODE != 0) { const int i0 = gw * rpw * 2, ii = (i0 + lane < 2 * T) ? i0 + lane : 2 * T - 1; tsl = tslot[ii]; twl = tw[ii]; }
    for (int k = 0; k < rpw; k += 2) {
        const int row = gw * rpw + k, b = row >> 11;
        f32x4 v[2][8]; u32x2 xraw[2][8];
        int s0[2], s1[2]; float w0[2], w1[2];
        if (MODE != 0) {
#pragma unroll
            for (int rr = 0; rr < 2; ++rr) { s0[rr] = __builtin_amdgcn_readlane(tsl, (k + rr) * 2); s1[rr] = __builtin_amdgcn_readlane(tsl, (k + rr) * 2 + 1);
                w0[rr] = __builtin_bit_cast(float, __builtin_amdgcn_readlane(__builtin_bit_cast(int, twl), (k + rr) * 2)); w1[rr] = __builtin_bit_cast(float, __builtin_amdgcn_readlane(__builtin_bit_cast(int, twl), (k + rr) * 2 + 1)); } }
#pragma unroll
        for (int rr = 0; rr < 2; ++rr) {
            if (MODE == 0) { const GAS f32x4* xr = (const GAS f32x4*)((const float*)xs + (size_t)(row + rr) * D) + lane;
#pragma unroll
                for (int j = 0; j < 8; ++j) v[rr][j] = xr[64 * j];
            } else { const GAS u32x2* xr = (const GAS u32x2*)((const bf16_t*)xs + (size_t)(row + rr) * D) + lane;
#pragma unroll
                for (int j = 0; j < 8; ++j) xraw[rr][j] = xr[64 * j]; } }
        f32x4 ggv[8], ssv[8], scv[8];
#define GSS_LOAD() do { const GAS f32x4* gn_ = (const GAS f32x4*)gain + lane; \
            if (MODE == 2) { _Pragma("unroll") for (int j = 0; j < 8; ++j) { ggv[j] = gn_[64 * j]; scv[j] = (f32x4){0.f, 0.f, 0.f, 0.f}; ssv[j] = (f32x4){0.f, 0.f, 0.f, 0.f}; } } \
            else { const GAS f32x4* sc_ = (const GAS f32x4*)(ada_scale + (size_t)b * 12288) + lane; const GAS f32x4* sh_ = (const GAS f32x4*)(ada_shift + (size_t)b * 12288) + lane; \
                _Pragma("unroll") for (int j = 0; j < 8; ++j) { ggv[j] = sc_[64 * j]; scv[j] = (f32x4){0.f, 0.f, 0.f, 0.f}; ssv[j] = sh_[64 * j]; } } asm volatile("" ::: "memory"); } while (0)
        if (MODE == 0) GSS_LOAD();
        if (MODE != 0) {
            const GAS f32x4* gt = (const GAS f32x4*)(ada_gate2 + (size_t)b * 12288) + lane;
#if Y_F8
            unsigned ya[2][8], yb[2][8];
#pragma unroll
            for (int rr = 0; rr < 2; ++rr) { const GAS unsigned* y0 = (const GAS unsigned*)((const unsigned char*)Y + (size_t)ms.row(s0[rr]) * D) + lane; const GAS unsigned* y1 = (const GAS unsigned*)((const unsigned char*)Y + (size_t)ms.row(s1[rr]) * D) + lane;
#pragma unroll
                for (int j = 0; j < 8; ++j) { ya[rr][j] = y0[64 * j]; yb[rr][j] = y1[64 * j]; } }
            f32x4 gtv[8];
#pragma unroll
            for (int j = 0; j < 8; ++j) gtv[j] = gt[64 * j];
            asm volatile("" ::: "memory");
#pragma unroll
            for (int rr = 0; rr < 2; ++rr)
#pragma unroll
                for (int j = 0; j < 8; ++j) { LPIN(xraw[rr][j]); LPIN(ya[rr][j]); LPIN(yb[rr][j]); }
#pragma unroll
            for (int j = 0; j < 8; ++j) LPIN(gtv[j]);
#pragma unroll
            for (int rr = 0; rr < 2; ++rr)
#pragma unroll
                for (int j = 0; j < 8; ++j) { const u32x2 r = xraw[rr][j]; v[rr][j] = (f32x4){bflo(r.x), bfhi(r.x), bflo(r.y), bfhi(r.y)}; }
#pragma unroll
            for (int j = 0; j < 8; ++j) { const f32x4 g = gtv[j];
#pragma unroll
                for (int rr = 0; rr < 2; ++rr) {
                    const f32x2_t a0l = __builtin_amdgcn_cvt_pk_f32_fp8((int)ya[rr][j], false), a0h = __builtin_amdgcn_cvt_pk_f32_fp8((int)ya[rr][j], true), a1l = __builtin_amdgcn_cvt_pk_f32_fp8((int)yb[rr][j], false), a1h = __builtin_amdgcn_cvt_pk_f32_fp8((int)yb[rr][j], true);
                    f32x4 m; m[0] = w0[rr] * a0l[0] + w1[rr] * a1l[0]; m[1] = w0[rr] * a0l[1] + w1[rr] * a1l[1]; m[2] = w0[rr] * a0h[0] + w1[rr] * a1h[0]; m[3] = w0[rr] * a0h[1] + w1[rr] * a1h[1];
                    v[rr][j] = v[rr][j] + g * m; } }
#else
            u32x2 ya[2][8], yb[2][8];
#pragma unroll
            for (int rr = 0; rr < 2; ++rr) { const GAS u32x2* y0 = (const GAS u32x2*)(Y + (size_t)ms.row(s0[rr]) * D) + lane; const GAS u32x2* y1 = (const GAS u32x2*)(Y + (size_t)ms.row(s1[rr]) * D) + lane;
#pragma unroll
                for (int j = 0; j < 8; ++j) { ya[rr][j] = y0[64 * j]; yb[rr][j] = y1[64 * j]; } }
#pragma unroll
            for (int j = 0; j < 8; ++j) { const f32x4 g = gt[64 * j];
#pragma unroll
                for (int rr = 0; rr < 2; ++rr) { const u32x2 a0 = ya[rr][j], a1 = yb[rr][j];
                    f32x4 m; m[0] = w0[rr] * bflo(a0.x) + w1[rr] * bflo(a1.x); m[1] = w0[rr] * bfhi(a0.x) + w1[rr] * bfhi(a1.x); m[2] = w0[rr] * bflo(a0.y) + w1[rr] * bflo(a1.y); m[3] = w0[rr] * bfhi(a0.y) + w1[rr] * bfhi(a1.y);
                    v[rr][j] = v[rr][j] + g * m; } }
#endif
            GSS_LOAD();
            if (MODE == 1) {
#pragma unroll
                for (int rr = 0; rr < 2; ++rr) { GAS u32x2* xw = (GAS u32x2*)((bf16_t*)xd + (size_t)(row + rr) * D) + lane;
#pragma unroll
                    for (int j = 0; j < 8; ++j) { u32x2 w; w.x = pk2(v[rr][j][0], v[rr][j][1]); w.y = pk2(v[rr][j][2], v[rr][j][3]); xw[64 * j] = w; } } }
        }
        float rstd[2];
#pragma unroll
        for (int rr = 0; rr < 2; ++rr) { float s = 0.f;
#pragma unroll
            for (int j = 0; j < 8; ++j) s += (v[rr][j][0] * v[rr][j][0] + v[rr][j][1] * v[rr][j][1]) + (v[rr][j][2] * v[rr][j][2] + v[rr][j][3] * v[rr][j][3]);
            rstd[rr] = 1.0f / sqrtf(wave_sum(s, lane) * (1.0f / D) + NORM_EPS); }
        if (MODE == 2) {
#pragma unroll
            for (int j = 0; j < 8; ++j) { const f32x4 gg = ggv[j];
#pragma unroll
                for (int rr = 0; rr < 2; ++rr) ((GAS f32x4*)((float*)xd + (size_t)(row + rr) * D) + lane)[64 * j] = v[rr][j] * rstd[rr] * gg; }
        } else {
#pragma unroll
            for (int j = 0; j < 8; ++j) { const f32x4 gg = ggv[j] * (scv[j] + 1.0f), ss = ssv[j];
#pragma unroll
                for (int rr = 0; rr < 2; ++rr) { const f32x4 hh = v[rr][j] * rstd[rr] * gg + ss;
#if PROJ_F8
                    ((GAS unsigned*)((unsigned char*)hout + (size_t)(row + rr) * D) + lane)[64 * j] = pk_fp8x4_ns(hh[0], hh[1], hh[2], hh[3]);
#else
                    u32x2 w; w.x = pk2(hh[0], hh[1]); w.y = pk2(hh[2], hh[3]); ((GAS u32x2*)(hout + (size_t)(row + rr) * D) + lane)[64 * j] = w;
#endif
                } }
        }
    }
}

__device__ __forceinline__ float reduce16(const float (&p)[NE], int lane) {
    float q[8], r[4], s2[2];
    const bool h5 = (lane & 32) != 0, h4 = (lane & 16) != 0, h3 = (lane & 8) != 0, h2 = (lane & 4) != 0;
#pragma unroll
    for (int i = 0; i < 8; ++i) q[i] = (h5 ? p[i + 8] : p[i]) + sx<32>(h5 ? p[i] : p[i + 8], lane);
#pragma unroll
    for (int i = 0; i < 4; ++i) r[i] = (h4 ? q[i + 4] : q[i]) + sx<16>(h4 ? q[i] : q[i + 4], lane);
#pragma unroll
    for (int i = 0; i < 2; ++i) s2[i] = (h3 ? r[i + 2] : r[i]) + sx<8>(h3 ? r[i] : r[i + 2], lane);
    float t = (h2 ? s2[1] : s2[0]) + sx<4>(h2 ? s2[0] : s2[1], lane);
    t += sx<2>(t, lane); t += sx<1>(t, lane);
    return t;
}
__device__ __forceinline__ void route_token(float affl, float sell, int& i0, int& i1, float& w0, float& w1) {
    float aff[NE], sel[NE];
#pragma unroll
    for (int e = 0; e < NE; ++e) { aff[e] = __builtin_bit_cast(float, __builtin_amdgcn_readlane(__builtin_bit_cast(int, affl), 4 * e)); sel[e] = __builtin_bit_cast(float, __builtin_amdgcn_readlane(__builtin_bit_cast(int, sell), 4 * e)); }
    float gs[4];
#pragma unroll
    for (int g = 0; g < 4; ++g) { const float a = sel[4 * g], b = sel[4 * g + 1], c = sel[4 * g + 2], d = sel[4 * g + 3];
        const float h1 = fmaxf(a, b), l1 = fminf(a, b), h2 = fmaxf(c, d), l2 = fminf(c, d);
        gs[g] = fmaxf(h1, h2) + fmaxf(fminf(h1, h2), fmaxf(l1, l2)); }
    int bg = 0; float best = gs[0];
#pragma unroll
    for (int g = 1; g < 4; ++g) { const bool c = gs[g] > best; best = c ? gs[g] : best; bg = c ? g : bg; }
    float s0 = -3.0e38f, s1 = -3.0e38f, a0 = 0.f, a1 = 0.f; int j0 = 0, j1 = 0;
#pragma unroll
    for (int j = 0; j < 4; ++j) {
        const float v = bg == 0 ? sel[j] : (bg == 1 ? sel[4 + j] : (bg == 2 ? sel[8 + j] : sel[12 + j]));
        const float af = bg == 0 ? aff[j] : (bg == 1 ? aff[4 + j] : (bg == 2 ? aff[8 + j] : aff[12 + j]));
        const bool gt0 = v > s0, gt1 = v > s1;
        s1 = gt0 ? s0 : (gt1 ? v : s1); j1 = gt0 ? j0 : (gt1 ? j : j1); a1 = gt0 ? a0 : (gt1 ? af : a1);
        s0 = gt0 ? v : s0; j0 = gt0 ? j : j0; a0 = gt0 ? af : a0; }
    i0 = 4 * bg + j0; i1 = 4 * bg + j1;
    const float inv = 1.0f / (a0 + a1); w0 = a0 * inv; w1 = a1 * inv;
}
__device__ __forceinline__ void router_phase(const bf16_t* xs, bf16_t* hout, const float* gain, const float* ada_scale, const float* ada_shift, const float* w_router, const float* b_router,
                                             unsigned* cnt, int* rlist, int* tslot, float* tw, LAS unsigned char* lds, int vcu, int G, int tid, int wave, int lane) {
    LAS float* wrT = (LAS float*)lds;
    LAS int* misc = (LAS int*)(lds + MISC_OFF + 64);
    LAS int* lcnt = misc; LAS int* lbase = misc + 16; LAS int* rinfo = misc + 32;
    for (int c = tid; c < D; c += NTHREADS) {
        const f32x4 w0 = *(const f32x4*)(w_router + c * 16), w1 = *(const f32x4*)(w_router + c * 16 + 4), w2 = *(const f32x4*)(w_router + c * 16 + 8), w3 = *(const f32x4*)(w_router + c * 16 + 12);
#pragma unroll
        for (int e = 0; e < 4; ++e) { wrT[e * D + c] = w0[e]; wrT[(4 + e) * D + c] = w1[e]; wrT[(8 + e) * D + c] = w2[e]; wrT[(12 + e) * D + c] = w3[e]; } }
    const int rows_per_blk = T / G;
    for (int base = vcu * rows_per_blk; base < T; base += G * rows_per_blk) {
        if (tid < 16) lcnt[tid] = 0;
        __syncthreads();
        const int rpw = rows_per_blk / NWAVES;
        for (int k = 0; k < rpw; k += 2) {
            const int lr = wave * rpw + k, row = base + lr, b = row >> 11;
            f32x4 v[2][8]; float rstd[2];
#pragma unroll
            for (int rr = 0; rr < 2; ++rr) { const GAS u32x2* xr = (const GAS u32x2*)(xs + (size_t)(row + rr) * D) + lane;
#pragma unroll
                for (int j = 0; j < 8; ++j) { const u32x2 r = xr[64 * j]; v[rr][j] = (f32x4){bflo(r.x), bfhi(r.x), bflo(r.y), bfhi(r.y)}; } }
            f32x4 ggv[8], ssv[8];
            { const GAS f32x4* sc = (const GAS f32x4*)(ada_scale + (size_t)b * 12288) + lane; const GAS f32x4* sh = (const GAS f32x4*)(ada_shift + (size_t)b * 12288) + lane;
#pragma unroll
              for (int j = 0; j < 8; ++j) { ggv[j] = sc[64 * j]; ssv[j] = sh[64 * j]; }
              asm volatile("" ::: "memory"); }
#pragma unroll
            for (int rr = 0; rr < 2; ++rr) { float s = 0.f;
#pragma unroll
                for (int j = 0; j < 8; ++j) s += (v[rr][j][0] * v[rr][j][0] + v[rr][j][1] * v[rr][j][1]) + (v[rr][j][2] * v[rr][j][2] + v[rr][j][3] * v[rr][j][3]);
                rstd[rr] = 1.0f / sqrtf(wave_sum(s, lane) * (1.0f / D) + NORM_EPS); }
#pragma unroll
            for (int jb = 0; jb < 8; jb += 4) {
#pragma unroll
                for (int jj = 0; jj < 4; ++jj) { const int j = jb + jj; const f32x4 gg = ggv[j], ss = ssv[j];
#pragma unroll
                    for (int rr = 0; rr < 2; ++rr) { v[rr][j] = v[rr][j] * rstd[rr] * gg + ss;
                        ((GAS unsigned*)((unsigned char*)hout + (size_t)(row + rr) * D) + lane)[64 * j] = pk_fp8x4_ns(v[rr][j][0], v[rr][j][1], v[rr][j][2], v[rr][j][3]); } }
                asm volatile("" ::: "memory"); }
            float p0[NE], p1[NE];
            f32x4 wA[8], wB[8];
#define RT_RD(W, e) do { _Pragma("unroll") for (int j = 0; j < 8; ++j) W[j] = *(const LAS f32x4*)(wrT + (e) * D + 4 * lane + 256 * j); asm volatile("" ::: "memory"); } while (0)
#define RT_FMA(W, e) do { f32x2 a0 = {0.f, 0.f}, a1 = {0.f, 0.f}; _Pragma("unroll") for (int j = 0; j < 8; ++j) { LPIN(W[j]); const f32x2 wl = {W[j][0], W[j][1]}, wh = {W[j][2], W[j][3]}; \
                a0 = __builtin_elementwise_fma((f32x2){v[0][j][0], v[0][j][1]}, wl, a0); a0 = __builtin_elementwise_fma((f32x2){v[0][j][2], v[0][j][3]}, wh, a0); \
                a1 = __builtin_elementwise_fma((f32x2){v[1][j][0], v[1][j][1]}, wl, a1); a1 = __builtin_elementwise_fma((f32x2){v[1][j][2], v[1][j][3]}, wh, a1); } \
                p0[e] = a0[0] + a0[1]; p1[e] = a1[0] + a1[1]; } while (0)
            RT_RD(wA, 0);
#pragma unroll
            for (int e = 0; e < NE; e += 2) { RT_RD(wB, e + 1); RT_FMA(wA, e); if (e + 2 < NE) RT_RD(wA, e + 2); RT_FMA(wB, e + 1); }
#undef RT_RD
#undef RT_FMA
            const float t0 = reduce16(p0, lane), t1 = reduce16(p1, lane);
            const float bre = b_router[lane >> 2];
#pragma unroll
            for (int rr = 0; rr < 2; ++rr) {
                const float affl = sigmoidf_(rr ? t1 : t0), sell = affl + bre;
                int i0, i1; float w0, w1; route_token(affl, sell, i0, i1, w0, w1);
                if (lane == 0) { const int r0 = atomicAdd((int*)lcnt + i0, 1), r1 = atomicAdd((int*)lcnt + i1, 1);
                    rinfo[(lr + rr) * 4 + 0] = (i0 << 16) | r0; rinfo[(lr + rr) * 4 + 1] = (i1 << 16) | r1;
                    tw[(row + rr) * 2] = w0; tw[(row + rr) * 2 + 1] = w1; } }
        }
        __syncthreads();
        if (tid < 16) lbase[tid] = (int)__hip_atomic_fetch_add(cnt + 64 * tid, (unsigned)lcnt[tid], RLX_AGENT);
        __syncthreads();
        if (tid < rows_per_blk * 2) { const int lr = tid >> 1, kk = tid & 1, info = rinfo[lr * 4 + kk], e = info >> 16, rank = lbase[e] + (info & 0xffff);
            rlist[(size_t)e * T + rank] = base + lr; tslot[(base + lr) * 2 + kk] = (e << 16) | rank; }
        __syncthreads();
    }
}

__device__ __forceinline__ int swz256(int row, int ch) { return 256 * row + 16 * (ch ^ (((row & 3) << 2) | ((row >> 2) & 3))); }
typedef short v4i16_t __attribute__((ext_vector_type(4)));
__device__ __forceinline__ s16x4 vtr(const LAS unsigned char* p) { return __builtin_bit_cast(s16x4, __builtin_amdgcn_ds_read_tr16_b64_v4i16((LAS v4i16_t*)p)); }

struct AttnPre { u32x4 kv[8]; bf16x8 qf[4]; };
__device__ __forceinline__ void attn_issue(AttnPre& R, const bf16_t* proj, int a, int tid, int wave, int lane) {
    const int sub = a & 15, bh = a >> 4, head = bh % 12, b = bh / 12, g = head >> 2;
    const int dsh = 2 * g, nbsh = 4 - 2 * g;
    const int nblk = sub & ((1 << nbsh) - 1), r = sub >> nbsh;
    const size_t tb = (size_t)b * SEQ;
    const int p0 = 128 * (nblk - 1);
#pragma unroll
    for (int it = 0; it < 8; ++it) { const int id = tid + NTHREADS * it, row = id >> 4, ch = id & 15, p = p0 + row;
        const int pc = p < 0 ? 0 : p;
        const size_t t = tb + ((size_t)pc << dsh) + r; R.kv[it] = *(const u32x4*)(proj + t * NP + KA + head * 128 + ch * 8); }
    const int fr = lane & 15, fq = lane >> 4, qi = 16 * wave + fr;
    const size_t tq = tb + ((size_t)(128 * nblk + qi) << dsh) + r;
    const bf16_t* qsrc = proj + tq * NP + QA + head * 128 + fq * 8;
#pragma unroll
    for (int ks = 0; ks < 4; ++ks) R.qf[ks] = *(const bf16x8*)(qsrc + 32 * ks);
}
__device__ __forceinline__ void attn_unit(LAS unsigned char* lds, AttnPre& R, const bf16_t* proj, bf16_t* atto, float* lse, int a, int a_next, int tid, int wave, int lane) {
    const int sub = a & 15, bh = a >> 4, head = bh % 12, b = bh / 12, g = head >> 2, hj = head & 3;
    const int dsh = 2 * g, nbsh = 4 - 2 * g;
    const int nblk = sub & ((1 << nbsh) - 1), r = sub >> nbsh;
    const size_t tb = (size_t)b * SEQ;
    const int p0 = 128 * (nblk - 1);
    LAS unsigned char* Kl = lds; LAS unsigned char* Vl = lds + 65536;
#pragma unroll
    for (int it = 0; it < 8; ++it) { const int id = tid + NTHREADS * it, row = id >> 4, ch = id & 15; *(LAS u32x4*)(Kl + swz256(row, ch)) = R.kv[it]; }
    u32x4 vv[8];
#pragma unroll
    for (int it = 0; it < 8; ++it) { const int id = tid + NTHREADS * it, row = id >> 4, ch = id & 15, p = p0 + row;
        const int pc = p < 0 ? 0 : p;
        const size_t t = tb + ((size_t)pc << dsh) + r; vv[it] = *(const u32x4*)(proj + t * NP + VA + head * 128 + ch * 8); }
    const int fr = lane & 15, fq = lane >> 4;
    const int qi = 16 * wave + fr;
    const size_t tq = tb + ((size_t)(128 * nblk + qi) << dsh) + r;
    bf16x8 qf[4];
#pragma unroll
    for (int ks = 0; ks < 4; ++ks) qf[ks] = R.qf[ks];
    __syncthreads();
    f32x4 sacc[9];
    unsigned kbase[4];
    { const int fK = ((fr & 3) << 2) | ((fr >> 2) & 3);
#pragma unroll
        for (int ks = 0; ks < 4; ++ks) kbase[ks] = (unsigned)(256 * (16 * wave + fr) + 16 * ((4 * ks + fq) ^ fK)); }
#pragma unroll
    for (int kt = 0; kt < 9; ++kt) { f32x4 acc = (f32x4){0.f, 0.f, 0.f, 0.f};
#pragma unroll
        for (int ks = 0; ks < 4; ++ks) { const bf16x8 kf = *(const LAS bf16x8*)(Kl + kbase[ks] + 4096 * kt); acc = __builtin_amdgcn_mfma_f32_16x16x32_bf16(kf, qf[ks], acc, 0, 0, 0); }
        sacc[kt] = acc; }
    const float sc = 0.12751743082459868f;
    float mx = -3.0e38f;
#pragma unroll
    for (int kt = 0; kt < 9; ++kt)
#pragma unroll
        for (int rg = 0; rg < 4; ++rg) { const int jk = 16 * (wave + kt) + 4 * fq + rg; const bool valid = (jk >= qi) && (jk <= qi + 128) && (p0 + jk >= 0);
            const float s = valid ? sacc[kt][rg] * sc : -3.0e38f; sacc[kt][rg] = s; mx = fmaxf(mx, s); }
    mx = fmaxf(mx, sx<16>(mx, lane)); mx = fmaxf(mx, sx<32>(mx, lane));
    float sum = 0.f;
#pragma unroll
    for (int kt = 0; kt < 9; ++kt)
#pragma unroll
        for (int rg = 0; rg < 4; ++rg) { const float p = __builtin_amdgcn_exp2f(sacc[kt][rg] - mx); sacc[kt][rg] = p; sum += p; }
    sum += sx<16>(sum, lane); sum += sx<32>(sum, lane);
#pragma unroll
    for (int it = 0; it < 8; ++it) { const int id = tid + NTHREADS * it, row = id >> 4, ch = id & 15; *(LAS u32x4*)(Vl + swz256(row, ch)) = vv[it]; }
    __syncthreads();
    if (a_next >= 0) attn_issue(R, proj, a_next, tid, wave, lane);
    f32x4 oacc[8];
#pragma unroll
    for (int dt = 0; dt < 8; ++dt) oacc[dt] = (f32x4){0.f, 0.f, 0.f, 0.f};
    const int li = lane & 15, qq = li >> 2, pp = li & 3;
    unsigned vbase[8];
    { const int fV = (qq << 2) | fq;
#pragma unroll
        for (int dt = 0; dt < 8; ++dt) vbase[dt] = (unsigned)(256 * (16 * wave + 4 * fq + qq) + 16 * ((2 * dt + (pp >> 1)) ^ fV) + 8 * (pp & 1)); }
#pragma unroll
    for (int s5 = 0; s5 < 5; ++s5) {
        const int t0 = 2 * s5, t1 = (2 * s5 + 1 < 9) ? 2 * s5 + 1 : 2 * s5;
        u32x4 pw; pw.x = pk2(sacc[t0][0], sacc[t0][1]); pw.y = pk2(sacc[t0][2], sacc[t0][3]);
        if (2 * s5 + 1 < 9) { pw.z = pk2(sacc[t1][0], sacc[t1][1]); pw.w = pk2(sacc[t1][2], sacc[t1][3]); } else { pw.z = 0u; pw.w = 0u; }
        const bf16x8 pf = __builtin_bit_cast(bf16x8, pw);
#pragma unroll
        for (int dt = 0; dt < 8; ++dt) {
            const s16x4 v0 = vtr(Vl + vbase[dt] + 4096 * t0);
            const s16x4 v1 = vtr(Vl + vbase[dt] + 4096 * t1);
            bf16x8 vf; vf[0] = v0[0]; vf[1] = v0[1]; vf[2] = v0[2]; vf[3] = v0[3]; vf[4] = v1[0]; vf[5] = v1[1]; vf[6] = v1[2]; vf[7] = v1[3];
            oacc[dt] = __builtin_amdgcn_mfma_f32_16x16x32_bf16(vf, pf, oacc[dt], 0, 0, 0);
        }
    }
    const float inv = 1.0f / sum;
    bf16_t* op = atto + ((size_t)g * T + tq) * 512 + hj * 128 + 4 * fq;
#pragma unroll
    for (int dt = 0; dt < 8; ++dt) { u32x2 w; w.x = pk2(oacc[dt][0] * inv, oacc[dt][1] * inv); w.y = pk2(oacc[dt][2] * inv, oacc[dt][3] * inv); *(u32x2*)(op + 16 * dt) = w; }
    if (fq == 0) lse[((size_t)g * T + tq) * 4 + hj] = mx * 0.6931471805599453f + __logf(sum);
    __syncthreads();
}

__device__ __forceinline__ int swz512(int row, int ch) { return 512 * row + 16 * (ch ^ (((row & 3) << 2) | ((row >> 2) & 3))); }

struct GlaPre { float al0, al1; u32x4 q[2], k[2], v[4]; };
__device__ __forceinline__ void gla_local_issue(GlaPre& R, const bf16_t* proj, const float* alow, int u, int tid) {
    const int n = u & 31, h = (u >> 5) & 3, b = u >> 7;
    const size_t t0 = (size_t)b * SEQ + 64 * n;
    R.al0 = alow[t0 * 16 + tid]; R.al1 = alow[t0 * 16 + 512 + tid];
#pragma unroll
    for (int it = 0; it < 2; ++it) { const int id = tid + NTHREADS * it, row = id >> 4, ch = id & 15; const bf16_t* src = proj + (t0 + row) * NP + h * 128 + ch * 8; R.q[it] = *(const u32x4*)(src + QB); R.k[it] = *(const u32x4*)(src + KB); }
#pragma unroll
    for (int it = 0; it < 4; ++it) { const int id = tid + NTHREADS * it, row = id >> 5, ch = id & 31; R.v[it] = *(const u32x4*)(proj + (t0 + row) * NP + VB + h * 256 + ch * 8); }
}
__device__ __forceinline__ void gla_local_unit(LAS unsigned char* lds, GlaPre& R, const bf16_t* proj, const float* alow, const float (&w2)[16], const float bias,
                                               bf16_t* qdg, bf16_t* oig, bf16_t* dstg, float* decg, int u, int u_next, int tid, int wave, int lane) {
    const int n = u & 31, h = (u >> 5) & 3, b = u >> 7;
    const int d = tid & 127, ig = tid >> 7;
    const int fr = lane & 15, fq = lane >> 4;
    LAS unsigned char* QD = lds; LAS unsigned char* KI = lds + 17408; LAS unsigned char* KET = lds + 34816; LAS unsigned char* VL = lds + 53248;
    LAS unsigned char* AT = lds + 86016;
    LAS float* CS = (LAS float*)(lds + 95232); LAS float* ALs = (LAS float*)(lds + 97280);
    const size_t t0 = (size_t)b * SEQ + 64 * n;
#pragma unroll
    for (int it = 0; it < 2; ++it) { const int id = tid + NTHREADS * it, row = id >> 4, ch = id & 15; *(LAS u32x4*)(QD + row * 272 + ch * 16) = R.q[it]; *(LAS u32x4*)(KI + row * 272 + ch * 16) = R.k[it]; }
    ALs[tid] = R.al0; ALs[512 + tid] = R.al1;
#pragma unroll
    for (int it = 0; it < 4; ++it) { const int id = tid + NTHREADS * it, row = id >> 5, ch = id & 31; *(LAS u32x4*)(VL + swz512(row, ch)) = R.v[it]; }
    __syncthreads();
    if (u_next >= 0) gla_local_issue(R, proj, alow, u_next, tid);
    float bl[16]; float run = 0.f;
#pragma unroll
    for (int ii = 0; ii < 16; ++ii) { float z = bias; const LAS f32x4* ap = (const LAS f32x4*)(ALs + (16 * ig + ii) * 16);
#pragma unroll
        for (int r4 = 0; r4 < 4; ++r4) { const f32x4 av = ap[r4]; z = fmaf(av[0], w2[4 * r4], z); z = fmaf(av[1], w2[4 * r4 + 1], z); z = fmaf(av[2], w2[4 * r4 + 2], z); z = fmaf(av[3], w2[4 * r4 + 3], z); }
        const float la = (fminf(z, 0.f) - __logf(1.0f + __expf(-fabsf(z)))) * 0.0625f; run += la; bl[ii] = run; }
    CS[ig * 128 + d] = run;
    __syncthreads();
    float pre = 0.f, tot = 0.f;
#pragma unroll
    for (int g2 = 0; g2 < 4; ++g2) { const float cv = CS[g2 * 128 + d]; tot += cv; pre += (g2 < ig) ? cv : 0.f; }
    const float qscale = 0.08838834764831845f; const float etot = __expf(tot);
    unsigned ke[8];
#pragma unroll
    for (int ii = 0; ii < 16; ++ii) { const float bb = pre + bl[ii];
        LAS bf16_t* qp = (LAS bf16_t*)(QD + (16 * ig + ii) * 272 + 2 * d); LAS bf16_t* kp = (LAS bf16_t*)(KI + (16 * ig + ii) * 272 + 2 * d);
        const float qf_ = bf2f(*qp), kf_ = bf2f(*kp);
        const float eb = __expf(bb), einv = __builtin_amdgcn_rcpf(eb);
        const float qd = qf_ * qscale * eb, ki = kf_ * einv, kend = kf_ * (etot * einv);
        *qp = (bf16_t)f2bf(qd); *kp = (bf16_t)f2bf(ki);
        if (ii & 1) ke[ii >> 1] |= f2bf(kend) << 16; else ke[ii >> 1] = f2bf(kend); }
    *(LAS u32x4*)(KET + d * 144 + 32 * ig) = (u32x4){ke[0], ke[1], ke[2], ke[3]}; *(LAS u32x4*)(KET + d * 144 + 32 * ig + 16) = (u32x4){ke[4], ke[5], ke[6], ke[7]};
    if (ig == 0) decg[(size_t)u * 128 + d] = etot;
    __syncthreads();
#pragma unroll
    for (int it = 0; it < 2; ++it) { const int id = tid + NTHREADS * it, row = id >> 4, ch = id & 15; *(u32x4*)(qdg + ((size_t)(b * 4 + h) * 32 + n) * 8192 + (size_t)((((row >> 4) * 4 + (ch >> 2)) * 64 + (row & 15) * 4 + (ch & 3)) * 8)) = *(const LAS u32x4*)(QD + row * 272 + ch * 16); }
#pragma unroll
    for (int x = 0; x < 2; ++x) { const int id = 2 * wave + x, ti = id >> 2, tj = id & 3; f32x4 acc = (f32x4){0.f, 0.f, 0.f, 0.f};
        if (tj <= ti) {
#pragma unroll
            for (int ks = 0; ks < 4; ++ks) { const bf16x8 af = *(const LAS bf16x8*)(QD + (16 * ti + fr) * 272 + (32 * ks + 8 * fq) * 2); const bf16x8 bfr = *(const LAS bf16x8*)(KI + (16 * tj + fr) * 272 + (32 * ks + 8 * fq) * 2);
                acc = __builtin_amdgcn_mfma_f32_16x16x32_bf16(af, bfr, acc, 0, 0, 0); } }
#pragma unroll
        for (int rg = 0; rg < 4; ++rg) { const int i = 16 * ti + 4 * fq + rg, j = 16 * tj + fr; const float vv = (i >= j) ? acc[rg] : 0.f; *(LAS bf16_t*)(AT + i * 144 + 2 * j) = (bf16_t)f2bf(vv); } }
    bf16x8 vfr[2][2];
    { const int li = lane & 15, qq = li >> 2, pp = li & 3;
#pragma unroll
        for (int tv = 0; tv < 2; ++tv)
#pragma unroll
            for (int ks = 0; ks < 2; ++ks) { const int vt = 2 * wave + tv;
                const int r0 = 32 * ks + 8 * fq + qq, r1 = r0 + 4;
                const s16x4 a0 = vtr(VL + swz512(r0, 2 * vt + (pp >> 1)) + 8 * (pp & 1)), a1 = vtr(VL + swz512(r1, 2 * vt + (pp >> 1)) + 8 * (pp & 1));
                bf16x8 f; f[0] = a0[0]; f[1] = a0[1]; f[2] = a0[2]; f[3] = a0[3]; f[4] = a1[0]; f[5] = a1[1]; f[6] = a1[2]; f[7] = a1[3]; vfr[tv][ks] = f; } }
#pragma unroll
    for (int dt = 0; dt < 8; ++dt) {
        bf16x8 kf[2];
#pragma unroll
        for (int ks = 0; ks < 2; ++ks) kf[ks] = *(const LAS bf16x8*)(KET + (16 * dt + fr) * 144 + (32 * ks + 8 * fq) * 2);
#pragma unroll
        for (int tv = 0; tv < 2; ++tv) { f32x4 acc = (f32x4){0.f, 0.f, 0.f, 0.f};
#pragma unroll
            for (int ks = 0; ks < 2; ++ks) acc = __builtin_amdgcn_mfma_f32_16x16x32_bf16(kf[ks], vfr[tv][ks], acc, 0, 0, 0);
            u32x2 w; w.x = pk2(acc[0], acc[1]); w.y = pk2(acc[2], acc[3]);
            *(u32x2*)(dstg + (((size_t)(b * 4 + h) * 8 + wave) * 32 + n) * 4096 + (size_t)(((dt * 2 + tv) * 64 + fr * 4 + fq) * 4)) = w; } }
    __syncthreads();
#pragma unroll
    for (int ti = 0; ti < 4; ++ti) {
        bf16x8 af[2];
#pragma unroll
        for (int ks = 0; ks < 2; ++ks) af[ks] = *(const LAS bf16x8*)(AT + (16 * ti + fr) * 144 + (32 * ks + 8 * fq) * 2);
#pragma unroll
        for (int tv = 0; tv < 2; ++tv) { f32x4 acc = (f32x4){0.f, 0.f, 0.f, 0.f};
#pragma unroll
            for (int ks = 0; ks < 2; ++ks) acc = __builtin_amdgcn_mfma_f32_16x16x32_bf16(vfr[tv][ks], af[ks], acc, 0, 0, 0);
            u32x2 w; w.x = pk2(acc[0], acc[1]); w.y = pk2(acc[2], acc[3]);
            *(u32x2*)(oig + (((size_t)(b * 4 + h) * 8 + wave) * 32 + n) * 2048 + (size_t)(((ti * 2 + tv) * 64 + fr * 4 + fq) * 4)) = w; } }
    __syncthreads();
}

template <bool FAKE>
__device__ __forceinline__ void gla_scan_unit(LAS unsigned char* lds, const bf16_t* qdg, const bf16_t* oig, const bf16_t* dstg, const float* decg, bf16_t* ob, float* ssq,
                                              int u, int tid, int wave, int lane) {
    const int vs = u & 7, h = (u >> 3) & 3, b = u >> 5;
    const int fr = lane & 15, fq = lane >> 4;
    const int ti = wave >> 1, tv = wave & 1;
    LAS unsigned char* STb = lds;
    LAS unsigned char* OBL = lds + 20480;
    LAS float* SQL = (LAS float*)(lds + 53248);
    f32x4 sst[2]; sst[0] = (f32x4){0.f, 0.f, 0.f, 0.f}; sst[1] = sst[0];
    { unsigned z0 = 0u; asm volatile("" : "+v"(z0)); *(LAS u32x4*)(STb + tid * 16) = (u32x4){z0, z0, z0, z0}; if (tid < 32) *(LAS u32x4*)(STb + 8192 + tid * 16) = (u32x4){z0, z0, z0, z0}; }
    const int ub = (b * 4 + h) * 32;
    struct StepOps { bf16x8 q[4]; u32x2 o; u32x2 ds[2]; f32x4 dc; };
    const unsigned qoff = (unsigned)((ti * 4 * 64 + fr * 4 + fq) * 16), ooff = (unsigned)(((ti * 2 + tv) * 64 + fr * 4 + fq) * 8);
    const unsigned dsoff = (unsigned)(((wave * 2) * 64 + fr * 4 + fq) * 8), dcoff = (unsigned)(16 * wave + 4 * fq) * 4u;
    const char* qbase = (const char*)(qdg + (size_t)(b * 4 + h) * SEQ * 128);
    const char* obase = (const char*)(oig + ((size_t)(b * 4 + h) * 8 + vs) * SEQ * 32);
    const char* dsbase = (const char*)(dstg + ((size_t)(b * 4 + h) * 8 + vs) * 32 * 32 * 128);
    const char* dcbase = (const char*)(decg + (size_t)ub * 128);
#define GLA_LOAD(R, nn_) do { const int nn = FAKE ? 0 : ((nn_) < 32 ? (nn_) : 31); \
        const char* qs_ = qbase + (size_t)nn * 16384; _Pragma("unroll") for (int ks = 0; ks < 4; ++ks) R.q[ks] = *(const bf16x8*)(qs_ + qoff + 1024 * ks); \
        R.o = *(const u32x2*)(obase + (size_t)nn * 4096 + ooff); \
        _Pragma("unroll") for (int t2 = 0; t2 < 2; ++t2) R.ds[t2] = *(const u32x2*)(dsbase + (size_t)nn * 8192 + 512 * t2 + dsoff); \
        R.dc = *(const f32x4*)(dcbase + (size_t)nn * 512 + dcoff); } while (0)
#define GLA_STEP(R, n_) do { const int n = (n_); const size_t t0 = (size_t)b * SEQ + 64 * n; \
        LAS unsigned char* STc = STb + (n & 1) * 8704; LAS unsigned char* STn = STb + ((n + 1) & 1) * 8704; \
        f32x4 acc; acc[0] = bflo(R.o.x); acc[1] = bfhi(R.o.x); acc[2] = bflo(R.o.y); acc[3] = bfhi(R.o.y); \
        _Pragma("unroll") for (int ks = 0; ks < 4; ++ks) { const bf16x8 sfr = *(const LAS bf16x8*)(STc + (16 * tv + fr) * 272 + (32 * ks + 8 * fq) * 2); acc = __builtin_amdgcn_mfma_f32_16x16x32_bf16(sfr, R.q[ks], acc, 0, 0, 0); } \
        { u32x2 w; w.x = pk2(acc[0], acc[1]); w.y = pk2(acc[2], acc[3]);              \
            *(LAS u32x2*)(OBL + (n & 7) * 4096 + (16 * ti + fr) * 64 + (16 * tv + 4 * fq) * 2) = w; \
            float q2 = (acc[0] * acc[0] + acc[1] * acc[1]) + (acc[2] * acc[2] + acc[3] * acc[3]); q2 += sx<16>(q2, lane); q2 += sx<32>(q2, lane); \
            if (fq == 0) SQL[(n & 7) * 128 + (16 * ti + fr) * 2 + tv] = q2; } \
        _Pragma("unroll") for (int t2 = 0; t2 < 2; ++t2) { \
            sst[t2][0] = sst[t2][0] * R.dc[0] + bflo(R.ds[t2].x); sst[t2][1] = sst[t2][1] * R.dc[1] + bfhi(R.ds[t2].x); \
            sst[t2][2] = sst[t2][2] * R.dc[2] + bflo(R.ds[t2].y); sst[t2][3] = sst[t2][3] * R.dc[3] + bfhi(R.ds[t2].y); \
            u32x2 w; w.x = pk2(sst[t2][0], sst[t2][1]); w.y = pk2(sst[t2][2], sst[t2][3]); \
            *(LAS u32x2*)(STn + (16 * t2 + fr) * 272 + (16 * wave + 4 * fq) * 2) = w; } \
        __syncthreads(); \
        if (!FAKE && (n & 7) == 7) { const size_t tf = (size_t)b * SEQ + 64 * (n - 7); \
            _Pragma("unroll") for (int it = 0; it < 4; ++it) { const int id = tid + NTHREADS * it, sf = id >> 8, row = (id >> 2) & 63, c = id & 3; \
                *(u32x4*)(ob + (tf + 64 * sf + row) * 1024 + h * 256 + 32 * vs + 8 * c) = *(const LAS u32x4*)(OBL + id * 16); } \
            _Pragma("unroll") for (int it = 0; it < 2; ++it) { const int id = tid + NTHREADS * it, sf = id >> 7, row = (id >> 1) & 63, tq = id & 1; \
                ssq[((tf + 64 * sf + row) * 4 + h) * 16 + vs * 2 + tq] = SQL[id]; } \
            __syncthreads(); } } while (0)
    StepOps r0, r1, r2, r3;
    GLA_LOAD(r0, 0); GLA_LOAD(r1, 1); GLA_LOAD(r2, 2);
    __syncthreads();
    for (int n4 = 0; n4 < 32; n4 += 4) {
        GLA_LOAD(r3, n4 + 3); GLA_STEP(r0, n4);
        GLA_LOAD(r0, n4 + 4); GLA_STEP(r1, n4 + 1);
        GLA_LOAD(r1, n4 + 5); GLA_STEP(r2, n4 + 2);
        GLA_LOAD(r2, n4 + 6); GLA_STEP(r3, n4 + 3);
    }
#undef GLA_STEP
#undef GLA_LOAD
}

__device__ __forceinline__ void merge_phase(const bf16_t* atto, const float* lse, const bf16_t* ob, const float* ssq, const bf16_t* proj, const float* gla_gain, bf16_t* ya, bf16_t* yb,
                                            int vcu, int G, int wave, int lane) {
    const int gw = vcu * NWAVES + wave, NGW = G * NWAVES;
    const int hj = lane >> 4;
    f32x4 g0[2], g1[2];
#pragma unroll
    for (int c = 0; c < 2; ++c) { const int col = 8 * lane + 512 * c; g0[c] = *(const f32x4*)(gla_gain + col); g1[c] = *(const f32x4*)(gla_gain + col + 4); }
    for (int row0 = 2 * gw; row0 < T; row0 += 2 * NGW) {
        float l0[2], l1[2], l2[2]; u32x4 a0[2], a1[2], a2[2], o[2][2], rr_[2][2]; f32x4 sq[2][2][4];
#pragma unroll
        for (int r = 0; r < 2; ++r) { const int row = row0 + r;
            l0[r] = lse[((size_t)0 * T + row) * 4 + hj]; l1[r] = lse[((size_t)1 * T + row) * 4 + hj]; l2[r] = lse[((size_t)2 * T + row) * 4 + hj];
            a0[r] = *(const u32x4*)(atto + ((size_t)0 * T + row) * 512 + 8 * lane); a1[r] = *(const u32x4*)(atto + ((size_t)1 * T + row) * 512 + 8 * lane); a2[r] = *(const u32x4*)(atto + ((size_t)2 * T + row) * 512 + 8 * lane);
#pragma unroll
            for (int c = 0; c < 2; ++c) { const int col = 8 * lane + 512 * c, hh = col >> 8;
                const f32x4* sp = (const f32x4*)(ssq + ((size_t)row * 4 + hh) * 16); sq[r][c][0] = sp[0]; sq[r][c][1] = sp[1]; sq[r][c][2] = sp[2]; sq[r][c][3] = sp[3];
                o[r][c] = *(const u32x4*)(ob + (size_t)row * 1024 + col);
#if GATE_F8
                { const u32x2 r8 = *(const u32x2*)((const unsigned char*)proj + (size_t)row * NP * 2 + G8_BYTE0 + col); rr_[r][c] = (u32x4){r8.x, r8.y, 0u, 0u}; }
#else
                rr_[r][c] = *(const u32x4*)(proj + (size_t)row * NP + RB + col);
#endif
            } }
#pragma unroll
        for (int r = 0; r < 2; ++r) { const int row = row0 + r;
            const float m = fmaxf(l0[r], fmaxf(l1[r], l2[r])); float e0 = __expf(l0[r] - m), e1 = __expf(l1[r] - m), e2 = __expf(l2[r] - m); const float inv = 1.0f / (e0 + e1 + e2); e0 *= inv; e1 *= inv; e2 *= inv;
            u32x4 w;
            w.x = pk2(e0 * bflo(a0[r].x) + e1 * bflo(a1[r].x) + e2 * bflo(a2[r].x), e0 * bfhi(a0[r].x) + e1 * bfhi(a1[r].x) + e2 * bfhi(a2[r].x));
            w.y = pk2(e0 * bflo(a0[r].y) + e1 * bflo(a1[r].y) + e2 * bflo(a2[r].y), e0 * bfhi(a0[r].y) + e1 * bfhi(a1[r].y) + e2 * bfhi(a2[r].y));
            w.z = pk2(e0 * bflo(a0[r].z) + e1 * bflo(a1[r].z) + e2 * bflo(a2[r].z), e0 * bfhi(a0[r].z) + e1 * bfhi(a1[r].z) + e2 * bfhi(a2[r].z));
            w.w = pk2(e0 * bflo(a0[r].w) + e1 * bflo(a1[r].w) + e2 * bflo(a2[r].w), e0 * bfhi(a0[r].w) + e1 * bfhi(a1[r].w) + e2 * bfhi(a2[r].w));
#if MIX_F8
            { u32x2 w8; w8.x = pk_fp8x4(bflo(w.x), bfhi(w.x), bflo(w.y), bfhi(w.y)); w8.y = pk_fp8x4(bflo(w.z), bfhi(w.z), bflo(w.w), bfhi(w.w)); *(u32x2*)((unsigned char*)ya + (BR_FUSE ? (size_t)row * 1536 + 1024 : (size_t)row * 512) + 8 * lane) = w8; }
#else
            *(u32x4*)(ya + (size_t)row * 512 + 8 * lane) = w;
#endif
#pragma unroll
            for (int c = 0; c < 2; ++c) { const int col = 8 * lane + 512 * c;
                const f32x4 s0 = sq[r][c][0], s1 = sq[r][c][1], s2 = sq[r][c][2], s3 = sq[r][c][3];
                const float tot = ((s0[0] + s0[1]) + (s0[2] + s0[3])) + ((s1[0] + s1[1]) + (s1[2] + s1[3])) + ((s2[0] + s2[1]) + (s2[2] + s2[3])) + ((s3[0] + s3[1]) + (s3[2] + s3[3]));
                const float rstd = 1.0f / sqrtf(tot * (1.0f / 256.0f) + NORM_EPS);
                const u32x4 ov = o[r][c], rv = rr_[r][c]; u32x4 y; float rf[8];
#if GATE_F8
                unpack_fp8x8((u32x2){rv.x, rv.y}, rf);
#else
                rf[0] = bflo(rv.x); rf[1] = bfhi(rv.x); rf[2] = bflo(rv.y); rf[3] = bfhi(rv.y); rf[4] = bflo(rv.z); rf[5] = bfhi(rv.z); rf[6] = bflo(rv.w); rf[7] = bfhi(rv.w);
#endif
                y.x = pk2(bflo(ov.x) * rstd * g0[c][0] * siluf_(rf[0]), bfhi(ov.x) * rstd * g0[c][1] * siluf_(rf[1]));
                y.y = pk2(bflo(ov.y) * rstd * g0[c][2] * siluf_(rf[2]), bfhi(ov.y) * rstd * g0[c][3] * siluf_(rf[3]));
                y.z = pk2(bflo(ov.z) * rstd * g1[c][0] * siluf_(rf[4]), bfhi(ov.z) * rstd * g1[c][1] * siluf_(rf[5]));
                y.w = pk2(bflo(ov.w) * rstd * g1[c][2] * siluf_(rf[6]), bfhi(ov.w) * rstd * g1[c][3] * siluf_(rf[7]));
#if MIX_F8
                { u32x2 y8; y8.x = pk_fp8x4(bflo(y.x), bfhi(y.x), bflo(y.y), bfhi(y.y)); y8.y = pk_fp8x4(bflo(y.z), bfhi(y.z), bflo(y.w), bfhi(y.w)); *(u32x2*)((unsigned char*)(BR_FUSE ? ya : yb) + (size_t)row * (BR_FUSE ? 1536 : 1024) + col) = y8; }
#else
                *(u32x4*)(yb + (size_t)row * 1024 + col) = y;
#endif
            } }
    }
}

constexpr int LS = 10;
__host__ __device__ constexpr int phase_kind(int k) { return k == 0 ? 0 : (k == 1 + DEPTH * LS ? LS + 1 : ((k - 1) % LS) + 1); }
constexpr int N_PHASES = 2 + DEPTH * LS;
typedef const __attribute__((address_space(4))) Args CArgs;
__device__ __forceinline__ CArgs* fresh_args() {
    unsigned long long v = (unsigned long long)__builtin_amdgcn_kernarg_segment_ptr();
    unsigned lo = (unsigned)v, hi = (unsigned)(v >> 32);
    asm volatile("" : "+s"(lo), "+s"(hi));
    lo = __builtin_amdgcn_readfirstlane(lo); hi = __builtin_amdgcn_readfirstlane(hi);
    return (CArgs*)(((unsigned long long)hi << 32) | lo);
}
template <unsigned MASK, bool ONE>
__global__ void __launch_bounds__(NTHREADS, 2) fwd_kernel(Args a_unused) {
    extern __shared__ __attribute__((aligned(16))) unsigned char lds_raw[];
    LAS unsigned char* lds = (LAS unsigned char*)lds_raw;
    const int wave0 = __builtin_amdgcn_readfirstlane((int)threadIdx.x >> 6);
    int lane = (int)__builtin_amdgcn_mbcnt_hi(~0u, __builtin_amdgcn_mbcnt_lo(~0u, 0u)), wave = wave0, tid = wave0 * 64 + lane;
    CArgs* ap = fresh_args();
    unsigned char* ws = ap->ws;
#define a (*ap)
#define FRESH_TID() do { ap = fresh_args(); ws = ap->ws; unsigned m1_ = ~0u; asm volatile("" : "+s"(m1_)); lane = (int)__builtin_amdgcn_mbcnt_hi(m1_, __builtin_amdgcn_mbcnt_lo(m1_, 0u)); asm volatile("" : "+v"(lane)); wave = wave0; tid = wave0 * 64 + lane; } while (0)
    const int G = gridDim.x; const int bx = blockIdx.x; const int vcu = (G % 8 == 0) ? (bx % 8) * (G / 8) + bx / 8 : bx;
    volatile LAS unsigned* MISC = (volatile LAS unsigned*)(lds + MISC_OFF);
    for (int u = tid; u < (LDS_BYTES - MISC_OFF) / 4; u += NTHREADS) ((LAS unsigned*)(lds + MISC_OFF))[u] = 0u;
    __syncthreads();
    if (ONE) (void)xcd_barrier_post((unsigned*)(ws + WS_CTL) + CW_BAR, MISC + 8);
    const int lo = ONE ? 0 : a.ph_lo, hi = ONE ? N_PHASES : a.ph_hi;
#define IN(k, kind) (((MASK >> (kind)) & 1u) && (ONE || (lo <= (k) && (k) < hi)))
#if defined(PROBE_EPI) && !defined(PROBE_MASK)
#endif
#ifdef PROBE_MASK
#define PB_ON(k) ((PROBE_MASK >> phase_kind(k)) & 1u)
#define PB_START(k) do { if (PB_ON(k) && threadIdx.x == 0) *(volatile LAS unsigned long long*)(lds + MISC_OFF + 8192) = __builtin_amdgcn_s_memrealtime(); } while (0)
#define PB_END(k) do { if (PB_ON(k) && threadIdx.x == 0) { volatile LAS unsigned long long* pb_ = (volatile LAS unsigned long long*)(lds + MISC_OFF + 8192); pb_[1] = pb_[1] + (__builtin_amdgcn_s_memrealtime() - pb_[0]); } } while (0)
#else
#define PB_START(k) do { } while (0)
#define PB_END(k) do { } while (0)
#endif
#define SEAM(k) do { if (ONE) { XcdBarrier bar_; bar_.bar = (unsigned*)(((CArgs*)fresh_args())->ws + WS_CTL) + CW_BAR; bar_.x = xb_xcc_id(); bar_.st = (volatile LAS unsigned*)(lds + MISC_OFF) + 8; xcd_barrier(bar_); } } while (0)

#define ada ((float*)(ws + WS_ADA))
#define ropec ((const float*)(ws + WS_ROPE))
#define ropes (((const float*)(ws + WS_ROPE)) + SEQ * 64)
#define alow ((float*)(ws + WS_ALOW))
#define lse ((float*)(ws + WS_LSE))
#define ssq ((float*)(ws + WS_SSQ))
#define rlist ((int*)(ws + WS_RLIST))
#define tslot ((int*)(ws + WS_TSLOT))
#define tw ((float*)(ws + WS_TW))
#define hbuf ((bf16_t*)(ws + WS_H))
#define ya ((bf16_t*)(ws + WS_YA))
#define yb ((bf16_t*)(ws + WS_YB))
#define mrg ((bf16_t*)(ws + WS_MRG))
#define atto ((bf16_t*)(ws + WS_ATTO))
#define obuf ((bf16_t*)(ws + WS_OB))
#define proj ((bf16_t*)(ws + WS_PROJ))
#define act ((bf16_t*)(ws + WS_ACT))
#define Y ((bf16_t*)(ws + WS_Y))
#define ctl ((unsigned*)(ws + WS_CTL))
#define xb_ ((bf16_t*)(ws + WS_XB))
#define qdb_ ((bf16_t*)(ws + WS_QD))
#define oib_ ((bf16_t*)(ws + WS_OI))
#define dstb_ ((bf16_t*)(ws + WS_DST))
#define decb_ ((float*)(ws + WS_DEC))

    PB_START(0);
    if (IN(0, 0)) { FRESH_TID(); prologue_phase(ap, lds, vcu, G, tid, wave, lane); }
#ifdef PROBE_DUP_PRO
    __syncthreads(); if (IN(0, 0)) { FRESH_TID(); prologue_phase(ap, lds, vcu, G, tid, wave, lane, PROBE_DUP_PRO); }
#endif
    SEAM(0); PB_END(0);

    for (int l = 0; l < DEPTH; ++l) {
        const int P = 1 + LS * l;
#define adal (ada + (size_t)l * NB * 12288)
#define cntl (ctl + CW_CNT + l * 1024)
#define cntp (ctl + CW_CNT + (l > 0 ? (l - 1) * 1024 : 0))
#define xsrc ((l == 0) ? a.x : a.out)
        PB_START(P);
        if (IN(P, 1)) { FRESH_TID();
            if (l == 0) norm_phase<0>(xsrc, nullptr, hbuf, a.norm_mix, adal + 2048, adal, nullptr, nullptr, nullptr, nullptr, nullptr, vcu, G, wave, lane);
            else norm_phase<1>(xb_, xb_, hbuf, a.norm_mix + (size_t)l * D, adal + 2048, adal, ada + (size_t)(l - 1) * NB * 12288 + 10240, Y, tslot, tw, cntp, vcu, G, wave, lane);
        }
        SEAM(P); PB_END(P); PB_START(P + 1);
        if (IN(P + 1, 2)) { FRESH_TID();
#if PROJ_F8
            pg8::StaticOrder S{T / 256, NP / 256, G, bx}; pg8::RowsContig AM; pg8::EpiProj E{proj, ropec, ropes, alow, pg8::W8_INV};
            pg8::gemm_phase<pg8::EpiProj, pg8::StaticOrder, pg8::RowsContig, true, true>(lds, tid, hbuf, (const bf16_t*)(ws + WS_WIN + (size_t)l * NP * D), 0, D / 2, S, AM, E);
#else
            pg8::StaticOrder S{T / 256, NP / 256, G, bx}; pg8::RowsContig AM; pg8::EpiProj E{proj, ropec, ropes, alow, 1.0f};
            pg8::gemm_phase<pg8::EpiProj, pg8::StaticOrder, pg8::RowsContig, true>(lds, tid, hbuf, (const bf16_t*)(ws + WS_WIN) + (size_t)l * NP * D, 0, D, S, AM, E);
#endif
        }
        SEAM(P + 1); PB_END(P + 1); PB_START(P + 2);
        if (IN(P + 2, 3)) { FRESH_TID();
            {
                const int hw = (vcu >> 5) & 3, dw = tid & 127; float w2[16];
#pragma unroll
                for (int r = 0; r < 16; ++r) w2[r] = (a.w_alpha2 + (size_t)l * 16 * 512)[r * 512 + hw * 128 + dw];
                const float bias = (a.b_alpha2 + (size_t)l * 512)[hw * 128 + dw];
                for (int u = vcu; u < NB * 4 * 32; u += G) { GlaPre R; gla_local_issue(R, proj, alow, u, tid);
                    gla_local_unit(lds, R, proj, alow, w2, bias, qdb_, oib_, dstb_, decb_, u, -1, tid, wave, lane); } }
            FRESH_TID();
            for (int u = vcu; u < NB * 12 * 16; u += G) { AttnPre R; attn_issue(R, proj, u, tid, wave, lane); attn_unit(lds, R, proj, atto, lse, u, -1, tid, wave, lane); }
#ifdef PROBE_DUP_ATTN
            for (int u = vcu; u < NB * 12 * 16; u += G) { AttnPre R; attn_issue(R, proj, u, tid, wave, lane); attn_unit(lds, R, proj, atto, lse, u, -1, tid, wave, lane); }
#endif
        }
        SEAM(P + 2); PB_END(P + 2); PB_START(P + 3);
        if (IN(P + 3, 4)) { FRESH_TID();
            for (int u = vcu; u < 256; u += G) gla_scan_unit<false>(lds, qdb_, oib_, dstb_, decb_, obuf, ssq, u, tid, wave, lane);
#ifdef PROBE_FAKESCAN
            __syncthreads(); for (int u = vcu; u < 256; u += G) gla_scan_unit<true>(lds, qdb_, oib_, dstb_, decb_, obuf, ssq, u, tid, wave, lane);
#endif
        }
        SEAM(P + 3); PB_END(P + 3); PB_START(P + 4);
        if (IN(P + 4, 5)) { FRESH_TID(); merge_phase(atto, lse, obuf, ssq, proj, a.gla_gain + (size_t)l * 1024, ya, yb, vcu, G, wave, lane); }
        SEAM(P + 4); PB_END(P + 4); PB_START(P + 5);
        if (IN(P + 5, 6)) { FRESH_TID();
#if BR_FUSE
            { pg8::SegOrder S2{T / 256, D / 256, G, bx}; pg8::RowsContig AM2; pg8::EpiGate2 E{proj, pg8::W8_INV, ws + WS_MRG8};
              pg8::gemm_phase<pg8::EpiGate2, pg8::SegOrder, pg8::RowsContig, true, true, true>(lds, tid, ya, (const bf16_t*)(ws + WS_WOA + (size_t)l * D * 1536), 0, 768, S2, AM2, E); }
#else
            pg8::StaticOrder S{T / 256, D / 256, G, bx}; pg8::RowsContig AM;
#if MIX_F8
            { pg8::EpiGate<true> E{mrg, proj, GA, pg8::W8_INV, nullptr}; pg8::gemm_phase<pg8::EpiGate<true>, pg8::StaticOrder, pg8::RowsContig, true, true>(lds, tid, ya, (const bf16_t*)(ws + WS_WOA + (size_t)l * D * 512), 0, 256, S, AM, E); }
#else
            { pg8::EpiGate<true> E{mrg, proj, GA, 1.0f, nullptr}; pg8::gemm_phase<pg8::EpiGate<true>, pg8::StaticOrder, pg8::RowsContig, true>(lds, tid, ya, (const bf16_t*)(ws + WS_WOA) + (size_t)l * D * 512, 0, 512, S, AM, E); }
#endif
            FRESH_TID();
#if MIX_F8
            { pg8::EpiGate<false> E{mrg, proj, GB, pg8::W8_INV, ws + WS_MRG8}; pg8::gemm_phase<pg8::EpiGate<false>, pg8::StaticOrder, pg8::RowsContig, true, true>(lds, tid, yb, (const bf16_t*)(ws + WS_WOB + (size_t)l * D * 1024), 0, 512, S, AM, E); }
#else
            { pg8::EpiGate<false> E{mrg, proj, GB, 1.0f, nullptr}; pg8::gemm_phase<pg8::EpiGate<false>, pg8::StaticOrder, pg8::RowsContig, true>(lds, tid, yb, (const bf16_t*)(ws + WS_WOB) + (size_t)l * D * 1024, 0, 1024, S, AM, E); }
#endif
#endif
        }
        SEAM(P + 5); PB_END(P + 5); PB_START(P + 6);
        if (IN(P + 6, 7)) { FRESH_TID();
            pg8::StaticOrder S{T / 256, D / 256, G, bx}; pg8::RowsContig AM;
#if MIX_F8
            if (l == 0) { pg8::EpiResid<true> E{a.x, xb_, adal + 4096, pg8::W8_INV}; pg8::gemm_phase<pg8::EpiResid<true>, pg8::StaticOrder, pg8::RowsContig, true, true>(lds, tid, (const bf16_t*)(ws + WS_MRG8), (const bf16_t*)(ws + WS_WO + (size_t)l * D * D), 0, D / 2, S, AM, E); }
            else { pg8::EpiResid<false> E{xb_, xb_, adal + 4096, pg8::W8_INV}; pg8::gemm_phase<pg8::EpiResid<false>, pg8::StaticOrder, pg8::RowsContig, true, true>(lds, tid, (const bf16_t*)(ws + WS_MRG8), (const bf16_t*)(ws + WS_WO + (size_t)l * D * D), 0, D / 2, S, AM, E); }
#else
            if (l == 0) { pg8::EpiResid<true> E{a.x, xb_, adal + 4096, 1.0f}; pg8::gemm_phase<pg8::EpiResid<true>, pg8::StaticOrder, pg8::RowsContig, true>(lds, tid, mrg, (const bf16_t*)(ws + WS_WO) + (size_t)l * D * D, 0, D, S, AM, E); }
            else { pg8::EpiResid<false> E{xb_, xb_, adal + 4096, 1.0f}; pg8::gemm_phase<pg8::EpiResid<false>, pg8::StaticOrder, pg8::RowsContig, true>(lds, tid, mrg, (const bf16_t*)(ws + WS_WO) + (size_t)l * D * D, 0, D, S, AM, E); }
#endif
        }
        SEAM(P + 6); PB_END(P + 6); PB_START(P + 7);
        if (IN(P + 7, 8)) { FRESH_TID(); router_phase(xb_, hbuf, a.norm_ffn + (size_t)l * D, adal + 8192, adal + 6144, a.w_router, a.b_router, cntl, rlist, tslot, tw, lds, vcu, G, tid, wave, lane); }
        SEAM(P + 7); PB_END(P + 7); PB_START(P + 8);
        if (IN(P + 8, 9)) { FRESH_TID();
            pg8::moe_table_build(lds, cntl, tid);
            pg8::MoeOrder S; S.init(lds, 8, G, bx); pg8::RowsGather AM{rlist, lds}; pg8::EpiSwiGLU8 E{(unsigned char*)act};
            pg8::gemm_phase<pg8::EpiSwiGLU8, pg8::MoeOrder, pg8::RowsGather, true, true>(lds, tid, hbuf, (const bf16_t*)(ws + WS_WGU + (size_t)l * NE * 2048 * D), (size_t)2048 * D / 2, D / 2, S, AM, E);
        }
        SEAM(P + 8); PB_END(P + 8); PB_START(P + 9);
        if (IN(P + 9, 10)) { FRESH_TID();
            pg8::moe_table_build(lds, cntl, tid);
            pg8::MoeOrder S; S.init(lds, 8, G, bx); pg8::RowsContig AM; pg8::EpiPlainS E{Y, pg8::W8_INV};
            pg8::gemm_phase<pg8::EpiPlainS, pg8::MoeOrder, pg8::RowsContig, true, true>(lds, tid, act, (const bf16_t*)(ws + WS_WDN + (size_t)l * NE * D * FF), (size_t)D * FF / 2, FF / 2, S, AM, E);
        }
        SEAM(P + 9); PB_END(P + 9);
    }
    PB_START(1 + DEPTH * LS);
    if (IN(1 + DEPTH * LS, LS + 1)) { FRESH_TID(); norm_phase<2>(xb_, a.out, nullptr, a.final_norm, nullptr, nullptr, ada + (size_t)(DEPTH - 1) * NB * 12288 + 10240, Y, tslot, tw, ctl + CW_CNT + (DEPTH - 1) * 1024, vcu, G, wave, lane); }
#ifdef PROBE_MASK
    __syncthreads(); PB_END(1 + DEPTH * LS);
    if (threadIdx.x == 0) { const unsigned long long t0_ = __builtin_amdgcn_s_memrealtime(), d_ = ((volatile LAS unsigned long long*)(lds + MISC_OFF + 8192))[1];
        while (__builtin_amdgcn_s_memrealtime() - t0_ < d_) __builtin_amdgcn_s_sleep(8); }
    __syncthreads();
#endif
#undef a
#undef IN
#undef SEAM
}

template <unsigned MASK, bool ONE>
static void launch_one(const Args& a, int grid, hipStream_t stream) {
    static bool attr_done = false;
    if (!attr_done) { (void)hipFuncSetAttribute((const void*)fwd_kernel<MASK, ONE>, hipFuncAttributeMaxDynamicSharedMemorySize, LDS_BYTES); attr_done = true; }
    hipLaunchKernelGGL((fwd_kernel<MASK, ONE>), dim3(grid), dim3(NTHREADS), LDS_BYTES, stream, a);
}
extern "C" void kernel_launch(void* const* d_in, const int* in_sizes, int n_in, void* d_out, int out_size, void* d_ws, size_t ws_size, hipStream_t stream) {
    static int grid = 0;
    if (grid == 0) {
        if (n_in != 19 || out_size != T * D || ws_size < WS_END) { fprintf(stderr, "kernel_launch: unexpected shapes (n_in %d, out %d, ws %zu < %zu); nothing launched\n", n_in, out_size, ws_size, (size_t)WS_END); grid = -1; return; }
        int dev = 0, cus = 0;
        if (hipGetDevice(&dev) != hipSuccess || hipDeviceGetAttribute(&cus, hipDeviceAttributeMultiprocessorCount, dev) != hipSuccess) { grid = -1; return; }
        grid = cus;
        if (grid != 256) fprintf(stderr, "kernel_launch: note: %d CUs (built for 256)\n", grid);
    }
    if (grid < 0) return;
    (void)hipMemsetAsync((char*)d_ws + WS_CTL, 0, CTL_ZERO_BYTES, stream);
    Args a{};
    a.x = (const float*)d_in[0]; a.c = (const float*)d_in[1]; a.w_ada = (const float*)d_in[2]; a.b_ada = (const float*)d_in[3]; a.norm_mix = (const float*)d_in[4]; a.norm_ffn = (const float*)d_in[5];
    a.w_in = (const float*)d_in[6]; a.w_alpha2 = (const float*)d_in[7]; a.b_alpha2 = (const float*)d_in[8]; a.gla_gain = (const float*)d_in[9]; a.w_out_a = (const float*)d_in[10];
    a.w_out_b = (const float*)d_in[11]; a.w_out = (const float*)d_in[12]; a.w_router = (const float*)d_in[13]; a.b_router = (const float*)d_in[14]; a.w_gate_e = (const float*)d_in[15];
    a.w_up_e = (const float*)d_in[16]; a.w_down_e = (const float*)d_in[17]; a.final_norm = (const float*)d_in[18];
    a.out = (float*)d_out; a.ws = (unsigned char*)d_ws;
#if MK_PER_PHASE
    for (int p = 0; p < N_PHASES; ++p) { a.ph_lo = p; a.ph_hi = p + 1;
        const int kind = phase_kind(p);
        switch (kind) {
            case 0: launch_one<1u << 0, false>(a, grid, stream); break; case 1: launch_one<1u << 1, false>(a, grid, stream); break;
            case 2: launch_one<1u << 2, false>(a, grid, stream); break; case 3: launch_one<1u << 3, false>(a, grid, stream); break;
            case 4: launch_one<1u << 4, false>(a, grid, stream); break; case 5: launch_one<1u << 5, false>(a, grid, stream); break;
            case 6: launch_one<1u << 6, false>(a, grid, stream); break; case 7: launch_one<1u << 7, false>(a, grid, stream); break;
            case 8: launch_one<1u << 8, false>(a, grid, stream); break; case 9: launch_one<1u << 9, false>(a, grid, stream); break;
            case 10: launch_one<1u << 10, false>(a, grid, stream); break;
            default: launch_one<1u << 11, false>(a, grid, stream); break; } }
#else
    a.ph_lo = 0; a.ph_hi = N_PHASES; launch_one<0xFFFFFu, true>(a, grid, stream);
#endif
    const hipError_t le = hipPeekAtLastError();
    if (le != hipSuccess) fprintf(stderr, "kernel_launch: launch failed: %s\n", hipGetErrorName(le));
}
```

```cpp
#include <hip/hip_runtime.h>
#include <cstdio>
#include <cstdint>

#ifndef PROJ_F8
#define PROJ_F8 1
#endif
#ifndef MIX_F8
#define MIX_F8 1
#endif
#ifndef GATE_F8
#define GATE_F8 1
#endif
#ifndef Y_F8
#define Y_F8 1
#endif
#ifndef BR_FUSE
#define BR_FUSE 1
#endif
#ifndef MK_PER_PHASE
#define MK_PER_PHASE 0
#endif

#define LAS __attribute__((address_space(3)))
#define GAS __attribute__((address_space(1)))
typedef unsigned short bf16_t;
typedef short bf16x8 __attribute__((ext_vector_type(8)));
typedef short s16x4 __attribute__((ext_vector_type(4)));
typedef float f32x4 __attribute__((ext_vector_type(4)));
typedef float f32x2 __attribute__((ext_vector_type(2)));
typedef unsigned u32x4 __attribute__((ext_vector_type(4)));
typedef unsigned u32x2 __attribute__((ext_vector_type(2)));
typedef GAS unsigned gu32;

constexpr int NB = 8, SEQ = 2048, T = NB * SEQ, D = 2048, DEPTH = 2;
constexpr int NIN = 11792;
constexpr int NP = 12032;
constexpr int QA = 0, KA = 1536, VA = 3072, QB = 4608, KB = 5120, VB = 5632, RB = 6656, GA = 7680, GB = 9728, AL = 11776;
constexpr int NE = 16, FF = 1024;
constexpr int MAXTILES = 144, MAXROWS = MAXTILES * 256;
constexpr float NORM_EPS = 1e-6f;
constexpr int NWAVES = 8, NTHREADS = 512;

constexpr size_t MiB = 1u << 20;
constexpr size_t WS_CTL = 0, CTL_ZERO_BYTES = 80 * 1024;
constexpr size_t WS_ADA = 1 * MiB;
constexpr size_t WS_ROPE = 2 * MiB;
constexpr size_t WS_ALOW = 3 * MiB;
constexpr size_t WS_LSE = 4 * MiB;
constexpr size_t WS_SSQ = 5 * MiB;
constexpr size_t WS_RLIST = 9 * MiB;
constexpr size_t WS_TSLOT = 10 * MiB;
constexpr size_t WS_TW = 10 * MiB + 512 * 1024;
constexpr size_t WS_WIN = 12 * MiB;
constexpr size_t WS_MRG8 = 60 * MiB;
constexpr size_t WS_WOA = 106 * MiB;
constexpr size_t WS_WOB = 110 * MiB;
constexpr size_t WS_WO = 118 * MiB;
constexpr size_t WS_WGU = 134 * MiB;
constexpr size_t WS_XB = 262 * MiB;
constexpr size_t WS_WDN = 390 * MiB;
constexpr size_t WS_H = 518 * MiB;
constexpr size_t WS_YA = 582 * MiB;
constexpr size_t WS_YB = 598 * MiB;
constexpr size_t WS_MRG = 630 * MiB;
constexpr size_t WS_ATTO = 694 * MiB;
constexpr size_t WS_OB = 742 * MiB;
constexpr size_t WS_PROJ = 774 * MiB;
constexpr size_t WS_ACT = WS_PROJ;
constexpr size_t WS_Y = WS_PROJ + 72 * MiB;
constexpr size_t WS_QD = 1150 * MiB;
constexpr size_t WS_OI = 1166 * MiB;
constexpr size_t WS_DST = 1198 * MiB;
constexpr size_t WS_DEC = 1262 * MiB;
constexpr size_t WS_END = 1263 * MiB;
constexpr int CW_BAR = 4096;
constexpr int CW_CNT = 16384;

constexpr int RING_BYTES = 131072;
constexpr int MISC_OFF = 135168;
constexpr int LDS_BYTES = 151552;

#define LDS_WAIT() asm volatile("s_waitcnt lgkmcnt(0)" ::: "memory")
#define VM_WAIT() asm volatile("s_waitcnt vmcnt(0)" ::: "memory")
#define RLX_AGENT __ATOMIC_RELAXED, __HIP_MEMORY_SCOPE_AGENT
__device__ __forceinline__ unsigned f2bf(float f) { unsigned u = __builtin_bit_cast(unsigned, f); return (u + 0x7fffu + ((u >> 16) & 1u)) >> 16; }
typedef float f32x2_t __attribute__((ext_vector_type(2)));
typedef __bf16 bf16x2_t __attribute__((ext_vector_type(2)));
__device__ __forceinline__ unsigned pk2(float lo, float hi) { const f32x2_t v = {lo, hi}; const bf16x2_t b = __builtin_convertvector(v, bf16x2_t); return __builtin_bit_cast(unsigned, b); }
__device__ __forceinline__ float sat8(float x) { return __builtin_amdgcn_fmed3f(x, -448.0f, 448.0f); }
__device__ __forceinline__ unsigned pk_fp8x4(float a, float b, float c, float d) { int p = __builtin_amdgcn_cvt_pk_fp8_f32(sat8(a), sat8(b), 0, false); p = __builtin_amdgcn_cvt_pk_fp8_f32(sat8(c), sat8(d), p, true); return (unsigned)p; }
constexpr int G8_BYTE0 = RB * 2;
__device__ __forceinline__ void unpack_fp8x8(u32x2 v, float (&f)[8]) { const f32x2_t a = __builtin_amdgcn_cvt_pk_f32_fp8((int)v.x, false), b = __builtin_amdgcn_cvt_pk_f32_fp8((int)v.x, true), c = __builtin_amdgcn_cvt_pk_f32_fp8((int)v.y, false), d = __builtin_amdgcn_cvt_pk_f32_fp8((int)v.y, true);
    f[0] = a[0]; f[1] = a[1]; f[2] = b[0]; f[3] = b[1]; f[4] = c[0]; f[5] = c[1]; f[6] = d[0]; f[7] = d[1]; }
__device__ __forceinline__ unsigned pk_fp8x4_ns(float a, float b, float c, float d) { int p = __builtin_amdgcn_cvt_pk_fp8_f32(a, b, 0, false); p = __builtin_amdgcn_cvt_pk_fp8_f32(c, d, p, true); return (unsigned)p; }
__device__ __forceinline__ float bflo(unsigned u) { return __builtin_bit_cast(float, u << 16); }
__device__ __forceinline__ float bfhi(unsigned u) { return __builtin_bit_cast(float, u & 0xffff0000u); }
__device__ __forceinline__ float bf2f(bf16_t h) { return __builtin_bit_cast(float, (unsigned)h << 16); }
template <int M> __device__ __forceinline__ float sx(float v, int lane) {
    if constexpr (M < 32) return __builtin_bit_cast(float, __builtin_amdgcn_ds_swizzle(__builtin_bit_cast(int, v), (M << 10) | 0x1F));
    else return __builtin_bit_cast(float, __builtin_amdgcn_ds_bpermute((lane ^ 32) << 2, __builtin_bit_cast(int, v)));
}
__device__ __forceinline__ float wave_sum(float v, int lane) {
    v += sx<1>(v, lane); v += sx<2>(v, lane); v += sx<4>(v, lane); v += sx<8>(v, lane); v += sx<16>(v, lane); v += sx<32>(v, lane);
    return v;
}
__device__ __forceinline__ float sigmoidf_(float x) { return __builtin_amdgcn_rcpf(1.0f + __expf(-x)); }
__device__ __forceinline__ float siluf_(float x) { return x * __builtin_amdgcn_rcpf(1.0f + __expf(-x)); }

#define XB_TMO      128
#define XB_XCNT(j)  (256  + 64 * (j))
#define XB_XSUB(j)  (1280 + 64 * (j))
#define XB_XGEN(j)  (2304 + 64 * (j))
#define XB_TOP      3328
#define XB_TOPGEN   3392
#define XCD_BAR_WORDS 3456
#define XB_SPIN_CAP (1u << 18)
__device__ __forceinline__ unsigned xb_ld(unsigned* p)              { return __hip_atomic_load(p, __ATOMIC_RELAXED, __HIP_MEMORY_SCOPE_AGENT); }
__device__ __forceinline__ unsigned xb_add(unsigned* p, unsigned v) { return __hip_atomic_fetch_add(p, v, __ATOMIC_RELAXED, __HIP_MEMORY_SCOPE_AGENT); }
__device__ __forceinline__ unsigned xb_xcc_id() { return (unsigned)__builtin_amdgcn_s_getreg((3 << 11) | 20) & 0xFu; }
#define XB_SPIN(cond, bar) do { unsigned _sp = 0; while (cond) { __builtin_amdgcn_s_sleep(1); \
    if ((++_sp & 255u) == 0u) { if (xb_ld(&(bar)[XB_TMO])) break; if (_sp > XB_SPIN_CAP) { atomicAdd(&(bar)[XB_TMO], 1u); break; } } } } while (0)
struct XcdBarrier { unsigned* bar; unsigned x; volatile LAS unsigned* st; };
__device__ __forceinline__ XcdBarrier xcd_barrier_post(unsigned* bar, volatile LAS unsigned* st) {
    XcdBarrier b; b.bar = bar; b.x = xb_xcc_id(); b.st = st;
    if (threadIdx.x == 0) (void)xb_add(&bar[XB_XCNT(b.x)], 1u);
    return b;
}
__device__ __forceinline__ void xcd_barrier_complete(unsigned* bar, unsigned x, unsigned& nloc, unsigned& nx) {
    const unsigned G = gridDim.x * gridDim.y * gridDim.z;
    unsigned sum, cnt, mine, sp = 0u;
    for (;;) {
        sum = 0u; cnt = 0u; mine = 0u;
#pragma unroll
        for (unsigned j = 0; j < 16; ++j) { const unsigned c = xb_ld(&bar[XB_XCNT(j)]); sum += c; cnt += (c > 0u) ? 1u : 0u; mine = (j == x) ? c : mine; }
        if (sum == G) break;
        __builtin_amdgcn_s_sleep(1);
        if ((++sp & 255u) == 0u) { if (xb_ld(&bar[XB_TMO])) break; if (sp > XB_SPIN_CAP) { atomicAdd(&bar[XB_TMO], 1u); break; } }
    }
    nloc = mine > 0u ? mine : 1u; nx = cnt > 0u ? cnt : 1u;
}
__device__ __forceinline__ void xcd_barrier(const XcdBarrier& b) {
    asm volatile("s_waitcnt vmcnt(0)" ::: "memory");
    __syncthreads();
    if (threadIdx.x == 0) {
        unsigned* bar = b.bar;
        __builtin_amdgcn_s_waitcnt(0);
        unsigned nloc = b.st[0], nx = b.st[1];
        if (nloc == 0u) { xcd_barrier_complete(bar, b.x, nloc, nx); b.st[0] = nloc; b.st[1] = nx; }
        const unsigned old = xb_add(&bar[XB_XSUB(b.x)], 1u);
        const unsigned gen = old / nloc;
        if (old + 1u == (gen + 1u) * nloc) {
            __builtin_amdgcn_fence(__ATOMIC_RELEASE, "agent");
            asm volatile("s_waitcnt vmcnt(0)" ::: "memory");
            const unsigned og = xb_add(&bar[XB_TOP], 1u);
            const unsigned tg = og / nx;
            if (og + 1u == (tg + 1u) * nx) xb_add(&bar[XB_TOPGEN], 1u);
            else XB_SPIN(xb_ld(&bar[XB_TOPGEN]) == tg, bar);
            __builtin_amdgcn_fence(__ATOMIC_ACQUIRE, "agent");
            xb_add(&bar[XB_XGEN(b.x)], 1u);
            asm volatile("s_waitcnt vmcnt(0)" ::: "memory");
        } else {
            XB_SPIN(xb_ld(&bar[XB_XGEN(b.x)]) == gen, bar);
            __builtin_amdgcn_fence(__ATOMIC_ACQUIRE, "agent");
            asm volatile("s_waitcnt vmcnt(0)" ::: "memory");
        }
    }
    __syncthreads();
}

namespace pg8 {
constexpr int BM = 256, BK = 64, HALF = 128, HTB = HALF * BK * 2, NXCD = 8, WGM = 2;
__device__ __forceinline__ int lds_byte(int r, int c) { const int st = (r >> 4) * 2 + (c >> 5), rr = r & 15, cc = c & 31, ob = rr * 64 + cc * 2; return st * 1024 + (ob ^ (((ob >> 9) & 1) << 5)); }
__device__ __forceinline__ void stage_rc(int b, int& R, int& C) { const int st = b / 1024, sb = b % 1024, swz = sb ^ (((sb >> 9) & 1) << 5); R = (st >> 1) * 16 + swz / 64; C = (st & 1) * 32 + (swz % 64) / 2; }
__device__ __forceinline__ int perm32(int rho) { const int n = rho >> 4, i = rho & 15; return 8 * (i >> 2) + 4 * n + (i & 3); }

struct Unit { int pm, pn, e, ti; };

__device__ __forceinline__ bool grid_order(int nM, int nN, int G, int c, int i, int& pm, int& pn) {
    const int nwg = nM * nN; const long L = (long)i * G + c; if (L >= nwg) return false;
    int wgid = (int)L; { const int q = nwg / NXCD, r = nwg % NXCD, xcd = wgid % NXCD, off = wgid / NXCD; wgid = (xcd < r ? xcd * (q + 1) : r * (q + 1) + (xcd - r) * q) + off; }
    const int nig = WGM * nN, gid = wgid / nig, fm = gid * WGM, gsz = (nM - fm) < WGM ? (nM - fm) : WGM;
    pm = fm + ((wgid % nig) % gsz); pn = (wgid % nig) / gsz; return true;
}
struct StaticOrder {
    int nM, nN, G, c;
    __device__ __forceinline__ bool next(int i, Unit& u) const { u.e = 0; u.ti = 0; return grid_order(nM, nN, G, c, i, u.pm, u.pn); }
};
struct SegOrder {
    int nM, nN, G, c;
    __device__ __forceinline__ bool next(int i, Unit& u) const { u.e = i & 1; u.ti = 0; return grid_order(nM, nN, G, c, i >> 1, u.pm, u.pn); }
};
constexpr int MOE_TAB_OFF = MISC_OFF + 4096;
__device__ __forceinline__ void moe_table_build(LAS unsigned char* lds, const unsigned* cnt, int tid) {
    if (tid < NE) { const int n = (int)__hip_atomic_load(cnt + 64 * tid, RLX_AGENT); ((LAS int*)(lds + MOE_TAB_OFF))[16 + tid] = n; }
    __syncthreads();
    if (tid == 0) { int acc = 0; for (int e = 0; e < NE; ++e) { acc += (((LAS int*)(lds + MOE_TAB_OFF))[16 + e] + 255) >> 8; ((LAS int*)(lds + MOE_TAB_OFF))[e] = acc; } }
    __syncthreads();
}
typedef int i32x4 __attribute__((ext_vector_type(4)));
struct MoeOrder {
    LAS unsigned char* lds; int NT, nN, G, c;
    __device__ __forceinline__ void init(LAS unsigned char* lds_, int nN_, int G_, int c_) {
        lds = lds_; NT = __builtin_amdgcn_readfirstlane(((LAS int*)(lds + MOE_TAB_OFF))[15]); nN = nN_; G = G_; c = c_; }
    __device__ __forceinline__ bool next(int i, Unit& u) const {
        if (!grid_order(NT, nN, G, c, i, u.pm, u.pn)) return false;
        int e = 0, ts = 0;
#pragma unroll
        for (int q = 0; q < 4; ++q) { const i32x4 t = ((const LAS i32x4*)(lds + MOE_TAB_OFF))[q];
#pragma unroll
            for (int j = 0; j < 4; ++j) { const bool ge = u.pm >= t[j]; e += ge ? 1 : 0; ts = ge ? t[j] : ts; } }
        u.e = __builtin_amdgcn_readfirstlane(e); u.ti = u.pm - __builtin_amdgcn_readfirstlane(ts); return true;
    }
};
struct RowsContig { static constexpr bool GATHER = false; __device__ __forceinline__ unsigned row(const Unit& u, int rr) const { return (unsigned)(u.pm * 256 + rr); } };
struct RowsGather {
    static constexpr bool GATHER = true;
    const int* rlist; LAS unsigned char* lds;
    __device__ __forceinline__ unsigned row(const Unit& u, int rr) const {
        const int n = ((LAS int*)(lds + MOE_TAB_OFF))[16 + u.e]; const int rank = u.ti * 256 + rr; const bool ok = rank < n;
        return (unsigned)rlist[(size_t)u.e * T + (ok ? rank : 0)];
    }
};

typedef int i32x4v __attribute__((ext_vector_type(4)));
typedef int i32x8 __attribute__((ext_vector_type(8)));
template <class Epi, class Sched, class AMap, bool ALIGN_EPI, bool F8 = false, bool SEG2 = false>
__device__ __forceinline__ void gemm_phase(LAS unsigned char* lds, const int tid, const bf16_t* A, const bf16_t* Bt, size_t bstride, int K, const Sched& S, const AMap& AM, const Epi& E) {
    const int wid = __builtin_amdgcn_readfirstlane(tid >> 6), lane = tid & 63, wr = wid >> 2, wc = wid & 3, fr = lane & 15, fq = lane >> 4;
    const int nt = K / BK;
    unsigned voffA[2], voffB[2];
#pragma unroll
    for (int i = 0; i < 2; ++i) { int R, C; stage_rc(tid * 16 + i * 8192, R, C); const int Rb = Epi::PERM ? ((R & ~31) + perm32(R & 31)) : R; voffA[i] = (unsigned)(R * K + C) * 2u; voffB[i] = (unsigned)(Rb * K + C) * 2u; }
    const unsigned kstep = (unsigned)(BK * 2);
    const unsigned hstep = (unsigned)HALF * (unsigned)K * 2u;
    const unsigned tstep = 2u * hstep;
    const __amdgpu_buffer_rsrc_t rsA = __builtin_amdgcn_make_buffer_rsrc((void*)A, 0, -1, 0x00020000), rsB = __builtin_amdgcn_make_buffer_rsrc((void*)Bt, 0, -1, 0x00020000);
    const unsigned ldsw = (unsigned)wid * 1024u;
    const int aoff = lds_byte(wr * 64 + fr, fq * 8), boff = lds_byte(wc * 32 + fr, fq * 8);
#define PG8_SA(b, h) (((b) * 2 + (h)) * HTB)
#define PG8_SB(b, h) ((4 + (b) * 2 + (h)) * HTB)
#define PG8_STAGE(bufoff, soffB, voff) do { _Pragma("unroll") for (int _i = 0; _i < 2; ++_i) \
        __builtin_amdgcn_raw_ptr_buffer_load_lds(rsB, (LAS unsigned*)(lds + (bufoff) + ldsw + _i * 8192), 16, (int)(voff)[_i], (int)(soffB), 0, 0); } while (0)
#define PG8_LDA(dst, b, h) do { _Pragma("unroll") for (int m = 0; m < 4; ++m) _Pragma("unroll") for (int k = 0; k < 2; ++k) dst[m][k] = *(const LAS bf16x8*)(lds + PG8_SA(b, h) + aoff + m * 2048 + k * 1024); } while (0)
#define PG8_LDB(dst, b, h) do { _Pragma("unroll") for (int n = 0; n < 2; ++n) _Pragma("unroll") for (int k = 0; k < 2; ++k) dst[n][k] = *(const LAS bf16x8*)(lds + PG8_SB(b, h) + boff + n * 2048 + k * 1024); } while (0)
#define PG8_MMA(ai, bj, At, Bt_) do { __builtin_amdgcn_s_setprio(1); _Pragma("unroll") for (int m = 0; m < 4; ++m) _Pragma("unroll") for (int n = 0; n < 2; ++n) _Pragma("unroll") for (int k = 0; k < 2; ++k) \
        acc[ai][bj][m][n] = __builtin_amdgcn_mfma_f32_16x16x32_bf16(Bt_[n][k], At[m][k], acc[ai][bj][m][n], 0, 0, 0); __builtin_amdgcn_s_setprio(0); } while (0)
#define PG8_LD8(dst, base) do { const i32x4v lo_ = *(const LAS i32x4v*)(lds + (base)); const i32x4v hi_ = *(const LAS i32x4v*)(lds + (base) + 1024); dst = __builtin_shufflevector(lo_, hi_, 0, 1, 2, 3, 4, 5, 6, 7); } while (0)
#define PG8_LDA8(dst, b, h) do { _Pragma("unroll") for (int m = 0; m < 4; ++m) PG8_LD8(dst[m], PG8_SA(b, h) + aoff + m * 2048); } while (0)
#define PG8_LDB8(dst, b, h) do { _Pragma("unroll") for (int n = 0; n < 2; ++n) PG8_LD8(dst[n], PG8_SB(b, h) + boff + n * 2048); } while (0)
#define PG8_MMA8(ai, bj, At, Bt_) do { __builtin_amdgcn_s_setprio(1); _Pragma("unroll") for (int m = 0; m < 4; ++m) _Pragma("unroll") for (int n = 0; n < 2; ++n) \
        asm volatile("v_mfma_f32_16x16x128_f8f6f4 %0, %1, %2, %0" : "+v"(acc[ai][bj][m][n]) : "v"(Bt_[n]), "v"(At[m])); __builtin_amdgcn_s_setprio(0); } while (0)
#define PG8_XLDA(b, h) do { if constexpr (F8) PG8_LDA8(At8, b, h); else PG8_LDA(At, b, h); } while (0)
#define PG8_XLDB(w, b, h) do { if constexpr (F8) { if (w == 0) PG8_LDB8(B08, b, h); else PG8_LDB8(B18, b, h); } else { if (w == 0) PG8_LDB(B0, b, h); else PG8_LDB(B1, b, h); } } while (0)
#define PG8_XMMA(ai, bj, w) do { if constexpr (F8) { if (w == 0) PG8_MMA8(ai, bj, At8, B08); else PG8_MMA8(ai, bj, At8, B18); } else { if (w == 0) PG8_MMA(ai, bj, At, B0); else PG8_MMA(ai, bj, At, B1); } } while (0)
#define PG8_WAIT_V(n) asm volatile("s_waitcnt vmcnt(" #n ")" ::: "memory")
#define PG8_WAIT_L(n) asm volatile("s_waitcnt lgkmcnt(" #n ")" ::: "memory")
#define PG8_BAR __builtin_amdgcn_s_barrier()
#define PG8_SCHED __builtin_amdgcn_sched_barrier(0)
#define PG8_OFFS(dst, u) do { _Pragma("unroll") for (int _h = 0; _h < 2; ++_h) _Pragma("unroll") for (int _i = 0; _i < 2; ++_i) { int _R, _C; stage_rc(tid * 16 + _i * 8192, _R, _C); \
        dst[_h][_i] = (AM.row(u, _h * HALF + _R) * (unsigned)K + (unsigned)_C) * 2u; } } while (0)
#define PG8_STAGE_A(bufoff, h, kb, NXT) do { if constexpr (AMap::GATHER) { _Pragma("unroll") for (int _i = 0; _i < 2; ++_i) { const unsigned _o = (NXT) ? offN[h][_i] : offC[h][_i]; \
            __builtin_amdgcn_raw_ptr_buffer_load_lds(rsA, (LAS unsigned*)(lds + (bufoff) + ldsw + _i * 8192), 16, (int)_o, (int)(kb), 0, 0); } } \
        else { const unsigned _g = ((NXT) ? nA : cA) + (h) * hstep + (kb); _Pragma("unroll") for (int _i = 0; _i < 2; ++_i) \
            __builtin_amdgcn_raw_ptr_buffer_load_lds(rsA, (LAS unsigned*)(lds + (bufoff) + ldsw + _i * 8192), 16, (int)voffA[_i], (int)_g, 0, 0); } } while (0)
    Unit cur, nxt, nn; int ui = 0; bool has_next = false, has_nn = false;
    if (!S.next(0, cur)) return;
    f32x4 acc[2][2][4][2];
#pragma unroll
    for (int a = 0; a < 2; ++a)
#pragma unroll
        for (int b = 0; b < 2; ++b)
#pragma unroll
            for (int m = 0; m < 4; ++m)
#pragma unroll
                for (int n = 0; n < 2; ++n) acc[a][b][m][n] = (f32x4){0.f, 0.f, 0.f, 0.f};
    bf16x8 At[4][2], B0[2][2], B1[2][2]; i32x8 At8[4], B08[2], B18[2];
    int sc8 = 0x7F7F7F7F; if constexpr (F8) asm volatile("" : "+v"(sc8));
#define PG8_RAW(dst, u) do { _Pragma("unroll") for (int _h = 0; _h < 2; ++_h) _Pragma("unroll") for (int _i = 0; _i < 2; ++_i) { int _R, _C; stage_rc(tid * 16 + _i * 8192, _R, _C); dst[_h][_i] = AM.row(u, _h * HALF + _R); } } while (0)
#define PG8_CONV(dst, raw) do { _Pragma("unroll") for (int _h = 0; _h < 2; ++_h) _Pragma("unroll") for (int _i = 0; _i < 2; ++_i) { int _R, _C; stage_rc(tid * 16 + _i * 8192, _R, _C); dst[_h][_i] = (raw[_h][_i] * (unsigned)K + (unsigned)_C) * 2u; } } while (0)
    unsigned offC[2][2], offN[2][2], rawN[2][2];
    if constexpr (AMap::GATHER) { PG8_OFFS(offC, cur); has_next = S.next(1, nxt);
        if (has_next) { PG8_RAW(rawN, nxt); } else {
#pragma unroll
            for (int h = 0; h < 2; ++h)
#pragma unroll
                for (int i = 0; i < 2; ++i) rawN[h][i] = 0u; } }
    unsigned cA = AMap::GATHER ? 0u : (unsigned)cur.pm * tstep + (SEG2 ? (unsigned)cur.e * 1024u : 0u), nA = cA;
    unsigned cB = (unsigned)cur.e * (SEG2 ? 1024u : (unsigned)(bstride * 2)) + (unsigned)cur.pn * tstep;
    PG8_STAGE(PG8_SB(0, 0), cB, voffB); PG8_STAGE(PG8_SB(0, 1), cB + hstep, voffB); PG8_STAGE_A(PG8_SA(0, 0), 0, 0, false); PG8_STAGE_A(PG8_SA(0, 1), 1, 0, false);
    if (wr == 1) PG8_BAR;
    PG8_WAIT_V(2); PG8_BAR;
    PG8_STAGE(PG8_SB(1, 0), cB + kstep, voffB); PG8_STAGE_A(PG8_SA(1, 0), 0, kstep, false); PG8_STAGE(PG8_SB(1, 1), cB + hstep + kstep, voffB);
    PG8_WAIT_V(6); PG8_BAR;
    for (;;) {
        if constexpr (!AMap::GATHER) has_next = S.next(ui + 1, nxt);
        if constexpr (AMap::GATHER) {
            if (has_next) { PG8_CONV(offN, rawN); }
            else {
#pragma unroll
                for (int h = 0; h < 2; ++h)
#pragma unroll
                    for (int i = 0; i < 2; ++i) offN[h][i] = offC[h][i];
            }
            has_nn = has_next && S.next(ui + 2, nn);
            if (has_nn) { PG8_RAW(rawN, nn); }
        } else { nA = has_next ? (unsigned)nxt.pm * tstep + (SEG2 ? (unsigned)nxt.e * 1024u : 0u) : cA; }
        const unsigned nB = has_next ? (unsigned)nxt.e * (SEG2 ? 1024u : (unsigned)(bstride * 2)) + (unsigned)nxt.pn * tstep : cB;
        const int ntc = SEG2 ? (cur.e ? 4 : 8) : nt;
#pragma nounroll
        for (int t = 0; t < ntc; t += 2) {
            const bool last = (t == ntc - 2);
            const unsigned k1 = (unsigned)(t + 1) * kstep, k2 = last ? 0u : (unsigned)(t + 2) * kstep, k3 = k2 + kstep;
            const unsigned b2 = last ? nB : cB + (unsigned)(t + 2) * kstep, b3 = b2 + kstep;
            PG8_XLDB(0, 0, 0); PG8_XLDB(1, 0, 1); PG8_SCHED; PG8_XLDA(0, 0); PG8_STAGE_A(PG8_SA(1, 1), 1, k1, false);
            PG8_WAIT_V(8); PG8_WAIT_L(0); PG8_BAR; PG8_XMMA(0, 0, 0); PG8_XMMA(0, 1, 1); PG8_BAR; PG8_SCHED;
            PG8_XLDA(0, 1); PG8_STAGE(PG8_SB(0, 0), b2, voffB); PG8_STAGE(PG8_SB(0, 1), b2 + hstep, voffB); PG8_STAGE_A(PG8_SA(0, 0), 0, k2, last);
            PG8_WAIT_V(8); PG8_WAIT_L(0); PG8_BAR; PG8_XMMA(1, 0, 0); PG8_XMMA(1, 1, 1); PG8_BAR; PG8_SCHED;
            PG8_XLDB(0, 1, 0); PG8_XLDB(1, 1, 1); PG8_SCHED; PG8_XLDA(1, 0); PG8_STAGE_A(PG8_SA(0, 1), 1, k2, last);
            PG8_WAIT_V(8); PG8_WAIT_L(0); PG8_BAR; PG8_XMMA(0, 0, 0); PG8_XMMA(0, 1, 1); PG8_BAR; PG8_SCHED;
            PG8_XLDA(1, 1); PG8_STAGE(PG8_SB(1, 0), b3, voffB); PG8_STAGE(PG8_SB(1, 1), b3 + hstep, voffB); PG8_STAGE_A(PG8_SA(1, 0), 0, k3, last);
            PG8_WAIT_V(8); PG8_WAIT_L(0); PG8_BAR; PG8_XMMA(1, 0, 0); PG8_XMMA(1, 1, 1); PG8_BAR; PG8_SCHED;
        }
#ifdef PROBE_EPI
        unsigned long long pe_t0 = 0; if (tid == 0) pe_t0 = __builtin_amdgcn_s_memrealtime();
#endif
        if constexpr (ALIGN_EPI) { if (wr == 0) PG8_BAR; }
        if constexpr (F8) asm volatile("s_nop 15\n\ts_nop 15" ::: "memory");
        E(acc, cur, wr, wc, fr, fq);
#ifdef PROBE_EPI
        if (tid == 0) { asm volatile("s_waitcnt vmcnt(0)" ::: "memory"); volatile LAS unsigned long long* pb_ = (volatile LAS unsigned long long*)(lds + MISC_OFF + 8192); pb_[1] = pb_[1] + (__builtin_amdgcn_s_memrealtime() - pe_t0); }
#endif
        if (!has_next) break;
        if (!(SEG2 && cur.e == 0))
#pragma unroll
        for (int a = 0; a < 2; ++a)
#pragma unroll
            for (int b = 0; b < 2; ++b)
#pragma unroll
                for (int m = 0; m < 4; ++m)
#pragma unroll
                    for (int n = 0; n < 2; ++n) acc[a][b][m][n] = (f32x4){0.f, 0.f, 0.f, 0.f};
        cur = nxt; cB = nB; cA = nA; ++ui;
        if constexpr (AMap::GATHER) { nxt = nn; has_next = has_nn;
#pragma unroll
            for (int h = 0; h < 2; ++h)
#pragma unroll
                for (int i = 0; i < 2; ++i) offC[h][i] = offN[h][i];
        }
        if constexpr (ALIGN_EPI) { if (wr == 1) PG8_BAR; }
    }
    PG8_WAIT_V(0);
    if constexpr (!ALIGN_EPI) { if (wr == 0) PG8_BAR; }
    PG8_BAR;
#undef PG8_STAGE_A
#undef PG8_LD8
#undef PG8_LDA8
#undef PG8_LDB8
#undef PG8_MMA8
#undef PG8_XLDA
#undef PG8_XLDB
#undef PG8_XMMA
#undef PG8_SA
#undef PG8_SB
#undef PG8_STAGE
#undef PG8_LDA
#undef PG8_LDB
#undef PG8_MMA
#undef PG8_WAIT_V
#undef PG8_WAIT_L
#undef PG8_BAR
#undef PG8_SCHED
#undef PG8_OFFS
#undef PG8_RAW
#undef PG8_CONV
}

#define EPI_PIN(x) asm volatile("" : "+v"(x))
#define LPIN(x) asm volatile("" : "+v"(x))
#define EPI_ROWSTEP(m) (((m) == 3) ? 80 : 16)
struct EpiProj {
    static constexpr bool PERM = true;
    bf16_t* O; const float* cs; const float* sn; float* alow; float scale;
    __device__ __forceinline__ void operator()(const f32x4 (&acc)[2][2][4][2], const Unit& u, int wr, int wc, int fr, int fq) const {
        const int row0 = u.pm * BM + wr * 64 + fr, col0 = u.pn * BM + wc * 32 + 8 * fq;
        unsigned off = (unsigned)(row0 * NP + col0) * 2u;
        if (u.pn < 12) {
            unsigned toff = (unsigned)((row0 & (SEQ - 1)) * 64 + wc * 16 + fq * 4) * 4u;
            f32x4 ct[2][4], st[2][4];
#pragma unroll
            for (int ai = 0; ai < 2; ++ai)
#pragma unroll
                for (int m = 0; m < 4; ++m) { ct[ai][m] = *(const f32x4*)((const char*)cs + toff + (ai * HALF + m * 16) * 64 * 4); st[ai][m] = *(const f32x4*)((const char*)sn + toff + (ai * HALF + m * 16) * 64 * 4); }
#pragma unroll
            for (int ai = 0; ai < 2; ++ai)
#pragma unroll
                for (int m = 0; m < 4; ++m) {
                    const f32x4 c4 = ct[ai][m], s4 = st[ai][m];
#pragma unroll
                    for (int bj = 0; bj < 2; ++bj) { const f32x4 v0 = acc[ai][bj][m][0] * scale, v1 = acc[ai][bj][m][1] * scale; u32x4 w;
                        w.x = pk2(v0[0] * c4[0] - v0[1] * s4[0], v0[1] * c4[0] + v0[0] * s4[0]);
                        w.y = pk2(v0[2] * c4[1] - v0[3] * s4[1], v0[3] * c4[1] + v0[2] * s4[1]);
                        w.z = pk2(v1[0] * c4[2] - v1[1] * s4[2], v1[1] * c4[2] + v1[0] * s4[2]);
                        w.w = pk2(v1[2] * c4[3] - v1[3] * s4[3], v1[3] * c4[3] + v1[2] * s4[3]);
                        *(u32x4*)((char*)O + off + bj * HALF * 2) = w; }
                    off += EPI_ROWSTEP(m) * NP * 2; EPI_PIN(off);
                }
        } else if (GATE_F8 && u.pn >= RB / 256 && u.pn < 46) {
            unsigned off8 = (unsigned)(row0 * NP) * 2u + (unsigned)(G8_BYTE0 + col0 - RB);
#pragma unroll
            for (int ai = 0; ai < 2; ++ai)
#pragma unroll
                for (int m = 0; m < 4; ++m) {
#pragma unroll
                    for (int bj = 0; bj < 2; ++bj) { const f32x4 v0 = acc[ai][bj][m][0] * scale, v1 = acc[ai][bj][m][1] * scale; u32x2 w;
                        w.x = pk_fp8x4(v0[0], v0[1], v0[2], v0[3]); w.y = pk_fp8x4(v1[0], v1[1], v1[2], v1[3]);
                        *(u32x2*)((char*)O + off8 + bj * HALF) = w; }
                    off8 += EPI_ROWSTEP(m) * NP * 2; EPI_PIN(off8); }
        } else if (u.pn < 46) {
#pragma unroll
            for (int ai = 0; ai < 2; ++ai)
#pragma unroll
                for (int m = 0; m < 4; ++m) {
#pragma unroll
                    for (int bj = 0; bj < 2; ++bj) { const f32x4 v0 = acc[ai][bj][m][0] * scale, v1 = acc[ai][bj][m][1] * scale; u32x4 w;
                        w.x = pk2(v0[0], v0[1]); w.y = pk2(v0[2], v0[3]); w.z = pk2(v1[0], v1[1]); w.w = pk2(v1[2], v1[3]);
                        *(u32x4*)((char*)O + off + bj * HALF * 2) = w; }
                    off += EPI_ROWSTEP(m) * NP * 2; EPI_PIN(off); }
        } else {
            if (wc == 0 && fq < 2) {
                unsigned aoff_ = (unsigned)(row0 * 16 + 8 * fq) * 4u;
#pragma unroll
                for (int ai = 0; ai < 2; ++ai)
#pragma unroll
                    for (int m = 0; m < 4; ++m) { float* rp = (float*)((char*)alow + aoff_);
                        *(f32x4*)rp = acc[ai][0][m][0] * scale; *(f32x4*)(rp + 4) = acc[ai][0][m][1] * scale;
                        aoff_ += EPI_ROWSTEP(m) * 16 * 4; EPI_PIN(aoff_); }
            }
        }
    }
};
template <bool FIRST> struct EpiGate {
    static constexpr bool PERM = true;
    bf16_t* O; const bf16_t* proj; int goff; float scale; unsigned char* O8;
    __device__ __forceinline__ void operator()(const f32x4 (&acc)[2][2][4][2], const Unit& u, int wr, int wc, int fr, int fq) const {
        const int row0 = u.pm * BM + wr * 64 + fr, col0 = u.pn * BM + wc * 32 + 8 * fq;
        const unsigned goffb = GATE_F8 ? (unsigned)(row0 * NP) * 2u + (unsigned)(G8_BYTE0 + goff - RB + col0) : (unsigned)(row0 * NP + goff + col0) * 2u, ooff = (unsigned)(row0 * D + col0) * 2u;
        u32x4 gA[2][2], gB[2][2], pA[2][2], pB[2][2];
#define EG_ROW(r) ((((r) >> 2) * 128) + (((r) & 3) * 16))
#define EG_LOAD(G, P, b) do { _Pragma("unroll") for (int rr = 0; rr < 2; ++rr) { const unsigned ro = EG_ROW(2 * (b) + rr); _Pragma("unroll") for (int bj = 0; bj < 2; ++bj) { \
            if (GATE_F8) { const u32x2 g8 = *(const u32x2*)((const char*)proj + goffb + ro * NP * 2 + bj * HALF); G[rr][bj] = (u32x4){g8.x, g8.y, 0u, 0u}; } \
            else G[rr][bj] = *(const u32x4*)((const char*)proj + goffb + ro * NP * 2 + bj * HALF * 2); \
            if (!FIRST) P[rr][bj] = *(const u32x4*)((const char*)O + ooff + ro * D * 2 + bj * HALF * 2); } } asm volatile("" ::: "memory"); } while (0)
#define EG_COMP(G, P, b) do { _Pragma("unroll") for (int rr = 0; rr < 2; ++rr) { const int r = 2 * (b) + rr, ai = r >> 2, m = r & 3; const unsigned ro = EG_ROW(r); _Pragma("unroll") for (int bj = 0; bj < 2; ++bj) { \
            const u32x4 gg = G[rr][bj]; const f32x4 v0 = acc[ai][bj][m][0] * scale, v1 = acc[ai][bj][m][1] * scale; float gf[8], r8[8]; \
            if (GATE_F8) unpack_fp8x8((u32x2){gg.x, gg.y}, gf); else { gf[0] = bflo(gg.x); gf[1] = bfhi(gg.x); gf[2] = bflo(gg.y); gf[3] = bfhi(gg.y); gf[4] = bflo(gg.z); gf[5] = bfhi(gg.z); gf[6] = bflo(gg.w); gf[7] = bfhi(gg.w); } \
            r8[0] = sigmoidf_(gf[0]) * v0[0]; r8[1] = sigmoidf_(gf[1]) * v0[1]; r8[2] = sigmoidf_(gf[2]) * v0[2]; r8[3] = sigmoidf_(gf[3]) * v0[3]; \
            r8[4] = sigmoidf_(gf[4]) * v1[0]; r8[5] = sigmoidf_(gf[5]) * v1[1]; r8[6] = sigmoidf_(gf[6]) * v1[2]; r8[7] = sigmoidf_(gf[7]) * v1[3]; \
            if (!FIRST) { const u32x4 pq = P[rr][bj]; r8[0] += bflo(pq.x); r8[1] += bfhi(pq.x); r8[2] += bflo(pq.y); r8[3] += bfhi(pq.y); r8[4] += bflo(pq.z); r8[5] += bfhi(pq.z); r8[6] += bflo(pq.w); r8[7] += bfhi(pq.w); } \
            if (!FIRST && O8) { u32x2 w8; w8.x = pk_fp8x4(r8[0], r8[1], r8[2], r8[3]); w8.y = pk_fp8x4(r8[4], r8[5], r8[6], r8[7]); *(u32x2*)(O8 + (ooff >> 1) + ro * D + bj * HALF) = w8; } \
            else { u32x4 w; w.x = pk2(r8[0], r8[1]); w.y = pk2(r8[2], r8[3]); w.z = pk2(r8[4], r8[5]); w.w = pk2(r8[6], r8[7]); *(u32x4*)((char*)O + ooff + ro * D * 2 + bj * HALF * 2) = w; } } } asm volatile("" ::: "memory"); } while (0)
        EG_LOAD(gA, pA, 0); EG_LOAD(gB, pB, 1); EG_COMP(gA, pA, 0); EG_LOAD(gA, pA, 2); EG_COMP(gB, pB, 1); EG_LOAD(gB, pB, 3); EG_COMP(gA, pA, 2); EG_COMP(gB, pB, 3);
#undef EG_LOAD
#undef EG_COMP
    }
};
struct EpiGate2 {
    static constexpr bool PERM = true;
    const bf16_t* proj; float scale; unsigned char* O8;
    __device__ __forceinline__ void operator()(f32x4 (&acc)[2][2][4][2], const Unit& u, int wr, int wc, int fr, int fq) const {
        const int row0 = u.pm * BM + wr * 64 + fr, col0 = u.pn * BM + wc * 32 + 8 * fq;
        const unsigned goffa = (unsigned)(row0 * NP) * 2u + (unsigned)(G8_BYTE0 + GA - RB + col0), ooff = (unsigned)(row0 * D + col0);
        u32x4 gA[2][2], gB[2][2];
#define EG_ROW(r) ((((r) >> 2) * 128) + (((r) & 3) * 16))
        if (u.e == 0) {
#define E2_LOAD(G, b) do { _Pragma("unroll") for (int rr = 0; rr < 2; ++rr) { const unsigned ro = EG_ROW(2 * (b) + rr); _Pragma("unroll") for (int bj = 0; bj < 2; ++bj) { \
            const u32x2 ga8 = *(const u32x2*)((const char*)proj + goffa + ro * NP * 2 + bj * HALF), gb8 = *(const u32x2*)((const char*)proj + goffa + (GB - GA) + ro * NP * 2 + bj * HALF); \
            G[rr][bj] = (u32x4){ga8.x, ga8.y, gb8.x, gb8.y}; } } asm volatile("" ::: "memory"); } while (0)
#define E2_COMP(G, b) do { _Pragma("unroll") for (int rr = 0; rr < 2; ++rr) { const int r = 2 * (b) + rr, ai = r >> 2, m = r & 3; _Pragma("unroll") for (int bj = 0; bj < 2; ++bj) { \
            const u32x4 gg = G[rr][bj]; float fa[8], fb[8]; unpack_fp8x8((u32x2){gg.x, gg.y}, fa); unpack_fp8x8((u32x2){gg.z, gg.w}, fb); \
            _Pragma("unroll") for (int j = 0; j < 8; ++j) { const float q = (1.0f + __expf(-fmaxf(fa[j], -30.0f))) * sigmoidf_(fb[j]); acc[ai][bj][m][j >> 2][j & 3] *= q; } } } } while (0)
            E2_LOAD(gA, 0); E2_LOAD(gB, 1); E2_COMP(gA, 0); E2_LOAD(gA, 2); E2_COMP(gB, 1); E2_LOAD(gB, 3); E2_COMP(gA, 2); E2_COMP(gB, 3);
#undef E2_LOAD
#undef E2_COMP
        } else {
#define E2_LOAD(G, b) do { _Pragma("unroll") for (int rr = 0; rr < 2; ++rr) { const unsigned ro = EG_ROW(2 * (b) + rr); _Pragma("unroll") for (int bj = 0; bj < 2; ++bj) { \
            const u32x2 ga8 = *(const u32x2*)((const char*)proj + goffa + ro * NP * 2 + bj * HALF); G[rr][bj] = (u32x4){ga8.x, ga8.y, 0u, 0u}; } } asm volatile("" ::: "memory"); } while (0)
#define E2_COMP(G, b) do { _Pragma("unroll") for (int rr = 0; rr < 2; ++rr) { const int r = 2 * (b) + rr, ai = r >> 2, m = r & 3; const unsigned ro = EG_ROW(r); _Pragma("unroll") for (int bj = 0; bj < 2; ++bj) { \
            const u32x4 gg = G[rr][bj]; float fa[8], r8[8]; unpack_fp8x8((u32x2){gg.x, gg.y}, fa); \
            _Pragma("unroll") for (int j = 0; j < 8; ++j) r8[j] = sigmoidf_(fmaxf(fa[j], -30.0f)) * (acc[ai][bj][m][j >> 2][j & 3] * scale); \
            u32x2 w8; w8.x = pk_fp8x4(r8[0], r8[1], r8[2], r8[3]); w8.y = pk_fp8x4(r8[4], r8[5], r8[6], r8[7]); *(u32x2*)(O8 + ooff + ro * D + bj * HALF) = w8; } } asm volatile("" ::: "memory"); } while (0)
            E2_LOAD(gA, 0); E2_LOAD(gB, 1); E2_COMP(gA, 0); E2_LOAD(gA, 2); E2_COMP(gB, 1); E2_LOAD(gB, 3); E2_COMP(gA, 2); E2_COMP(gB, 3);
#undef E2_LOAD
#undef E2_COMP
        }
#undef EG_ROW
    }
};
#define EG_ROW(r) ((((r) >> 2) * 128) + (((r) & 3) * 16))
template <bool XF32> struct EpiResid {
    static constexpr bool PERM = true;
    const void* xi; bf16_t* xo; const float* gate; float scale;
    __device__ __forceinline__ void operator()(const f32x4 (&acc)[2][2][4][2], const Unit& u, int wr, int wc, int fr, int fq) const {
        const int row0 = u.pm * BM + wr * 64 + fr, col0 = u.pn * BM + wc * 32 + 8 * fq;
        const int b = (u.pm * BM) / SEQ;
        f32x4 gt[2][2];
#pragma unroll
        for (int bj = 0; bj < 2; ++bj)
#pragma unroll
            for (int n = 0; n < 2; ++n) gt[bj][n] = *(const f32x4*)(gate + (size_t)b * 12288 + col0 + bj * HALF + 4 * n) * scale;
        const unsigned off = (unsigned)(row0 * D + col0);
        constexpr int RB_ = XF32 ? 1 : 2, NBAT = 8 / RB_;
        f32x4 xA[RB_][2][2], xB[RB_][2][2];
#define ER_LOAD(X, bb) do { _Pragma("unroll") for (int rr = 0; rr < RB_; ++rr) { const unsigned ro = EG_ROW(RB_ * (bb) + rr); _Pragma("unroll") for (int bj = 0; bj < 2; ++bj) { const unsigned o = off + ro * D + bj * HALF; \
            if (XF32) { X[rr][bj][0] = *(const f32x4*)((const float*)xi + o); X[rr][bj][1] = *(const f32x4*)((const float*)xi + o + 4); } \
            else { const u32x4 rw = *(const u32x4*)((const bf16_t*)xi + o); X[rr][bj][0] = (f32x4){bflo(rw.x), bfhi(rw.x), bflo(rw.y), bfhi(rw.y)}; X[rr][bj][1] = (f32x4){bflo(rw.z), bfhi(rw.z), bflo(rw.w), bfhi(rw.w)}; } } } asm volatile("" ::: "memory"); } while (0)
#define ER_COMP(X, bb) do { _Pragma("unroll") for (int rr = 0; rr < RB_; ++rr) { const int r = RB_ * (bb) + rr, ai = r >> 2, m = r & 3; const unsigned ro = EG_ROW(r); _Pragma("unroll") for (int bj = 0; bj < 2; ++bj) { const unsigned o = off + ro * D + bj * HALF; \
            const f32x4 v0 = X[rr][bj][0] + gt[bj][0] * acc[ai][bj][m][0], v1 = X[rr][bj][1] + gt[bj][1] * acc[ai][bj][m][1]; \
            u32x4 w; w.x = pk2(v0[0], v0[1]); w.y = pk2(v0[2], v0[3]); w.z = pk2(v1[0], v1[1]); w.w = pk2(v1[2], v1[3]); *(u32x4*)(xo + o) = w; } } asm volatile("" ::: "memory"); } while (0)
        ER_LOAD(xA, 0);
#pragma unroll
        for (int bb = 0; bb < NBAT; bb += 2) {
            ER_LOAD(xB, bb + 1); ER_COMP(xA, bb);
            if (bb + 2 < NBAT) ER_LOAD(xA, bb + 2);
            ER_COMP(xB, bb + 1); }
#undef ER_LOAD
#undef ER_COMP
#undef EG_ROW
    }
};
struct EpiSwiGLU {
    static constexpr bool PERM = true;
    bf16_t* O;
    __device__ __forceinline__ void operator()(const f32x4 (&acc)[2][2][4][2], const Unit& u, int wr, int wc, int fr, int fq) const {
        const int row0 = u.pm * BM + wr * 64 + fr, col0 = u.pn * HALF + wc * 32 + 8 * fq;
        unsigned off = (unsigned)(row0 * FF + col0) * 2u;
#pragma unroll
        for (int ai = 0; ai < 2; ++ai)
#pragma unroll
            for (int m = 0; m < 4; ++m) { const f32x4 g0 = acc[ai][0][m][0], g1 = acc[ai][0][m][1], u0 = acc[ai][1][m][0], u1 = acc[ai][1][m][1]; u32x4 w;
                w.x = pk2(siluf_(g0[0]) * u0[0], siluf_(g0[1]) * u0[1]); w.y = pk2(siluf_(g0[2]) * u0[2], siluf_(g0[3]) * u0[3]);
                w.z = pk2(siluf_(g1[0]) * u1[0], siluf_(g1[1]) * u1[1]); w.w = pk2(siluf_(g1[2]) * u1[2], siluf_(g1[3]) * u1[3]);
                *(u32x4*)((char*)O + off) = w;
                off += EPI_ROWSTEP(m) * FF * 2; EPI_PIN(off); }
    }
};
struct EpiPlain {
    static constexpr bool PERM = true;
    bf16_t* O;
    __device__ __forceinline__ void operator()(const f32x4 (&acc)[2][2][4][2], const Unit& u, int wr, int wc, int fr, int fq) const {
        const int row0 = u.pm * BM + wr * 64 + fr, col0 = u.pn * BM + wc * 32 + 8 * fq;
        unsigned off = (unsigned)(row0 * D + col0) * 2u;
#pragma unroll
        for (int ai = 0; ai < 2; ++ai)
#pragma unroll
            for (int m = 0; m < 4; ++m) {
#pragma unroll
                for (int bj = 0; bj < 2; ++bj) { const f32x4 v0 = acc[ai][bj][m][0], v1 = acc[ai][bj][m][1]; u32x4 w;
                    w.x = pk2(v0[0], v0[1]); w.y = pk2(v0[2], v0[3]); w.z = pk2(v1[0], v1[1]); w.w = pk2(v1[2], v1[3]);
                    *(u32x4*)((char*)O + off + bj * HALF * 2) = w; }
                off += EPI_ROWSTEP(m) * D * 2; EPI_PIN(off); }
    }
};
constexpr float W8_SCALE = 32.0f, W8_INV = 1.0f / 32.0f;
struct EpiSwiGLU8 {
    static constexpr bool PERM = true;
    unsigned char* O;
    __device__ __forceinline__ void operator()(const f32x4 (&acc)[2][2][4][2], const Unit& u, int wr, int wc, int fr, int fq) const {
        const int row0 = u.pm * BM + wr * 64 + fr, col0 = u.pn * HALF + wc * 32 + 8 * fq;
        unsigned off = (unsigned)(row0 * FF + col0);
#pragma unroll
        for (int ai = 0; ai < 2; ++ai)
#pragma unroll
            for (int m = 0; m < 4; ++m) { const f32x4 g0 = acc[ai][0][m][0] * W8_INV, g1 = acc[ai][0][m][1] * W8_INV, u0 = acc[ai][1][m][0] * W8_INV, u1 = acc[ai][1][m][1] * W8_INV; u32x2 w;
                w.x = pk_fp8x4(siluf_(g0[0]) * u0[0], siluf_(g0[1]) * u0[1], siluf_(g0[2]) * u0[2], siluf_(g0[3]) * u0[3]);
                w.y = pk_fp8x4(siluf_(g1[0]) * u1[0], siluf_(g1[1]) * u1[1], siluf_(g1[2]) * u1[2], siluf_(g1[3]) * u1[3]);
                *(u32x2*)(O + off) = w;
                off += EPI_ROWSTEP(m) * FF; EPI_PIN(off); }
    }
};
struct EpiPlainS {
    static constexpr bool PERM = true;
    bf16_t* O; float scale;
    __device__ __forceinline__ void operator()(const f32x4 (&acc)[2][2][4][2], const Unit& u, int wr, int wc, int fr, int fq) const {
        const int row0 = u.pm * BM + wr * 64 + fr, col0 = u.pn * BM + wc * 32 + 8 * fq;
        unsigned off = (unsigned)(row0 * D + col0) * (Y_F8 ? 1u : 2u);
#pragma unroll
        for (int ai = 0; ai < 2; ++ai)
#pragma unroll
            for (int m = 0; m < 4; ++m) {
#pragma unroll
                for (int bj = 0; bj < 2; ++bj) { const f32x4 v0 = acc[ai][bj][m][0] * scale, v1 = acc[ai][bj][m][1] * scale;
#if Y_F8
                    u32x2 w; w.x = pk_fp8x4(v0[0], v0[1], v0[2], v0[3]); w.y = pk_fp8x4(v1[0], v1[1], v1[2], v1[3]);
                    *(u32x2*)((char*)O + off + bj * HALF) = w;
#else
                    u32x4 w; w.x = pk2(v0[0], v0[1]); w.y = pk2(v0[2], v0[3]); w.z = pk2(v1[0], v1[1]); w.w = pk2(v1[2], v1[3]);
                    *(u32x4*)((char*)O + off + bj * HALF * 2) = w;
#endif
                }
                off += EPI_ROWSTEP(m) * D * (Y_F8 ? 1 : 2); EPI_PIN(off); }
    }
};
}

struct Args {
    const float* x; const float* c; const float* w_ada; const float* b_ada; const float* norm_mix; const float* norm_ffn; const float* w_in;
    const float* w_alpha2; const float* b_alpha2; const float* gla_gain; const float* w_out_a; const float* w_out_b; const float* w_out;
    const float* w_router; const float* b_router; const float* w_gate_e; const float* w_up_e; const float* w_down_e; const float* final_norm;
    float* out; unsigned char* ws; int ph_lo, ph_hi;
};

__device__ __forceinline__ int proj_src_col(int n) {
    if (n < 3072) { const int blk = n >> 7, w = n & 127; return (blk << 7) + (w >> 1) + ((w & 1) << 6); }
    if (n < 7680) return n;
    if (n < 11776) return n + 16;
    if (n < 11792) return n - 4096;
    return -1;
}
struct TrDesc { const float* src; unsigned char* dst; int ldw, K, zero, rope, f8; };
__device__ __forceinline__ void tr_load(const TrDesc& d, f32x4 (&v)[16]) {
#pragma unroll
    for (int i = 0; i < 16; ++i) v[i] = *(const f32x4*)(d.src + (size_t)(4 * i) * d.ldw);
}
__device__ __forceinline__ void tr_finish(const TrDesc& d, f32x4 (&v)[16], LAS float* scr, int lane) {
    const int kk = lane >> 4, q4 = lane & 15;
    if (d.zero) {
#pragma unroll
        for (int i = 0; i < 16; ++i) v[i] = (f32x4){0.f, 0.f, 0.f, 0.f}; }
    const int d0 = d.rope ? 8 * (q4 & 7) + (q4 >> 3) : 4 * q4, ds = d.rope ? 2 : 1;
    { LAS float* rp = scr + kk * 65 + d0;
#pragma unroll
        for (int i = 0; i < 16; ++i) { rp[4 * i * 65] = v[i][0]; rp[4 * i * 65 + ds] = v[i][1]; rp[4 * i * 65 + 2 * ds] = v[i][2]; rp[4 * i * 65 + 3 * ds] = v[i][3]; } }
    LDS_WAIT(); asm volatile("" ::: "memory");
    if (d.f8) {
        const int c = lane & 3, nl = lane >> 2; const LAS float* sp = scr + (16 * c) * 65 + nl; unsigned char* dp = d.dst + (size_t)nl * d.K + 16 * c;
#pragma unroll
        for (int j = 0; j < 4; ++j) { u32x4 o;
            o.x = pk_fp8x4(sp[0 * 65 + 16 * j] * 32.0f, sp[1 * 65 + 16 * j] * 32.0f, sp[2 * 65 + 16 * j] * 32.0f, sp[3 * 65 + 16 * j] * 32.0f);
            o.y = pk_fp8x4(sp[4 * 65 + 16 * j] * 32.0f, sp[5 * 65 + 16 * j] * 32.0f, sp[6 * 65 + 16 * j] * 32.0f, sp[7 * 65 + 16 * j] * 32.0f);
            o.z = pk_fp8x4(sp[8 * 65 + 16 * j] * 32.0f, sp[9 * 65 + 16 * j] * 32.0f, sp[10 * 65 + 16 * j] * 32.0f, sp[11 * 65 + 16 * j] * 32.0f);
            o.w = pk_fp8x4(sp[12 * 65 + 16 * j] * 32.0f, sp[13 * 65 + 16 * j] * 32.0f, sp[14 * 65 + 16 * j] * 32.0f, sp[15 * 65 + 16 * j] * 32.0f);
            *(GAS u32x4*)(dp + (size_t)(16 * j) * d.K) = o; }
    } else {
        const int c = lane & 7, nl = lane >> 3; const LAS float* sp = scr + (8 * c) * 65 + nl; unsigned char* dp = d.dst + ((size_t)nl * d.K + 8 * c) * 2;
#pragma unroll
        for (int j = 0; j < 8; ++j) { u32x4 o;
            o.x = pk2(sp[0 * 65 + 8 * j], sp[1 * 65 + 8 * j]); o.y = pk2(sp[2 * 65 + 8 * j], sp[3 * 65 + 8 * j]); o.z = pk2(sp[4 * 65 + 8 * j], sp[5 * 65 + 8 * j]); o.w = pk2(sp[6 * 65 + 8 * j], sp[7 * 65 + 8 * j]);
            *(GAS u32x4*)(dp + (size_t)(8 * j) * d.K * 2) = o; }
    }
    LDS_WAIT(); asm volatile("" ::: "memory");
}

typedef const __attribute__((address_space(4))) Args CArgsP;
__device__ __forceinline__ void prologue_phase(CArgsP* ap_, LAS unsigned char* lds, int vcu, int G, int tid, int wave, int lane, int parts = 7) {
#define a (*ap_)
    unsigned char* ws = a.ws;
    if (parts & 1) {
        LAS float* cact = (LAS float*)lds;
        LAS float* red = (LAS float*)(lds + 65536);
        for (int i = tid; i < NB * D; i += NTHREADS) { const int b = i >> 11, k = i & 2047; cact[k * 8 + b] = siluf_(a.c[i]); }
        __syncthreads();
        float* ada = (float*)(ws + WS_ADA);
        const int q = tid & 7, kg = tid >> 3;
        for (int u = vcu; u < DEPTH * 384; u += G) {
            const int l = u / 384, n0 = (u % 384) * 32;
            const float* W = a.w_ada + (size_t)l * D * 12288 + n0 + 4 * q;
            f32x4 acc[8];
#pragma unroll
            for (int b = 0; b < 8; ++b) acc[b] = (f32x4){0.f, 0.f, 0.f, 0.f};
#pragma unroll 8
            for (int kk = 0; kk < 32; ++kk) { const int k = kg * 32 + kk; const f32x4 w = *(const f32x4*)(W + (size_t)k * 12288);
                const f32x4 c0 = *(const LAS f32x4*)(cact + k * 8), c1 = *(const LAS f32x4*)(cact + k * 8 + 4);
                acc[0] += w * c0[0]; acc[1] += w * c0[1]; acc[2] += w * c0[2]; acc[3] += w * c0[3];
                acc[4] += w * c1[0]; acc[5] += w * c1[1]; acc[6] += w * c1[2]; acc[7] += w * c1[3]; }
#pragma unroll
            for (int b = 0; b < 8; ++b) *(LAS f32x4*)(red + (kg * 8 + b) * 32 + 4 * q) = acc[b];
            __syncthreads();
            if (tid < 256) { const int b = tid >> 5, col = tid & 31; float s = a.b_ada[(size_t)l * 12288 + n0 + col];
                for (int g = 0; g < 64; ++g) s += red[(g * 8 + b) * 32 + col];
                const int n = n0 + col;
                if (n >= 2048 && n < 4096) s = (1.0f + s) * a.norm_mix[(size_t)l * D + n - 2048]; else if (n >= 8192 && n < 10240) s = (1.0f + s) * a.norm_ffn[(size_t)l * D + n - 8192];
                ada[((size_t)l * NB + b) * 12288 + n] = s; }
            __syncthreads();
        }
    }
    if (parts & 2) {
        float* cs = (float*)(ws + WS_ROPE); float* sn = cs + SEQ * 64;
        for (int i = vcu * NTHREADS + tid; i < SEQ * 64; i += G * NTHREADS) {
            const int pos = i >> 6, fi = i & 63;
            double f = 1.0;
            if (fi & 1) f *= 0.8659643233600653; if (fi & 2) f *= 0.7498942093324558; if (fi & 4) f *= 0.5623413251903491;
            if (fi & 8) f *= 0.31622776601683794; if (fi & 16) f *= 0.09999999999999999; if (fi & 32) f *= 0.009999999999999998;
            double rev = (double)pos * f * 0.15915494309189535; rev -= __builtin_floor(rev);
            const float rv = (float)rev;
            cs[i] = __builtin_amdgcn_cosf(rv); sn[i] = __builtin_amdgcn_sinf(rv);
        }
    }
    if (parts & 4) {
        LAS float* scr = (LAS float*)(lds + wave * 16640);
        const int gw = vcu * NWAVES + wave, NGW = G * NWAVES;
        constexpr int C_IN = 32 * 188, C_OA = 8 * 32, C_OB = 16 * 32, C_O = 32 * 32, C_GU = 16 * 32 * 32, C_DN = 16 * 16 * 32, C_L = C_IN + C_OA + C_OB + C_O + C_GU + C_DN, NIT = DEPTH * C_L;
        const int q4 = lane & 15, kk = lane >> 4;
        auto decode = [&](int it) -> TrDesc {
            TrDesc d; d.zero = 0; d.rope = 0; d.f8 = 0;
            const int l = it / C_L; int r = it % C_L;
            const float* W; unsigned char* WT; int ldw, K, k0, n0, scol, esz = 2;
            if (r < C_IN) { const int kb = r / 188, nb = r % 188; n0 = 64 * nb; k0 = 64 * kb; ldw = NIN; K = D; W = a.w_in + (size_t)l * D * NIN;
                if (n0 < 3072) { d.rope = 1; scol = (n0 >> 7) * 128 + 32 * ((n0 >> 6) & 1) + 64 * (q4 >> 3) + 4 * (q4 & 7); }
                else if (n0 < 7680) scol = n0 + 4 * q4;
                else if (n0 < 11776) scol = n0 + 16 + 4 * q4;
                else if (n0 == 11776) { scol = (q4 < 4) ? 7680 + 4 * q4 : 0; d.zero = (q4 < 4) ? 0 : 1; }
                else { scol = 0; d.zero = 1; }
#if PROJ_F8
                d.f8 = 1; esz = 1; WT = ws + WS_WIN + (size_t)l * NP * D;
#else
                WT = ws + WS_WIN + (size_t)l * NP * D * 2;
#endif
            } else if ((r -= C_IN) < C_OA) { const int kb = r / 32, nb = r % 32; n0 = 64 * nb; k0 = 64 * kb; ldw = D; K = 512; scol = n0 + 4 * q4; W = a.w_out_a + (size_t)l * 512 * D; WT = ws + WS_WOA + (size_t)l * D * 512 * (MIX_F8 ? 1 : 2); if (MIX_F8) { d.f8 = 1; esz = 1; }
                if (BR_FUSE) { K = 1536; WT = ws + WS_WOA + (size_t)l * D * 1536 + 1024; }
            } else if ((r -= C_OA) < C_OB) { const int kb = r / 32, nb = r % 32; n0 = 64 * nb; k0 = 64 * kb; ldw = D; K = 1024; scol = n0 + 4 * q4; W = a.w_out_b + (size_t)l * 1024 * D; WT = ws + WS_WOB + (size_t)l * D * 1024 * (MIX_F8 ? 1 : 2); if (MIX_F8) { d.f8 = 1; esz = 1; }
                if (BR_FUSE) { K = 1536; WT = ws + WS_WOA + (size_t)l * D * 1536; }
            } else if ((r -= C_OB) < C_O) { const int kb = r / 32, nb = r % 32; n0 = 64 * nb; k0 = 64 * kb; ldw = D; K = D; scol = n0 + 4 * q4; W = a.w_out + (size_t)l * D * D; WT = ws + WS_WO + (size_t)l * D * D * (MIX_F8 ? 1 : 2); if (MIX_F8) { d.f8 = 1; esz = 1; }
            } else if ((r -= C_O) < C_GU) { const int e = r / 1024, r2 = r % 1024, kb = r2 / 32, nb = r2 % 32, pn = nb >> 2, sgu = (nb >> 1) & 1, c0 = 64 * (nb & 1);
                n0 = 64 * nb; k0 = 64 * kb; ldw = FF; K = D; scol = 128 * pn + c0 + 4 * q4; W = (sgu ? a.w_up_e : a.w_gate_e) + (size_t)(l * NE + e) * D * FF; WT = ws + WS_WGU + (size_t)(l * NE + e) * 2048 * D; d.f8 = 1; esz = 1;
            } else { r -= C_GU; const int e = r / 512, r2 = r % 512, kb = r2 / 32, nb = r2 % 32;
                n0 = 64 * nb; k0 = 64 * kb; ldw = D; K = FF; scol = n0 + 4 * q4; W = a.w_down_e + (size_t)(l * NE + e) * FF * D; WT = ws + WS_WDN + (size_t)(l * NE + e) * D * FF; d.f8 = 1; esz = 1; }
            d.src = W + (size_t)(k0 + kk) * ldw + scol; d.ldw = ldw; d.K = K; d.dst = WT + ((size_t)n0 * K + k0) * esz;
            return d; };
        int it = gw; TrDesc dA, dB; f32x4 vA[16], vB[16];
        if (it < NIT) { dA = decode(it); tr_load(dA, vA); }
        while (it < NIT) {
            const int itB = it + NGW;
            if (itB < NIT) { dB = decode(itB); tr_load(dB, vB); }
            tr_finish(dA, vA, scr, lane);
            if (itB >= NIT) break;
            const int itA = itB + NGW;
            if (itA < NIT) { dA = decode(itA); tr_load(dA, vA); }
            tr_finish(dB, vB, scr, lane);
            it = itA;
        }
    }
}
#undef a

struct MoeStarts {
    int ts[NE];
    __device__ __forceinline__ void init(const unsigned* cnt) { int acc = 0;
#pragma unroll
        for (int e = 0; e < NE; ++e) { ts[e] = acc; acc += ((int)__hip_atomic_load(cnt + 64 * e, RLX_AGENT) + 255) >> 8; } }
    __device__ __forceinline__ int row(int slot) const { const int e = slot >> 16; int t0 = 0;
#pragma unroll
        for (int j = 0; j < NE; ++j) t0 = (e == j) ? ts[j] : t0;
        return t0 * 256 + (slot & 0xffff); }
};

template <int MODE>
__device__ __forceinline__ void norm_phase(const void* xs, void* xd, bf16_t* hout, const float* gain, const float* ada_scale, const float* ada_shift, const float* ada_gate2,
                                           const bf16_t* Y, const int* tslot, const float* tw, const unsigned* cnt, int vcu, int G, int wave, int lane) {
    const int gw = vcu * NWAVES + wave, NGW = G * NWAVES, rpw = T / NGW;
    MoeStarts ms; if (MODE != 0) ms.init(cnt);
    int tsl = 0; float twl = 0.f;
    if (MODE != 0) { const int i0 = gw * rpw * 2, ii = (i0 + lane < 2 * T) ? i0 + lane : 2 * T - 1; tsl = tslot[ii]; twl = tw[ii]; }
    for (int k = 0; k < rpw; k += 2) {
        const int row = gw * rpw + k, b = row >> 11;
        f32x4 v[2][8]; u32x2 xraw[2][8];
        int s0[2], s1[2]; float w0[2], w1[2];
        if (MODE != 0) {
#pragma unroll
            for (int rr = 0; rr < 2; ++rr) { s0[rr] = __builtin_amdgcn_readlane(tsl, (k + rr) * 2); s1[rr] = __builtin_amdgcn_readlane(tsl, (k + rr) * 2 + 1);
                w0[rr] = __builtin_bit_cast(float, __builtin_amdgcn_readlane(__builtin_bit_cast(int, twl), (k + rr) * 2)); w1[rr] = __builtin_bit_cast(float, __builtin_amdgcn_readlane(__builtin_bit_cast(int, twl), (k + rr) * 2 + 1)); } }
#pragma unroll
        for (int rr = 0; rr < 2; ++rr) {
            if (MODE == 0) { const GAS f32x4* xr = (const GAS f32x4*)((const float*)xs + (size_t)(row + rr) * D) + lane;
#pragma unroll
                for (int j = 0; j < 8; ++j) v[rr][j] = xr[64 * j];
            } else { const GAS u32x2* xr = (const GAS u32x2*)((const bf16_t*)xs + (size_t)(row + rr) * D) + lane;
#pragma unroll
                for (int j = 0; j < 8; ++j) xraw[rr][j] = xr[64 * j]; } }
        f32x4 ggv[8], ssv[8], scv[8];
#define GSS_LOAD() do { const GAS f32x4* gn_ = (const GAS f32x4*)gain + lane; \
            if (MODE == 2) { _Pragma("unroll") for (int j = 0; j < 8; ++j) { ggv[j] = gn_[64 * j]; scv[j] = (f32x4){0.f, 0.f, 0.f, 0.f}; ssv[j] = (f32x4){0.f, 0.f, 0.f, 0.f}; } } \
            else { const GAS f32x4* sc_ = (const GAS f32x4*)(ada_scale + (size_t)b * 12288) + lane; const GAS f32x4* sh_ = (const GAS f32x4*)(ada_shift + (size_t)b * 12288) + lane; \
                _Pragma("unroll") for (int j = 0; j < 8; ++j) { ggv[j] = sc_[64 * j]; scv[j] = (f32x4){0.f, 0.f, 0.f, 0.f}; ssv[j] = sh_[64 * j]; } } asm volatile("" ::: "memory"); } while (0)
        if (MODE == 0) GSS_LOAD();
        if (MODE != 0) {
            const GAS f32x4* gt = (const GAS f32x4*)(ada_gate2 + (size_t)b * 12288) + lane;
#if Y_F8
            unsigned ya[2][8], yb[2][8];
#pragma unroll
            for (int rr = 0; rr < 2; ++rr) { const GAS unsigned* y0 = (const GAS unsigned*)((const unsigned char*)Y + (size_t)ms.row(s0[rr]) * D) + lane; const GAS unsigned* y1 = (const GAS unsigned*)((const unsigned char*)Y + (size_t)ms.row(s1[rr]) * D) + lane;
#pragma unroll
                for (int j = 0; j < 8; ++j) { ya[rr][j] = y0[64 * j]; yb[rr][j] = y1[64 * j]; } }
            f32x4 gtv[8];
#pragma unroll
            for (int j = 0; j < 8; ++j) gtv[j] = gt[64 * j];
            asm volatile("" ::: "memory");
#pragma unroll
            for (int rr = 0; rr < 2; ++rr)
#pragma unroll
                for (int j = 0; j < 8; ++j) { LPIN(xraw[rr][j]); LPIN(ya[rr][j]); LPIN(yb[rr][j]); }
#pragma unroll
            for (int j = 0; j < 8; ++j) LPIN(gtv[j]);
#pragma unroll
            for (int rr = 0; rr < 2; ++rr)
#pragma unroll
                for (int j = 0; j < 8; ++j) { const u32x2 r = xraw[rr][j]; v[rr][j] = (f32x4){bflo(r.x), bfhi(r.x), bflo(r.y), bfhi(r.y)}; }
#pragma unroll
            for (int j = 0; j < 8; ++j) { const f32x4 g = gtv[j];
#pragma unroll
                for (int rr = 0; rr < 2; ++rr) {
                    const f32x2_t a0l = __builtin_amdgcn_cvt_pk_f32_fp8((int)ya[rr][j], false), a0h = __builtin_amdgcn_cvt_pk_f32_fp8((int)ya[rr][j], true), a1l = __builtin_amdgcn_cvt_pk_f32_fp8((int)yb[rr][j], false), a1h = __builtin_amdgcn_cvt_pk_f32_fp8((int)yb[rr][j], true);
                    f32x4 m; m[0] = w0[rr] * a0l[0] + w1[rr] * a1l[0]; m[1] = w0[rr] * a0l[1] + w1[rr] * a1l[1]; m[2] = w0[rr] * a0h[0] + w1[rr] * a1h[0]; m[3] = w0[rr] * a0h[1] + w1[rr] * a1h[1];
                    v[rr][j] = v[rr][j] + g * m; } }
#else
            u32x2 ya[2][8], yb[2][8];
#pragma unroll
            for (int rr = 0; rr < 2; ++rr) { const GAS u32x2* y0 = (const GAS u32x2*)(Y + (size_t)ms.row(s0[rr]) * D) + lane; const GAS u32x2* y1 = (const GAS u32x2*)(Y + (size_t)ms.row(s1[rr]) * D) + lane;
#pragma unroll
                for (int j = 0; j < 8; ++j) { ya[rr][j] = y0[64 * j]; yb[rr][j] = y1[64 * j]; } }
#pragma unroll
            for (int j = 0; j < 8; ++j) { const f32x4 g = gt[64 * j];
#pragma unroll
                for (int rr = 0; rr < 2; ++rr) { const u32x2 a0 = ya[rr][j], a1 = yb[rr][j];
                    f32x4 m; m[0] = w0[rr] * bflo(a0.x) + w1[rr] * bflo(a1.x); m[1] = w0[rr] * bfhi(a0.x) + w1[rr] * bfhi(a1.x); m[2] = w0[rr] * bflo(a0.y) + w1[rr] * bflo(a1.y); m[3] = w0[rr] * bfhi(a0.y) + w1[rr] * bfhi(a1.y);
                    v[rr][j] = v[rr][j] + g * m; } }
#endif
            GSS_LOAD();
            if (MODE == 1) {
#pragma unroll
                for (int rr = 0; rr < 2; ++rr) { GAS u32x2* xw = (GAS u32x2*)((bf16_t*)xd + (size_t)(row + rr) * D) + lane;
#pragma unroll
                    for (int j = 0; j < 8; ++j) { u32x2 w; w.x = pk2(v[rr][j][0], v[rr][j][1]); w.y = pk2(v[rr][j][2], v[rr][j][3]); xw[64 * j] = w; } } }
        }
        float rstd[2];
#pragma unroll
        for (int rr = 0; rr < 2; ++rr) { float s = 0.f;
#pragma unroll
            for (int j = 0; j < 8; ++j) s += (v[rr][j][0] * v[rr][j][0] + v[rr][j][1] * v[rr][j][1]) + (v[rr][j][2] * v[rr][j][2] + v[rr][j][3] * v[rr][j][3]);
            rstd[rr] = 1.0f / sqrtf(wave_sum(s, lane) * (1.0f / D) + NORM_EPS); }
        if (MODE == 2) {
#pragma unroll
            for (int j = 0; j < 8; ++j) { const f32x4 gg = ggv[j];
#pragma unroll
                for (int rr = 0; rr < 2; ++rr) ((GAS f32x4*)((float*)xd + (size_t)(row + rr) * D) + lane)[64 * j] = v[rr][j] * rstd[rr] * gg; }
        } else {
#pragma unroll
            for (int j = 0; j < 8; ++j) { const f32x4 gg = ggv[j] * (scv[j] + 1.0f), ss = ssv[j];
#pragma unroll
                for (int rr = 0; rr < 2; ++rr) { const f32x4 hh = v[rr][j] * rstd[rr] * gg + ss;
#if PROJ_F8
                    ((GAS unsigned*)((unsigned char*)hout + (size_t)(row + rr) * D) + lane)[64 * j] = pk_fp8x4_ns(hh[0], hh[1], hh[2], hh[3]);
#else
                    u32x2 w; w.x = pk2(hh[0], hh[1]); w.y = pk2(hh[2], hh[3]); ((GAS u32x2*)(hout + (size_t)(row + rr) * D) + lane)[64 * j] = w;
#endif
                } }
        }
    }
}

__device__ __forceinline__ float reduce16(const float (&p)[NE], int lane) {
    float q[8], r[4], s2[2];
    const bool h5 = (lane & 32) != 0, h4 = (lane & 16) != 0, h3 = (lane & 8) != 0, h2 = (lane & 4) != 0;
#pragma unroll
    for (int i = 0; i < 8; ++i) q[i] = (h5 ? p[i + 8] : p[i]) + sx<32>(h5 ? p[i] : p[i + 8], lane);
#pragma unroll
    for (int i = 0; i < 4; ++i) r[i] = (h4 ? q[i + 4] : q[i]) + sx<16>(h4 ? q[i] : q[i + 4], lane);
#pragma unroll
    for (int i = 0; i < 2; ++i) s2[i] = (h3 ? r[i + 2] : r[i]) + sx<8>(h3 ? r[i] : r[i + 2], lane);
    float t = (h2 ? s2[1] : s2[0]) + sx<4>(h2 ? s2[0] : s2[1], lane);
    t += sx<2>(t, lane); t += sx<1>(t, lane);
    return t;
}
__device__ __forceinline__ void route_token(float affl, float sell, int& i0, int& i1, float& w0, float& w1) {
    float aff[NE], sel[NE];
#pragma unroll
    for (int e = 0; e < NE; ++e) { aff[e] = __builtin_bit_cast(float, __builtin_amdgcn_readlane(__builtin_bit_cast(int, affl), 4 * e)); sel[e] = __builtin_bit_cast(float, __builtin_amdgcn_readlane(__builtin_bit_cast(int, sell), 4 * e)); }
    float gs[4];
#pragma unroll
    for (int g = 0; g < 4; ++g) { const float a = sel[4 * g], b = sel[4 * g + 1], c = sel[4 * g + 2], d = sel[4 * g + 3];
        const float h1 = fmaxf(a, b), l1 = fminf(a, b), h2 = fmaxf(c, d), l2 = fminf(c, d);
        gs[g] = fmaxf(h1, h2) + fmaxf(fminf(h1, h2), fmaxf(l1, l2)); }
    int bg = 0; float best = gs[0];
#pragma unroll
    for (int g = 1; g < 4; ++g) { const bool c = gs[g] > best; best = c ? gs[g] : best; bg = c ? g : bg; }
    float s0 = -3.0e38f, s1 = -3.0e38f, a0 = 0.f, a1 = 0.f; int j0 = 0, j1 = 0;
#pragma unroll
    for (int j = 0; j < 4; ++j) {
        const float v = bg == 0 ? sel[j] : (bg == 1 ? sel[4 + j] : (bg == 2 ? sel[8 + j] : sel[12 + j]));
        const float af = bg == 0 ? aff[j] : (bg == 1 ? aff[4 + j] : (bg == 2 ? aff[8 + j] : aff[12 + j]));
        const bool gt0 = v > s0, gt1 = v > s1;
        s1 = gt0 ? s0 : (gt1 ? v : s1); j1 = gt0 ? j0 : (gt1 ? j : j1); a1 = gt0 ? a0 : (gt1 ? af : a1);
        s0 = gt0 ? v : s0; j0 = gt0 ? j : j0; a0 = gt0 ? af : a0; }
    i0 = 4 * bg + j0; i1 = 4 * bg + j1;
    const float inv = 1.0f / (a0 + a1); w0 = a0 * inv; w1 = a1 * inv;
}
__device__ __forceinline__ void router_phase(const bf16_t* xs, bf16_t* hout, const float* gain, const float* ada_scale, const float* ada_shift, const float* w_router, const float* b_router,
                                             unsigned* cnt, int* rlist, int* tslot, float* tw, LAS unsigned char* lds, int vcu, int G, int tid, int wave, int lane) {
    LAS float* wrT = (LAS float*)lds;
    LAS int* misc = (LAS int*)(lds + MISC_OFF + 64);
    LAS int* lcnt = misc; LAS int* lbase = misc + 16; LAS int* rinfo = misc + 32;
    for (int c = tid; c < D; c += NTHREADS) {
        const f32x4 w0 = *(const f32x4*)(w_router + c * 16), w1 = *(const f32x4*)(w_router + c * 16 + 4), w2 = *(const f32x4*)(w_router + c * 16 + 8), w3 = *(const f32x4*)(w_router + c * 16 + 12);
#pragma unroll
        for (int e = 0; e < 4; ++e) { wrT[e * D + c] = w0[e]; wrT[(4 + e) * D + c] = w1[e]; wrT[(8 + e) * D + c] = w2[e]; wrT[(12 + e) * D + c] = w3[e]; } }
    const int rows_per_blk = T / G;
    for (int base = vcu * rows_per_blk; base < T; base += G * rows_per_blk) {
        if (tid < 16) lcnt[tid] = 0;
        __syncthreads();
        const int rpw = rows_per_blk / NWAVES;
        for (int k = 0; k < rpw; k += 2) {
            const int lr = wave * rpw + k, row = base + lr, b = row >> 11;
            f32x4 v[2][8]; float rstd[2];
#pragma unroll
            for (int rr = 0; rr < 2; ++rr) { const GAS u32x2* xr = (const GAS u32x2*)(xs + (size_t)(row + rr) * D) + lane;
#pragma unroll
                for (int j = 0; j < 8; ++j) { const u32x2 r = xr[64 * j]; v[rr][j] = (f32x4){bflo(r.x), bfhi(r.x), bflo(r.y), bfhi(r.y)}; } }
            f32x4 ggv[8], ssv[8];
            { const GAS f32x4* sc = (const GAS f32x4*)(ada_scale + (size_t)b * 12288) + lane; const GAS f32x4* sh = (const GAS f32x4*)(ada_shift + (size_t)b * 12288) + lane;
#pragma unroll
              for (int j = 0; j < 8; ++j) { ggv[j] = sc[64 * j]; ssv[j] = sh[64 * j]; }
              asm volatile("" ::: "memory"); }
#pragma unroll
            for (int rr = 0; rr < 2; ++rr) { float s = 0.f;
#pragma unroll
                for (int j = 0; j < 8; ++j) s += (v[rr][j][0] * v[rr][j][0] + v[rr][j][1] * v[rr][j][1]) + (v[rr][j][2] * v[rr][j][2] + v[rr][j][3] * v[rr][j][3]);
                rstd[rr] = 1.0f / sqrtf(wave_sum(s, lane) * (1.0f / D) + NORM_EPS); }
#pragma unroll
            for (int jb = 0; jb < 8; jb += 4) {
#pragma unroll
                for (int jj = 0; jj < 4; ++jj) { const int j = jb + jj; const f32x4 gg = ggv[j], ss = ssv[j];
#pragma unroll
                    for (int rr = 0; rr < 2; ++rr) { v[rr][j] = v[rr][j] * rstd[rr] * gg + ss;
                        ((GAS unsigned*)((unsigned char*)hout + (size_t)(row + rr) * D) + lane)[64 * j] = pk_fp8x4_ns(v[rr][j][0], v[rr][j][1], v[rr][j][2], v[rr][j][3]); } }
                asm volatile("" ::: "memory"); }
            float p0[NE], p1[NE];
            f32x4 wA[8], wB[8];
#define RT_RD(W, e) do { _Pragma("unroll") for (int j = 0; j < 8; ++j) W[j] = *(const LAS f32x4*)(wrT + (e) * D + 4 * lane + 256 * j); asm volatile("" ::: "memory"); } while (0)
#define RT_FMA(W, e) do { f32x2 a0 = {0.f, 0.f}, a1 = {0.f, 0.f}; _Pragma("unroll") for (int j = 0; j < 8; ++j) { LPIN(W[j]); const f32x2 wl = {W[j][0], W[j][1]}, wh = {W[j][2], W[j][3]}; \
                a0 = __builtin_elementwise_fma((f32x2){v[0][j][0], v[0][j][1]}, wl, a0); a0 = __builtin_elementwise_fma((f32x2){v[0][j][2], v[0][j][3]}, wh, a0); \
                a1 = __builtin_elementwise_fma((f32x2){v[1][j][0], v[1][j][1]}, wl, a1); a1 = __builtin_elementwise_fma((f32x2){v[1][j][2], v[1][j][3]}, wh, a1); } \
                p0[e] = a0[0] + a0[1]; p1[e] = a1[0] + a1[1]; } while (0)
            RT_RD(wA, 0);
#pragma unroll
            for (int e = 0; e < NE; e += 2) { RT_RD(wB, e + 1); RT_FMA(wA, e); if (e + 2 < NE) RT_RD(wA, e + 2); RT_FMA(wB, e + 1); }
#undef RT_RD
#undef RT_FMA
            const float t0 = reduce16(p0, lane), t1 = reduce16(p1, lane);
            const float bre = b_router[lane >> 2];
#pragma unroll
            for (int rr = 0; rr < 2; ++rr) {
                const float affl = sigmoidf_(rr ? t1 : t0), sell = affl + bre;
                int i0, i1; float w0, w1; route_token(affl, sell, i0, i1, w0, w1);
                if (lane == 0) { const int r0 = atomicAdd((int*)lcnt + i0, 1), r1 = atomicAdd((int*)lcnt + i1, 1);
                    rinfo[(lr + rr) * 4 + 0] = (i0 << 16) | r0; rinfo[(lr + rr) * 4 + 1] = (i1 << 16) | r1;
                    tw[(row + rr) * 2] = w0; tw[(row + rr) * 2 + 1] = w1; } }
        }
        __syncthreads();
        if (tid < 16) lbase[tid] = (int)__hip_atomic_fetch_add(cnt + 64 * tid, (unsigned)lcnt[tid], RLX_AGENT);
        __syncthreads();
        if (tid < rows_per_blk * 2) { const int lr = tid >> 1, kk = tid & 1, info = rinfo[lr * 4 + kk], e = info >> 16, rank = lbase[e] + (info & 0xffff);
            rlist[(size_t)e * T + rank] = base + lr; tslot[(base + lr) * 2 + kk] = (e << 16) | rank; }
        __syncthreads();
    }
}

__device__ __forceinline__ int swz256(int row, int ch) { return 256 * row + 16 * (ch ^ (((row & 3) << 2) | ((row >> 2) & 3))); }
typedef short v4i16_t __attribute__((ext_vector_type(4)));
__device__ __forceinline__ s16x4 vtr(const LAS unsigned char* p) { return __builtin_bit_cast(s16x4, __builtin_amdgcn_ds_read_tr16_b64_v4i16((LAS v4i16_t*)p)); }

struct AttnPre { u32x4 kv[8]; bf16x8 qf[4]; };
__device__ __forceinline__ void attn_issue(AttnPre& R, const bf16_t* proj, int a, int tid, int wave, int lane) {
    const int sub = a & 15, bh = a >> 4, head = bh % 12, b = bh / 12, g = head >> 2;
    const int dsh = 2 * g, nbsh = 4 - 2 * g;
    const int nblk = sub & ((1 << nbsh) - 1), r = sub >> nbsh;
    const size_t tb = (size_t)b * SEQ;
    const int p0 = 128 * (nblk - 1);
#pragma unroll
    for (int it = 0; it < 8; ++it) { const int id = tid + NTHREADS * it, row = id >> 4, ch = id & 15, p = p0 + row;
        const int pc = p < 0 ? 0 : p;
        const size_t t = tb + ((size_t)pc << dsh) + r; R.kv[it] = *(const u32x4*)(proj + t * NP + KA + head * 128 + ch * 8); }
    const int fr = lane & 15, fq = lane >> 4, qi = 16 * wave + fr;
    const size_t tq = tb + ((size_t)(128 * nblk + qi) << dsh) + r;
    const bf16_t* qsrc = proj + tq * NP + QA + head * 128 + fq * 8;
#pragma unroll
    for (int ks = 0; ks < 4; ++ks) R.qf[ks] = *(const bf16x8*)(qsrc + 32 * ks);
}
__device__ __forceinline__ void attn_unit(LAS unsigned char* lds, AttnPre& R, const bf16_t* proj, bf16_t* atto, float* lse, int a, int a_next, int tid, int wave, int lane) {
    const int sub = a & 15, bh = a >> 4, head = bh % 12, b = bh / 12, g = head >> 2, hj = head & 3;
    const int dsh = 2 * g, nbsh = 4 - 2 * g;
    const int nblk = sub & ((1 << nbsh) - 1), r = sub >> nbsh;
    const size_t tb = (size_t)b * SEQ;
    const int p0 = 128 * (nblk - 1);
    LAS unsigned char* Kl = lds; LAS unsigned char* Vl = lds + 65536;
#pragma unroll
    for (int it = 0; it < 8; ++it) { const int id = tid + NTHREADS * it, row = id >> 4, ch = id & 15; *(LAS u32x4*)(Kl + swz256(row, ch)) = R.kv[it]; }
    u32x4 vv[8];
#pragma unroll
    for (int it = 0; it < 8; ++it) { const int id = tid + NTHREADS * it, row = id >> 4, ch = id & 15, p = p0 + row;
        const int pc = p < 0 ? 0 : p;
        const size_t t = tb + ((size_t)pc << dsh) + r; vv[it] = *(const u32x4*)(proj + t * NP + VA + head * 128 + ch * 8); }
    const int fr = lane & 15, fq = lane >> 4;
    const int qi = 16 * wave + fr;
    const size_t tq = tb + ((size_t)(128 * nblk + qi) << dsh) + r;
    bf16x8 qf[4];
#pragma unroll
    for (int ks = 0; ks < 4; ++ks) qf[ks] = R.qf[ks];
    __syncthreads();
    f32x4 sacc[9];
    unsigned kbase[4];
    { const int fK = ((fr & 3) << 2) | ((fr >> 2) & 3);
#pragma unroll
        for (int ks = 0; ks < 4; ++ks) kbase[ks] = (unsigned)(256 * (16 * wave + fr) + 16 * ((4 * ks + fq) ^ fK)); }
#pragma unroll
    for (int kt = 0; kt < 9; ++kt) { f32x4 acc = (f32x4){0.f, 0.f, 0.f, 0.f};
#pragma unroll
        for (int ks = 0; ks < 4; ++ks) { const bf16x8 kf = *(const LAS bf16x8*)(Kl + kbase[ks] + 4096 * kt); acc = __builtin_amdgcn_mfma_f32_16x16x32_bf16(kf, qf[ks], acc, 0, 0, 0); }
        sacc[kt] = acc; }
    const float sc = 0.12751743082459868f;
    float mx = -3.0e38f;
#pragma unroll
    for (int kt = 0; kt < 9; ++kt)
#pragma unroll
        for (int rg = 0; rg < 4; ++rg) { const int jk = 16 * (wave + kt) + 4 * fq + rg; const bool valid = (jk >= qi) && (jk <= qi + 128) && (p0 + jk >= 0);
            const float s = valid ? sacc[kt][rg] * sc : -3.0e38f; sacc[kt][rg] = s; mx = fmaxf(mx, s); }
    mx = fmaxf(mx, sx<16>(mx, lane)); mx = fmaxf(mx, sx<32>(mx, lane));
    float sum = 0.f;
#pragma unroll
    for (int kt = 0; kt < 9; ++kt)
#pragma unroll
        for (int rg = 0; rg < 4; ++rg) { const float p = __builtin_amdgcn_exp2f(sacc[kt][rg] - mx); sacc[kt][rg] = p; sum += p; }
    sum += sx<16>(sum, lane); sum += sx<32>(sum, lane);
#pragma unroll
    for (int it = 0; it < 8; ++it) { const int id = tid + NTHREADS * it, row = id >> 4, ch = id & 15; *(LAS u32x4*)(Vl + swz256(row, ch)) = vv[it]; }
    __syncthreads();
    if (a_next >= 0) attn_issue(R, proj, a_next, tid, wave, lane);
    f32x4 oacc[8];
#pragma unroll
    for (int dt = 0; dt < 8; ++dt) oacc[dt] = (f32x4){0.f, 0.f, 0.f, 0.f};
    const int li = lane & 15, qq = li >> 2, pp = li & 3;
    unsigned vbase[8];
    { const int fV = (qq << 2) | fq;
#pragma unroll
        for (int dt = 0; dt < 8; ++dt) vbase[dt] = (unsigned)(256 * (16 * wave + 4 * fq + qq) + 16 * ((2 * dt + (pp >> 1)) ^ fV) + 8 * (pp & 1)); }
#pragma unroll
    for (int s5 = 0; s5 < 5; ++s5) {
        const int t0 = 2 * s5, t1 = (2 * s5 + 1 < 9) ? 2 * s5 + 1 : 2 * s5;
        u32x4 pw; pw.x = pk2(sacc[t0][0], sacc[t0][1]); pw.y = pk2(sacc[t0][2], sacc[t0][3]);
        if (2 * s5 + 1 < 9) { pw.z = pk2(sacc[t1][0], sacc[t1][1]); pw.w = pk2(sacc[t1][2], sacc[t1][3]); } else { pw.z = 0u; pw.w = 0u; }
        const bf16x8 pf = __builtin_bit_cast(bf16x8, pw);
#pragma unroll
        for (int dt = 0; dt < 8; ++dt) {
            const s16x4 v0 = vtr(Vl + vbase[dt] + 4096 * t0);
            const s16x4 v1 = vtr(Vl + vbase[dt] + 4096 * t1);
            bf16x8 vf; vf[0] = v0[0]; vf[1] = v0[1]; vf[2] = v0[2]; vf[3] = v0[3]; vf[4] = v1[0]; vf[5] = v1[1]; vf[6] = v1[2]; vf[7] = v1[3];
            oacc[dt] = __builtin_amdgcn_mfma_f32_16x16x32_bf16(vf, pf, oacc[dt], 0, 0, 0);
        }
    }
    const float inv = 1.0f / sum;
    bf16_t* op = atto + ((size_t)g * T + tq) * 512 + hj * 128 + 4 * fq;
#pragma unroll
    for (int dt = 0; dt < 8; ++dt) { u32x2 w; w.x = pk2(oacc[dt][0] * inv, oacc[dt][1] * inv); w.y = pk2(oacc[dt][2] * inv, oacc[dt][3] * inv); *(u32x2*)(op + 16 * dt) = w; }
    if (fq == 0) lse[((size_t)g * T + tq) * 4 + hj] = mx * 0.6931471805599453f + __logf(sum);
    __syncthreads();
}

__device__ __forceinline__ int swz512(int row, int ch) { return 512 * row + 16 * (ch ^ (((row & 3) << 2) | ((row >> 2) & 3))); }

struct GlaPre { float al0, al1; u32x4 q[2], k[2], v[4]; };
__device__ __forceinline__ void gla_local_issue(GlaPre& R, const bf16_t* proj, const float* alow, int u, int tid) {
    const int n = u & 31, h = (u >> 5) & 3, b = u >> 7;
    const size_t t0 = (size_t)b * SEQ + 64 * n;
    R.al0 = alow[t0 * 16 + tid]; R.al1 = alow[t0 * 16 + 512 + tid];
#pragma unroll
    for (int it = 0; it < 2; ++it) { const int id = tid + NTHREADS * it, row = id >> 4, ch = id & 15; const bf16_t* src = proj + (t0 + row) * NP + h * 128 + ch * 8; R.q[it] = *(const u32x4*)(src + QB); R.k[it] = *(const u32x4*)(src + KB); }
#pragma unroll
    for (int it = 0; it < 4; ++it) { const int id = tid + NTHREADS * it, row = id >> 5, ch = id & 31; R.v[it] = *(const u32x4*)(proj + (t0 + row) * NP + VB + h * 256 + ch * 8); }
}
__device__ __forceinline__ void gla_local_unit(LAS unsigned char* lds, GlaPre& R, const bf16_t* proj, const float* alow, const float (&w2)[16], const float bias,
                                               bf16_t* qdg, bf16_t* oig, bf16_t* dstg, float* decg, int u, int u_next, int tid, int wave, int lane) {
    const int n = u & 31, h = (u >> 5) & 3, b = u >> 7;
    const int d = tid & 127, ig = tid >> 7;
    const int fr = lane & 15, fq = lane >> 4;
    LAS unsigned char* QD = lds; LAS unsigned char* KI = lds + 17408; LAS unsigned char* KET = lds + 34816; LAS unsigned char* VL = lds + 53248;
    LAS unsigned char* AT = lds + 86016;
    LAS float* CS = (LAS float*)(lds + 95232); LAS float* ALs = (LAS float*)(lds + 97280);
    const size_t t0 = (size_t)b * SEQ + 64 * n;
#pragma unroll
    for (int it = 0; it < 2; ++it) { const int id = tid + NTHREADS * it, row = id >> 4, ch = id & 15; *(LAS u32x4*)(QD + row * 272 + ch * 16) = R.q[it]; *(LAS u32x4*)(KI + row * 272 + ch * 16) = R.k[it]; }
    ALs[tid] = R.al0; ALs[512 + tid] = R.al1;
#pragma unroll
    for (int it = 0; it < 4; ++it) { const int id = tid + NTHREADS * it, row = id >> 5, ch = id & 31; *(LAS u32x4*)(VL + swz512(row, ch)) = R.v[it]; }
    __syncthreads();
    if (u_next >= 0) gla_local_issue(R, proj, alow, u_next, tid);
    float bl[16]; float run = 0.f;
#pragma unroll
    for (int ii = 0; ii < 16; ++ii) { float z = bias; const LAS f32x4* ap = (const LAS f32x4*)(ALs + (16 * ig + ii) * 16);
#pragma unroll
        for (int r4 = 0; r4 < 4; ++r4) { const f32x4 av = ap[r4]; z = fmaf(av[0], w2[4 * r4], z); z = fmaf(av[1], w2[4 * r4 + 1], z); z = fmaf(av[2], w2[4 * r4 + 2], z); z = fmaf(av[3], w2[4 * r4 + 3], z); }
        const float la = (fminf(z, 0.f) - __logf(1.0f + __expf(-fabsf(z)))) * 0.0625f; run += la; bl[ii] = run; }
    CS[ig * 128 + d] = run;
    __syncthreads();
    float pre = 0.f, tot = 0.f;
#pragma unroll
    for (int g2 = 0; g2 < 4; ++g2) { const float cv = CS[g2 * 128 + d]; tot += cv; pre += (g2 < ig) ? cv : 0.f; }
    const float qscale = 0.08838834764831845f; const float etot = __expf(tot);
    unsigned ke[8];
#pragma unroll
    for (int ii = 0; ii < 16; ++ii) { const float bb = pre + bl[ii];
        LAS bf16_t* qp = (LAS bf16_t*)(QD + (16 * ig + ii) * 272 + 2 * d); LAS bf16_t* kp = (LAS bf16_t*)(KI + (16 * ig + ii) * 272 + 2 * d);
        const float qf_ = bf2f(*qp), kf_ = bf2f(*kp);
        const float eb = __expf(bb), einv = __builtin_amdgcn_rcpf(eb);
        const float qd = qf_ * qscale * eb, ki = kf_ * einv, kend = kf_ * (etot * einv);
        *qp = (bf16_t)f2bf(qd); *kp = (bf16_t)f2bf(ki);
        if (ii & 1) ke[ii >> 1] |= f2bf(kend) << 16; else ke[ii >> 1] = f2bf(kend); }
    *(LAS u32x4*)(KET + d * 144 + 32 * ig) = (u32x4){ke[0], ke[1], ke[2], ke[3]}; *(LAS u32x4*)(KET + d * 144 + 32 * ig + 16) = (u32x4){ke[4], ke[5], ke[6], ke[7]};
    if (ig == 0) decg[(size_t)u * 128 + d] = etot;
    __syncthreads();
#pragma unroll
    for (int it = 0; it < 2; ++it) { const int id = tid + NTHREADS * it, row = id >> 4, ch = id & 15; *(u32x4*)(qdg + ((size_t)(b * 4 + h) * 32 + n) * 8192 + (size_t)((((row >> 4) * 4 + (ch >> 2)) * 64 + (row & 15) * 4 + (ch & 3)) * 8)) = *(const LAS u32x4*)(QD + row * 272 + ch * 16); }
#pragma unroll
    for (int x = 0; x < 2; ++x) { const int id = 2 * wave + x, ti = id >> 2, tj = id & 3; f32x4 acc = (f32x4){0.f, 0.f, 0.f, 0.f};
        if (tj <= ti) {
#pragma unroll
            for (int ks = 0; ks < 4; ++ks) { const bf16x8 af = *(const LAS bf16x8*)(QD + (16 * ti + fr) * 272 + (32 * ks + 8 * fq) * 2); const bf16x8 bfr = *(const LAS bf16x8*)(KI + (16 * tj + fr) * 272 + (32 * ks + 8 * fq) * 2);
                acc = __builtin_amdgcn_mfma_f32_16x16x32_bf16(af, bfr, acc, 0, 0, 0); } }
#pragma unroll
        for (int rg = 0; rg < 4; ++rg) { const int i = 16 * ti + 4 * fq + rg, j = 16 * tj + fr; const float vv = (i >= j) ? acc[rg] : 0.f; *(LAS bf16_t*)(AT + i * 144 + 2 * j) = (bf16_t)f2bf(vv); } }
    bf16x8 vfr[2][2];
    { const int li = lane & 15, qq = li >> 2, pp = li & 3;
#pragma unroll
        for (int tv = 0; tv < 2; ++tv)
#pragma unroll
            for (int ks = 0; ks < 2; ++ks) { const int vt = 2 * wave + tv;
                const int r0 = 32 * ks + 8 * fq + qq, r1 = r0 + 4;
                const s16x4 a0 = vtr(VL + swz512(r0, 2 * vt + (pp >> 1)) + 8 * (pp & 1)), a1 = vtr(VL + swz512(r1, 2 * vt + (pp >> 1)) + 8 * (pp & 1));
                bf16x8 f; f[0] = a0[0]; f[1] = a0[1]; f[2] = a0[2]; f[3] = a0[3]; f[4] = a1[0]; f[5] = a1[1]; f[6] = a1[2]; f[7] = a1[3]; vfr[tv][ks] = f; } }
#pragma unroll
    for (int dt = 0; dt < 8; ++dt) {
        bf16x8 kf[2];
#pragma unroll
        for (int ks = 0; ks < 2; ++ks) kf[ks] = *(const LAS bf16x8*)(KET + (16 * dt + fr) * 144 + (32 * ks + 8 * fq) * 2);
#pragma unroll
        for (int tv = 0; tv < 2; ++tv) { f32x4 acc = (f32x4){0.f, 0.f, 0.f, 0.f};
#pragma unroll
            for (int ks = 0; ks < 2; ++ks) acc = __builtin_amdgcn_mfma_f32_16x16x32_bf16(kf[ks], vfr[tv][ks], acc, 0, 0, 0);
            u32x2 w; w.x = pk2(acc[0], acc[1]); w.y = pk2(acc[2], acc[3]);
            *(u32x2*)(dstg + (((size_t)(b * 4 + h) * 8 + wave) * 32 + n) * 4096 + (size_t)(((dt * 2 + tv) * 64 + fr * 4 + fq) * 4)) = w; } }
    __syncthreads();
#pragma unroll
    for (int ti = 0; ti < 4; ++ti) {
        bf16x8 af[2];
#pragma unroll
        for (int ks = 0; ks < 2; ++ks) af[ks] = *(const LAS bf16x8*)(AT + (16 * ti + fr) * 144 + (32 * ks + 8 * fq) * 2);
#pragma unroll
        for (int tv = 0; tv < 2; ++tv) { f32x4 acc = (f32x4){0.f, 0.f, 0.f, 0.f};
#pragma unroll
            for (int ks = 0; ks < 2; ++ks) acc = __builtin_amdgcn_mfma_f32_16x16x32_bf16(vfr[tv][ks], af[ks], acc, 0, 0, 0);
            u32x2 w; w.x = pk2(acc[0], acc[1]); w.y = pk2(acc[2], acc[3]);
            *(u32x2*)(oig + (((size_t)(b * 4 + h) * 8 + wave) * 32 + n) * 2048 + (size_t)(((ti * 2 + tv) * 64 + fr * 4 + fq) * 4)) = w; } }
    __syncthreads();
}

template <bool FAKE>
__device__ __forceinline__ void gla_scan_unit(LAS unsigned char* lds, const bf16_t* qdg, const bf16_t* oig, const bf16_t* dstg, const float* decg, bf16_t* ob, float* ssq,
                                              int u, int tid, int wave, int lane) {
    const int vs = u & 7, h = (u >> 3) & 3, b = u >> 5;
    const int fr = lane & 15, fq = lane >> 4;
    const int ti = wave >> 1, tv = wave & 1;
    LAS unsigned char* STb = lds;
    LAS unsigned char* OBL = lds + 20480;
    LAS float* SQL = (LAS float*)(lds + 53248);
    f32x4 sst[2]; sst[0] = (f32x4){0.f, 0.f, 0.f, 0.f}; sst[1] = sst[0];
    { unsigned z0 = 0u; asm volatile("" : "+v"(z0)); *(LAS u32x4*)(STb + tid * 16) = (u32x4){z0, z0, z0, z0}; if (tid < 32) *(LAS u32x4*)(STb + 8192 + tid * 16) = (u32x4){z0, z0, z0, z0}; }
    const int ub = (b * 4 + h) * 32;
    struct StepOps { bf16x8 q[4]; u32x2 o; u32x2 ds[2]; f32x4 dc; };
    const unsigned qoff = (unsigned)((ti * 4 * 64 + fr * 4 + fq) * 16), ooff = (unsigned)(((ti * 2 + tv) * 64 + fr * 4 + fq) * 8);
    const unsigned dsoff = (unsigned)(((wave * 2) * 64 + fr * 4 + fq) * 8), dcoff = (unsigned)(16 * wave + 4 * fq) * 4u;
    const char* qbase = (const char*)(qdg + (size_t)(b * 4 + h) * SEQ * 128);
    const char* obase = (const char*)(oig + ((size_t)(b * 4 + h) * 8 + vs) * SEQ * 32);
    const char* dsbase = (const char*)(dstg + ((size_t)(b * 4 + h) * 8 + vs) * 32 * 32 * 128);
    const char* dcbase = (const char*)(decg + (size_t)ub * 128);
#define GLA_LOAD(R, nn_) do { const int nn = FAKE ? 0 : ((nn_) < 32 ? (nn_) : 31); \
        const char* qs_ = qbase + (size_t)nn * 16384; _Pragma("unroll") for (int ks = 0; ks < 4; ++ks) R.q[ks] = *(const bf16x8*)(qs_ + qoff + 1024 * ks); \
        R.o = *(const u32x2*)(obase + (size_t)nn * 4096 + ooff); \
        _Pragma("unroll") for (int t2 = 0; t2 < 2; ++t2) R.ds[t2] = *(const u32x2*)(dsbase + (size_t)nn * 8192 + 512 * t2 + dsoff); \
        R.dc = *(const f32x4*)(dcbase + (size_t)nn * 512 + dcoff); } while (0)
#define GLA_STEP(R, n_) do { const int n = (n_); const size_t t0 = (size_t)b * SEQ + 64 * n; \
        LAS unsigned char* STc = STb + (n & 1) * 8704; LAS unsigned char* STn = STb + ((n + 1) & 1) * 8704; \
        f32x4 acc; acc[0] = bflo(R.o.x); acc[1] = bfhi(R.o.x); acc[2] = bflo(R.o.y); acc[3] = bfhi(R.o.y); \
        _Pragma("unroll") for (int ks = 0; ks < 4; ++ks) { const bf16x8 sfr = *(const LAS bf16x8*)(STc + (16 * tv + fr) * 272 + (32 * ks + 8 * fq) * 2); acc = __builtin_amdgcn_mfma_f32_16x16x32_bf16(sfr, R.q[ks], acc, 0, 0, 0); } \
        { u32x2 w; w.x = pk2(acc[0], acc[1]); w.y = pk2(acc[2], acc[3]);              \
            *(LAS u32x2*)(OBL + (n & 7) * 4096 + (16 * ti + fr) * 64 + (16 * tv + 4 * fq) * 2) = w; \
            float q2 = (acc[0] * acc[0] + acc[1] * acc[1]) + (acc[2] * acc[2] + acc[3] * acc[3]); q2 += sx<16>(q2, lane); q2 += sx<32>(q2, lane); \
            if (fq == 0) SQL[(n & 7) * 128 + (16 * ti + fr) * 2 + tv] = q2; } \
        _Pragma("unroll") for (int t2 = 0; t2 < 2; ++t2) { \
            sst[t2][0] = sst[t2][0] * R.dc[0] + bflo(R.ds[t2].x); sst[t2][1] = sst[t2][1] * R.dc[1] + bfhi(R.ds[t2].x); \
            sst[t2][2] = sst[t2][2] * R.dc[2] + bflo(R.ds[t2].y); sst[t2][3] = sst[t2][3] * R.dc[3] + bfhi(R.ds[t2].y); \
            u32x2 w; w.x = pk2(sst[t2][0], sst[t2][1]); w.y = pk2(sst[t2][2], sst[t2][3]); \
            *(LAS u32x2*)(STn + (16 * t2 + fr) * 272 + (16 * wave + 4 * fq) * 2) = w; } \
        __syncthreads(); \
        if (!FAKE && (n & 7) == 7) { const size_t tf = (size_t)b * SEQ + 64 * (n - 7); \
            _Pragma("unroll") for (int it = 0; it < 4; ++it) { const int id = tid + NTHREADS * it, sf = id >> 8, row = (id >> 2) & 63, c = id & 3; \
                *(u32x4*)(ob + (tf + 64 * sf + row) * 1024 + h * 256 + 32 * vs + 8 * c) = *(const LAS u32x4*)(OBL + id * 16); } \
            _Pragma("unroll") for (int it = 0; it < 2; ++it) { const int id = tid + NTHREADS * it, sf = id >> 7, row = (id >> 1) & 63, tq = id & 1; \
                ssq[((tf + 64 * sf + row) * 4 + h) * 16 + vs * 2 + tq] = SQL[id]; } \
            __syncthreads(); } } while (0)
    StepOps r0, r1, r2, r3;
    GLA_LOAD(r0, 0); GLA_LOAD(r1, 1); GLA_LOAD(r2, 2);
    __syncthreads();
    for (int n4 = 0; n4 < 32; n4 += 4) {
        GLA_LOAD(r3, n4 + 3); GLA_STEP(r0, n4);
        GLA_LOAD(r0, n4 + 4); GLA_STEP(r1, n4 + 1);
        GLA_LOAD(r1, n4 + 5); GLA_STEP(r2, n4 + 2);
        GLA_LOAD(r2, n4 + 6); GLA_STEP(r3, n4 + 3);
    }
#undef GLA_STEP
#undef GLA_LOAD
}

__device__ __forceinline__ void merge_phase(const bf16_t* atto, const float* lse, const bf16_t* ob, const float* ssq, const bf16_t* proj, const float* gla_gain, bf16_t* ya, bf16_t* yb,
                                            int vcu, int G, int wave, int lane) {
    const int gw = vcu * NWAVES + wave, NGW = G * NWAVES;
    const int hj = lane >> 4;
    f32x4 g0[2], g1[2];
#pragma unroll
    for (int c = 0; c < 2; ++c) { const int col = 8 * lane + 512 * c; g0[c] = *(const f32x4*)(gla_gain + col); g1[c] = *(const f32x4*)(gla_gain + col + 4); }
    for (int row0 = 2 * gw; row0 < T; row0 += 2 * NGW) {
        float l0[2], l1[2], l2[2]; u32x4 a0[2], a1[2], a2[2], o[2][2], rr_[2][2]; f32x4 sq[2][2][4];
#pragma unroll
        for (int r = 0; r < 2; ++r) { const int row = row0 + r;
            l0[r] = lse[((size_t)0 * T + row) * 4 + hj]; l1[r] = lse[((size_t)1 * T + row) * 4 + hj]; l2[r] = lse[((size_t)2 * T + row) * 4 + hj];
            a0[r] = *(const u32x4*)(atto + ((size_t)0 * T + row) * 512 + 8 * lane); a1[r] = *(const u32x4*)(atto + ((size_t)1 * T + row) * 512 + 8 * lane); a2[r] = *(const u32x4*)(atto + ((size_t)2 * T + row) * 512 + 8 * lane);
#pragma unroll
            for (int c = 0; c < 2; ++c) { const int col = 8 * lane + 512 * c, hh = col >> 8;
                const f32x4* sp = (const f32x4*)(ssq + ((size_t)row * 4 + hh) * 16); sq[r][c][0] = sp[0]; sq[r][c][1] = sp[1]; sq[r][c][2] = sp[2]; sq[r][c][3] = sp[3];
                o[r][c] = *(const u32x4*)(ob + (size_t)row * 1024 + col);
#if GATE_F8
                { const u32x2 r8 = *(const u32x2*)((const unsigned char*)proj + (size_t)row * NP * 2 + G8_BYTE0 + col); rr_[r][c] = (u32x4){r8.x, r8.y, 0u, 0u}; }
#else
                rr_[r][c] = *(const u32x4*)(proj + (size_t)row * NP + RB + col);
#endif
            } }
#pragma unroll
        for (int r = 0; r < 2; ++r) { const int row = row0 + r;
            const float m = fmaxf(l0[r], fmaxf(l1[r], l2[r])); float e0 = __expf(l0[r] - m), e1 = __expf(l1[r] - m), e2 = __expf(l2[r] - m); const float inv = 1.0f / (e0 + e1 + e2); e0 *= inv; e1 *= inv; e2 *= inv;
            u32x4 w;
            w.x = pk2(e0 * bflo(a0[r].x) + e1 * bflo(a1[r].x) + e2 * bflo(a2[r].x), e0 * bfhi(a0[r].x) + e1 * bfhi(a1[r].x) + e2 * bfhi(a2[r].x));
            w.y = pk2(e0 * bflo(a0[r].y) + e1 * bflo(a1[r].y) + e2 * bflo(a2[r].y), e0 * bfhi(a0[r].y) + e1 * bfhi(a1[r].y) + e2 * bfhi(a2[r].y));
            w.z = pk2(e0 * bflo(a0[r].z) + e1 * bflo(a1[r].z) + e2 * bflo(a2[r].z), e0 * bfhi(a0[r].z) + e1 * bfhi(a1[r].z) + e2 * bfhi(a2[r].z));
            w.w = pk2(e0 * bflo(a0[r].w) + e1 * bflo(a1[r].w) + e2 * bflo(a2[r].w), e0 * bfhi(a0[r].w) + e1 * bfhi(a1[r].w) + e2 * bfhi(a2[r].w));
#if MIX_F8
            { u32x2 w8; w8.x = pk_fp8x4(bflo(w.x), bfhi(w.x), bflo(w.y), bfhi(w.y)); w8.y = pk_fp8x4(bflo(w.z), bfhi(w.z), bflo(w.w), bfhi(w.w)); *(u32x2*)((unsigned char*)ya + (BR_FUSE ? (size_t)row * 1536 + 1024 : (size_t)row * 512) + 8 * lane) = w8; }
#else
            *(u32x4*)(ya + (size_t)row * 512 + 8 * lane) = w;
#endif
#pragma unroll
            for (int c = 0; c < 2; ++c) { const int col = 8 * lane + 512 * c;
                const f32x4 s0 = sq[r][c][0], s1 = sq[r][c][1], s2 = sq[r][c][2], s3 = sq[r][c][3];
                const float tot = ((s0[0] + s0[1]) + (s0[2] + s0[3])) + ((s1[0] + s1[1]) + (s1[2] + s1[3])) + ((s2[0] + s2[1]) + (s2[2] + s2[3])) + ((s3[0] + s3[1]) + (s3[2] + s3[3]));
                const float rstd = 1.0f / sqrtf(tot * (1.0f / 256.0f) + NORM_EPS);
                const u32x4 ov = o[r][c], rv = rr_[r][c]; u32x4 y; float rf[8];
#if GATE_F8
                unpack_fp8x8((u32x2){rv.x, rv.y}, rf);
#else
                rf[0] = bflo(rv.x); rf[1] = bfhi(rv.x); rf[2] = bflo(rv.y); rf[3] = bfhi(rv.y); rf[4] = bflo(rv.z); rf[5] = bfhi(rv.z); rf[6] = bflo(rv.w); rf[7] = bfhi(rv.w);
#endif
                y.x = pk2(bflo(ov.x) * rstd * g0[c][0] * siluf_(rf[0]), bfhi(ov.x) * rstd * g0[c][1] * siluf_(rf[1]));
                y.y = pk2(bflo(ov.y) * rstd * g0[c][2] * siluf_(rf[2]), bfhi(ov.y) * rstd * g0[c][3] * siluf_(rf[3]));
                y.z = pk2(bflo(ov.z) * rstd * g1[c][0] * siluf_(rf[4]), bfhi(ov.z) * rstd * g1[c][1] * siluf_(rf[5]));
                y.w = pk2(bflo(ov.w) * rstd * g1[c][2] * siluf_(rf[6]), bfhi(ov.w) * rstd * g1[c][3] * siluf_(rf[7]));
#if MIX_F8
                { u32x2 y8; y8.x = pk_fp8x4(bflo(y.x), bfhi(y.x), bflo(y.y), bfhi(y.y)); y8.y = pk_fp8x4(bflo(y.z), bfhi(y.z), bflo(y.w), bfhi(y.w)); *(u32x2*)((unsigned char*)(BR_FUSE ? ya : yb) + (size_t)row * (BR_FUSE ? 1536 : 1024) + col) = y8; }
#else
                *(u32x4*)(yb + (size_t)row * 1024 + col) = y;
#endif
            } }
    }
}

constexpr int LS = 10;
__host__ __device__ constexpr int phase_kind(int k) { return k == 0 ? 0 : (k == 1 + DEPTH * LS ? LS + 1 : ((k - 1) % LS) + 1); }
constexpr int N_PHASES = 2 + DEPTH * LS;
typedef const __attribute__((address_space(4))) Args CArgs;
__device__ __forceinline__ CArgs* fresh_args() {
    unsigned long long v = (unsigned long long)__builtin_amdgcn_kernarg_segment_ptr();
    unsigned lo = (unsigned)v, hi = (unsigned)(v >> 32);
    asm volatile("" : "+s"(lo), "+s"(hi));
    lo = __builtin_amdgcn_readfirstlane(lo); hi = __builtin_amdgcn_readfirstlane(hi);
    return (CArgs*)(((unsigned long long)hi << 32) | lo);
}
template <unsigned MASK, bool ONE>
__global__ void __launch_bounds__(NTHREADS, 2) fwd_kernel(Args a_unused) {
    extern __shared__ __attribute__((aligned(16))) unsigned char lds_raw[];
    LAS unsigned char* lds = (LAS unsigned char*)lds_raw;
    const int wave0 = __builtin_amdgcn_readfirstlane((int)threadIdx.x >> 6);
    int lane = (int)__builtin_amdgcn_mbcnt_hi(~0u, __builtin_amdgcn_mbcnt_lo(~0u, 0u)), wave = wave0, tid = wave0 * 64 + lane;
    CArgs* ap = fresh_args();
    unsigned char* ws = ap->ws;
#define a (*ap)
#define FRESH_TID() do { ap = fresh_args(); ws = ap->ws; unsigned m1_ = ~0u; asm volatile("" : "+s"(m1_)); lane = (int)__builtin_amdgcn_mbcnt_hi(m1_, __builtin_amdgcn_mbcnt_lo(m1_, 0u)); asm volatile("" : "+v"(lane)); wave = wave0; tid = wave0 * 64 + lane; } while (0)
    const int G = gridDim.x; const int bx = blockIdx.x; const int vcu = (G % 8 == 0) ? (bx % 8) * (G / 8) + bx / 8 : bx;
    volatile LAS unsigned* MISC = (volatile LAS unsigned*)(lds + MISC_OFF);
    for (int u = tid; u < (LDS_BYTES - MISC_OFF) / 4; u += NTHREADS) ((LAS unsigned*)(lds + MISC_OFF))[u] = 0u;
    __syncthreads();
    if (ONE) (void)xcd_barrier_post((unsigned*)(ws + WS_CTL) + CW_BAR, MISC + 8);
    const int lo = ONE ? 0 : a.ph_lo, hi = ONE ? N_PHASES : a.ph_hi;
#define IN(k, kind) (((MASK >> (kind)) & 1u) && (ONE || (lo <= (k) && (k) < hi)))
#if defined(PROBE_EPI) && !defined(PROBE_MASK)
#endif
#ifdef PROBE_MASK
#define PB_ON(k) ((PROBE_MASK >> phase_kind(k)) & 1u)
#define PB_START(k) do { if (PB_ON(k) && threadIdx.x == 0) *(volatile LAS unsigned long long*)(lds + MISC_OFF + 8192) = __builtin_amdgcn_s_memrealtime(); } while (0)
#define PB_END(k) do { if (PB_ON(k) && threadIdx.x == 0) { volatile LAS unsigned long long* pb_ = (volatile LAS unsigned long long*)(lds + MISC_OFF + 8192); pb_[1] = pb_[1] + (__builtin_amdgcn_s_memrealtime() - pb_[0]); } } while (0)
#else
#define PB_START(k) do { } while (0)
#define PB_END(k) do { } while (0)
#endif
#define SEAM(k) do { if (ONE) { XcdBarrier bar_; bar_.bar = (unsigned*)(((CArgs*)fresh_args())->ws + WS_CTL) + CW_BAR; bar_.x = xb_xcc_id(); bar_.st = (volatile LAS unsigned*)(lds + MISC_OFF) + 8; xcd_barrier(bar_); } } while (0)

#define ada ((float*)(ws + WS_ADA))
#define ropec ((const float*)(ws + WS_ROPE))
#define ropes (((const float*)(ws + WS_ROPE)) + SEQ * 64)
#define alow ((float*)(ws + WS_ALOW))
#define lse ((float*)(ws + WS_LSE))
#define ssq ((float*)(ws + WS_SSQ))
#define rlist ((int*)(ws + WS_RLIST))
#define tslot ((int*)(ws + WS_TSLOT))
#define tw ((float*)(ws + WS_TW))
#define hbuf ((bf16_t*)(ws + WS_H))
#define ya ((bf16_t*)(ws + WS_YA))
#define yb ((bf16_t*)(ws + WS_YB))
#define mrg ((bf16_t*)(ws + WS_MRG))
#define atto ((bf16_t*)(ws + WS_ATTO))
#define obuf ((bf16_t*)(ws + WS_OB))
#define proj ((bf16_t*)(ws + WS_PROJ))
#define act ((bf16_t*)(ws + WS_ACT))
#define Y ((bf16_t*)(ws + WS_Y))
#define ctl ((unsigned*)(ws + WS_CTL))
#define xb_ ((bf16_t*)(ws + WS_XB))
#define qdb_ ((bf16_t*)(ws + WS_QD))
#define oib_ ((bf16_t*)(ws + WS_OI))
#define dstb_ ((bf16_t*)(ws + WS_DST))
#define decb_ ((float*)(ws + WS_DEC))

    PB_START(0);
    if (IN(0, 0)) { FRESH_TID(); prologue_phase(ap, lds, vcu, G, tid, wave, lane); }
#ifdef PROBE_DUP_PRO
    __syncthreads(); if (IN(0, 0)) { FRESH_TID(); prologue_phase(ap, lds, vcu, G, tid, wave, lane, PROBE_DUP_PRO); }
#endif
    SEAM(0); PB_END(0);

    for (int l = 0; l < DEPTH; ++l) {
        const int P = 1 + LS * l;
#define adal (ada + (size_t)l * NB * 12288)
#define cntl (ctl + CW_CNT + l * 1024)
#define cntp (ctl + CW_CNT + (l > 0 ? (l - 1) * 1024 : 0))
#define xsrc ((l == 0) ? a.x : a.out)
        PB_START(P);
        if (IN(P, 1)) { FRESH_TID();
            if (l == 0) norm_phase<0>(xsrc, nullptr, hbuf, a.norm_mix, adal + 2048, adal, nullptr, nullptr, nullptr, nullptr, nullptr, vcu, G, wave, lane);
            else norm_phase<1>(xb_, xb_, hbuf, a.norm_mix + (size_t)l * D, adal + 2048, adal, ada + (size_t)(l - 1) * NB * 12288 + 10240, Y, tslot, tw, cntp, vcu, G, wave, lane);
        }
        SEAM(P); PB_END(P); PB_START(P + 1);
        if (IN(P + 1, 2)) { FRESH_TID();
#if PROJ_F8
            pg8::StaticOrder S{T / 256, NP / 256, G, bx}; pg8::RowsContig AM; pg8::EpiProj E{proj, ropec, ropes, alow, pg8::W8_INV};
            pg8::gemm_phase<pg8::EpiProj, pg8::StaticOrder, pg8::RowsContig, true, true>(lds, tid, hbuf, (const bf16_t*)(ws + WS_WIN + (size_t)l * NP * D), 0, D / 2, S, AM, E);
#else
            pg8::StaticOrder S{T / 256, NP / 256, G, bx}; pg8::RowsContig AM; pg8::EpiProj E{proj, ropec, ropes, alow, 1.0f};
            pg8::gemm_phase<pg8::EpiProj, pg8::StaticOrder, pg8::RowsContig, true>(lds, tid, hbuf, (const bf16_t*)(ws + WS_WIN) + (size_t)l * NP * D, 0, D, S, AM, E);
#endif
        }
        SEAM(P + 1); PB_END(P + 1); PB_START(P + 2);
        if (IN(P + 2, 3)) { FRESH_TID();
            {
                const int hw = (vcu >> 5) & 3, dw = tid & 127; float w2[16];
#pragma unroll
                for (int r = 0; r < 16; ++r) w2[r] = (a.w_alpha2 + (size_t)l * 16 * 512)[r * 512 + hw * 128 + dw];
                const float bias = (a.b_alpha2 + (size_t)l * 512)[hw * 128 + dw];
                for (int u = vcu; u < NB * 4 * 32; u += G) { GlaPre R; gla_local_issue(R, proj, alow, u, tid);
                    gla_local_unit(lds, R, proj, alow, w2, bias, qdb_, oib_, dstb_, decb_, u, -1, tid, wave, lane); } }
            FRESH_TID();
            for (int u = vcu; u < NB * 12 * 16; u += G) { AttnPre R; attn_issue(R, proj, u, tid, wave, lane); attn_unit(lds, R, proj, atto, lse, u, -1, tid, wave, lane); }
#ifdef PROBE_DUP_ATTN
            for (int u = vcu; u < NB * 12 * 16; u += G) { AttnPre R; attn_issue(R, proj, u, tid, wave, lane); attn_unit(lds, R, proj, atto, lse, u, -1, tid, wave, lane); }
#endif
        }
        SEAM(P + 2); PB_END(P + 2); PB_START(P + 3);
        if (IN(P + 3, 4)) { FRESH_TID();
            for (int u = vcu; u < 256; u += G) gla_scan_unit<false>(lds, qdb_, oib_, dstb_, decb_, obuf, ssq, u, tid, wave, lane);
#ifdef PROBE_FAKESCAN
            __syncthreads(); for (int u = vcu; u < 256; u += G) gla_scan_unit<true>(lds, qdb_, oib_, dstb_, decb_, obuf, ssq, u, tid, wave, lane);
#endif
        }
        SEAM(P + 3); PB_END(P + 3); PB_START(P + 4);
        if (IN(P + 4, 5)) { FRESH_TID(); merge_phase(atto, lse, obuf, ssq, proj, a.gla_gain + (size_t)l * 1024, ya, yb, vcu, G, wave, lane); }
        SEAM(P + 4); PB_END(P + 4); PB_START(P + 5);
        if (IN(P + 5, 6)) { FRESH_TID();
#if BR_FUSE
            { pg8::SegOrder S2{T / 256, D / 256, G, bx}; pg8::RowsContig AM2; pg8::EpiGate2 E{proj, pg8::W8_INV, ws + WS_MRG8};
              pg8::gemm_phase<pg8::EpiGate2, pg8::SegOrder, pg8::RowsContig, true, true, true>(lds, tid, ya, (const bf16_t*)(ws + WS_WOA + (size_t)l * D * 1536), 0, 768, S2, AM2, E); }
#else
            pg8::StaticOrder S{T / 256, D / 256, G, bx}; pg8::RowsContig AM;
#if MIX_F8
            { pg8::EpiGate<true> E{mrg, proj, GA, pg8::W8_INV, nullptr}; pg8::gemm_phase<pg8::EpiGate<true>, pg8::StaticOrder, pg8::RowsContig, true, true>(lds, tid, ya, (const bf16_t*)(ws + WS_WOA + (size_t)l * D * 512), 0, 256, S, AM, E); }
#else
            { pg8::EpiGate<true> E{mrg, proj, GA, 1.0f, nullptr}; pg8::gemm_phase<pg8::EpiGate<true>, pg8::StaticOrder, pg8::RowsContig, true>(lds, tid, ya, (const bf16_t*)(ws + WS_WOA) + (size_t)l * D * 512, 0, 512, S, AM, E); }
#endif
            FRESH_TID();
#if MIX_F8
            { pg8::EpiGate<false> E{mrg, proj, GB, pg8::W8_INV, ws + WS_MRG8}; pg8::gemm_phase<pg8::EpiGate<false>, pg8::StaticOrder, pg8::RowsContig, true, true>(lds, tid, yb, (const bf16_t*)(ws + WS_WOB + (size_t)l * D * 1024), 0, 512, S, AM, E); }
#else
            { pg8::EpiGate<false> E{mrg, proj, GB, 1.0f, nullptr}; pg8::gemm_phase<pg8::EpiGate<false>, pg8::StaticOrder, pg8::RowsContig, true>(lds, tid, yb, (const bf16_t*)(ws + WS_WOB) + (size_t)l * D * 1024, 0, 1024, S, AM, E); }
#endif
#endif
        }
        SEAM(P + 5); PB_END(P + 5); PB_START(P + 6);
        if (IN(P + 6, 7)) { FRESH_TID();
            pg8::StaticOrder S{T / 256, D / 256, G, bx}; pg8::RowsContig AM;
#if MIX_F8
            if (l == 0) { pg8::EpiResid<true> E{a.x, xb_, adal + 4096, pg8::W8_INV}; pg8::gemm_phase<pg8::EpiResid<true>, pg8::StaticOrder, pg8::RowsContig, true, true>(lds, tid, (const bf16_t*)(ws + WS_MRG8), (const bf16_t*)(ws + WS_WO + (size_t)l * D * D), 0, D / 2, S, AM, E); }
            else { pg8::EpiResid<false> E{xb_, xb_, adal + 4096, pg8::W8_INV}; pg8::gemm_phase<pg8::EpiResid<false>, pg8::StaticOrder, pg8::RowsContig, true, true>(lds, tid, (const bf16_t*)(ws + WS_MRG8), (const bf16_t*)(ws + WS_WO + (size_t)l * D * D), 0, D / 2, S, AM, E); }
#else
            if (l == 0) { pg8::EpiResid<true> E{a.x, xb_, adal + 4096, 1.0f}; pg8::gemm_phase<pg8::EpiResid<true>, pg8::StaticOrder, pg8::RowsContig, true>(lds, tid, mrg, (const bf16_t*)(ws + WS_WO) + (size_t)l * D * D, 0, D, S, AM, E); }
            else { pg8::EpiResid<false> E{xb_, xb_, adal + 4096, 1.0f}; pg8::gemm_phase<pg8::EpiResid<false>, pg8::StaticOrder, pg8::RowsContig, true>(lds, tid, mrg, (const bf16_t*)(ws + WS_WO) + (size_t)l * D * D, 0, D, S, AM, E); }
#endif
        }
        SEAM(P + 6); PB_END(P + 6); PB_START(P + 7);
        if (IN(P + 7, 8)) { FRESH_TID(); router_phase(xb_, hbuf, a.norm_ffn + (size_t)l * D, adal + 8192, adal + 6144, a.w_router, a.b_router, cntl, rlist, tslot, tw, lds, vcu, G, tid, wave, lane); }
        SEAM(P + 7); PB_END(P + 7); PB_START(P + 8);
        if (IN(P + 8, 9)) { FRESH_TID();
            pg8::moe_table_build(lds, cntl, tid);
            pg8::MoeOrder S; S.init(lds, 8, G, bx); pg8::RowsGather AM{rlist, lds}; pg8::EpiSwiGLU8 E{(unsigned char*)act};
            pg8::gemm_phase<pg8::EpiSwiGLU8, pg8::MoeOrder, pg8::RowsGather, true, true>(lds, tid, hbuf, (const bf16_t*)(ws + WS_WGU + (size_t)l * NE * 2048 * D), (size_t)2048 * D / 2, D / 2, S, AM, E);
        }
        SEAM(P + 8); PB_END(P + 8); PB_START(P + 9);
        if (IN(P + 9, 10)) { FRESH_TID();
            pg8::moe_table_build(lds, cntl, tid);
            pg8::MoeOrder S; S.init(lds, 8, G, bx); pg8::RowsContig AM; pg8::EpiPlainS E{Y, pg8::W8_INV};
            pg8::gemm_phase<pg8::EpiPlainS, pg8::MoeOrder, pg8::RowsContig, true, true>(lds, tid, act, (const bf16_t*)(ws + WS_WDN + (size_t)l * NE * D * FF), (size_t)D * FF / 2, FF / 2, S, AM, E);
        }
        SEAM(P + 9); PB_END(P + 9);
    }
    PB_START(1 + DEPTH * LS);
    if (IN(1 + DEPTH * LS, LS + 1)) { FRESH_TID(); norm_phase<2>(xb_, a.out, nullptr, a.final_norm, nullptr, nullptr, ada + (size_t)(DEPTH - 1) * NB * 12288 + 10240, Y, tslot, tw, ctl + CW_CNT + (DEPTH - 1) * 1024, vcu, G, wave, lane); }
#ifdef PROBE_MASK
    __syncthreads(); PB_END(1 + DEPTH * LS);
    if (threadIdx.x == 0) { const unsigned long long t0_ = __builtin_amdgcn_s_memrealtime(), d_ = ((volatile LAS unsigned long long*)(lds + MISC_OFF + 8192))[1];
        while (__builtin_amdgcn_s_memrealtime() - t0_ < d_) __builtin_amdgcn_s_sleep(8); }
    __syncthreads();
#endif
#undef a
#undef IN
#undef SEAM
}

template <unsigned MASK, bool ONE>
static void launch_one(const Args& a, int grid, hipStream_t stream) {
    static bool attr_done = false;
    if (!attr_done) { (void)hipFuncSetAttribute((const void*)fwd_kernel<MASK, ONE>, hipFuncAttributeMaxDynamicSharedMemorySize, LDS_BYTES); attr_done = true; }
    hipLaunchKernelGGL((fwd_kernel<MASK, ONE>), dim3(grid), dim3(NTHREADS), LDS_BYTES, stream, a);
}
extern "C" void kernel_launch(void* const* d_in, const int* in_sizes, int n_in, void* d_out, int out_size, void* d_ws, size_t ws_size, hipStream_t stream) {
    static int grid = 0;
    if (grid == 0) {
        if (n_in != 19 || out_size != T * D || ws_size < WS_END) { fprintf(stderr, "kernel_launch: unexpected shapes (n_in %d, out %d, ws %zu < %zu); nothing launched\n", n_in, out_size, ws_size, (size_t)WS_END); grid = -1; return; }
        int dev = 0, cus = 0;
        if (hipGetDevice(&dev) != hipSuccess || hipDeviceGetAttribute(&cus, hipDeviceAttributeMultiprocessorCount, dev) != hipSuccess) { grid = -1; return; }
        grid = cus;
        if (grid != 256) fprintf(stderr, "kernel_launch: note: %d CUs (built for 256)\n", grid);
    }
    if (grid < 0) return;
    (void)hipMemsetAsync((char*)d_ws + WS_CTL, 0, CTL_ZERO_BYTES, stream);
    Args a{};
    a.x = (const float*)d_in[0]; a.c = (const float*)d_in[1]; a.w_ada = (const float*)d_in[2]; a.b_ada = (const float*)d_in[3]; a.norm_mix = (const float*)d_in[4]; a.norm_ffn = (const float*)d_in[5];
    a.w_in = (const float*)d_in[6]; a.w_alpha2 = (const float*)d_in[7]; a.b_alpha2 = (const float*)d_in[8]; a.gla_gain = (const float*)d_in[9]; a.w_out_a = (const float*)d_in[10];
    a.w_out_b = (const float*)d_in[11]; a.w_out = (const float*)d_in[12]; a.w_router = (const float*)d_in[13]; a.b_router = (const float*)d_in[14]; a.w_gate_e = (const float*)d_in[15];
    a.w_up_e = (const float*)d_in[16]; a.w_down_e = (const float*)d_in[17]; a.final_norm = (const float*)d_in[18];
    a.out = (float*)d_out; a.ws = (unsigned char*)d_ws;
#if MK_PER_PHASE
    for (int p = 0; p < N_PHASES; ++p) { a.ph_lo = p; a.ph_hi = p + 1;
        const int kind = phase_kind(p);
        switch (kind) {
            case 0: launch_one<1u << 0, false>(a, grid, stream); break; case 1: launch_one<1u << 1, false>(a, grid, stream); break;
            case 2: launch_one<1u << 2, false>(a, grid, stream); break; case 3: launch_one<1u << 3, false>(a, grid, stream); break;
            case 4: launch_one<1u << 4, false>(a, grid, stream); break; case 5: launch_one<1u << 5, false>(a, grid, stream); break;
            case 6: launch_one<1u << 6, false>(a, grid, stream); break; case 7: launch_one<1u << 7, false>(a, grid, stream); break;
            case 8: launch_one<1u << 8, false>(a, grid, stream); break; case 9: launch_one<1u << 9, false>(a, grid, stream); break;
            case 10: launch_one<1u << 10, false>(a, grid, stream); break;
            default: launch_one<1u << 11, false>(a, grid, stream); break; } }
#else
    a.ph_lo = 0; a.ph_hi = N_PHASES; launch_one<0xFFFFFu, true>(a, grid, stream);
#endif
    const hipError_t le = hipPeekAtLastError();
    if (le != hipSuccess) fprintf(stderr, "kernel_launch: launch failed: %s\n", hipGetErrorName(le));
}
```

```cpp
#include <hip/hip_runtime.h>
#include <cstdio>
#include <cstdint>

#ifndef PROJ_F8
#define PROJ_F8 1
#endif
#ifndef MIX_F8
#define MIX_F8 1
#endif
#ifndef GATE_F8
#define GATE_F8 1
#endif
#ifndef Y_F8
#define Y_F8 1
#endif
#ifndef BR_FUSE
#define BR_FUSE 1
#endif
#ifndef MK_PER_PHASE
#define MK_PER_PHASE 0
#endif

#define LAS __attribute__((address_space(3)))
#define GAS __attribute__((address_space(1)))
typedef unsigned short bf16_t;
typedef short bf16x8 __attribute__((ext_vector_type(8)));
typedef short s16x4 __attribute__((ext_vector_type(4)));
typedef float f32x4 __attribute__((ext_vector_type(4)));
typedef float f32x2 __attribute__((ext_vector_type(2)));
typedef unsigned u32x4 __attribute__((ext_vector_type(4)));
typedef unsigned u32x2 __attribute__((ext_vector_type(2)));
typedef GAS unsigned gu32;

constexpr int NB = 8, SEQ = 2048, T = NB * SEQ, D = 2048, DEPTH = 2;
constexpr int NIN = 11792;
constexpr int NP = 12032;
constexpr int QA = 0, KA = 1536, VA = 3072, QB = 4608, KB = 5120, VB = 5632, RB = 6656, GA = 7680, GB = 9728, AL = 11776;
constexpr int NE = 16, FF = 1024;
constexpr int MAXTILES = 144, MAXROWS = MAXTILES * 256;
constexpr float NORM_EPS = 1e-6f;
constexpr int NWAVES = 8, NTHREADS = 512;

constexpr size_t MiB = 1u << 20;
constexpr size_t WS_CTL = 0, CTL_ZERO_BYTES = 80 * 1024;
constexpr size_t WS_ADA = 1 * MiB;
constexpr size_t WS_ROPE = 2 * MiB;
constexpr size_t WS_ALOW = 3 * MiB;
constexpr size_t WS_LSE = 4 * MiB;
constexpr size_t WS_SSQ = 5 * MiB;
constexpr size_t WS_RLIST = 9 * MiB;
constexpr size_t WS_TSLOT = 10 * MiB;
constexpr size_t WS_TW = 10 * MiB + 512 * 1024;
constexpr size_t WS_WIN = 12 * MiB;
constexpr size_t WS_MRG8 = 60 * MiB;
constexpr size_t WS_WOA = 106 * MiB;
constexpr size_t WS_WOB = 110 * MiB;
constexpr size_t WS_WO = 118 * MiB;
constexpr size_t WS_WGU = 134 * MiB;
constexpr size_t WS_XB = 262 * MiB;
constexpr size_t WS_WDN = 390 * MiB;
constexpr size_t WS_H = 518 * MiB;
constexpr size_t WS_YA = 582 * MiB;
constexpr size_t WS_YB = 598 * MiB;
constexpr size_t WS_MRG = 630 * MiB;
constexpr size_t WS_ATTO = 694 * MiB;
constexpr size_t WS_OB = 742 * MiB;
constexpr size_t WS_PROJ = 774 * MiB;
constexpr size_t WS_ACT = WS_PROJ;
constexpr size_t WS_Y = WS_PROJ + 72 * MiB;
constexpr size_t WS_QD = 1150 * MiB;
constexpr size_t WS_OI = 1166 * MiB;
constexpr size_t WS_DST = 1198 * MiB;
constexpr size_t WS_DEC = 1262 * MiB;
constexpr size_t WS_END = 1263 * MiB;
constexpr int CW_BAR = 4096;
constexpr int CW_CNT = 16384;

constexpr int RING_BYTES = 131072;
constexpr int MISC_OFF = 135168;
constexpr int LDS_BYTES = 151552;

#define LDS_WAIT() asm volatile("s_waitcnt lgkmcnt(0)" ::: "memory")
#define VM_WAIT() asm volatile("s_waitcnt vmcnt(0)" ::: "memory")
#define RLX_AGENT __ATOMIC_RELAXED, __HIP_MEMORY_SCOPE_AGENT
__device__ __forceinline__ unsigned f2bf(float f) { unsigned u = __builtin_bit_cast(unsigned, f); return (u + 0x7fffu + ((u >> 16) & 1u)) >> 16; }
typedef float f32x2_t __attribute__((ext_vector_type(2)));
typedef __bf16 bf16x2_t __attribute__((ext_vector_type(2)));
__device__ __forceinline__ unsigned pk2(float lo, float hi) { const f32x2_t v = {lo, hi}; const bf16x2_t b = __builtin_convertvector(v, bf16x2_t); return __builtin_bit_cast(unsigned, b); }
__device__ __forceinline__ float sat8(float x) { return __builtin_amdgcn_fmed3f(x, -448.0f, 448.0f); }
__device__ __forceinline__ unsigned pk_fp8x4(float a, float b, float c, float d) { int p = __builtin_amdgcn_cvt_pk_fp8_f32(sat8(a), sat8(b), 0, false); p = __builtin_amdgcn_cvt_pk_fp8_f32(sat8(c), sat8(d), p, true); return (unsigned)p; }
constexpr int G8_BYTE0 = RB * 2;
__device__ __forceinline__ void unpack_fp8x8(u32x2 v, float (&f)[8]) { const f32x2_t a = __builtin_amdgcn_cvt_pk_f32_fp8((int)v.x, false), b = __builtin_amdgcn_cvt_pk_f32_fp8((int)v.x, true), c = __builtin_amdgcn_cvt_pk_f32_fp8((int)v.y, false), d = __builtin_amdgcn_cvt_pk_f32_fp8((int)v.y, true);
    f[0] = a[0]; f[1] = a[1]; f[2] = b[0]; f[3] = b[1]; f[4] = c[0]; f[5] = c[1]; f[6] = d[0]; f[7] = d[1]; }
__device__ __forceinline__ unsigned pk_fp8x4_ns(float a, float b, float c, float d) { int p = __builtin_amdgcn_cvt_pk_fp8_f32(a, b, 0, false); p = __builtin_amdgcn_cvt_pk_fp8_f32(c, d, p, true); return (unsigned)p; }
__device__ __forceinline__ float bflo(unsigned u) { return __builtin_bit_cast(float, u << 16); }
__device__ __forceinline__ float bfhi(unsigned u) { return __builtin_bit_cast(float, u & 0xffff0000u); }
__device__ __forceinline__ float bf2f(bf16_t h) { return __builtin_bit_cast(float, (unsigned)h << 16); }
template <int M> __device__ __forceinline__ float sx(float v, int lane) {
    if constexpr (M < 32) return __builtin_bit_cast(float, __builtin_amdgcn_ds_swizzle(__builtin_bit_cast(int, v), (M << 10) | 0x1F));
    else return __builtin_bit_cast(float, __builtin_amdgcn_ds_bpermute((lane ^ 32) << 2, __builtin_bit_cast(int, v)));
}
__device__ __forceinline__ float wave_sum(float v, int lane) {
    v += sx<1>(v, lane); v += sx<2>(v, lane); v += sx<4>(v, lane); v += sx<8>(v, lane); v += sx<16>(v, lane); v += sx<32>(v, lane);
    return v;
}
__device__ __forceinline__ float sigmoidf_(float x) { return __builtin_amdgcn_rcpf(1.0f + __expf(-x)); }
__device__ __forceinline__ float siluf_(float x) { return x * __builtin_amdgcn_rcpf(1.0f + __expf(-x)); }

#define XB_TMO      128
#define XB_XCNT(j)  (256  + 64 * (j))
#define XB_XSUB(j)  (1280 + 64 * (j))
#define XB_XGEN(j)  (2304 + 64 * (j))
#define XB_TOP      3328
#define XB_TOPGEN   3392
#define XCD_BAR_WORDS 3456
#define XB_SPIN_CAP (1u << 18)
__device__ __forceinline__ unsigned xb_ld(unsigned* p)              { return __hip_atomic_load(p, __ATOMIC_RELAXED, __HIP_MEMORY_SCOPE_AGENT); }
__device__ __forceinline__ unsigned xb_add(unsigned* p, unsigned v) { return __hip_atomic_fetch_add(p, v, __ATOMIC_RELAXED, __HIP_MEMORY_SCOPE_AGENT); }
__device__ __forceinline__ unsigned xb_xcc_id() { return (unsigned)__builtin_amdgcn_s_getreg((3 << 11) | 20) & 0xFu; }
#define XB_SPIN(cond, bar) do { unsigned _sp = 0; while (cond) { __builtin_amdgcn_s_sleep(1); \
    if ((++_sp & 255u) == 0u) { if (xb_ld(&(bar)[XB_TMO])) break; if (_sp > XB_SPIN_CAP) { atomicAdd(&(bar)[XB_TMO], 1u); break; } } } } while (0)
struct XcdBarrier { unsigned* bar; unsigned x; volatile LAS unsigned* st; };
__device__ __forceinline__ XcdBarrier xcd_barrier_post(unsigned* bar, volatile LAS unsigned* st) {
    XcdBarrier b; b.bar = bar; b.x = xb_xcc_id(); b.st = st;
    if (threadIdx.x == 0) (void)xb_add(&bar[XB_XCNT(b.x)], 1u);
    return b;
}
__device__ __forceinline__ void xcd_barrier_complete(unsigned* bar, unsigned x, unsigned& nloc, unsigned& nx) {
    const unsigned G = gridDim.x * gridDim.y * gridDim.z;
    unsigned sum, cnt, mine, sp = 0u;
    for (;;) {
        sum = 0u; cnt = 0u; mine = 0u;
#pragma unroll
        for (unsigned j = 0; j < 16; ++j) { const unsigned c = xb_ld(&bar[XB_XCNT(j)]); sum += c; cnt += (c > 0u) ? 1u : 0u; mine = (j == x) ? c : mine; }
        if (sum == G) break;
        __builtin_amdgcn_s_sleep(1);
        if ((++sp & 255u) == 0u) { if (xb_ld(&bar[XB_TMO])) break; if (sp > XB_SPIN_CAP) { atomicAdd(&bar[XB_TMO], 1u); break; } }
    }
    nloc = mine > 0u ? mine : 1u; nx = cnt > 0u ? cnt : 1u;
}
__device__ __forceinline__ void xcd_barrier(const XcdBarrier& b) {
    asm volatile("s_waitcnt vmcnt(0)" ::: "memory");
    __syncthreads();
    if (threadIdx.x == 0) {
        unsigned* bar = b.bar;
        __builtin_amdgcn_s_waitcnt(0);
        unsigned nloc = b.st[0], nx = b.st[1];
        if (nloc == 0u) { xcd_barrier_complete(bar, b.x, nloc, nx); b.st[0] = nloc; b.st[1] = nx; }
        const unsigned old = xb_add(&bar[XB_XSUB(b.x)], 1u);
        const unsigned gen = old / nloc;
        if (old + 1u == (gen + 1u) * nloc) {
            __builtin_amdgcn_fence(__ATOMIC_RELEASE, "agent");
            asm volatile("s_waitcnt vmcnt(0)" ::: "memory");
            const unsigned og = xb_add(&bar[XB_TOP], 1u);
            const unsigned tg = og / nx;
            if (og + 1u == (tg + 1u) * nx) xb_add(&bar[XB_TOPGEN], 1u);
            else XB_SPIN(xb_ld(&bar[XB_TOPGEN]) == tg, bar);
            __builtin_amdgcn_fence(__ATOMIC_ACQUIRE, "agent");
            xb_add(&bar[XB_XGEN(b.x)], 1u);
            asm volatile("s_waitcnt vmcnt(0)" ::: "memory");
        } else {
            XB_SPIN(xb_ld(&bar[XB_XGEN(b.x)]) == gen, bar);
            __builtin_amdgcn_fence(__ATOMIC_ACQUIRE, "agent");
            asm volatile("s_waitcnt vmcnt(0)" ::: "memory");
        }
    }
    __syncthreads();
}

namespace pg8 {
constexpr int BM = 256, BK = 64, HALF = 128, HTB = HALF * BK * 2, NXCD = 8, WGM = 3;
__device__ __forceinline__ int lds_byte(int r, int c) { const int st = (r >> 4) * 2 + (c >> 5), rr = r & 15, cc = c & 31, ob = rr * 64 + cc * 2; return st * 1024 + (ob ^ (((ob >> 9) & 1) << 5)); }
__device__ __forceinline__ void stage_rc(int b, int& R, int& C) { const int st = b / 1024, sb = b % 1024, swz = sb ^ (((sb >> 9) & 1) << 5); R = (st >> 1) * 16 + swz / 64; C = (st & 1) * 32 + (swz % 64) / 2; }
__device__ __forceinline__ int perm32(int rho) { const int n = rho >> 4, i = rho & 15; return 8 * (i >> 2) + 4 * n + (i & 3); }

struct Unit { int pm, pn, e, ti; };

__device__ __forceinline__ bool grid_order(int nM, int nN, int G, int c, int i, int& pm, int& pn) {
    const int nwg = nM * nN; const long L = (long)i * G + c; if (L >= nwg) return false;
    int wgid = (int)L; { const int q = nwg / NXCD, r = nwg % NXCD, xcd = wgid % NXCD, off = wgid / NXCD; wgid = (xcd < r ? xcd * (q + 1) : r * (q + 1) + (xcd - r) * q) + off; }
    const int nig = WGM * nN, gid = wgid / nig, fm = gid * WGM, gsz = (nM - fm) < WGM ? (nM - fm) : WGM;
    pm = fm + ((wgid % nig) % gsz); pn = (wgid % nig) / gsz; return true;
}
struct StaticOrder {
    int nM, nN, G, c;
    __device__ __forceinline__ bool next(int i, Unit& u) const { u.e = 0; u.ti = 0; return grid_order(nM, nN, G, c, i, u.pm, u.pn); }
};
struct SegOrder {
    int nM, nN, G, c;
    __device__ __forceinline__ bool next(int i, Unit& u) const { u.e = i & 1; u.ti = 0; return grid_order(nM, nN, G, c, i >> 1, u.pm, u.pn); }
};
constexpr int MOE_TAB_OFF = MISC_OFF + 4096;
__device__ __forceinline__ void moe_table_build(LAS unsigned char* lds, const unsigned* cnt, int tid) {
    if (tid < NE) { const int n = (int)__hip_atomic_load(cnt + 64 * tid, RLX_AGENT); ((LAS int*)(lds + MOE_TAB_OFF))[16 + tid] = n; }
    __syncthreads();
    if (tid == 0) { int acc = 0; for (int e = 0; e < NE; ++e) { acc += (((LAS int*)(lds + MOE_TAB_OFF))[16 + e] + 255) >> 8; ((LAS int*)(lds + MOE_TAB_OFF))[e] = acc; } }
    __syncthreads();
}
typedef int i32x4 __attribute__((ext_vector_type(4)));
struct MoeOrder {
    LAS unsigned char* lds; int NT, nN, G, c;
    __device__ __forceinline__ void init(LAS unsigned char* lds_, int nN_, int G_, int c_) {
        lds = lds_; NT = __builtin_amdgcn_readfirstlane(((LAS int*)(lds + MOE_TAB_OFF))[15]); nN = nN_; G = G_; c = c_; }
    __device__ __forceinline__ bool next(int i, Unit& u) const {
        if (!grid_order(NT, nN, G, c, i, u.pm, u.pn)) return false;
        int e = 0, ts = 0;
#pragma unroll
        for (int q = 0; q < 4; ++q) { const i32x4 t = ((const LAS i32x4*)(lds + MOE_TAB_OFF))[q];
#pragma unroll
            for (int j = 0; j < 4; ++j) { const bool ge = u.pm >= t[j]; e += ge ? 1 : 0; ts = ge ? t[j] : ts; } }
        u.e = __builtin_amdgcn_readfirstlane(e); u.ti = u.pm - __builtin_amdgcn_readfirstlane(ts); return true;
    }
};
struct RowsContig { static constexpr bool GATHER = false; __device__ __forceinline__ unsigned row(const Unit& u, int rr) const { return (unsigned)(u.pm * 256 + rr); } };
struct RowsGather {
    static constexpr bool GATHER = true;
    const int* rlist; LAS unsigned char* lds;
    __device__ __forceinline__ unsigned row(const Unit& u, int rr) const {
        const int n = ((LAS int*)(lds + MOE_TAB_OFF))[16 + u.e]; const int rank = u.ti * 256 + rr; const bool ok = rank < n;
        return (unsigned)rlist[(size_t)u.e * T + (ok ? rank : 0)];
    }
};

typedef int i32x4v __attribute__((ext_vector_type(4)));
typedef int i32x8 __attribute__((ext_vector_type(8)));
template <class Epi, class Sched, class AMap, bool ALIGN_EPI, bool F8 = false, bool SEG2 = false>
__device__ __forceinline__ void gemm_phase(LAS unsigned char* lds, const int tid, const bf16_t* A, const bf16_t* Bt, size_t bstride, int K, const Sched& S, const AMap& AM, const Epi& E) {
    const int wid = __builtin_amdgcn_readfirstlane(tid >> 6), lane = tid & 63, wr = wid >> 2, wc = wid & 3, fr = lane & 15, fq = lane >> 4;
    const int nt = K / BK;
    unsigned voffA[2], voffB[2];
#pragma unroll
    for (int i = 0; i < 2; ++i) { int R, C; stage_rc(tid * 16 + i * 8192, R, C); const int Rb = Epi::PERM ? ((R & ~31) + perm32(R & 31)) : R; voffA[i] = (unsigned)(R * K + C) * 2u; voffB[i] = (unsigned)(Rb * K + C) * 2u; }
    const unsigned kstep = (unsigned)(BK * 2);
    const unsigned hstep = (unsigned)HALF * (unsigned)K * 2u;
    const unsigned tstep = 2u * hstep;
    const __amdgpu_buffer_rsrc_t rsA = __builtin_amdgcn_make_buffer_rsrc((void*)A, 0, -1, 0x00020000), rsB = __builtin_amdgcn_make_buffer_rsrc((void*)Bt, 0, -1, 0x00020000);
    const unsigned ldsw = (unsigned)wid * 1024u;
    const int aoff = lds_byte(wr * 64 + fr, fq * 8), boff = lds_byte(wc * 32 + fr, fq * 8);
#define PG8_SA(b, h) (((b) * 2 + (h)) * HTB)
#define PG8_SB(b, h) ((4 + (b) * 2 + (h)) * HTB)
#define PG8_STAGE(bufoff, soffB, voff) do { _Pragma("unroll") for (int _i = 0; _i < 2; ++_i) \
        __builtin_amdgcn_raw_ptr_buffer_load_lds(rsB, (LAS unsigned*)(lds + (bufoff) + ldsw + _i * 8192), 16, (int)(voff)[_i], (int)(soffB), 0, 0); } while (0)
#define PG8_LDA(dst, b, h) do { _Pragma("unroll") for (int m = 0; m < 4; ++m) _Pragma("unroll") for (int k = 0; k < 2; ++k) dst[m][k] = *(const LAS bf16x8*)(lds + PG8_SA(b, h) + aoff + m * 2048 + k * 1024); } while (0)
#define PG8_LDB(dst, b, h) do { _Pragma("unroll") for (int n = 0; n < 2; ++n) _Pragma("unroll") for (int k = 0; k < 2; ++k) dst[n][k] = *(const LAS bf16x8*)(lds + PG8_SB(b, h) + boff + n * 2048 + k * 1024); } while (0)
#define PG8_MMA(ai, bj, At, Bt_) do { __builtin_amdgcn_s_setprio(1); _Pragma("unroll") for (int m = 0; m < 4; ++m) _Pragma("unroll") for (int n = 0; n < 2; ++n) _Pragma("unroll") for (int k = 0; k < 2; ++k) \
        acc[ai][bj][m][n] = __builtin_amdgcn_mfma_f32_16x16x32_bf16(Bt_[n][k], At[m][k], acc[ai][bj][m][n], 0, 0, 0); __builtin_amdgcn_s_setprio(0); } while (0)
#define PG8_LD8(dst, base) do { const i32x4v lo_ = *(const LAS i32x4v*)(lds + (base)); const i32x4v hi_ = *(const LAS i32x4v*)(lds + (base) + 1024); dst = __builtin_shufflevector(lo_, hi_, 0, 1, 2, 3, 4, 5, 6, 7); } while (0)
#define PG8_LDA8(dst, b, h) do { _Pragma("unroll") for (int m = 0; m < 4; ++m) PG8_LD8(dst[m], PG8_SA(b, h) + aoff + m * 2048); } while (0)
#define PG8_LDB8(dst, b, h) do { _Pragma("unroll") for (int n = 0; n < 2; ++n) PG8_LD8(dst[n], PG8_SB(b, h) + boff + n * 2048); } while (0)
#define PG8_MMA8(ai, bj, At, Bt_) do { __builtin_amdgcn_s_setprio(1); _Pragma("unroll") for (int m = 0; m < 4; ++m) _Pragma("unroll") for (int n = 0; n < 2; ++n) \
        asm volatile("v_mfma_f32_16x16x128_f8f6f4 %0, %1, %2, %0" : "+v"(acc[ai][bj][m][n]) : "v"(Bt_[n]), "v"(At[m])); __builtin_amdgcn_s_setprio(0); } while (0)
#define PG8_XLDA(b, h) do { if constexpr (F8) PG8_LDA8(At8, b, h); else PG8_LDA(At, b, h); } while (0)
#define PG8_XLDB(w, b, h) do { if constexpr (F8) { if (w == 0) PG8_LDB8(B08, b, h); else PG8_LDB8(B18, b, h); } else { if (w == 0) PG8_LDB(B0, b, h); else PG8_LDB(B1, b, h); } } while (0)
#define PG8_XMMA(ai, bj, w) do { if constexpr (F8) { if (w == 0) PG8_MMA8(ai, bj, At8, B08); else PG8_MMA8(ai, bj, At8, B18); } else { if (w == 0) PG8_MMA(ai, bj, At, B0); else PG8_MMA(ai, bj, At, B1); } } while (0)
#define PG8_WAIT_V(n) asm volatile("s_waitcnt vmcnt(" #n ")" ::: "memory")
#define PG8_WAIT_L(n) asm volatile("s_waitcnt lgkmcnt(" #n ")" ::: "memory")
#define PG8_BAR __builtin_amdgcn_s_barrier()
#define PG8_SCHED __builtin_amdgcn_sched_barrier(0)
#define PG8_OFFS(dst, u) do { _Pragma("unroll") for (int _h = 0; _h < 2; ++_h) _Pragma("unroll") for (int _i = 0; _i < 2; ++_i) { int _R, _C; stage_rc(tid * 16 + _i * 8192, _R, _C); \
        dst[_h][_i] = (AM.row(u, _h * HALF + _R) * (unsigned)K + (unsigned)_C) * 2u; } } while (0)
#define PG8_STAGE_A(bufoff, h, kb, NXT) do { if constexpr (AMap::GATHER) { _Pragma("unroll") for (int _i = 0; _i < 2; ++_i) { const unsigned _o = (NXT) ? offN[h][_i] : offC[h][_i]; \
            __builtin_amdgcn_raw_ptr_buffer_load_lds(rsA, (LAS unsigned*)(lds + (bufoff) + ldsw + _i * 8192), 16, (int)_o, (int)(kb), 0, 0); } } \
        else { const unsigned _g = ((NXT) ? nA : cA) + (h) * hstep + (kb); _Pragma("unroll") for (int _i = 0; _i < 2; ++_i) \
            __builtin_amdgcn_raw_ptr_buffer_load_lds(rsA, (LAS unsigned*)(lds + (bufoff) + ldsw + _i * 8192), 16, (int)voffA[_i], (int)_g, 0, 0); } } while (0)
    Unit cur, nxt, nn; int ui = 0; bool has_next = false, has_nn = false;
    if (!S.next(0, cur)) return;
    f32x4 acc[2][2][4][2];
#pragma unroll
    for (int a = 0; a < 2; ++a)
#pragma unroll
        for (int b = 0; b < 2; ++b)
#pragma unroll
            for (int m = 0; m < 4; ++m)
#pragma unroll
                for (int n = 0; n < 2; ++n) acc[a][b][m][n] = (f32x4){0.f, 0.f, 0.f, 0.f};
    bf16x8 At[4][2], B0[2][2], B1[2][2]; i32x8 At8[4], B08[2], B18[2];
    int sc8 = 0x7F7F7F7F; if constexpr (F8) asm volatile("" : "+v"(sc8));
#define PG8_RAW(dst, u) do { _Pragma("unroll") for (int _h = 0; _h < 2; ++_h) _Pragma("unroll") for (int _i = 0; _i < 2; ++_i) { int _R, _C; stage_rc(tid * 16 + _i * 8192, _R, _C); dst[_h][_i] = AM.row(u, _h * HALF + _R); } } while (0)
#define PG8_CONV(dst, raw) do { _Pragma("unroll") for (int _h = 0; _h < 2; ++_h) _Pragma("unroll") for (int _i = 0; _i < 2; ++_i) { int _R, _C; stage_rc(tid * 16 + _i * 8192, _R, _C); dst[_h][_i] = (raw[_h][_i] * (unsigned)K + (unsigned)_C) * 2u; } } while (0)
    unsigned offC[2][2], offN[2][2], rawN[2][2];
    if constexpr (AMap::GATHER) { PG8_OFFS(offC, cur); has_next = S.next(1, nxt);
        if (has_next) { PG8_RAW(rawN, nxt); } else {
#pragma unroll
            for (int h = 0; h < 2; ++h)
#pragma unroll
                for (int i = 0; i < 2; ++i) rawN[h][i] = 0u; } }
    unsigned cA = AMap::GATHER ? 0u : (unsigned)cur.pm * tstep + (SEG2 ? (unsigned)cur.e * 1024u : 0u), nA = cA;
    unsigned cB = (unsigned)cur.e * (SEG2 ? 1024u : (unsigned)(bstride * 2)) + (unsigned)cur.pn * tstep;
    PG8_STAGE(PG8_SB(0, 0), cB, voffB); PG8_STAGE(PG8_SB(0, 1), cB + hstep, voffB); PG8_STAGE_A(PG8_SA(0, 0), 0, 0, false); PG8_STAGE_A(PG8_SA(0, 1), 1, 0, false);
    if (wr == 1) PG8_BAR;
    PG8_WAIT_V(2); PG8_BAR;
    PG8_STAGE(PG8_SB(1, 0), cB + kstep, voffB); PG8_STAGE_A(PG8_SA(1, 0), 0, kstep, false); PG8_STAGE(PG8_SB(1, 1), cB + hstep + kstep, voffB);
    PG8_WAIT_V(6); PG8_BAR;
    for (;;) {
        if constexpr (!AMap::GATHER) has_next = S.next(ui + 1, nxt);
        if constexpr (AMap::GATHER) {
            if (has_next) { PG8_CONV(offN, rawN); }
            else {
#pragma unroll
                for (int h = 0; h < 2; ++h)
#pragma unroll
                    for (int i = 0; i < 2; ++i) offN[h][i] = offC[h][i];
            }
            has_nn = has_next && S.next(ui + 2, nn);
            if (has_nn) { PG8_RAW(rawN, nn); }
        } else { nA = has_next ? (unsigned)nxt.pm * tstep + (SEG2 ? (unsigned)nxt.e * 1024u : 0u) : cA; }
        const unsigned nB = has_next ? (unsigned)nxt.e * (SEG2 ? 1024u : (unsigned)(bstride * 2)) + (unsigned)nxt.pn * tstep : cB;
        const int ntc = SEG2 ? (cur.e ? 4 : 8) : nt;
#pragma nounroll
        for (int t = 0; t < ntc; t += 2) {
            const bool last = (t == ntc - 2);
            const unsigned k1 = (unsigned)(t + 1) * kstep, k2 = last ? 0u : (unsigned)(t + 2) * kstep, k3 = k2 + kstep;
            const unsigned b2 = last ? nB : cB + (unsigned)(t + 2) * kstep, b3 = b2 + kstep;
            PG8_XLDB(0, 0, 0); PG8_XLDB(1, 0, 1); PG8_SCHED; PG8_XLDA(0, 0); PG8_STAGE_A(PG8_SA(1, 1), 1, k1, false);
            PG8_WAIT_V(8); PG8_WAIT_L(0); PG8_BAR; PG8_XMMA(0, 0, 0); PG8_XMMA(0, 1, 1); PG8_BAR; PG8_SCHED;
            PG8_XLDA(0, 1); PG8_STAGE(PG8_SB(0, 0), b2, voffB); PG8_STAGE(PG8_SB(0, 1), b2 + hstep, voffB); PG8_STAGE_A(PG8_SA(0, 0), 0, k2, last);
            PG8_WAIT_V(8); PG8_WAIT_L(0); PG8_BAR; PG8_XMMA(1, 0, 0); PG8_XMMA(1, 1, 1); PG8_BAR; PG8_SCHED;
            PG8_XLDB(0, 1, 0); PG8_XLDB(1, 1, 1); PG8_SCHED; PG8_XLDA(1, 0); PG8_STAGE_A(PG8_SA(0, 1), 1, k2, last);
            PG8_WAIT_V(8); PG8_WAIT_L(0); PG8_BAR; PG8_XMMA(0, 0, 0); PG8_XMMA(0, 1, 1); PG8_BAR; PG8_SCHED;
            PG8_XLDA(1, 1); PG8_STAGE(PG8_SB(1, 0), b3, voffB); PG8_STAGE(PG8_SB(1, 1), b3 + hstep, voffB); PG8_STAGE_A(PG8_SA(1, 0), 0, k3, last);
            PG8_WAIT_V(8); PG8_WAIT_L(0); PG8_BAR; PG8_XMMA(1, 0, 0); PG8_XMMA(1, 1, 1); PG8_BAR; PG8_SCHED;
        }
#ifdef PROBE_EPI
        unsigned long long pe_t0 = 0; if (tid == 0) pe_t0 = __builtin_amdgcn_s_memrealtime();
#endif
        if constexpr (ALIGN_EPI) { if (wr == 0) PG8_BAR; }
        if constexpr (F8) asm volatile("s_nop 15\n\ts_nop 15" ::: "memory");
        E(acc, cur, wr, wc, fr, fq);
#ifdef PROBE_EPI
        if (tid == 0) { asm volatile("s_waitcnt vmcnt(0)" ::: "memory"); volatile LAS unsigned long long* pb_ = (volatile LAS unsigned long long*)(lds + MISC_OFF + 8192); pb_[1] = pb_[1] + (__builtin_amdgcn_s_memrealtime() - pe_t0); }
#endif
        if (!has_next) break;
        if (!(SEG2 && cur.e == 0))
#pragma unroll
        for (int a = 0; a < 2; ++a)
#pragma unroll
            for (int b = 0; b < 2; ++b)
#pragma unroll
                for (int m = 0; m < 4; ++m)
#pragma unroll
                    for (int n = 0; n < 2; ++n) acc[a][b][m][n] = (f32x4){0.f, 0.f, 0.f, 0.f};
        cur = nxt; cB = nB; cA = nA; ++ui;
        if constexpr (AMap::GATHER) { nxt = nn; has_next = has_nn;
#pragma unroll
            for (int h = 0; h < 2; ++h)
#pragma unroll
                for (int i = 0; i < 2; ++i) offC[h][i] = offN[h][i];
        }
        if constexpr (ALIGN_EPI) { if (wr == 1) PG8_BAR; }
    }
    PG8_WAIT_V(0);
    if constexpr (!ALIGN_EPI) { if (wr == 0) PG8_BAR; }
    PG8_BAR;
#undef PG8_STAGE_A
#undef PG8_LD8
#undef PG8_LDA8
#undef PG8_LDB8
#undef PG8_MMA8
#undef PG8_XLDA
#undef PG8_XLDB
#undef PG8_XMMA
#undef PG8_SA
#undef PG8_SB
#undef PG8_STAGE
#undef PG8_LDA
#undef PG8_LDB
#undef PG8_MMA
#undef PG8_WAIT_V
#undef PG8_WAIT_L
#undef PG8_BAR
#undef PG8_SCHED
#undef PG8_OFFS
#undef PG8_RAW
#undef PG8_CONV
}

#define EPI_PIN(x) asm volatile("" : "+v"(x))
#define LPIN(x) asm volatile("" : "+v"(x))
#define EPI_ROWSTEP(m) (((m) == 3) ? 80 : 16)
struct EpiProj {
    static constexpr bool PERM = true;
    bf16_t* O; const float* cs; const float* sn; float* alow; float scale;
    __device__ __forceinline__ void operator()(const f32x4 (&acc)[2][2][4][2], const Unit& u, int wr, int wc, int fr, int fq) const {
        const int row0 = u.pm * BM + wr * 64 + fr, col0 = u.pn * BM + wc * 32 + 8 * fq;
        unsigned off = (unsigned)(row0 * NP + col0) * 2u;
        if (u.pn < 12) {
            unsigned toff = (unsigned)((row0 & (SEQ - 1)) * 64 + wc * 16 + fq * 4) * 4u;
            f32x4 ct[2][4], st[2][4];
#pragma unroll
            for (int ai = 0; ai < 2; ++ai)
#pragma unroll
                for (int m = 0; m < 4; ++m) { ct[ai][m] = *(const f32x4*)((const char*)cs + toff + (ai * HALF + m * 16) * 64 * 4); st[ai][m] = *(const f32x4*)((const char*)sn + toff + (ai * HALF + m * 16) * 64 * 4); }
#pragma unroll
            for (int ai = 0; ai < 2; ++ai)
#pragma unroll
                for (int m = 0; m < 4; ++m) {
                    const f32x4 c4 = ct[ai][m], s4 = st[ai][m];
#pragma unroll
                    for (int bj = 0; bj < 2; ++bj) { const f32x4 v0 = acc[ai][bj][m][0] * scale, v1 = acc[ai][bj][m][1] * scale; u32x4 w;
                        w.x = pk2(v0[0] * c4[0] - v0[1] * s4[0], v0[1] * c4[0] + v0[0] * s4[0]);
                        w.y = pk2(v0[2] * c4[1] - v0[3] * s4[1], v0[3] * c4[1] + v0[2] * s4[1]);
                        w.z = pk2(v1[0] * c4[2] - v1[1] * s4[2], v1[1] * c4[2] + v1[0] * s4[2]);
                        w.w = pk2(v1[2] * c4[3] - v1[3] * s4[3], v1[3] * c4[3] + v1[2] * s4[3]);
                        *(u32x4*)((char*)O + off + bj * HALF * 2) = w; }
                    off += EPI_ROWSTEP(m) * NP * 2; EPI_PIN(off);
                }
        } else if (GATE_F8 && u.pn >= RB / 256 && u.pn < 46) {
            unsigned off8 = (unsigned)(row0 * NP) * 2u + (unsigned)(G8_BYTE0 + col0 - RB);
#pragma unroll
            for (int ai = 0; ai < 2; ++ai)
#pragma unroll
                for (int m = 0; m < 4; ++m) {
#pragma unroll
                    for (int bj = 0; bj < 2; ++bj) { const f32x4 v0 = acc[ai][bj][m][0] * scale, v1 = acc[ai][bj][m][1] * scale; u32x2 w;
                        w.x = pk_fp8x4(v0[0], v0[1], v0[2], v0[3]); w.y = pk_fp8x4(v1[0], v1[1], v1[2], v1[3]);
                        *(u32x2*)((char*)O + off8 + bj * HALF) = w; }
                    off8 += EPI_ROWSTEP(m) * NP * 2; EPI_PIN(off8); }
        } else if (u.pn < 46) {
#pragma unroll
            for (int ai = 0; ai < 2; ++ai)
#pragma unroll
                for (int m = 0; m < 4; ++m) {
#pragma unroll
                    for (int bj = 0; bj < 2; ++bj) { const f32x4 v0 = acc[ai][bj][m][0] * scale, v1 = acc[ai][bj][m][1] * scale; u32x4 w;
                        w.x = pk2(v0[0], v0[1]); w.y = pk2(v0[2], v0[3]); w.z = pk2(v1[0], v1[1]); w.w = pk2(v1[2], v1[3]);
                        *(u32x4*)((char*)O + off + bj * HALF * 2) = w; }
                    off += EPI_ROWSTEP(m) * NP * 2; EPI_PIN(off); }
        } else {
            if (wc == 0 && fq < 2) {
                unsigned aoff_ = (unsigned)(row0 * 16 + 8 * fq) * 4u;
#pragma unroll
                for (int ai = 0; ai < 2; ++ai)
#pragma unroll
                    for (int m = 0; m < 4; ++m) { float* rp = (float*)((char*)alow + aoff_);
                        *(f32x4*)rp = acc[ai][0][m][0] * scale; *(f32x4*)(rp + 4) = acc[ai][0][m][1] * scale;
                        aoff_ += EPI_ROWSTEP(m) * 16 * 4; EPI_PIN(aoff_); }
            }
        }
    }
};
template <bool FIRST> struct EpiGate {
    static constexpr bool PERM = true;
    bf16_t* O; const bf16_t* proj; int goff; float scale; unsigned char* O8;
    __device__ __forceinline__ void operator()(const f32x4 (&acc)[2][2][4][2], const Unit& u, int wr, int wc, int fr, int fq) const {
        const int row0 = u.pm * BM + wr * 64 + fr, col0 = u.pn * BM + wc * 32 + 8 * fq;
        const unsigned goffb = GATE_F8 ? (unsigned)(row0 * NP) * 2u + (unsigned)(G8_BYTE0 + goff - RB + col0) : (unsigned)(row0 * NP + goff + col0) * 2u, ooff = (unsigned)(row0 * D + col0) * 2u;
        u32x4 gA[2][2], gB[2][2], pA[2][2], pB[2][2];
#define EG_ROW(r) ((((r) >> 2) * 128) + (((r) & 3) * 16))
#define EG_LOAD(G, P, b) do { _Pragma("unroll") for (int rr = 0; rr < 2; ++rr) { const unsigned ro = EG_ROW(2 * (b) + rr); _Pragma("unroll") for (int bj = 0; bj < 2; ++bj) { \
            if (GATE_F8) { const u32x2 g8 = *(const u32x2*)((const char*)proj + goffb + ro * NP * 2 + bj * HALF); G[rr][bj] = (u32x4){g8.x, g8.y, 0u, 0u}; } \
            else G[rr][bj] = *(const u32x4*)((const char*)proj + goffb + ro * NP * 2 + bj * HALF * 2); \
            if (!FIRST) P[rr][bj] = *(const u32x4*)((const char*)O + ooff + ro * D * 2 + bj * HALF * 2); } } asm volatile("" ::: "memory"); } while (0)
#define EG_COMP(G, P, b) do { _Pragma("unroll") for (int rr = 0; rr < 2; ++rr) { const int r = 2 * (b) + rr, ai = r >> 2, m = r & 3; const unsigned ro = EG_ROW(r); _Pragma("unroll") for (int bj = 0; bj < 2; ++bj) { \
            const u32x4 gg = G[rr][bj]; const f32x4 v0 = acc[ai][bj][m][0] * scale, v1 = acc[ai][bj][m][1] * scale; float gf[8], r8[8]; \
            if (GATE_F8) unpack_fp8x8((u32x2){gg.x, gg.y}, gf); else { gf[0] = bflo(gg.x); gf[1] = bfhi(gg.x); gf[2] = bflo(gg.y); gf[3] = bfhi(gg.y); gf[4] = bflo(gg.z); gf[5] = bfhi(gg.z); gf[6] = bflo(gg.w); gf[7] = bfhi(gg.w); } \
            r8[0] = sigmoidf_(gf[0]) * v0[0]; r8[1] = sigmoidf_(gf[1]) * v0[1]; r8[2] = sigmoidf_(gf[2]) * v0[2]; r8[3] = sigmoidf_(gf[3]) * v0[3]; \
            r8[4] = sigmoidf_(gf[4]) * v1[0]; r8[5] = sigmoidf_(gf[5]) * v1[1]; r8[6] = sigmoidf_(gf[6]) * v1[2]; r8[7] = sigmoidf_(gf[7]) * v1[3]; \
            if (!FIRST) { const u32x4 pq = P[rr][bj]; r8[0] += bflo(pq.x); r8[1] += bfhi(pq.x); r8[2] += bflo(pq.y); r8[3] += bfhi(pq.y); r8[4] += bflo(pq.z); r8[5] += bfhi(pq.z); r8[6] += bflo(pq.w); r8[7] += bfhi(pq.w); } \
            if (!FIRST && O8) { u32x2 w8; w8.x = pk_fp8x4(r8[0], r8[1], r8[2], r8[3]); w8.y = pk_fp8x4(r8[4], r8[5], r8[6], r8[7]); *(u32x2*)(O8 + (ooff >> 1) + ro * D + bj * HALF) = w8; } \
            else { u32x4 w; w.x = pk2(r8[0], r8[1]); w.y = pk2(r8[2], r8[3]); w.z = pk2(r8[4], r8[5]); w.w = pk2(r8[6], r8[7]); *(u32x4*)((char*)O + ooff + ro * D * 2 + bj * HALF * 2) = w; } } } asm volatile("" ::: "memory"); } while (0)
        EG_LOAD(gA, pA, 0); EG_LOAD(gB, pB, 1); EG_COMP(gA, pA, 0); EG_LOAD(gA, pA, 2); EG_COMP(gB, pB, 1); EG_LOAD(gB, pB, 3); EG_COMP(gA, pA, 2); EG_COMP(gB, pB, 3);
#undef EG_LOAD
#undef EG_COMP
    }
};
struct EpiGate2 {
    static constexpr bool PERM = true;
    const bf16_t* proj; float scale; unsigned char* O8;
    __device__ __forceinline__ void operator()(f32x4 (&acc)[2][2][4][2], const Unit& u, int wr, int wc, int fr, int fq) const {
        const int row0 = u.pm * BM + wr * 64 + fr, col0 = u.pn * BM + wc * 32 + 8 * fq;
        const unsigned goffa = (unsigned)(row0 * NP) * 2u + (unsigned)(G8_BYTE0 + GA - RB + col0), ooff = (unsigned)(row0 * D + col0);
        u32x4 gA[2][2], gB[2][2];
#define EG_ROW(r) ((((r) >> 2) * 128) + (((r) & 3) * 16))
        if (u.e == 0) {
#define E2_LOAD(G, b) do { _Pragma("unroll") for (int rr = 0; rr < 2; ++rr) { const unsigned ro = EG_ROW(2 * (b) + rr); _Pragma("unroll") for (int bj = 0; bj < 2; ++bj) { \
            const u32x2 ga8 = *(const u32x2*)((const char*)proj + goffa + ro * NP * 2 + bj * HALF), gb8 = *(const u32x2*)((const char*)proj + goffa + (GB - GA) + ro * NP * 2 + bj * HALF); \
            G[rr][bj] = (u32x4){ga8.x, ga8.y, gb8.x, gb8.y}; } } asm volatile("" ::: "memory"); } while (0)
#define E2_COMP(G, b) do { _Pragma("unroll") for (int rr = 0; rr < 2; ++rr) { const int r = 2 * (b) + rr, ai = r >> 2, m = r & 3; _Pragma("unroll") for (int bj = 0; bj < 2; ++bj) { \
            const u32x4 gg = G[rr][bj]; float fa[8], fb[8]; unpack_fp8x8((u32x2){gg.x, gg.y}, fa); unpack_fp8x8((u32x2){gg.z, gg.w}, fb); \
            _Pragma("unroll") for (int j = 0; j < 8; ++j) { const float q = (1.0f + __expf(-fmaxf(fa[j], -30.0f))) * sigmoidf_(fb[j]); acc[ai][bj][m][j >> 2][j & 3] *= q; } } } } while (0)
            E2_LOAD(gA, 0); E2_LOAD(gB, 1); E2_COMP(gA, 0); E2_LOAD(gA, 2); E2_COMP(gB, 1); E2_LOAD(gB, 3); E2_COMP(gA, 2); E2_COMP(gB, 3);
#undef E2_LOAD
#undef E2_COMP
        } else {
#define E2_LOAD(G, b) do { _Pragma("unroll") for (int rr = 0; rr < 2; ++rr) { const unsigned ro = EG_ROW(2 * (b) + rr); _Pragma("unroll") for (int bj = 0; bj < 2; ++bj) { \
            const u32x2 ga8 = *(const u32x2*)((const char*)proj + goffa + ro * NP * 2 + bj * HALF); G[rr][bj] = (u32x4){ga8.x, ga8.y, 0u, 0u}; } } asm volatile("" ::: "memory"); } while (0)
#define E2_COMP(G, b) do { _Pragma("unroll") for (int rr = 0; rr < 2; ++rr) { const int r = 2 * (b) + rr, ai = r >> 2, m = r & 3; const unsigned ro = EG_ROW(r); _Pragma("unroll") for (int bj = 0; bj < 2; ++bj) { \
            const u32x4 gg = G[rr][bj]; float fa[8], r8[8]; unpack_fp8x8((u32x2){gg.x, gg.y}, fa); \
            _Pragma("unroll") for (int j = 0; j < 8; ++j) r8[j] = sigmoidf_(fmaxf(fa[j], -30.0f)) * (acc[ai][bj][m][j >> 2][j & 3] * scale); \
            u32x2 w8; w8.x = pk_fp8x4(r8[0], r8[1], r8[2], r8[3]); w8.y = pk_fp8x4(r8[4], r8[5], r8[6], r8[7]); *(u32x2*)(O8 + ooff + ro * D + bj * HALF) = w8; } } asm volatile("" ::: "memory"); } while (0)
            E2_LOAD(gA, 0); E2_LOAD(gB, 1); E2_COMP(gA, 0); E2_LOAD(gA, 2); E2_COMP(gB, 1); E2_LOAD(gB, 3); E2_COMP(gA, 2); E2_COMP(gB, 3);
#undef E2_LOAD
#undef E2_COMP
        }
#undef EG_ROW
    }
};
#define EG_ROW(r) ((((r) >> 2) * 128) + (((r) & 3) * 16))
template <bool XF32> struct EpiResid {
    static constexpr bool PERM = true;
    const void* xi; bf16_t* xo; const float* gate; float scale;
    __device__ __forceinline__ void operator()(const f32x4 (&acc)[2][2][4][2], const Unit& u, int wr, int wc, int fr, int fq) const {
        const int row0 = u.pm * BM + wr * 64 + fr, col0 = u.pn * BM + wc * 32 + 8 * fq;
        const int b = (u.pm * BM) / SEQ;
        f32x4 gt[2][2];
#pragma unroll
        for (int bj = 0; bj < 2; ++bj)
#pragma unroll
            for (int n = 0; n < 2; ++n) gt[bj][n] = *(const f32x4*)(gate + (size_t)b * 12288 + col0 + bj * HALF + 4 * n) * scale;
        const unsigned off = (unsigned)(row0 * D + col0);
        constexpr int RB_ = XF32 ? 1 : 2, NBAT = 8 / RB_;
        f32x4 xA[RB_][2][2], xB[RB_][2][2];
#define ER_LOAD(X, bb) do { _Pragma("unroll") for (int rr = 0; rr < RB_; ++rr) { const unsigned ro = EG_ROW(RB_ * (bb) + rr); _Pragma("unroll") for (int bj = 0; bj < 2; ++bj) { const unsigned o = off + ro * D + bj * HALF; \
            if (XF32) { X[rr][bj][0] = *(const f32x4*)((const float*)xi + o); X[rr][bj][1] = *(const f32x4*)((const float*)xi + o + 4); } \
            else { const u32x4 rw = *(const u32x4*)((const bf16_t*)xi + o); X[rr][bj][0] = (f32x4){bflo(rw.x), bfhi(rw.x), bflo(rw.y), bfhi(rw.y)}; X[rr][bj][1] = (f32x4){bflo(rw.z), bfhi(rw.z), bflo(rw.w), bfhi(rw.w)}; } } } asm volatile("" ::: "memory"); } while (0)
#define ER_COMP(X, bb) do { _Pragma("unroll") for (int rr = 0; rr < RB_; ++rr) { const int r = RB_ * (bb) + rr, ai = r >> 2, m = r & 3; const unsigned ro = EG_ROW(r); _Pragma("unroll") for (int bj = 0; bj < 2; ++bj) { const unsigned o = off + ro * D + bj * HALF; \
            const f32x4 v0 = X[rr][bj][0] + gt[bj][0] * acc[ai][bj][m][0], v1 = X[rr][bj][1] + gt[bj][1] * acc[ai][bj][m][1]; \
            u32x4 w; w.x = pk2(v0[0], v0[1]); w.y = pk2(v0[2], v0[3]); w.z = pk2(v1[0], v1[1]); w.w = pk2(v1[2], v1[3]); *(u32x4*)(xo + o) = w; } } asm volatile("" ::: "memory"); } while (0)
        ER_LOAD(xA, 0);
#pragma unroll
        for (int bb = 0; bb < NBAT; bb += 2) {
            ER_LOAD(xB, bb + 1); ER_COMP(xA, bb);
            if (bb + 2 < NBAT) ER_LOAD(xA, bb + 2);
            ER_COMP(xB, bb + 1); }
#undef ER_LOAD
#undef ER_COMP
#undef EG_ROW
    }
};
struct EpiSwiGLU {
    static constexpr bool PERM = true;
    bf16_t* O;
    __device__ __forceinline__ void operator()(const f32x4 (&acc)[2][2][4][2], const Unit& u, int wr, int wc, int fr, int fq) const {
        const int row0 = u.pm * BM + wr * 64 + fr, col0 = u.pn * HALF + wc * 32 + 8 * fq;
        unsigned off = (unsigned)(row0 * FF + col0) * 2u;
#pragma unroll
        for (int ai = 0; ai < 2; ++ai)
#pragma unroll
            for (int m = 0; m < 4; ++m) { const f32x4 g0 = acc[ai][0][m][0], g1 = acc[ai][0][m][1], u0 = acc[ai][1][m][0], u1 = acc[ai][1][m][1]; u32x4 w;
                w.x = pk2(siluf_(g0[0]) * u0[0], siluf_(g0[1]) * u0[1]); w.y = pk2(siluf_(g0[2]) * u0[2], siluf_(g0[3]) * u0[3]);
                w.z = pk2(siluf_(g1[0]) * u1[0], siluf_(g1[1]) * u1[1]); w.w = pk2(siluf_(g1[2]) * u1[2], siluf_(g1[3]) * u1[3]);
                *(u32x4*)((char*)O + off) = w;
                off += EPI_ROWSTEP(m) * FF * 2; EPI_PIN(off); }
    }
};
struct EpiPlain {
    static constexpr bool PERM = true;
    bf16_t* O;
    __device__ __forceinline__ void operator()(const f32x4 (&acc)[2][2][4][2], const Unit& u, int wr, int wc, int fr, int fq) const {
        const int row0 = u.pm * BM + wr * 64 + fr, col0 = u.pn * BM + wc * 32 + 8 * fq;
        unsigned off = (unsigned)(row0 * D + col0) * 2u;
#pragma unroll
        for (int ai = 0; ai < 2; ++ai)
#pragma unroll
            for (int m = 0; m < 4; ++m) {
#pragma unroll
                for (int bj = 0; bj < 2; ++bj) { const f32x4 v0 = acc[ai][bj][m][0], v1 = acc[ai][bj][m][1]; u32x4 w;
                    w.x = pk2(v0[0], v0[1]); w.y = pk2(v0[2], v0[3]); w.z = pk2(v1[0], v1[1]); w.w = pk2(v1[2], v1[3]);
                    *(u32x4*)((char*)O + off + bj * HALF * 2) = w; }
                off += EPI_ROWSTEP(m) * D * 2; EPI_PIN(off); }
    }
};
constexpr float W8_SCALE = 32.0f, W8_INV = 1.0f / 32.0f;
struct EpiSwiGLU8 {
    static constexpr bool PERM = true;
    unsigned char* O;
    __device__ __forceinline__ void operator()(const f32x4 (&acc)[2][2][4][2], const Unit& u, int wr, int wc, int fr, int fq) const {
        const int row0 = u.pm * BM + wr * 64 + fr, col0 = u.pn * HALF + wc * 32 + 8 * fq;
        unsigned off = (unsigned)(row0 * FF + col0);
#pragma unroll
        for (int ai = 0; ai < 2; ++ai)
#pragma unroll
            for (int m = 0; m < 4; ++m) { const f32x4 g0 = acc[ai][0][m][0] * W8_INV, g1 = acc[ai][0][m][1] * W8_INV, u0 = acc[ai][1][m][0] * W8_INV, u1 = acc[ai][1][m][1] * W8_INV; u32x2 w;
                w.x = pk_fp8x4(siluf_(g0[0]) * u0[0], siluf_(g0[1]) * u0[1], siluf_(g0[2]) * u0[2], siluf_(g0[3]) * u0[3]);
                w.y = pk_fp8x4(siluf_(g1[0]) * u1[0], siluf_(g1[1]) * u1[1], siluf_(g1[2]) * u1[2], siluf_(g1[3]) * u1[3]);
                *(u32x2*)(O + off) = w;
                off += EPI_ROWSTEP(m) * FF; EPI_PIN(off); }
    }
};
struct EpiPlainS {
    static constexpr bool PERM = true;
    bf16_t* O; float scale;
    __device__ __forceinline__ void operator()(const f32x4 (&acc)[2][2][4][2], const Unit& u, int wr, int wc, int fr, int fq) const {
        const int row0 = u.pm * BM + wr * 64 + fr, col0 = u.pn * BM + wc * 32 + 8 * fq;
        unsigned off = (unsigned)(row0 * D + col0) * (Y_F8 ? 1u : 2u);
#pragma unroll
        for (int ai = 0; ai < 2; ++ai)
#pragma unroll
            for (int m = 0; m < 4; ++m) {
#pragma unroll
                for (int bj = 0; bj < 2; ++bj) { const f32x4 v0 = acc[ai][bj][m][0] * scale, v1 = acc[ai][bj][m][1] * scale;
#if Y_F8
                    u32x2 w; w.x = pk_fp8x4(v0[0], v0[1], v0[2], v0[3]); w.y = pk_fp8x4(v1[0], v1[1], v1[2], v1[3]);
                    *(u32x2*)((char*)O + off + bj * HALF) = w;
#else
                    u32x4 w; w.x = pk2(v0[0], v0[1]); w.y = pk2(v0[2], v0[3]); w.z = pk2(v1[0], v1[1]); w.w = pk2(v1[2], v1[3]);
                    *(u32x4*)((char*)O + off + bj * HALF * 2) = w;
#endif
                }
                off += EPI_ROWSTEP(m) * D * (Y_F8 ? 1 : 2); EPI_PIN(off); }
    }
};
}

struct Args {
    const float* x; const float* c; const float* w_ada; const float* b_ada; const float* norm_mix; const float* norm_ffn; const float* w_in;
    const float* w_alpha2; const float* b_alpha2; const float* gla_gain; const float* w_out_a; const float* w_out_b; const float* w_out;
    const float* w_router; const float* b_router; const float* w_gate_e; const float* w_up_e; const float* w_down_e; const float* final_norm;
    float* out; unsigned char* ws; int ph_lo, ph_hi;
};

__device__ __forceinline__ int proj_src_col(int n) {
    if (n < 3072) { const int blk = n >> 7, w = n & 127; return (blk << 7) + (w >> 1) + ((w & 1) << 6); }
    if (n < 7680) return n;
    if (n < 11776) return n + 16;
    if (n < 11792) return n - 4096;
    return -1;
}
struct TrDesc { const float* src; unsigned char* dst; int ldw, K, zero, rope, f8; };
__device__ __forceinline__ void tr_load(const TrDesc& d, f32x4 (&v)[16]) {
#pragma unroll
    for (int i = 0; i < 16; ++i) v[i] = *(const f32x4*)(d.src + (size_t)(4 * i) * d.ldw);
}
__device__ __forceinline__ void tr_finish(const TrDesc& d, f32x4 (&v)[16], LAS float* scr, int lane) {
    const int kk = lane >> 4, q4 = lane & 15;
    if (d.zero) {
#pragma unroll
        for (int i = 0; i < 16; ++i) v[i] = (f32x4){0.f, 0.f, 0.f, 0.f}; }
    const int d0 = d.rope ? 8 * (q4 & 7) + (q4 >> 3) : 4 * q4, ds = d.rope ? 2 : 1;
    { LAS float* rp = scr + kk * 65 + d0;
#pragma unroll
        for (int i = 0; i < 16; ++i) { rp[4 * i * 65] = v[i][0]; rp[4 * i * 65 + ds] = v[i][1]; rp[4 * i * 65 + 2 * ds] = v[i][2]; rp[4 * i * 65 + 3 * ds] = v[i][3]; } }
    LDS_WAIT(); asm volatile("" ::: "memory");
    if (d.f8) {
        const int c = lane & 3, nl = lane >> 2; const LAS float* sp = scr + (16 * c) * 65 + nl; unsigned char* dp = d.dst + (size_t)nl * d.K + 16 * c;
#pragma unroll
        for (int j = 0; j < 4; ++j) { u32x4 o;
            o.x = pk_fp8x4(sp[0 * 65 + 16 * j] * 32.0f, sp[1 * 65 + 16 * j] * 32.0f, sp[2 * 65 + 16 * j] * 32.0f, sp[3 * 65 + 16 * j] * 32.0f);
            o.y = pk_fp8x4(sp[4 * 65 + 16 * j] * 32.0f, sp[5 * 65 + 16 * j] * 32.0f, sp[6 * 65 + 16 * j] * 32.0f, sp[7 * 65 + 16 * j] * 32.0f);
            o.z = pk_fp8x4(sp[8 * 65 + 16 * j] * 32.0f, sp[9 * 65 + 16 * j] * 32.0f, sp[10 * 65 + 16 * j] * 32.0f, sp[11 * 65 + 16 * j] * 32.0f);
            o.w = pk_fp8x4(sp[12 * 65 + 16 * j] * 32.0f, sp[13 * 65 + 16 * j] * 32.0f, sp[14 * 65 + 16 * j] * 32.0f, sp[15 * 65 + 16 * j] * 32.0f);
            *(GAS u32x4*)(dp + (size_t)(16 * j) * d.K) = o; }
    } else {
        const int c = lane & 7, nl = lane >> 3; const LAS float* sp = scr + (8 * c) * 65 + nl; unsigned char* dp = d.dst + ((size_t)nl * d.K + 8 * c) * 2;
#pragma unroll
        for (int j = 0; j < 8; ++j) { u32x4 o;
            o.x = pk2(sp[0 * 65 + 8 * j], sp[1 * 65 + 8 * j]); o.y = pk2(sp[2 * 65 + 8 * j], sp[3 * 65 + 8 * j]); o.z = pk2(sp[4 * 65 + 8 * j], sp[5 * 65 + 8 * j]); o.w = pk2(sp[6 * 65 + 8 * j], sp[7 * 65 + 8 * j]);
            *(GAS u32x4*)(dp + (size_t)(8 * j) * d.K * 2) = o; }
    }
    LDS_WAIT(); asm volatile("" ::: "memory");
}

typedef const __attribute__((address_space(4))) Args CArgsP;
__device__ __forceinline__ void prologue_phase(CArgsP* ap_, LAS unsigned char* lds, int vcu, int G, int tid, int wave, int lane, int parts = 7) {
#define a (*ap_)
    unsigned char* ws = a.ws;
    if (parts & 1) {
        LAS float* cact = (LAS float*)lds;
        LAS float* red = (LAS float*)(lds + 65536);
        for (int i = tid; i < NB * D; i += NTHREADS) { const int b = i >> 11, k = i & 2047; cact[k * 8 + b] = siluf_(a.c[i]); }
        __syncthreads();
        float* ada = (float*)(ws + WS_ADA);
        const int q = tid & 7, kg = tid >> 3;
        for (int u = vcu; u < DEPTH * 384; u += G) {
            const int l = u / 384, n0 = (u % 384) * 32;
            const float* W = a.w_ada + (size_t)l * D * 12288 + n0 + 4 * q;
            f32x4 acc[8];
#pragma unroll
            for (int b = 0; b < 8; ++b) acc[b] = (f32x4){0.f, 0.f, 0.f, 0.f};
#pragma unroll 8
            for (int kk = 0; kk < 32; ++kk) { const int k = kg * 32 + kk; const f32x4 w = *(const f32x4*)(W + (size_t)k * 12288);
                const f32x4 c0 = *(const LAS f32x4*)(cact + k * 8), c1 = *(const LAS f32x4*)(cact + k * 8 + 4);
                acc[0] += w * c0[0]; acc[1] += w * c0[1]; acc[2] += w * c0[2]; acc[3] += w * c0[3];
                acc[4] += w * c1[0]; acc[5] += w * c1[1]; acc[6] += w * c1[2]; acc[7] += w * c1[3]; }
#pragma unroll
            for (int b = 0; b < 8; ++b) *(LAS f32x4*)(red + (kg * 8 + b) * 32 + 4 * q) = acc[b];
            __syncthreads();
            if (tid < 256) { const int b = tid >> 5, col = tid & 31; float s = a.b_ada[(size_t)l * 12288 + n0 + col];
                for (int g = 0; g < 64; ++g) s += red[(g * 8 + b) * 32 + col];
                const int n = n0 + col;
                if (n >= 2048 && n < 4096) s = (1.0f + s) * a.norm_mix[(size_t)l * D + n - 2048]; else if (n >= 8192 && n < 10240) s = (1.0f + s) * a.norm_ffn[(size_t)l * D + n - 8192];
                ada[((size_t)l * NB + b) * 12288 + n] = s; }
            __syncthreads();
        }
    }
    if (parts & 2) {
        float* cs = (float*)(ws + WS_ROPE); float* sn = cs + SEQ * 64;
        for (int i = vcu * NTHREADS + tid; i < SEQ * 64; i += G * NTHREADS) {
            const int pos = i >> 6, fi = i & 63;
            double f = 1.0;
            if (fi & 1) f *= 0.8659643233600653; if (fi & 2) f *= 0.7498942093324558; if (fi & 4) f *= 0.5623413251903491;
            if (fi & 8) f *= 0.31622776601683794; if (fi & 16) f *= 0.09999999999999999; if (fi & 32) f *= 0.009999999999999998;
            double rev = (double)pos * f * 0.15915494309189535; rev -= __builtin_floor(rev);
            const float rv = (float)rev;
            cs[i] = __builtin_amdgcn_cosf(rv); sn[i] = __builtin_amdgcn_sinf(rv);
        }
    }
    if (parts & 4) {
        LAS float* scr = (LAS float*)(lds + wave * 16640);
        const int gw = vcu * NWAVES + wave, NGW = G * NWAVES;
        constexpr int C_IN = 32 * 188, C_OA = 8 * 32, C_OB = 16 * 32, C_O = 32 * 32, C_GU = 16 * 32 * 32, C_DN = 16 * 16 * 32, C_L = C_IN + C_OA + C_OB + C_O + C_GU + C_DN, NIT = DEPTH * C_L;
        const int q4 = lane & 15, kk = lane >> 4;
        auto decode = [&](int it) -> TrDesc {
            TrDesc d; d.zero = 0; d.rope = 0; d.f8 = 0;
            const int l = it / C_L; int r = it % C_L;
            const float* W; unsigned char* WT; int ldw, K, k0, n0, scol, esz = 2;
            if (r < C_IN) { const int kb = r / 188, nb = r % 188; n0 = 64 * nb; k0 = 64 * kb; ldw = NIN; K = D; W = a.w_in + (size_t)l * D * NIN;
                if (n0 < 3072) { d.rope = 1; scol = (n0 >> 7) * 128 + 32 * ((n0 >> 6) & 1) + 64 * (q4 >> 3) + 4 * (q4 & 7); }
                else if (n0 < 7680) scol = n0 + 4 * q4;
                else if (n0 < 11776) scol = n0 + 16 + 4 * q4;
                else if (n0 == 11776) { scol = (q4 < 4) ? 7680 + 4 * q4 : 0; d.zero = (q4 < 4) ? 0 : 1; }
                else { scol = 0; d.zero = 1; }
#if PROJ_F8
                d.f8 = 1; esz = 1; WT = ws + WS_WIN + (size_t)l * NP * D;
#else
                WT = ws + WS_WIN + (size_t)l * NP * D * 2;
#endif
            } else if ((r -= C_IN) < C_OA) { const int kb = r / 32, nb = r % 32; n0 = 64 * nb; k0 = 64 * kb; ldw = D; K = 512; scol = n0 + 4 * q4; W = a.w_out_a + (size_t)l * 512 * D; WT = ws + WS_WOA + (size_t)l * D * 512 * (MIX_F8 ? 1 : 2); if (MIX_F8) { d.f8 = 1; esz = 1; }
                if (BR_FUSE) { K = 1536; WT = ws + WS_WOA + (size_t)l * D * 1536 + 1024; }
            } else if ((r -= C_OA) < C_OB) { const int kb = r / 32, nb = r % 32; n0 = 64 * nb; k0 = 64 * kb; ldw = D; K = 1024; scol = n0 + 4 * q4; W = a.w_out_b + (size_t)l * 1024 * D; WT = ws + WS_WOB + (size_t)l * D * 1024 * (MIX_F8 ? 1 : 2); if (MIX_F8) { d.f8 = 1; esz = 1; }
                if (BR_FUSE) { K = 1536; WT = ws + WS_WOA + (size_t)l * D * 1536; }
            } else if ((r -= C_OB) < C_O) { const int kb = r / 32, nb = r % 32; n0 = 64 * nb; k0 = 64 * kb; ldw = D; K = D; scol = n0 + 4 * q4; W = a.w_out + (size_t)l * D * D; WT = ws + WS_WO + (size_t)l * D * D * (MIX_F8 ? 1 : 2); if (MIX_F8) { d.f8 = 1; esz = 1; }
            } else if ((r -= C_O) < C_GU) { const int e = r / 1024, r2 = r % 1024, kb = r2 / 32, nb = r2 % 32, pn = nb >> 2, sgu = (nb >> 1) & 1, c0 = 64 * (nb & 1);
                n0 = 64 * nb; k0 = 64 * kb; ldw = FF; K = D; scol = 128 * pn + c0 + 4 * q4; W = (sgu ? a.w_up_e : a.w_gate_e) + (size_t)(l * NE + e) * D * FF; WT = ws + WS_WGU + (size_t)(l * NE + e) * 2048 * D; d.f8 = 1; esz = 1;
            } else { r -= C_GU; const int e = r / 512, r2 = r % 512, kb = r2 / 32, nb = r2 % 32;
                n0 = 64 * nb; k0 = 64 * kb; ldw = D; K = FF; scol = n0 + 4 * q4; W = a.w_down_e + (size_t)(l * NE + e) * FF * D; WT = ws + WS_WDN + (size_t)(l * NE + e) * D * FF; d.f8 = 1; esz = 1; }
            d.src = W + (size_t)(k0 + kk) * ldw + scol; d.ldw = ldw; d.K = K; d.dst = WT + ((size_t)n0 * K + k0) * esz;
            return d; };
        int it = gw; TrDesc dA, dB; f32x4 vA[16], vB[16];
        if (it < NIT) { dA = decode(it); tr_load(dA, vA); }
        while (it < NIT) {
            const int itB = it + NGW;
            if (itB < NIT) { dB = decode(itB); tr_load(dB, vB); }
            tr_finish(dA, vA, scr, lane);
            if (itB >= NIT) break;
            const int itA = itB + NGW;
            if (itA < NIT) { dA = decode(itA); tr_load(dA, vA); }
            tr_finish(dB, vB, scr, lane);
            it = itA;
        }
    }
}
#undef a

struct MoeStarts {
    int ts[NE];
    __device__ __forceinline__ void init(const unsigned* cnt) { int acc = 0;
#pragma unroll
        for (int e = 0; e < NE; ++e) { ts[e] = acc; acc += ((int)__hip_atomic_load(cnt + 64 * e, RLX_AGENT) + 255) >> 8; } }
    __device__ __forceinline__ int row(int slot) const { const int e = slot >> 16; int t0 = 0;
#pragma unroll
        for (int j = 0; j < NE; ++j) t0 = (e == j) ? ts[j] : t0;
        return t0 * 256 + (slot & 0xffff); }
};

template <int MODE>
__device__ __forceinline__ void norm_phase(const void* xs, void* xd, bf16_t* hout, const float* gain, const float* ada_scale, const float* ada_shift, const float* ada_gate2,
                                           const bf16_t* Y, const int* tslot, const float* tw, const unsigned* cnt, int vcu, int G, int wave, int lane) {
    const int gw = vcu * NWAVES + wave, NGW = G * NWAVES, rpw = T / NGW;
    MoeStarts ms; if (MODE != 0) ms.init(cnt);
    int tsl = 0; float twl = 0.f;
    if (MODE != 0) { const int i0 = gw * rpw * 2, ii = (i0 + lane < 2 * T) ? i0 + lane : 2 * T - 1; tsl = tslot[ii]; twl = tw[ii]; }
    for (int k = 0; k < rpw; k += 2) {
        const int row = gw * rpw + k, b = row >> 11;
        f32x4 v[2][8]; u32x2 xraw[2][8];
        int s0[2], s1[2]; float w0[2], w1[2];
        if (MODE != 0) {
#pragma unroll
            for (int rr = 0; rr < 2; ++rr) { s0[rr] = __builtin_amdgcn_readlane(tsl, (k + rr) * 2); s1[rr] = __builtin_amdgcn_readlane(tsl, (k + rr) * 2 + 1);
                w0[rr] = __builtin_bit_cast(float, __builtin_amdgcn_readlane(__builtin_bit_cast(int, twl), (k + rr) * 2)); w1[rr] = __builtin_bit_cast(float, __builtin_amdgcn_readlane(__builtin_bit_cast(int, twl), (k + rr) * 2 + 1)); } }
#pragma unroll
        for (int rr = 0; rr < 2; ++rr) {
            if (MODE == 0) { const GAS f32x4* xr = (const GAS f32x4*)((const float*)xs + (size_t)(row + rr) * D) + lane;
#pragma unroll
                for (int j = 0; j < 8; ++j) v[rr][j] = xr[64 * j];
            } else { const GAS u32x2* xr = (const GAS u32x2*)((const bf16_t*)xs + (size_t)(row + rr) * D) + lane;
#pragma unroll
                for (int j = 0; j < 8; ++j) xraw[rr][j] = xr[64 * j]; } }
        f32x4 ggv[8], ssv[8], scv[8];
#define GSS_LOAD() do { const GAS f32x4* gn_ = (const GAS f32x4*)gain + lane; \
            if (MODE == 2) { _Pragma("unroll") for (int j = 0; j < 8; ++j) { ggv[j] = gn_[64 * j]; scv[j] = (f32x4){0.f, 0.f, 0.f, 0.f}; ssv[j] = (f32x4){0.f, 0.f, 0.f, 0.f}; } } \
            else { const GAS f32x4* sc_ = (const GAS f32x4*)(ada_scale + (size_t)b * 12288) + lane; const GAS f32x4* sh_ = (const GAS f32x4*)(ada_shift + (size_t)b * 12288) + lane; \
                _Pragma("unroll") for (int j = 0; j < 8; ++j) { ggv[j] = sc_[64 * j]; scv[j] = (f32x4){0.f, 0.f, 0.f, 0.f}; ssv[j] = sh_[64 * j]; } } asm volatile("" ::: "memory"); } while (0)
        if (MODE == 0) GSS_LOAD();
        if (MODE != 0) {
            const GAS f32x4* gt = (const GAS f32x4*)(ada_gate2 + (size_t)b * 12288) + lane;
#if Y_F8
            unsigned ya[2][8], yb[2][8];
#pragma unroll
            for (int rr = 0; rr < 2; ++rr) { const GAS unsigned* y0 = (const GAS unsigned*)((const unsigned char*)Y + (size_t)ms.row(s0[rr]) * D) + lane; const GAS unsigned* y1 = (const GAS unsigned*)((const unsigned char*)Y + (size_t)ms.row(s1[rr]) * D) + lane;
#pragma unroll
                for (int j = 0; j < 8; ++j) { ya[rr][j] = y0[64 * j]; yb[rr][j] = y1[64 * j]; } }
            f32x4 gtv[8];
#pragma unroll
            for (int j = 0; j < 8; ++j) gtv[j] = gt[64 * j];
            asm volatile("" ::: "memory");
#pragma unroll
            for (int rr = 0; rr < 2; ++rr)
#pragma unroll
                for (int j = 0; j < 8; ++j) { LPIN(xraw[rr][j]); LPIN(ya[rr][j]); LPIN(yb[rr][j]); }
#pragma unroll
            for (int j = 0; j < 8; ++j) LPIN(gtv[j]);
#pragma unroll
            for (int rr = 0; rr < 2; ++rr)
#pragma unroll
                for (int j = 0; j < 8; ++j) { const u32x2 r = xraw[rr][j]; v[rr][j] = (f32x4){bflo(r.x), bfhi(r.x), bflo(r.y), bfhi(r.y)}; }
#pragma unroll
            for (int j = 0; j < 8; ++j) { const f32x4 g = gtv[j];
#pragma unroll
                for (int rr = 0; rr < 2; ++rr) {
                    const f32x2_t a0l = __builtin_amdgcn_cvt_pk_f32_fp8((int)ya[rr][j], false), a0h = __builtin_amdgcn_cvt_pk_f32_fp8((int)ya[rr][j], true), a1l = __builtin_amdgcn_cvt_pk_f32_fp8((int)yb[rr][j], false), a1h = __builtin_amdgcn_cvt_pk_f32_fp8((int)yb[rr][j], true);
                    f32x4 m; m[0] = w0[rr] * a0l[0] + w1[rr] * a1l[0]; m[1] = w0[rr] * a0l[1] + w1[rr] * a1l[1]; m[2] = w0[rr] * a0h[0] + w1[rr] * a1h[0]; m[3] = w0[rr] * a0h[1] + w1[rr] * a1h[1];
                    v[rr][j] = v[rr][j] + g * m; } }
#else
            u32x2 ya[2][8], yb[2][8];
#pragma unroll
            for (int rr = 0; rr < 2; ++rr) { const GAS u32x2* y0 = (const GAS u32x2*)(Y + (size_t)ms.row(s0[rr]) * D) + lane; const GAS u32x2* y1 = (const GAS u32x2*)(Y + (size_t)ms.row(s1[rr]) * D) + lane;
#pragma unroll
                for (int j = 0; j < 8; ++j) { ya[rr][j] = y0[64 * j]; yb[rr][j] = y1[64 * j]; } }
#pragma unroll
            for (int j = 0; j < 8; ++j) { const f32x4 g = gt[64 * j];
#pragma unroll
                for (int rr = 0; rr < 2; ++rr) { const u32x2 a0 = ya[rr][j], a1 = yb[rr][j];
                    f32x4 m; m[0] = w0[rr] * bflo(a0.x) + w1[rr] * bflo(a1.x); m[1] = w0[rr] * bfhi(a0.x) + w1[rr] * bfhi(a1.x); m[2] = w0[rr] * bflo(a0.y) + w1[rr] * bflo(a1.y); m[3] = w0[rr] * bfhi(a0.y) + w1[rr] * bfhi(a1.y);
                    v[rr][j] = v[rr][j] + g * m; } }
#endif
            GSS_LOAD();
            if (MODE == 1) {
#pragma unroll
                for (int rr = 0; rr < 2; ++rr) { GAS u32x2* xw = (GAS u32x2*)((bf16_t*)xd + (size_t)(row + rr) * D) + lane;
#pragma unroll
                    for (int j = 0; j < 8; ++j) { u32x2 w; w.x = pk2(v[rr][j][0], v[rr][j][1]); w.y = pk2(v[rr][j][2], v[rr][j][3]); xw[64 * j] = w; } } }
        }
        float rstd[2];
#pragma unroll
        for (int rr = 0; rr < 2; ++rr) { float s = 0.f;
#pragma unroll
            for (int j = 0; j < 8; ++j) s += (v[rr][j][0] * v[rr][j][0] + v[rr][j][1] * v[rr][j][1]) + (v[rr][j][2] * v[rr][j][2] + v[rr][j][3] * v[rr][j][3]);
            rstd[rr] = 1.0f / sqrtf(wave_sum(s, lane) * (1.0f / D) + NORM_EPS); }
        if (MODE == 2) {
#pragma unroll
            for (int j = 0; j < 8; ++j) { const f32x4 gg = ggv[j];
#pragma unroll
                for (int rr = 0; rr < 2; ++rr) ((GAS f32x4*)((float*)xd + (size_t)(row + rr) * D) + lane)[64 * j] = v[rr][j] * rstd[rr] * gg; }
        } else {
#pragma unroll
            for (int j = 0; j < 8; ++j) { const f32x4 gg = ggv[j] * (scv[j] + 1.0f), ss = ssv[j];
#pragma unroll
                for (int rr = 0; rr < 2; ++rr) { const f32x4 hh = v[rr][j] * rstd[rr] * gg + ss;
#if PROJ_F8
                    ((GAS unsigned*)((unsigned char*)hout + (size_t)(row + rr) * D) + lane)[64 * j] = pk_fp8x4_ns(hh[0], hh[1], hh[2], hh[3]);
#else
                    u32x2 w; w.x = pk2(hh[0], hh[1]); w.y = pk2(hh[2], hh[3]); ((GAS u32x2*)(hout + (size_t)(row + rr) * D) + lane)[64 * j] = w;
#endif
                } }
        }
    }
}

__device__ __forceinline__ float reduce16(const float (&p)[NE], int lane) {
    float q[8], r[4], s2[2];
    const bool h5 = (lane & 32) != 0, h4 = (lane & 16) != 0, h3 = (lane & 8) != 0, h2 = (lane & 4) != 0;
#pragma unroll
    for (int i = 0; i < 8; ++i) q[i] = (h5 ? p[i + 8] : p[i]) + sx<32>(h5 ? p[i] : p[i + 8], lane);
#pragma unroll
    for (int i = 0; i < 4; ++i) r[i] = (h4 ? q[i + 4] : q[i]) + sx<16>(h4 ? q[i] : q[i + 4], lane);
#pragma unroll
    for (int i = 0; i < 2; ++i) s2[i] = (h3 ? r[i + 2] : r[i]) + sx<8>(h3 ? r[i] : r[i + 2], lane);
    float t = (h2 ? s2[1] : s2[0]) + sx<4>(h2 ? s2[0] : s2[1], lane);
    t += sx<2>(t, lane); t += sx<1>(t, lane);
    return t;
}
__device__ __forceinline__ void route_token(float affl, float sell, int& i0, int& i1, float& w0, float& w1) {
    float aff[NE], sel[NE];
#pragma unroll
    for (int e = 0; e < NE; ++e) { aff[e] = __builtin_bit_cast(float, __builtin_amdgcn_readlane(__builtin_bit_cast(int, affl), 4 * e)); sel[e] = __builtin_bit_cast(float, __builtin_amdgcn_readlane(__builtin_bit_cast(int, sell), 4 * e)); }
    float gs[4];
#pragma unroll
    for (int g = 0; g < 4; ++g) { const float a = sel[4 * g], b = sel[4 * g + 1], c = sel[4 * g + 2], d = sel[4 * g + 3];
        const float h1 = fmaxf(a, b), l1 = fminf(a, b), h2 = fmaxf(c, d), l2 = fminf(c, d);
        gs[g] = fmaxf(h1, h2) + fmaxf(fminf(h1, h2), fmaxf(l1, l2)); }
    int bg = 0; float best = gs[0];
#pragma unroll
    for (int g = 1; g < 4; ++g) { const bool c = gs[g] > best; best = c ? gs[g] : best; bg = c ? g : bg; }
    float s0 = -3.0e38f, s1 = -3.0e38f, a0 = 0.f, a1 = 0.f; int j0 = 0, j1 = 0;
#pragma unroll
    for (int j = 0; j < 4; ++j) {
        const float v = bg == 0 ? sel[j] : (bg == 1 ? sel[4 + j] : (bg == 2 ? sel[8 + j] : sel[12 + j]));
        const float af = bg == 0 ? aff[j] : (bg == 1 ? aff[4 + j] : (bg == 2 ? aff[8 + j] : aff[12 + j]));
        const bool gt0 = v > s0, gt1 = v > s1;
        s1 = gt0 ? s0 : (gt1 ? v : s1); j1 = gt0 ? j0 : (gt1 ? j : j1); a1 = gt0 ? a0 : (gt1 ? af : a1);
        s0 = gt0 ? v : s0; j0 = gt0 ? j : j0; a0 = gt0 ? af : a0; }
    i0 = 4 * bg + j0; i1 = 4 * bg + j1;
    const float inv = 1.0f / (a0 + a1); w0 = a0 * inv; w1 = a1 * inv;
}
__device__ __forceinline__ void router_phase(const bf16_t* xs, bf16_t* hout, const float* gain, const float* ada_scale, const float* ada_shift, const float* w_router, const float* b_router,
                                             unsigned* cnt, int* rlist, int* tslot, float* tw, LAS unsigned char* lds, int vcu, int G, int tid, int wave, int lane) {
    LAS float* wrT = (LAS float*)lds;
    LAS int* misc = (LAS int*)(lds + MISC_OFF + 64);
    LAS int* lcnt = misc; LAS int* lbase = misc + 16; LAS int* rinfo = misc + 32;
    for (int c = tid; c < D; c += NTHREADS) {
        const f32x4 w0 = *(const f32x4*)(w_router + c * 16), w1 = *(const f32x4*)(w_router + c * 16 + 4), w2 = *(const f32x4*)(w_router + c * 16 + 8), w3 = *(const f32x4*)(w_router + c * 16 + 12);
#pragma unroll
        for (int e = 0; e < 4; ++e) { wrT[e * D + c] = w0[e]; wrT[(4 + e) * D + c] = w1[e]; wrT[(8 + e) * D + c] = w2[e]; wrT[(12 + e) * D + c] = w3[e]; } }
    const int rows_per_blk = T / G;
    for (int base = vcu * rows_per_blk; base < T; base += G * rows_per_blk) {
        if (tid < 16) lcnt[tid] = 0;
        __syncthreads();
        const int rpw = rows_per_blk / NWAVES;
        for (int k = 0; k < rpw; k += 2) {
            const int lr = wave * rpw + k, row = base + lr, b = row >> 11;
            f32x4 v[2][8]; float rstd[2];
#pragma unroll
            for (int rr = 0; rr < 2; ++rr) { const GAS u32x2* xr = (const GAS u32x2*)(xs + (size_t)(row + rr) * D) + lane;
#pragma unroll
                for (int j = 0; j < 8; ++j) { const u32x2 r = xr[64 * j]; v[rr][j] = (f32x4){bflo(r.x), bfhi(r.x), bflo(r.y), bfhi(r.y)}; } }
            f32x4 ggv[8], ssv[8];
            { const GAS f32x4* sc = (const GAS f32x4*)(ada_scale + (size_t)b * 12288) + lane; const GAS f32x4* sh = (const GAS f32x4*)(ada_shift + (size_t)b * 12288) + lane;
#pragma unroll
              for (int j = 0; j < 8; ++j) { ggv[j] = sc[64 * j]; ssv[j] = sh[64 * j]; }
              asm volatile("" ::: "memory"); }
#pragma unroll
            for (int rr = 0; rr < 2; ++rr) { float s = 0.f;
#pragma unroll
                for (int j = 0; j < 8; ++j) s += (v[rr][j][0] * v[rr][j][0] + v[rr][j][1] * v[rr][j][1]) + (v[rr][j][2] * v[rr][j][2] + v[rr][j][3] * v[rr][j][3]);
                rstd[rr] = 1.0f / sqrtf(wave_sum(s, lane) * (1.0f / D) + NORM_EPS); }
#pragma unroll
            for (int jb = 0; jb < 8; jb += 4) {
#pragma unroll
                for (int jj = 0; jj < 4; ++jj) { const int j = jb + jj; const f32x4 gg = ggv[j], ss = ssv[j];
#pragma unroll
                    for (int rr = 0; rr < 2; ++rr) { v[rr][j] = v[rr][j] * rstd[rr] * gg + ss;
                        ((GAS unsigned*)((unsigned char*)hout + (size_t)(row + rr) * D) + lane)[64 * j] = pk_fp8x4_ns(v[rr][j][0], v[rr][j][1], v[rr][j][2], v[rr][j][3]); } }
                asm volatile("" ::: "memory"); }
            float p0[NE], p1[NE];
            f32x4 wA[8], wB[8];
#define RT_RD(W, e) do { _Pragma("unroll") for (int j = 0; j < 8; ++j) W[j] = *(const LAS f32x4*)(wrT + (e) * D + 4 * lane + 256 * j); asm volatile("" ::: "memory"); } while (0)
#define RT_FMA(W, e) do { f32x2 a0 = {0.f, 0.f}, a1 = {0.f, 0.f}; _Pragma("unroll") for (int j = 0; j < 8; ++j) { LPIN(W[j]); const f32x2 wl = {W[j][0], W[j][1]}, wh = {W[j][2], W[j][3]}; \
                a0 = __builtin_elementwise_fma((f32x2){v[0][j][0], v[0][j][1]}, wl, a0); a0 = __builtin_elementwise_fma((f32x2){v[0][j][2], v[0][j][3]}, wh, a0); \
                a1 = __builtin_elementwise_fma((f32x2){v[1][j][0], v[1][j][1]}, wl, a1); a1 = __builtin_elementwise_fma((f32x2){v[1][j][2], v[1][j][3]}, wh, a1); } \
                p0[e] = a0[0] + a0[1]; p1[e] = a1[0] + a1[1]; } while (0)
            RT_RD(wA, 0);
#pragma unroll
            for (int e = 0; e < NE; e += 2) { RT_RD(wB, e + 1); RT_FMA(wA, e); if (e + 2 < NE) RT_RD(wA, e + 2); RT_FMA(wB, e + 1); }
#undef RT_RD
#undef RT_FMA
            const float t0 = reduce16(p0, lane), t1 = reduce16(p1, lane);
            const float bre = b_router[lane >> 2];
#pragma unroll
            for (int rr = 0; rr < 2; ++rr) {
                const float affl = sigmoidf_(rr ? t1 : t0), sell = affl + bre;
                int i0, i1; float w0, w1; route_token(affl, sell, i0, i1, w0, w1);
                if (lane == 0) { const int r0 = atomicAdd((int*)lcnt + i0, 1), r1 = atomicAdd((int*)lcnt + i1, 1);
                    rinfo[(lr + rr) * 4 + 0] = (i0 << 16) | r0; rinfo[(lr + rr) * 4 + 1] = (i1 << 16) | r1;
                    tw[(row + rr) * 2] = w0; tw[(row + rr) * 2 + 1] = w1; } }
        }
        __syncthreads();
        if (tid < 16) lbase[tid] = (int)__hip_atomic_fetch_add(cnt + 64 * tid, (unsigned)lcnt[tid], RLX_AGENT);
        __syncthreads();
        if (tid < rows_per_blk * 2) { const int lr = tid >> 1, kk = tid & 1, info = rinfo[lr * 4 + kk], e = info >> 16, rank = lbase[e] + (info & 0xffff);
            rlist[(size_t)e * T + rank] = base + lr; tslot[(base + lr) * 2 + kk] = (e << 16) | rank; }
        __syncthreads();
    }
}

__device__ __forceinline__ int swz256(int row, int ch) { return 256 * row + 16 * (ch ^ (((row & 3) << 2) | ((row >> 2) & 3))); }
typedef short v4i16_t __attribute__((ext_vector_type(4)));
__device__ __forceinline__ s16x4 vtr(const LAS unsigned char* p) { return __builtin_bit_cast(s16x4, __builtin_amdgcn_ds_read_tr16_b64_v4i16((LAS v4i16_t*)p)); }

struct AttnPre { u32x4 kv[8]; bf16x8 qf[4]; };
__device__ __forceinline__ void attn_issue(AttnPre& R, const bf16_t* proj, int a, int tid, int wave, int lane) {
    const int sub = a & 15, bh = a >> 4, head = bh % 12, b = bh / 12, g = head >> 2;
    const int dsh = 2 * g, nbsh = 4 - 2 * g;
    const int nblk = sub & ((1 << nbsh) - 1), r = sub >> nbsh;
    const size_t tb = (size_t)b * SEQ;
    const int p0 = 128 * (nblk - 1);
#pragma unroll
    for (int it = 0; it < 8; ++it) { const int id = tid + NTHREADS * it, row = id >> 4, ch = id & 15, p = p0 + row;
        const int pc = p < 0 ? 0 : p;
        const size_t t = tb + ((size_t)pc << dsh) + r; R.kv[it] = *(const u32x4*)(proj + t * NP + KA + head * 128 + ch * 8); }
    const int fr = lane & 15, fq = lane >> 4, qi = 16 * wave + fr;
    const size_t tq = tb + ((size_t)(128 * nblk + qi) << dsh) + r;
    const bf16_t* qsrc = proj + tq * NP + QA + head * 128 + fq * 8;
#pragma unroll
    for (int ks = 0; ks < 4; ++ks) R.qf[ks] = *(const bf16x8*)(qsrc + 32 * ks);
}
__device__ __forceinline__ void attn_unit(LAS unsigned char* lds, AttnPre& R, const bf16_t* proj, bf16_t* atto, float* lse, int a, int a_next, int tid, int wave, int lane) {
    const int sub = a & 15, bh = a >> 4, head = bh % 12, b = bh / 12, g = head >> 2, hj = head & 3;
    const int dsh = 2 * g, nbsh = 4 - 2 * g;
    const int nblk = sub & ((1 << nbsh) - 1), r = sub >> nbsh;
    const size_t tb = (size_t)b * SEQ;
    const int p0 = 128 * (nblk - 1);
    LAS unsigned char* Kl = lds; LAS unsigned char* Vl = lds + 65536;
#pragma unroll
    for (int it = 0; it < 8; ++it) { const int id = tid + NTHREADS * it, row = id >> 4, ch = id & 15; *(LAS u32x4*)(Kl + swz256(row, ch)) = R.kv[it]; }
    u32x4 vv[8];
#pragma unroll
    for (int it = 0; it < 8; ++it) { const int id = tid + NTHREADS * it, row = id >> 4, ch = id & 15, p = p0 + row;
        const int pc = p < 0 ? 0 : p;
        const size_t t = tb + ((size_t)pc << dsh) + r; vv[it] = *(const u32x4*)(proj + t * NP + VA + head * 128 + ch * 8); }
    const int fr = lane & 15, fq = lane >> 4;
    const int qi = 16 * wave + fr;
    const size_t tq = tb + ((size_t)(128 * nblk + qi) << dsh) + r;
    bf16x8 qf[4];
#pragma unroll
    for (int ks = 0; ks < 4; ++ks) qf[ks] = R.qf[ks];
    __syncthreads();
    f32x4 sacc[9];
    unsigned kbase[4];
    { const int fK = ((fr & 3) << 2) | ((fr >> 2) & 3);
#pragma unroll
        for (int ks = 0; ks < 4; ++ks) kbase[ks] = (unsigned)(256 * (16 * wave + fr) + 16 * ((4 * ks + fq) ^ fK)); }
#pragma unroll
    for (int kt = 0; kt < 9; ++kt) { f32x4 acc = (f32x4){0.f, 0.f, 0.f, 0.f};
#pragma unroll
        for (int ks = 0; ks < 4; ++ks) { const bf16x8 kf = *(const LAS bf16x8*)(Kl + kbase[ks] + 4096 * kt); acc = __builtin_amdgcn_mfma_f32_16x16x32_bf16(kf, qf[ks], acc, 0, 0, 0); }
        sacc[kt] = acc; }
    const float sc = 0.12751743082459868f;
    float mx = -3.0e38f;
#pragma unroll
    for (int kt = 0; kt < 9; ++kt)
#pragma unroll
        for (int rg = 0; rg < 4; ++rg) { const int jk = 16 * (wave + kt) + 4 * fq + rg; const bool valid = (jk >= qi) && (jk <= qi + 128) && (p0 + jk >= 0);
            const float s = valid ? sacc[kt][rg] * sc : -3.0e38f; sacc[kt][rg] = s; mx = fmaxf(mx, s); }
    mx = fmaxf(mx, sx<16>(mx, lane)); mx = fmaxf(mx, sx<32>(mx, lane));
    float sum = 0.f;
#pragma unroll
    for (int kt = 0; kt < 9; ++kt)
#pragma unroll
        for (int rg = 0; rg < 4; ++rg) { const float p = __builtin_amdgcn_exp2f(sacc[kt][rg] - mx); sacc[kt][rg] = p; sum += p; }
    sum += sx<16>(sum, lane); sum += sx<32>(sum, lane);
#pragma unroll
    for (int it = 0; it < 8; ++it) { const int id = tid + NTHREADS * it, row = id >> 4, ch = id & 15; *(LAS u32x4*)(Vl + swz256(row, ch)) = vv[it]; }
    __syncthreads();
    if (a_next >= 0) attn_issue(R, proj, a_next, tid, wave, lane);
    f32x4 oacc[8];
#pragma unroll
    for (int dt = 0; dt < 8; ++dt) oacc[dt] = (f32x4){0.f, 0.f, 0.f, 0.f};
    const int li = lane & 15, qq = li >> 2, pp = li & 3;
    unsigned vbase[8];
    { const int fV = (qq << 2) | fq;
#pragma unroll
        for (int dt = 0; dt < 8; ++dt) vbase[dt] = (unsigned)(256 * (16 * wave + 4 * fq + qq) + 16 * ((2 * dt + (pp >> 1)) ^ fV) + 8 * (pp & 1)); }
#pragma unroll
    for (int s5 = 0; s5 < 5; ++s5) {
        const int t0 = 2 * s5, t1 = (2 * s5 + 1 < 9) ? 2 * s5 + 1 : 2 * s5;
        u32x4 pw; pw.x = pk2(sacc[t0][0], sacc[t0][1]); pw.y = pk2(sacc[t0][2], sacc[t0][3]);
        if (2 * s5 + 1 < 9) { pw.z = pk2(sacc[t1][0], sacc[t1][1]); pw.w = pk2(sacc[t1][2], sacc[t1][3]); } else { pw.z = 0u; pw.w = 0u; }
        const bf16x8 pf = __builtin_bit_cast(bf16x8, pw);
#pragma unroll
        for (int dt = 0; dt < 8; ++dt) {
            const s16x4 v0 = vtr(Vl + vbase[dt] + 4096 * t0);
            const s16x4 v1 = vtr(Vl + vbase[dt] + 4096 * t1);
            bf16x8 vf; vf[0] = v0[0]; vf[1] = v0[1]; vf[2] = v0[2]; vf[3] = v0[3]; vf[4] = v1[0]; vf[5] = v1[1]; vf[6] = v1[2]; vf[7] = v1[3];
            oacc[dt] = __builtin_amdgcn_mfma_f32_16x16x32_bf16(vf, pf, oacc[dt], 0, 0, 0);
        }
    }
    const float inv = 1.0f / sum;
    bf16_t* op = atto + ((size_t)g * T + tq) * 512 + hj * 128 + 4 * fq;
#pragma unroll
    for (int dt = 0; dt < 8; ++dt) { u32x2 w; w.x = pk2(oacc[dt][0] * inv, oacc[dt][1] * inv); w.y = pk2(oacc[dt][2] * inv, oacc[dt][3] * inv); *(u32x2*)(op + 16 * dt) = w; }
    if (fq == 0) lse[((size_t)g * T + tq) * 4 + hj] = mx * 0.6931471805599453f + __logf(sum);
    __syncthreads();
}

__device__ __forceinline__ int swz512(int row, int ch) { return 512 * row + 16 * (ch ^ (((row & 3) << 2) | ((row >> 2) & 3))); }

struct GlaPre { float al0, al1; u32x4 q[2], k[2], v[4]; };
__device__ __forceinline__ void gla_local_issue(GlaPre& R, const bf16_t* proj, const float* alow, int u, int tid) {
    const int n = u & 31, h = (u >> 5) & 3, b = u >> 7;
    const size_t t0 = (size_t)b * SEQ + 64 * n;
    R.al0 = alow[t0 * 16 + tid]; R.al1 = alow[t0 * 16 + 512 + tid];
#pragma unroll
    for (int it = 0; it < 2; ++it) { const int id = tid + NTHREADS * it, row = id >> 4, ch = id & 15; const bf16_t* src = proj + (t0 + row) * NP + h * 128 + ch * 8; R.q[it] = *(const u32x4*)(src + QB); R.k[it] = *(const u32x4*)(src + KB); }
#pragma unroll
    for (int it = 0; it < 4; ++it) { const int id = tid + NTHREADS * it, row = id >> 5, ch = id & 31; R.v[it] = *(const u32x4*)(proj + (t0 + row) * NP + VB + h * 256 + ch * 8); }
}
__device__ __forceinline__ void gla_local_unit(LAS unsigned char* lds, GlaPre& R, const bf16_t* proj, const float* alow, const float (&w2)[16], const float bias,
                                               bf16_t* qdg, bf16_t* oig, bf16_t* dstg, float* decg, int u, int u_next, int tid, int wave, int lane) {
    const int n = u & 31, h = (u >> 5) & 3, b = u >> 7;
    const int d = tid & 127, ig = tid >> 7;
    const int fr = lane & 15, fq = lane >> 4;
    LAS unsigned char* QD = lds; LAS unsigned char* KI = lds + 17408; LAS unsigned char* KET = lds + 34816; LAS unsigned char* VL = lds + 53248;
    LAS unsigned char* AT = lds + 86016;
    LAS float* CS = (LAS float*)(lds + 95232); LAS float* ALs = (LAS float*)(lds + 97280);
    const size_t t0 = (size_t)b * SEQ + 64 * n;
#pragma unroll
    for (int it = 0; it < 2; ++it) { const int id = tid + NTHREADS * it, row = id >> 4, ch = id & 15; *(LAS u32x4*)(QD + row * 272 + ch * 16) = R.q[it]; *(LAS u32x4*)(KI + row * 272 + ch * 16) = R.k[it]; }
    ALs[tid] = R.al0; ALs[512 + tid] = R.al1;
#pragma unroll
    for (int it = 0; it < 4; ++it) { const int id = tid + NTHREADS * it, row = id >> 5, ch = id & 31; *(LAS u32x4*)(VL + swz512(row, ch)) = R.v[it]; }
    __syncthreads();
    if (u_next >= 0) gla_local_issue(R, proj, alow, u_next, tid);
    float bl[16]; float run = 0.f;
#pragma unroll
    for (int ii = 0; ii < 16; ++ii) { float z = bias; const LAS f32x4* ap = (const LAS f32x4*)(ALs + (16 * ig + ii) * 16);
#pragma unroll
        for (int r4 = 0; r4 < 4; ++r4) { const f32x4 av = ap[r4]; z = fmaf(av[0], w2[4 * r4], z); z = fmaf(av[1], w2[4 * r4 + 1], z); z = fmaf(av[2], w2[4 * r4 + 2], z); z = fmaf(av[3], w2[4 * r4 + 3], z); }
        const float la = (fminf(z, 0.f) - __logf(1.0f + __expf(-fabsf(z)))) * 0.0625f; run += la; bl[ii] = run; }
    CS[ig * 128 + d] = run;
    __syncthreads();
    float pre = 0.f, tot = 0.f;
#pragma unroll
    for (int g2 = 0; g2 < 4; ++g2) { const float cv = CS[g2 * 128 + d]; tot += cv; pre += (g2 < ig) ? cv : 0.f; }
    const float qscale = 0.08838834764831845f; const float etot = __expf(tot);
    unsigned ke[8];
#pragma unroll
    for (int ii = 0; ii < 16; ++ii) { const float bb = pre + bl[ii];
        LAS bf16_t* qp = (LAS bf16_t*)(QD + (16 * ig + ii) * 272 + 2 * d); LAS bf16_t* kp = (LAS bf16_t*)(KI + (16 * ig + ii) * 272 + 2 * d);
        const float qf_ = bf2f(*qp), kf_ = bf2f(*kp);
        const float eb = __expf(bb), einv = __builtin_amdgcn_rcpf(eb);
        const float qd = qf_ * qscale * eb, ki = kf_ * einv, kend = kf_ * (etot * einv);
        *qp = (bf16_t)f2bf(qd); *kp = (bf16_t)f2bf(ki);
        if (ii & 1) ke[ii >> 1] |= f2bf(kend) << 16; else ke[ii >> 1] = f2bf(kend); }
    *(LAS u32x4*)(KET + d * 144 + 32 * ig) = (u32x4){ke[0], ke[1], ke[2], ke[3]}; *(LAS u32x4*)(KET + d * 144 + 32 * ig + 16) = (u32x4){ke[4], ke[5], ke[6], ke[7]};
    if (ig == 0) decg[(size_t)u * 128 + d] = etot;
    __syncthreads();
#pragma unroll
    for (int it = 0; it < 2; ++it) { const int id = tid + NTHREADS * it, row = id >> 4, ch = id & 15; *(u32x4*)(qdg + ((size_t)(b * 4 + h) * 32 + n) * 8192 + (size_t)((((row >> 4) * 4 + (ch >> 2)) * 64 + (row & 15) * 4 + (ch & 3)) * 8)) = *(const LAS u32x4*)(QD + row * 272 + ch * 16); }
#pragma unroll
    for (int x = 0; x < 2; ++x) { const int id = 2 * wave + x, ti = id >> 2, tj = id & 3; f32x4 acc = (f32x4){0.f, 0.f, 0.f, 0.f};
        if (tj <= ti) {
#pragma unroll
            for (int ks = 0; ks < 4; ++ks) { const bf16x8 af = *(const LAS bf16x8*)(QD + (16 * ti + fr) * 272 + (32 * ks + 8 * fq) * 2); const bf16x8 bfr = *(const LAS bf16x8*)(KI + (16 * tj + fr) * 272 + (32 * ks + 8 * fq) * 2);
                acc = __builtin_amdgcn_mfma_f32_16x16x32_bf16(af, bfr, acc, 0, 0, 0); } }
#pragma unroll
        for (int rg = 0; rg < 4; ++rg) { const int i = 16 * ti + 4 * fq + rg, j = 16 * tj + fr; const float vv = (i >= j) ? acc[rg] : 0.f; *(LAS bf16_t*)(AT + i * 144 + 2 * j) = (bf16_t)f2bf(vv); } }
    bf16x8 vfr[2][2];
    { const int li = lane & 15, qq = li >> 2, pp = li & 3;
#pragma unroll
        for (int tv = 0; tv < 2; ++tv)
#pragma unroll
            for (int ks = 0; ks < 2; ++ks) { const int vt = 2 * wave + tv;
                const int r0 = 32 * ks + 8 * fq + qq, r1 = r0 + 4;
                const s16x4 a0 = vtr(VL + swz512(r0, 2 * vt + (pp >> 1)) + 8 * (pp & 1)), a1 = vtr(VL + swz512(r1, 2 * vt + (pp >> 1)) + 8 * (pp & 1));
                bf16x8 f; f[0] = a0[0]; f[1] = a0[1]; f[2] = a0[2]; f[3] = a0[3]; f[4] = a1[0]; f[5] = a1[1]; f[6] = a1[2]; f[7] = a1[3]; vfr[tv][ks] = f; } }
#pragma unroll
    for (int dt = 0; dt < 8; ++dt) {
        bf16x8 kf[2];
#pragma unroll
        for (int ks = 0; ks < 2; ++ks) kf[ks] = *(const LAS bf16x8*)(KET + (16 * dt + fr) * 144 + (32 * ks + 8 * fq) * 2);
#pragma unroll
        for (int tv = 0; tv < 2; ++tv) { f32x4 acc = (f32x4){0.f, 0.f, 0.f, 0.f};
#pragma unroll
            for (int ks = 0; ks < 2; ++ks) acc = __builtin_amdgcn_mfma_f32_16x16x32_bf16(kf[ks], vfr[tv][ks], acc, 0, 0, 0);
            u32x2 w; w.x = pk2(acc[0], acc[1]); w.y = pk2(acc[2], acc[3]);
            *(u32x2*)(dstg + (((size_t)(b * 4 + h) * 8 + wave) * 32 + n) * 4096 + (size_t)(((dt * 2 + tv) * 64 + fr * 4 + fq) * 4)) = w; } }
    __syncthreads();
#pragma unroll
    for (int ti = 0; ti < 4; ++ti) {
        bf16x8 af[2];
#pragma unroll
        for (int ks = 0; ks < 2; ++ks) af[ks] = *(const LAS bf16x8*)(AT + (16 * ti + fr) * 144 + (32 * ks + 8 * fq) * 2);
#pragma unroll
        for (int tv = 0; tv < 2; ++tv) { f32x4 acc = (f32x4){0.f, 0.f, 0.f, 0.f};
#pragma unroll
            for (int ks = 0; ks < 2; ++ks) acc = __builtin_amdgcn_mfma_f32_16x16x32_bf16(vfr[tv][ks], af[ks], acc, 0, 0, 0);
            u32x2 w; w.x = pk2(acc[0], acc[1]); w.y = pk2(acc[2], acc[3]);
            *(u32x2*)(oig + (((size_t)(b * 4 + h) * 8 + wave) * 32 + n) * 2048 + (size_t)(((ti * 2 + tv) * 64 + fr * 4 + fq) * 4)) = w; } }
    __syncthreads();
}

template <bool FAKE>
__device__ __forceinline__ void gla_scan_unit(LAS unsigned char* lds, const bf16_t* qdg, const bf16_t* oig, const bf16_t* dstg, const float* decg, bf16_t* ob, float* ssq,
                                              int u, int tid, int wave, int lane) {
    const int vs = u & 7, h = (u >> 3) & 3, b = u >> 5;
    const int fr = lane & 15, fq = lane >> 4;
    const int ti = wave >> 1, tv = wave & 1;
    LAS unsigned char* STb = lds;
    LAS unsigned char* OBL = lds + 20480;
    LAS float* SQL = (LAS float*)(lds + 53248);
    f32x4 sst[2]; sst[0] = (f32x4){0.f, 0.f, 0.f, 0.f}; sst[1] = sst[0];
    { unsigned z0 = 0u; asm volatile("" : "+v"(z0)); *(LAS u32x4*)(STb + tid * 16) = (u32x4){z0, z0, z0, z0}; if (tid < 32) *(LAS u32x4*)(STb + 8192 + tid * 16) = (u32x4){z0, z0, z0, z0}; }
    const int ub = (b * 4 + h) * 32;
    struct StepOps { bf16x8 q[4]; u32x2 o; u32x2 ds[2]; f32x4 dc; };
    const unsigned qoff = (unsigned)((ti * 4 * 64 + fr * 4 + fq) * 16), ooff = (unsigned)(((ti * 2 + tv) * 64 + fr * 4 + fq) * 8);
    const unsigned dsoff = (unsigned)(((wave * 2) * 64 + fr * 4 + fq) * 8), dcoff = (unsigned)(16 * wave + 4 * fq) * 4u;
    const char* qbase = (const char*)(qdg + (size_t)(b * 4 + h) * SEQ * 128);
    const char* obase = (const char*)(oig + ((size_t)(b * 4 + h) * 8 + vs) * SEQ * 32);
    const char* dsbase = (const char*)(dstg + ((size_t)(b * 4 + h) * 8 + vs) * 32 * 32 * 128);
    const char* dcbase = (const char*)(decg + (size_t)ub * 128);
#define GLA_LOAD(R, nn_) do { const int nn = FAKE ? 0 : ((nn_) < 32 ? (nn_) : 31); \
        const char* qs_ = qbase + (size_t)nn * 16384; _Pragma("unroll") for (int ks = 0; ks < 4; ++ks) R.q[ks] = *(const bf16x8*)(qs_ + qoff + 1024 * ks); \
        R.o = *(const u32x2*)(obase + (size_t)nn * 4096 + ooff); \
        _Pragma("unroll") for (int t2 = 0; t2 < 2; ++t2) R.ds[t2] = *(const u32x2*)(dsbase + (size_t)nn * 8192 + 512 * t2 + dsoff); \
        R.dc = *(const f32x4*)(dcbase + (size_t)nn * 512 + dcoff); } while (0)
#define GLA_STEP(R, n_) do { const int n = (n_); const size_t t0 = (size_t)b * SEQ + 64 * n; \
        LAS unsigned char* STc = STb + (n & 1) * 8704; LAS unsigned char* STn = STb + ((n + 1) & 1) * 8704; \
        f32x4 acc; acc[0] = bflo(R.o.x); acc[1] = bfhi(R.o.x); acc[2] = bflo(R.o.y); acc[3] = bfhi(R.o.y); \
        _Pragma("unroll") for (int ks = 0; ks < 4; ++ks) { const bf16x8 sfr = *(const LAS bf16x8*)(STc + (16 * tv + fr) * 272 + (32 * ks + 8 * fq) * 2); acc = __builtin_amdgcn_mfma_f32_16x16x32_bf16(sfr, R.q[ks], acc, 0, 0, 0); } \
        { u32x2 w; w.x = pk2(acc[0], acc[1]); w.y = pk2(acc[2], acc[3]);              \
            *(LAS u32x2*)(OBL + (n & 7) * 4096 + (16 * ti + fr) * 64 + (16 * tv + 4 * fq) * 2) = w; \
            float q2 = (acc[0] * acc[0] + acc[1] * acc[1]) + (acc[2] * acc[2] + acc[3] * acc[3]); q2 += sx<16>(q2, lane); q2 += sx<32>(q2, lane); \
            if (fq == 0) SQL[(n & 7) * 128 + (16 * ti + fr) * 2 + tv] = q2; } \
        _Pragma("unroll") for (int t2 = 0; t2 < 2; ++t2) { \
            sst[t2][0] = sst[t2][0] * R.dc[0] + bflo(R.ds[t2].x); sst[t2][1] = sst[t2][1] * R.dc[1] + bfhi(R.ds[t2].x); \
            sst[t2][2] = sst[t2][2] * R.dc[2] + bflo(R.ds[t2].y); sst[t2][3] = sst[t2][3] * R.dc[3] + bfhi(R.ds[t2].y); \
            u32x2 w; w.x = pk2(sst[t2][0], sst[t2][1]); w.y = pk2(sst[t2][2], sst[t2][3]); \
            *(LAS u32x2*)(STn + (16 * t2 + fr) * 272 + (16 * wave + 4 * fq) * 2) = w; } \
        __syncthreads(); \
        if (!FAKE && (n & 7) == 7) { const size_t tf = (size_t)b * SEQ + 64 * (n - 7); \
            _Pragma("unroll") for (int it = 0; it < 4; ++it) { const int id = tid + NTHREADS * it, sf = id >> 8, row = (id >> 2) & 63, c = id & 3; \
                *(u32x4*)(ob + (tf + 64 * sf + row) * 1024 + h * 256 + 32 * vs + 8 * c) = *(const LAS u32x4*)(OBL + id * 16); } \
            _Pragma("unroll") for (int it = 0; it < 2; ++it) { const int id = tid + NTHREADS * it, sf = id >> 7, row = (id >> 1) & 63, tq = id & 1; \
                ssq[((tf + 64 * sf + row) * 4 + h) * 16 + vs * 2 + tq] = SQL[id]; } \
            __syncthreads(); } } while (0)
    StepOps r0, r1, r2, r3;
    GLA_LOAD(r0, 0); GLA_LOAD(r1, 1); GLA_LOAD(r2, 2);
    __syncthreads();
    for (int n4 = 0; n4 < 32; n4 += 4) {
        GLA_LOAD(r3, n4 + 3); GLA_STEP(r0, n4);
        GLA_LOAD(r0, n4 + 4); GLA_STEP(r1, n4 + 1);
        GLA_LOAD(r1, n4 + 5); GLA_STEP(r2, n4 + 2);
        GLA_LOAD(r2, n4 + 6); GLA_STEP(r3, n4 + 3);
    }
#undef GLA_STEP
#undef GLA_LOAD
}

__device__ __forceinline__ void merge_phase(const bf16_t* atto, const float* lse, const bf16_t* ob, const float* ssq, const bf16_t* proj, const float* gla_gain, bf16_t* ya, bf16_t* yb,
                                            int vcu, int G, int wave, int lane) {
    const int gw = vcu * NWAVES + wave, NGW = G * NWAVES;
    const int hj = lane >> 4;
    f32x4 g0[2], g1[2];
#pragma unroll
    for (int c = 0; c < 2; ++c) { const int col = 8 * lane + 512 * c; g0[c] = *(const f32x4*)(gla_gain + col); g1[c] = *(const f32x4*)(gla_gain + col + 4); }
    for (int row0 = 2 * gw; row0 < T; row0 += 2 * NGW) {
        float l0[2], l1[2], l2[2]; u32x4 a0[2], a1[2], a2[2], o[2][2], rr_[2][2]; f32x4 sq[2][2][4];
#pragma unroll
        for (int r = 0; r < 2; ++r) { const int row = row0 + r;
            l0[r] = lse[((size_t)0 * T + row) * 4 + hj]; l1[r] = lse[((size_t)1 * T + row) * 4 + hj]; l2[r] = lse[((size_t)2 * T + row) * 4 + hj];
            a0[r] = *(const u32x4*)(atto + ((size_t)0 * T + row) * 512 + 8 * lane); a1[r] = *(const u32x4*)(atto + ((size_t)1 * T + row) * 512 + 8 * lane); a2[r] = *(const u32x4*)(atto + ((size_t)2 * T + row) * 512 + 8 * lane);
#pragma unroll
            for (int c = 0; c < 2; ++c) { const int col = 8 * lane + 512 * c, hh = col >> 8;
                const f32x4* sp = (const f32x4*)(ssq + ((size_t)row * 4 + hh) * 16); sq[r][c][0] = sp[0]; sq[r][c][1] = sp[1]; sq[r][c][2] = sp[2]; sq[r][c][3] = sp[3];
                o[r][c] = *(const u32x4*)(ob + (size_t)row * 1024 + col);
#if GATE_F8
                { const u32x2 r8 = *(const u32x2*)((const unsigned char*)proj + (size_t)row * NP * 2 + G8_BYTE0 + col); rr_[r][c] = (u32x4){r8.x, r8.y, 0u, 0u}; }
#else
                rr_[r][c] = *(const u32x4*)(proj + (size_t)row * NP + RB + col);
#endif
            } }
#pragma unroll
        for (int r = 0; r < 2; ++r) { const int row = row0 + r;
            const float m = fmaxf(l0[r], fmaxf(l1[r], l2[r])); float e0 = __expf(l0[r] - m), e1 = __expf(l1[r] - m), e2 = __expf(l2[r] - m); const float inv = 1.0f / (e0 + e1 + e2); e0 *= inv; e1 *= inv; e2 *= inv;
            u32x4 w;
            w.x = pk2(e0 * bflo(a0[r].x) + e1 * bflo(a1[r].x) + e2 * bflo(a2[r].x), e0 * bfhi(a0[r].x) + e1 * bfhi(a1[r].x) + e2 * bfhi(a2[r].x));
            w.y = pk2(e0 * bflo(a0[r].y) + e1 * bflo(a1[r].y) + e2 * bflo(a2[r].y), e0 * bfhi(a0[r].y) + e1 * bfhi(a1[r].y) + e2 * bfhi(a2[r].y));
            w.z = pk2(e0 * bflo(a0[r].z) + e1 * bflo(a1[r].z) + e2 * bflo(a2[r].z), e0 * bfhi(a0[r].z) + e1 * bfhi(a1[r].z) + e2 * bfhi(a2[r].z));
            w.w = pk2(e0 * bflo(a0[r].w) + e1 * bflo(a1[r].w) + e2 * bflo(a2[r].w), e0 * bfhi(a0[r].w) + e1 * bfhi(a1[r].w) + e2 * bfhi(a2[r].w));
#if MIX_F8
            { u32x2 w8; w8.x = pk_fp8x4(bflo(w.x), bfhi(w.x), bflo(w.y), bfhi(w.y)); w8.y = pk_fp8x4(bflo(w.z), bfhi(w.z), bflo(w.w), bfhi(w.w)); *(u32x2*)((unsigned char*)ya + (BR_FUSE ? (size_t)row * 1536 + 1024 : (size_t)row * 512) + 8 * lane) = w8; }
#else
            *(u32x4*)(ya + (size_t)row * 512 + 8 * lane) = w;
#endif
#pragma unroll
            for (int c = 0; c < 2; ++c) { const int col = 8 * lane + 512 * c;
                const f32x4 s0 = sq[r][c][0], s1 = sq[r][c][1], s2 = sq[r][c][2], s3 = sq[r][c][3];
                const float tot = ((s0[0] + s0[1]) + (s0[2] + s0[3])) + ((s1[0] + s1[1]) + (s1[2] + s1[3])) + ((s2[0] + s2[1]) + (s2[2] + s2[3])) + ((s3[0] + s3[1]) + (s3[2] + s3[3]));
                const float rstd = 1.0f / sqrtf(tot * (1.0f / 256.0f) + NORM_EPS);
                const u32x4 ov = o[r][c], rv = rr_[r][c]; u32x4 y; float rf[8];
#if GATE_F8
                unpack_fp8x8((u32x2){rv.x, rv.y}, rf);
#else
                rf[0] = bflo(rv.x); rf[1] = bfhi(rv.x); rf[2] = bflo(rv.y); rf[3] = bfhi(rv.y); rf[4] = bflo(rv.z); rf[5] = bfhi(rv.z); rf[6] = bflo(rv.w); rf[7] = bfhi(rv.w);
#endif
                y.x = pk2(bflo(ov.x) * rstd * g0[c][0] * siluf_(rf[0]), bfhi(ov.x) * rstd * g0[c][1] * siluf_(rf[1]));
                y.y = pk2(bflo(ov.y) * rstd * g0[c][2] * siluf_(rf[2]), bfhi(ov.y) * rstd * g0[c][3] * siluf_(rf[3]));
                y.z = pk2(bflo(ov.z) * rstd * g1[c][0] * siluf_(rf[4]), bfhi(ov.z) * rstd * g1[c][1] * siluf_(rf[5]));
                y.w = pk2(bflo(ov.w) * rstd * g1[c][2] * siluf_(rf[6]), bfhi(ov.w) * rstd * g1[c][3] * siluf_(rf[7]));
#if MIX_F8
                { u32x2 y8; y8.x = pk_fp8x4(bflo(y.x), bfhi(y.x), bflo(y.y), bfhi(y.y)); y8.y = pk_fp8x4(bflo(y.z), bfhi(y.z), bflo(y.w), bfhi(y.w)); *(u32x2*)((unsigned char*)(BR_FUSE ? ya : yb) + (size_t)row * (BR_FUSE ? 1536 : 1024) + col) = y8; }
#else
                *(u32x4*)(yb + (size_t)row * 1024 + col) = y;
#endif
            } }
    }
}

constexpr int LS = 10;
__host__ __device__ constexpr int phase_kind(int k) { return k == 0 ? 0 : (k == 1 + DEPTH * LS ? LS + 1 : ((k - 1) % LS) + 1); }
constexpr int N_PHASES = 2 + DEPTH * LS;
typedef const __attribute__((address_space(4))) Args CArgs;
__device__ __forceinline__ CArgs* fresh_args() {
    unsigned long long v = (unsigned long long)__builtin_amdgcn_kernarg_segment_ptr();
    unsigned lo = (unsigned)v, hi = (unsigned)(v >> 32);
    asm volatile("" : "+s"(lo), "+s"(hi));
    lo = __builtin_amdgcn_readfirstlane(lo); hi = __builtin_amdgcn_readfirstlane(hi);
    return (CArgs*)(((unsigned long long)hi << 32) | lo);
}
template <unsigned MASK, bool ONE>
__global__ void __launch_bounds__(NTHREADS, 2) fwd_kernel(Args a_unused) {
    extern __shared__ __attribute__((aligned(16))) unsigned char lds_raw[];
    LAS unsigned char* lds = (LAS unsigned char*)lds_raw;
    const int wave0 = __builtin_amdgcn_readfirstlane((int)threadIdx.x >> 6);
    int lane = (int)__builtin_amdgcn_mbcnt_hi(~0u, __builtin_amdgcn_mbcnt_lo(~0u, 0u)), wave = wave0, tid = wave0 * 64 + lane;
    CArgs* ap = fresh_args();
    unsigned char* ws = ap->ws;
#define a (*ap)
#define FRESH_TID() do { ap = fresh_args(); ws = ap->ws; unsigned m1_ = ~0u; asm volatile("" : "+s"(m1_)); lane = (int)__builtin_amdgcn_mbcnt_hi(m1_, __builtin_amdgcn_mbcnt_lo(m1_, 0u)); asm volatile("" : "+v"(lane)); wave = wave0; tid = wave0 * 64 + lane; } while (0)
    const int G = gridDim.x; const int bx = blockIdx.x; const int vcu = (G % 8 == 0) ? (bx % 8) * (G / 8) + bx / 8 : bx;
    volatile LAS unsigned* MISC = (volatile LAS unsigned*)(lds + MISC_OFF);
    for (int u = tid; u < (LDS_BYTES - MISC_OFF) / 4; u += NTHREADS) ((LAS unsigned*)(lds + MISC_OFF))[u] = 0u;
    __syncthreads();
    if (ONE) (void)xcd_barrier_post((unsigned*)(ws + WS_CTL) + CW_BAR, MISC + 8);
    const int lo = ONE ? 0 : a.ph_lo, hi = ONE ? N_PHASES : a.ph_hi;
#define IN(k, kind) (((MASK >> (kind)) & 1u) && (ONE || (lo <= (k) && (k) < hi)))
#if defined(PROBE_EPI) && !defined(PROBE_MASK)
#endif
#ifdef PROBE_MASK
#define PB_ON(k) ((PROBE_MASK >> phase_kind(k)) & 1u)
#define PB_START(k) do { if (PB_ON(k) && threadIdx.x == 0) *(volatile LAS unsigned long long*)(lds + MISC_OFF + 8192) = __builtin_amdgcn_s_memrealtime(); } while (0)
#define PB_END(k) do { if (PB_ON(k) && threadIdx.x == 0) { volatile LAS unsigned long long* pb_ = (volatile LAS unsigned long long*)(lds + MISC_OFF + 8192); pb_[1] = pb_[1] + (__builtin_amdgcn_s_memrealtime() - pb_[0]); } } while (0)
#else
#define PB_START(k) do { } while (0)
#define PB_END(k) do { } while (0)
#endif
#define SEAM(k) do { if (ONE) { XcdBarrier bar_; bar_.bar = (unsigned*)(((CArgs*)fresh_args())->ws + WS_CTL) + CW_BAR; bar_.x = xb_xcc_id(); bar_.st = (volatile LAS unsigned*)(lds + MISC_OFF) + 8; xcd_barrier(bar_); } } while (0)

#define ada ((float*)(ws + WS_ADA))
#define ropec ((const float*)(ws + WS_ROPE))
#define ropes (((const float*)(ws + WS_ROPE)) + SEQ * 64)
#define alow ((float*)(ws + WS_ALOW))
#define lse ((float*)(ws + WS_LSE))
#define ssq ((float*)(ws + WS_SSQ))
#define rlist ((int*)(ws + WS_RLIST))
#define tslot ((int*)(ws + WS_TSLOT))
#define tw ((float*)(ws + WS_TW))
#define hbuf ((bf16_t*)(ws + WS_H))
#define ya ((bf16_t*)(ws + WS_YA))
#define yb ((bf16_t*)(ws + WS_YB))
#define mrg ((bf16_t*)(ws + WS_MRG))
#define atto ((bf16_t*)(ws + WS_ATTO))
#define obuf ((bf16_t*)(ws + WS_OB))
#define proj ((bf16_t*)(ws + WS_PROJ))
#define act ((bf16_t*)(ws + WS_ACT))
#define Y ((bf16_t*)(ws + WS_Y))
#define ctl ((unsigned*)(ws + WS_CTL))
#define xb_ ((bf16_t*)(ws + WS_XB))
#define qdb_ ((bf16_t*)(ws + WS_QD))
#define oib_ ((bf16_t*)(ws + WS_OI))
#define dstb_ ((bf16_t*)(ws + WS_DST))
#define decb_ ((float*)(ws + WS_DEC))

    PB_START(0);
    if (IN(0, 0)) { FRESH_TID(); prologue_phase(ap, lds, vcu, G, tid, wave, lane); }
#ifdef PROBE_DUP_PRO
    __syncthreads(); if (IN(0, 0)) { FRESH_TID(); prologue_phase(ap, lds, vcu, G, tid, wave, lane, PROBE_DUP_PRO); }
#endif
    SEAM(0); PB_END(0);

    for (int l = 0; l < DEPTH; ++l) {
        const int P = 1 + LS * l;
#define adal (ada + (size_t)l * NB * 12288)
#define cntl (ctl + CW_CNT + l * 1024)
#define cntp (ctl + CW_CNT + (l > 0 ? (l - 1) * 1024 : 0))
#define xsrc ((l == 0) ? a.x : a.out)
        PB_START(P);
        if (IN(P, 1)) { FRESH_TID();
            if (l == 0) norm_phase<0>(xsrc, nullptr, hbuf, a.norm_mix, adal + 2048, adal, nullptr, nullptr, nullptr, nullptr, nullptr, vcu, G, wave, lane);
            else norm_phase<1>(xb_, xb_, hbuf, a.norm_mix + (size_t)l * D, adal + 2048, adal, ada + (size_t)(l - 1) * NB * 12288 + 10240, Y, tslot, tw, cntp, vcu, G, wave, lane);
        }
        SEAM(P); PB_END(P); PB_START(P + 1);
        if (IN(P + 1, 2)) { FRESH_TID();
#if PROJ_F8
            pg8::StaticOrder S{T / 256, NP / 256, G, bx}; pg8::RowsContig AM; pg8::EpiProj E{proj, ropec, ropes, alow, pg8::W8_INV};
            pg8::gemm_phase<pg8::EpiProj, pg8::StaticOrder, pg8::RowsContig, true, true>(lds, tid, hbuf, (const bf16_t*)(ws + WS_WIN + (size_t)l * NP * D), 0, D / 2, S, AM, E);
#else
            pg8::StaticOrder S{T / 256, NP / 256, G, bx}; pg8::RowsContig AM; pg8::EpiProj E{proj, ropec, ropes, alow, 1.0f};
            pg8::gemm_phase<pg8::EpiProj, pg8::StaticOrder, pg8::RowsContig, true>(lds, tid, hbuf, (const bf16_t*)(ws + WS_WIN) + (size_t)l * NP * D, 0, D, S, AM, E);
#endif
        }
        SEAM(P + 1); PB_END(P + 1); PB_START(P + 2);
        if (IN(P + 2, 3)) { FRESH_TID();
            {
                const int hw = (vcu >> 5) & 3, dw = tid & 127; float w2[16];
#pragma unroll
                for (int r = 0; r < 16; ++r) w2[r] = (a.w_alpha2 + (size_t)l * 16 * 512)[r * 512 + hw * 128 + dw];
                const float bias = (a.b_alpha2 + (size_t)l * 512)[hw * 128 + dw];
                for (int u = vcu; u < NB * 4 * 32; u += G) { GlaPre R; gla_local_issue(R, proj, alow, u, tid);
                    gla_local_unit(lds, R, proj, alow, w2, bias, qdb_, oib_, dstb_, decb_, u, -1, tid, wave, lane); } }
            FRESH_TID();
            for (int u = vcu; u < NB * 12 * 16; u += G) { AttnPre R; attn_issue(R, proj, u, tid, wave, lane); attn_unit(lds, R, proj, atto, lse, u, -1, tid, wave, lane); }
#ifdef PROBE_DUP_ATTN
            for (int u = vcu; u < NB * 12 * 16; u += G) { AttnPre R; attn_issue(R, proj, u, tid, wave, lane); attn_unit(lds, R, proj, atto, lse, u, -1, tid, wave, lane); }
#endif
        }
        SEAM(P + 2); PB_END(P + 2); PB_START(P + 3);
        if (IN(P + 3, 4)) { FRESH_TID();
            for (int u = vcu; u < 256; u += G) gla_scan_unit<false>(lds, qdb_, oib_, dstb_, decb_, obuf, ssq, u, tid, wave, lane);
#ifdef PROBE_FAKESCAN
            __syncthreads(); for (int u = vcu; u < 256; u += G) gla_scan_unit<true>(lds, qdb_, oib_, dstb_, decb_, obuf, ssq, u, tid, wave, lane);
#endif
        }
        SEAM(P + 3); PB_END(P + 3); PB_START(P + 4);
        if (IN(P + 4, 5)) { FRESH_TID(); merge_phase(atto, lse, obuf, ssq, proj, a.gla_gain + (size_t)l * 1024, ya, yb, vcu, G, wave, lane); }
        SEAM(P + 4); PB_END(P + 4); PB_START(P + 5);
        if (IN(P + 5, 6)) { FRESH_TID();
#if BR_FUSE
            { pg8::SegOrder S2{T / 256, D / 256, G, bx}; pg8::RowsContig AM2; pg8::EpiGate2 E{proj, pg8::W8_INV, ws + WS_MRG8};
              pg8::gemm_phase<pg8::EpiGate2, pg8::SegOrder, pg8::RowsContig, true, true, true>(lds, tid, ya, (const bf16_t*)(ws + WS_WOA + (size_t)l * D * 1536), 0, 768, S2, AM2, E); }
#else
            pg8::StaticOrder S{T / 256, D / 256, G, bx}; pg8::RowsContig AM;
#if MIX_F8
            { pg8::EpiGate<true> E{mrg, proj, GA, pg8::W8_INV, nullptr}; pg8::gemm_phase<pg8::EpiGate<true>, pg8::StaticOrder, pg8::RowsContig, true, true>(lds, tid, ya, (const bf16_t*)(ws + WS_WOA + (size_t)l * D * 512), 0, 256, S, AM, E); }
#else
            { pg8::EpiGate<true> E{mrg, proj, GA, 1.0f, nullptr}; pg8::gemm_phase<pg8::EpiGate<true>, pg8::StaticOrder, pg8::RowsContig, true>(lds, tid, ya, (const bf16_t*)(ws + WS_WOA) + (size_t)l * D * 512, 0, 512, S, AM, E); }
#endif
            FRESH_TID();
#if MIX_F8
            { pg8::EpiGate<false> E{mrg, proj, GB, pg8::W8_INV, ws + WS_MRG8}; pg8::gemm_phase<pg8::EpiGate<false>, pg8::StaticOrder, pg8::RowsContig, true, true>(lds, tid, yb, (const bf16_t*)(ws + WS_WOB + (size_t)l * D * 1024), 0, 512, S, AM, E); }
#else
            { pg8::EpiGate<false> E{mrg, proj, GB, 1.0f, nullptr}; pg8::gemm_phase<pg8::EpiGate<false>, pg8::StaticOrder, pg8::RowsContig, true>(lds, tid, yb, (const bf16_t*)(ws + WS_WOB) + (size_t)l * D * 1024, 0, 1024, S, AM, E); }
#endif
#endif
        }
        SEAM(P + 5); PB_END(P + 5); PB_START(P + 6);
        if (IN(P + 6, 7)) { FRESH_TID();
            pg8::StaticOrder S{T / 256, D / 256, G, bx}; pg8::RowsContig AM;
#if MIX_F8
            if (l == 0) { pg8::EpiResid<true> E{a.x, xb_, adal + 4096, pg8::W8_INV}; pg8::gemm_phase<pg8::EpiResid<true>, pg8::StaticOrder, pg8::RowsContig, true, true>(lds, tid, (const bf16_t*)(ws + WS_MRG8), (const bf16_t*)(ws + WS_WO + (size_t)l * D * D), 0, D / 2, S, AM, E); }
            else { pg8::EpiResid<false> E{xb_, xb_, adal + 4096, pg8::W8_INV}; pg8::gemm_phase<pg8::EpiResid<false>, pg8::StaticOrder, pg8::RowsContig, true, true>(lds, tid, (const bf16_t*)(ws + WS_MRG8), (const bf16_t*)(ws + WS_WO + (size_t)l * D * D), 0, D / 2, S, AM, E); }
#else
            if (l == 0) { pg8::EpiResid<true> E{a.x, xb_, adal + 4096, 1.0f}; pg8::gemm_phase<pg8::EpiResid<true>, pg8::StaticOrder, pg8::RowsContig, true>(lds, tid, mrg, (const bf16_t*)(ws + WS_WO) + (size_t)l * D * D, 0, D, S, AM, E); }
            else { pg8::EpiResid<false> E{xb_, xb_, adal + 4096, 1.0f}; pg8::gemm_phase<pg8::EpiResid<false>, pg8::StaticOrder, pg8::RowsContig, true>(lds, tid, mrg, (const bf16_t*)(ws + WS_WO) + (size_t)l * D * D, 0, D, S, AM, E); }
#endif
        }
        SEAM(P + 6); PB_END(P + 6); PB_START(P + 7);
        if (IN(P + 7, 8)) { FRESH_TID(); router_phase(xb_, hbuf, a.norm_ffn + (size_t)l * D, adal + 8192, adal + 6144, a.w_router, a.b_router, cntl, rlist, tslot, tw, lds, vcu, G, tid, wave, lane); }
        SEAM(P + 7); PB_END(P + 7); PB_START(P + 8);
        if (IN(P + 8, 9)) { FRESH_TID();
            pg8::moe_table_build(lds, cntl, tid);
            pg8::MoeOrder S; S.init(lds, 8, G, bx); pg8::RowsGather AM{rlist, lds}; pg8::EpiSwiGLU8 E{(unsigned char*)act};
            pg8::gemm_phase<pg8::EpiSwiGLU8, pg8::MoeOrder, pg8::RowsGather, true, true>(lds, tid, hbuf, (const bf16_t*)(ws + WS_WGU + (size_t)l * NE * 2048 * D), (size_t)2048 * D / 2, D / 2, S, AM, E);
        }
        SEAM(P + 8); PB_END(P + 8); PB_START(P + 9);
        if (IN(P + 9, 10)) { FRESH_TID();
            pg8::moe_table_build(lds, cntl, tid);
            pg8::MoeOrder S; S.init(lds, 8, G, bx); pg8::RowsContig AM; pg8::EpiPlainS E{Y, pg8::W8_INV};
            pg8::gemm_phase<pg8::EpiPlainS, pg8::MoeOrder, pg8::RowsContig, true, true>(lds, tid, act, (const bf16_t*)(ws + WS_WDN + (size_t)l * NE * D * FF), (size_t)D * FF / 2, FF / 2, S, AM, E);
        }
        SEAM(P + 9); PB_END(P + 9);
    }
    PB_START(1 + DEPTH * LS);
    if (IN(1 + DEPTH * LS, LS + 1)) { FRESH_TID(); norm_phase<2>(xb_, a.out, nullptr, a.final_norm, nullptr, nullptr, ada + (size_t)(DEPTH - 1) * NB * 12288 + 10240, Y, tslot, tw, ctl + CW_CNT + (DEPTH - 1) * 1024, vcu, G, wave, lane); }
#ifdef PROBE_MASK
    __syncthreads(); PB_END(1 + DEPTH * LS);
    if (threadIdx.x == 0) { const unsigned long long t0_ = __builtin_amdgcn_s_memrealtime(), d_ = ((volatile LAS unsigned long long*)(lds + MISC_OFF + 8192))[1];
        while (__builtin_amdgcn_s_memrealtime() - t0_ < d_) __builtin_amdgcn_s_sleep(8); }
    __syncthreads();
#endif
#undef a
#undef IN
#undef SEAM
}

template <unsigned MASK, bool ONE>
static void launch_one(const Args& a, int grid, hipStream_t stream) {
    static bool attr_done = false;
    if (!attr_done) { (void)hipFuncSetAttribute((const void*)fwd_kernel<MASK, ONE>, hipFuncAttributeMaxDynamicSharedMemorySize, LDS_BYTES); attr_done = true; }
    hipLaunchKernelGGL((fwd_kernel<MASK, ONE>), dim3(grid), dim3(NTHREADS), LDS_BYTES, stream, a);
}
extern "C" void kernel_launch(void* const* d_in, const int* in_sizes, int n_in, void* d_out, int out_size, void* d_ws, size_t ws_size, hipStream_t stream) {
    static int grid = 0;
    if (grid == 0) {
        if (n_in != 19 || out_size != T * D || ws_size < WS_END) { fprintf(stderr, "kernel_launch: unexpected shapes (n_in %d, out %d, ws %zu < %zu); nothing launched\n", n_in, out_size, ws_size, (size_t)WS_END); grid = -1; return; }
        int dev = 0, cus = 0;
        if (hipGetDevice(&dev) != hipSuccess || hipDeviceGetAttribute(&cus, hipDeviceAttributeMultiprocessorCount, dev) != hipSuccess) { grid = -1; return; }
        grid = cus;
        if (grid != 256) fprintf(stderr, "kernel_launch: note: %d CUs (built for 256)\n", grid);
    }
    if (grid < 0) return;
    (void)hipMemsetAsync((char*)d_ws + WS_CTL, 0, CTL_ZERO_BYTES, stream);
    Args a{};
    a.x = (const float*)d_in[0]; a.c = (const float*)d_in[1]; a.w_ada = (const float*)d_in[2]; a.b_ada = (const float*)d_in[3]; a.norm_mix = (const float*)d_in[4]; a.norm_ffn = (const float*)d_in[5];
    a.w_in = (const float*)d_in[6]; a.w_alpha2 = (const float*)d_in[7]; a.b_alpha2 = (const float*)d_in[8]; a.gla_gain = (const float*)d_in[9]; a.w_out_a = (const float*)d_in[10];
    a.w_out_b = (const float*)d_in[11]; a.w_out = (const float*)d_in[12]; a.w_router = (const float*)d_in[13]; a.b_router = (const float*)d_in[14]; a.w_gate_e = (const float*)d_in[15];
    a.w_up_e = (const float*)d_in[16]; a.w_down_e = (const float*)d_in[17]; a.final_norm = (const float*)d_in[18];
    a.out = (float*)d_out; a.ws = (unsigned char*)d_ws;
#if MK_PER_PHASE
    for (int p = 0; p < N_PHASES; ++p) { a.ph_lo = p; a.ph_hi = p + 1;
        const int kind = phase_kind(p);
        switch (kind) {
            case 0: launch_one<1u << 0, false>(a, grid, stream); break; case 1: launch_one<1u << 1, false>(a, grid, stream); break;
            case 2: launch_one<1u << 2, false>(a, grid, stream); break; case 3: launch_one<1u << 3, false>(a, grid, stream); break;
            case 4: launch_one<1u << 4, false>(a, grid, stream); break; case 5: launch_one<1u << 5, false>(a, grid, stream); break;
            case 6: launch_one<1u << 6, false>(a, grid, stream); break; case 7: launch_one<1u << 7, false>(a, grid, stream); break;
            case 8: launch_one<1u << 8, false>(a, grid, stream); break; case 9: launch_one<1u << 9, false>(a, grid, stream); break;
            case 10: launch_one<1u << 10, false>(a, grid, stream); break;
            default: launch_one<1u << 11, false>(a, grid, stream); break; } }
#else
    a.ph_lo = 0; a.ph_hi = N_PHASES; launch_one<0xFFFFFu, true>(a, grid, stream);
#endif
    const hipError_t le = hipPeekAtLastError();
    if (le != hipSuccess) fprintf(stderr, "kernel_launch: launch failed: %s\n", hipGetErrorName(le));
}
```

```cpp
#include <hip/hip_runtime.h>
#include <cstdio>
#include <cstdint>

#ifndef PROJ_F8
#define PROJ_F8 1
#endif
#ifndef MIX_F8
#define MIX_F8 1
#endif
#ifndef GATE_F8
#define GATE_F8 1
#endif
#ifndef Y_F8
#define Y_F8 1
#endif
#ifndef BR_FUSE
#define BR_FUSE 1
#endif
#ifndef MK_PER_PHASE
#define MK_PER_PHASE 0
#endif

#define LAS __attribute__((address_space(3)))
#define GAS __attribute__((address_space(1)))
typedef unsigned short bf16_t;
typedef short bf16x8 __attribute__((ext_vector_type(8)));
typedef short s16x4 __attribute__((ext_vector_type(4)));
typedef float f32x4 __attribute__((ext_vector_type(4)));
typedef float f32x2 __attribute__((ext_vector_type(2)));
typedef unsigned u32x4 __attribute__((ext_vector_type(4)));
typedef unsigned u32x2 __attribute__((ext_vector_type(2)));
typedef GAS unsigned gu32;

constexpr int NB = 8, SEQ = 2048, T = NB * SEQ, D = 2048, DEPTH = 2;
constexpr int NIN = 11792;
constexpr int NP = 12032;
constexpr int QA = 0, KA = 1536, VA = 3072, QB = 4608, KB = 5120, VB = 5632, RB = 6656, GA = 7680, GB = 9728, AL = 11776;
constexpr int NE = 16, FF = 1024;
constexpr int MAXTILES = 144, MAXROWS = MAXTILES * 256;
constexpr float NORM_EPS = 1e-6f;
constexpr int NWAVES = 8, NTHREADS = 512;

constexpr size_t MiB = 1u << 20;
constexpr size_t WS_CTL = 0, CTL_ZERO_BYTES = 80 * 1024;
constexpr size_t WS_ADA = 1 * MiB;
constexpr size_t WS_ROPE = 2 * MiB;
constexpr size_t WS_ALOW = 3 * MiB;
constexpr size_t WS_LSE = 4 * MiB;
constexpr size_t WS_SSQ = 5 * MiB;
constexpr size_t WS_RLIST = 9 * MiB;
constexpr size_t WS_TSLOT = 10 * MiB;
constexpr size_t WS_TW = 10 * MiB + 512 * 1024;
constexpr size_t WS_WIN = 12 * MiB;
constexpr size_t WS_MRG8 = 60 * MiB;
constexpr size_t WS_WOA = 106 * MiB;
constexpr size_t WS_WOB = 110 * MiB;
constexpr size_t WS_WO = 118 * MiB;
constexpr size_t WS_WGU = 134 * MiB;
constexpr size_t WS_XB = 262 * MiB;
constexpr size_t WS_WDN = 390 * MiB;
constexpr size_t WS_H = 518 * MiB;
constexpr size_t WS_YA = 582 * MiB;
constexpr size_t WS_YB = 598 * MiB;
constexpr size_t WS_MRG = 630 * MiB;
constexpr size_t WS_ATTO = 694 * MiB;
constexpr size_t WS_OB = 742 * MiB;
constexpr size_t WS_PROJ = 774 * MiB;
constexpr size_t WS_ACT = WS_PROJ;
constexpr size_t WS_Y = WS_PROJ + 72 * MiB;
constexpr size_t WS_QD = 1150 * MiB;
constexpr size_t WS_OI = 1166 * MiB;
constexpr size_t WS_DST = 1198 * MiB;
constexpr size_t WS_DEC = 1262 * MiB;
constexpr size_t WS_END = 1263 * MiB;
constexpr int CW_BAR = 4096;
constexpr int CW_CNT = 16384;

constexpr int RING_BYTES = 131072;
constexpr int MISC_OFF = 135168;
constexpr int LDS_BYTES = 151552;

#define LDS_WAIT() asm volatile("s_waitcnt lgkmcnt(0)" ::: "memory")
#define VM_WAIT() asm volatile("s_waitcnt vmcnt(0)" ::: "memory")
#define RLX_AGENT __ATOMIC_RELAXED, __HIP_MEMORY_SCOPE_AGENT
__device__ __forceinline__ unsigned f2bf(float f) { unsigned u = __builtin_bit_cast(unsigned, f); return (u + 0x7fffu + ((u >> 16) & 1u)) >> 16; }
typedef float f32x2_t __attribute__((ext_vector_type(2)));
typedef __bf16 bf16x2_t __attribute__((ext_vector_type(2)));
__device__ __forceinline__ unsigned pk2(float lo, float hi) { const f32x2_t v = {lo, hi}; const bf16x2_t b = __builtin_convertvector(v, bf16x2_t); return __builtin_bit_cast(unsigned, b); }
__device__ __forceinline__ float sat8(float x) { return __builtin_amdgcn_fmed3f(x, -448.0f, 448.0f); }
__device__ __forceinline__ unsigned pk_fp8x4(float a, float b, float c, float d) { int p = __builtin_amdgcn_cvt_pk_fp8_f32(sat8(a), sat8(b), 0, false); p = __builtin_amdgcn_cvt_pk_fp8_f32(sat8(c), sat8(d), p, true); return (unsigned)p; }
constexpr int G8_BYTE0 = RB * 2;
__device__ __forceinline__ void unpack_fp8x8(u32x2 v, float (&f)[8]) { const f32x2_t a = __builtin_amdgcn_cvt_pk_f32_fp8((int)v.x, false), b = __builtin_amdgcn_cvt_pk_f32_fp8((int)v.x, true), c = __builtin_amdgcn_cvt_pk_f32_fp8((int)v.y, false), d = __builtin_amdgcn_cvt_pk_f32_fp8((int)v.y, true);
    f[0] = a[0]; f[1] = a[1]; f[2] = b[0]; f[3] = b[1]; f[4] = c[0]; f[5] = c[1]; f[6] = d[0]; f[7] = d[1]; }
__device__ __forceinline__ unsigned pk_fp8x4_ns(float a, float b, float c, float d) { int p = __builtin_amdgcn_cvt_pk_fp8_f32(a, b, 0, false); p = __builtin_amdgcn_cvt_pk_fp8_f32(c, d, p, true); return (unsigned)p; }
__device__ __forceinline__ float bflo(unsigned u) { return __builtin_bit_cast(float, u << 16); }
__device__ __forceinline__ float bfhi(unsigned u) { return __builtin_bit_cast(float, u & 0xffff0000u); }
__device__ __forceinline__ float bf2f(bf16_t h) { return __builtin_bit_cast(float, (unsigned)h << 16); }
template <int M> __device__ __forceinline__ float sx(float v, int lane) {
    if constexpr (M < 32) return __builtin_bit_cast(float, __builtin_amdgcn_ds_swizzle(__builtin_bit_cast(int, v), (M << 10) | 0x1F));
    else return __builtin_bit_cast(float, __builtin_amdgcn_ds_bpermute((lane ^ 32) << 2, __builtin_bit_cast(int, v)));
}
__device__ __forceinline__ float wave_sum(float v, int lane) {
    v += sx<1>(v, lane); v += sx<2>(v, lane); v += sx<4>(v, lane); v += sx<8>(v, lane); v += sx<16>(v, lane); v += sx<32>(v, lane);
    return v;
}
__device__ __forceinline__ float sigmoidf_(float x) { return __builtin_amdgcn_rcpf(1.0f + __expf(-x)); }
__device__ __forceinline__ float siluf_(float x) { return x * __builtin_amdgcn_rcpf(1.0f + __expf(-x)); }

#define XB_TMO      128
#define XB_XCNT(j)  (256  + 64 * (j))
#define XB_XSUB(j)  (1280 + 64 * (j))
#define XB_XGEN(j)  (2304 + 64 * (j))
#define XB_TOP      3328
#define XB_TOPGEN   3392
#define XCD_BAR_WORDS 3456
#define XB_SPIN_CAP (1u << 18)
__device__ __forceinline__ unsigned xb_ld(unsigned* p)              { return __hip_atomic_load(p, __ATOMIC_RELAXED, __HIP_MEMORY_SCOPE_AGENT); }
__device__ __forceinline__ unsigned xb_add(unsigned* p, unsigned v) { return __hip_atomic_fetch_add(p, v, __ATOMIC_RELAXED, __HIP_MEMORY_SCOPE_AGENT); }
__device__ __forceinline__ unsigned xb_xcc_id() { return (unsigned)__builtin_amdgcn_s_getreg((3 << 11) | 20) & 0xFu; }
#define XB_SPIN(cond, bar) do { unsigned _sp = 0; while (cond) { __builtin_amdgcn_s_sleep(1); \
    if ((++_sp & 255u) == 0u) { if (xb_ld(&(bar)[XB_TMO])) break; if (_sp > XB_SPIN_CAP) { atomicAdd(&(bar)[XB_TMO], 1u); break; } } } } while (0)
struct XcdBarrier { unsigned* bar; unsigned x; volatile LAS unsigned* st; };
__device__ __forceinline__ XcdBarrier xcd_barrier_post(unsigned* bar, volatile LAS unsigned* st) {
    XcdBarrier b; b.bar = bar; b.x = xb_xcc_id(); b.st = st;
    if (threadIdx.x == 0) (void)xb_add(&bar[XB_XCNT(b.x)], 1u);
    return b;
}
__device__ __forceinline__ void xcd_barrier_complete(unsigned* bar, unsigned x, unsigned& nloc, unsigned& nx) {
    const unsigned G = gridDim.x * gridDim.y * gridDim.z;
    unsigned sum, cnt, mine, sp = 0u;
    for (;;) {
        sum = 0u; cnt = 0u; mine = 0u;
#pragma unroll
        for (unsigned j = 0; j < 16; ++j) { const unsigned c = xb_ld(&bar[XB_XCNT(j)]); sum += c; cnt += (c > 0u) ? 1u : 0u; mine = (j == x) ? c : mine; }
        if (sum == G) break;
        __builtin_amdgcn_s_sleep(1);
        if ((++sp & 255u) == 0u) { if (xb_ld(&bar[XB_TMO])) break; if (sp > XB_SPIN_CAP) { atomicAdd(&bar[XB_TMO], 1u); break; } }
    }
    nloc = mine > 0u ? mine : 1u; nx = cnt > 0u ? cnt : 1u;
}
__device__ __forceinline__ void xcd_barrier(const XcdBarrier& b) {
    asm volatile("s_waitcnt vmcnt(0)" ::: "memory");
    __syncthreads();
    if (threadIdx.x == 0) {
        unsigned* bar = b.bar;
        __builtin_amdgcn_s_waitcnt(0);
        unsigned nloc = b.st[0], nx = b.st[1];
        if (nloc == 0u) { xcd_barrier_complete(bar, b.x, nloc, nx); b.st[0] = nloc; b.st[1] = nx; }
        const unsigned old = xb_add(&bar[XB_XSUB(b.x)], 1u);
        const unsigned gen = old / nloc;
        if (old + 1u == (gen + 1u) * nloc) {
            __builtin_amdgcn_fence(__ATOMIC_RELEASE, "agent");
            asm volatile("s_waitcnt vmcnt(0)" ::: "memory");
            const unsigned og = xb_add(&bar[XB_TOP], 1u);
            const unsigned tg = og / nx;
            if (og + 1u == (tg + 1u) * nx) xb_add(&bar[XB_TOPGEN], 1u);
            else XB_SPIN(xb_ld(&bar[XB_TOPGEN]) == tg, bar);
            __builtin_amdgcn_fence(__ATOMIC_ACQUIRE, "agent");
            xb_add(&bar[XB_XGEN(b.x)], 1u);
            asm volatile("s_waitcnt vmcnt(0)" ::: "memory");
        } else {
            XB_SPIN(xb_ld(&bar[XB_XGEN(b.x)]) == gen, bar);
            __builtin_amdgcn_fence(__ATOMIC_ACQUIRE, "agent");
            asm volatile("s_waitcnt vmcnt(0)" ::: "memory");
        }
    }
    __syncthreads();
}

namespace pg8 {
constexpr int BM = 256, BK = 64, HALF = 128, HTB = HALF * BK * 2, NXCD = 8;
#ifndef WGM_PROJ
#define WGM_PROJ 3
#endif
#ifndef WGM_MIX
#define WGM_MIX 4
#endif
#ifndef WGM_MOE
#define WGM_MOE 4
#endif
__device__ __forceinline__ int lds_byte(int r, int c) { const int st = (r >> 4) * 2 + (c >> 5), rr = r & 15, cc = c & 31, ob = rr * 64 + cc * 2; return st * 1024 + (ob ^ (((ob >> 9) & 1) << 5)); }
__device__ __forceinline__ void stage_rc(int b, int& R, int& C) { const int st = b / 1024, sb = b % 1024, swz = sb ^ (((sb >> 9) & 1) << 5); R = (st >> 1) * 16 + swz / 64; C = (st & 1) * 32 + (swz % 64) / 2; }
__device__ __forceinline__ int perm32(int rho) { const int n = rho >> 4, i = rho & 15; return 8 * (i >> 2) + 4 * n + (i & 3); }

struct Unit { int pm, pn, e, ti; };

template <int WGM>
__device__ __forceinline__ bool grid_order(int nM, int nN, int G, int c, int i, int& pm, int& pn) {
    const int nwg = nM * nN; const long L = (long)i * G + c; if (L >= nwg) return false;
    int wgid = (int)L; { const int q = nwg / NXCD, r = nwg % NXCD, xcd = wgid % NXCD, off = wgid / NXCD; wgid = (xcd < r ? xcd * (q + 1) : r * (q + 1) + (xcd - r) * q) + off; }
    const int nig = WGM * nN, gid = wgid / nig, fm = gid * WGM, gsz = (nM - fm) < WGM ? (nM - fm) : WGM;
    pm = fm + ((wgid % nig) % gsz); pn = (wgid % nig) / gsz; return true;
}
template <int WGM> struct StaticOrderT {
    int nM, nN, G, c;
    __device__ __forceinline__ bool next(int i, Unit& u) const { u.e = 0; u.ti = 0; return grid_order<WGM>(nM, nN, G, c, i, u.pm, u.pn); }
};
typedef StaticOrderT<WGM_PROJ> StaticOrderP; typedef StaticOrderT<WGM_MIX> StaticOrder;
struct SegOrder {
    int nM, nN, G, c;
    __device__ __forceinline__ bool next(int i, Unit& u) const { u.e = i & 1; u.ti = 0; return grid_order<WGM_MIX>(nM, nN, G, c, i >> 1, u.pm, u.pn); }
};
constexpr int MOE_TAB_OFF = MISC_OFF + 4096;
__device__ __forceinline__ void moe_table_build(LAS unsigned char* lds, const unsigned* cnt, int tid) {
    if (tid < NE) { const int n = (int)__hip_atomic_load(cnt + 64 * tid, RLX_AGENT); ((LAS int*)(lds + MOE_TAB_OFF))[16 + tid] = n; }
    __syncthreads();
    if (tid == 0) { int acc = 0; for (int e = 0; e < NE; ++e) { acc += (((LAS int*)(lds + MOE_TAB_OFF))[16 + e] + 255) >> 8; ((LAS int*)(lds + MOE_TAB_OFF))[e] = acc; } }
    __syncthreads();
}
typedef int i32x4 __attribute__((ext_vector_type(4)));
struct MoeOrder {
    LAS unsigned char* lds; int NT, nN, G, c;
    __device__ __forceinline__ void init(LAS unsigned char* lds_, int nN_, int G_, int c_) {
        lds = lds_; NT = __builtin_amdgcn_readfirstlane(((LAS int*)(lds + MOE_TAB_OFF))[15]); nN = nN_; G = G_; c = c_; }
    __device__ __forceinline__ bool next(int i, Unit& u) const {
        if (!grid_order<WGM_MOE>(NT, nN, G, c, i, u.pm, u.pn)) return false;
        int e = 0, ts = 0;
#pragma unroll
        for (int q = 0; q < 4; ++q) { const i32x4 t = ((const LAS i32x4*)(lds + MOE_TAB_OFF))[q];
#pragma unroll
            for (int j = 0; j < 4; ++j) { const bool ge = u.pm >= t[j]; e += ge ? 1 : 0; ts = ge ? t[j] : ts; } }
        u.e = __builtin_amdgcn_readfirstlane(e); u.ti = u.pm - __builtin_amdgcn_readfirstlane(ts); return true;
    }
};
struct RowsContig { static constexpr bool GATHER = false; __device__ __forceinline__ unsigned row(const Unit& u, int rr) const { return (unsigned)(u.pm * 256 + rr); } };
struct RowsGather {
    static constexpr bool GATHER = true;
    const int* rlist; LAS unsigned char* lds;
    __device__ __forceinline__ unsigned row(const Unit& u, int rr) const {
        const int n = ((LAS int*)(lds + MOE_TAB_OFF))[16 + u.e]; const int rank = u.ti * 256 + rr; const bool ok = rank < n;
        return (unsigned)rlist[(size_t)u.e * T + (ok ? rank : 0)];
    }
};

typedef int i32x4v __attribute__((ext_vector_type(4)));
typedef int i32x8 __attribute__((ext_vector_type(8)));
template <class Epi, class Sched, class AMap, bool ALIGN_EPI, bool F8 = false, bool SEG2 = false>
__device__ __forceinline__ void gemm_phase(LAS unsigned char* lds, const int tid, const bf16_t* A, const bf16_t* Bt, size_t bstride, int K, const Sched& S, const AMap& AM, const Epi& E) {
    const int wid = __builtin_amdgcn_readfirstlane(tid >> 6), lane = tid & 63, wr = wid >> 2, wc = wid & 3, fr = lane & 15, fq = lane >> 4;
    const int nt = K / BK;
    unsigned voffA[2], voffB[2];
#pragma unroll
    for (int i = 0; i < 2; ++i) { int R, C; stage_rc(tid * 16 + i * 8192, R, C); const int Rb = Epi::PERM ? ((R & ~31) + perm32(R & 31)) : R; voffA[i] = (unsigned)(R * K + C) * 2u; voffB[i] = (unsigned)(Rb * K + C) * 2u; }
    const unsigned kstep = (unsigned)(BK * 2);
    const unsigned hstep = (unsigned)HALF * (unsigned)K * 2u;
    const unsigned tstep = 2u * hstep;
    const __amdgpu_buffer_rsrc_t rsA = __builtin_amdgcn_make_buffer_rsrc((void*)A, 0, -1, 0x00020000), rsB = __builtin_amdgcn_make_buffer_rsrc((void*)Bt, 0, -1, 0x00020000);
    const unsigned ldsw = (unsigned)wid * 1024u;
    const int aoff = lds_byte(wr * 64 + fr, fq * 8), boff = lds_byte(wc * 32 + fr, fq * 8);
#define PG8_SA(b, h) (((b) * 2 + (h)) * HTB)
#define PG8_SB(b, h) ((4 + (b) * 2 + (h)) * HTB)
#define PG8_STAGE(bufoff, soffB, voff) do { _Pragma("unroll") for (int _i = 0; _i < 2; ++_i) \
        __builtin_amdgcn_raw_ptr_buffer_load_lds(rsB, (LAS unsigned*)(lds + (bufoff) + ldsw + _i * 8192), 16, (int)(voff)[_i], (int)(soffB), 0, 0); } while (0)
#define PG8_LDA(dst, b, h) do { _Pragma("unroll") for (int m = 0; m < 4; ++m) _Pragma("unroll") for (int k = 0; k < 2; ++k) dst[m][k] = *(const LAS bf16x8*)(lds + PG8_SA(b, h) + aoff + m * 2048 + k * 1024); } while (0)
#define PG8_LDB(dst, b, h) do { _Pragma("unroll") for (int n = 0; n < 2; ++n) _Pragma("unroll") for (int k = 0; k < 2; ++k) dst[n][k] = *(const LAS bf16x8*)(lds + PG8_SB(b, h) + boff + n * 2048 + k * 1024); } while (0)
#define PG8_MMA(ai, bj, At, Bt_) do { __builtin_amdgcn_s_setprio(1); _Pragma("unroll") for (int m = 0; m < 4; ++m) _Pragma("unroll") for (int n = 0; n < 2; ++n) _Pragma("unroll") for (int k = 0; k < 2; ++k) \
        acc[ai][bj][m][n] = __builtin_amdgcn_mfma_f32_16x16x32_bf16(Bt_[n][k], At[m][k], acc[ai][bj][m][n], 0, 0, 0); __builtin_amdgcn_s_setprio(0); } while (0)
#define PG8_LD8(dst, base) do { const i32x4v lo_ = *(const LAS i32x4v*)(lds + (base)); const i32x4v hi_ = *(const LAS i32x4v*)(lds + (base) + 1024); dst = __builtin_shufflevector(lo_, hi_, 0, 1, 2, 3, 4, 5, 6, 7); } while (0)
#define PG8_LDA8(dst, b, h) do { _Pragma("unroll") for (int m = 0; m < 4; ++m) PG8_LD8(dst[m], PG8_SA(b, h) + aoff + m * 2048); } while (0)
#define PG8_LDB8(dst, b, h) do { _Pragma("unroll") for (int n = 0; n < 2; ++n) PG8_LD8(dst[n], PG8_SB(b, h) + boff + n * 2048); } while (0)
#define PG8_MMA8(ai, bj, At, Bt_) do { __builtin_amdgcn_s_setprio(1); _Pragma("unroll") for (int m = 0; m < 4; ++m) _Pragma("unroll") for (int n = 0; n < 2; ++n) \
        asm volatile("v_mfma_f32_16x16x128_f8f6f4 %0, %1, %2, %0" : "+v"(acc[ai][bj][m][n]) : "v"(Bt_[n]), "v"(At[m])); __builtin_amdgcn_s_setprio(0); } while (0)
#define PG8_XLDA(b, h) do { if constexpr (F8) PG8_LDA8(At8, b, h); else PG8_LDA(At, b, h); } while (0)
#define PG8_XLDB(w, b, h) do { if constexpr (F8) { if (w == 0) PG8_LDB8(B08, b, h); else PG8_LDB8(B18, b, h); } else { if (w == 0) PG8_LDB(B0, b, h); else PG8_LDB(B1, b, h); } } while (0)
#define PG8_XMMA(ai, bj, w) do { if constexpr (F8) { if (w == 0) PG8_MMA8(ai, bj, At8, B08); else PG8_MMA8(ai, bj, At8, B18); } else { if (w == 0) PG8_MMA(ai, bj, At, B0); else PG8_MMA(ai, bj, At, B1); } } while (0)
#define PG8_WAIT_V(n) asm volatile("s_waitcnt vmcnt(" #n ")" ::: "memory")
#define PG8_WAIT_L(n) asm volatile("s_waitcnt lgkmcnt(" #n ")" ::: "memory")
#define PG8_BAR __builtin_amdgcn_s_barrier()
#define PG8_SCHED __builtin_amdgcn_sched_barrier(0)
#define PG8_OFFS(dst, u) do { _Pragma("unroll") for (int _h = 0; _h < 2; ++_h) _Pragma("unroll") for (int _i = 0; _i < 2; ++_i) { int _R, _C; stage_rc(tid * 16 + _i * 8192, _R, _C); \
        dst[_h][_i] = (AM.row(u, _h * HALF + _R) * (unsigned)K + (unsigned)_C) * 2u; } } while (0)
#define PG8_STAGE_A(bufoff, h, kb, NXT) do { if constexpr (AMap::GATHER) { _Pragma("unroll") for (int _i = 0; _i < 2; ++_i) { const unsigned _o = (NXT) ? offN[h][_i] : offC[h][_i]; \
            __builtin_amdgcn_raw_ptr_buffer_load_lds(rsA, (LAS unsigned*)(lds + (bufoff) + ldsw + _i * 8192), 16, (int)_o, (int)(kb), 0, 0); } } \
        else { const unsigned _g = ((NXT) ? nA : cA) + (h) * hstep + (kb); _Pragma("unroll") for (int _i = 0; _i < 2; ++_i) \
            __builtin_amdgcn_raw_ptr_buffer_load_lds(rsA, (LAS unsigned*)(lds + (bufoff) + ldsw + _i * 8192), 16, (int)voffA[_i], (int)_g, 0, 0); } } while (0)
    Unit cur, nxt, nn; int ui = 0; bool has_next = false, has_nn = false;
    if (!S.next(0, cur)) return;
    f32x4 acc[2][2][4][2];
#pragma unroll
    for (int a = 0; a < 2; ++a)
#pragma unroll
        for (int b = 0; b < 2; ++b)
#pragma unroll
            for (int m = 0; m < 4; ++m)
#pragma unroll
                for (int n = 0; n < 2; ++n) acc[a][b][m][n] = (f32x4){0.f, 0.f, 0.f, 0.f};
    bf16x8 At[4][2], B0[2][2], B1[2][2]; i32x8 At8[4], B08[2], B18[2];
    int sc8 = 0x7F7F7F7F; if constexpr (F8) asm volatile("" : "+v"(sc8));
#define PG8_RAW(dst, u) do { _Pragma("unroll") for (int _h = 0; _h < 2; ++_h) _Pragma("unroll") for (int _i = 0; _i < 2; ++_i) { int _R, _C; stage_rc(tid * 16 + _i * 8192, _R, _C); dst[_h][_i] = AM.row(u, _h * HALF + _R); } } while (0)
#define PG8_CONV(dst, raw) do { _Pragma("unroll") for (int _h = 0; _h < 2; ++_h) _Pragma("unroll") for (int _i = 0; _i < 2; ++_i) { int _R, _C; stage_rc(tid * 16 + _i * 8192, _R, _C); dst[_h][_i] = (raw[_h][_i] * (unsigned)K + (unsigned)_C) * 2u; } } while (0)
    unsigned offC[2][2], offN[2][2], rawN[2][2];
    if constexpr (AMap::GATHER) { PG8_OFFS(offC, cur); has_next = S.next(1, nxt);
        if (has_next) { PG8_RAW(rawN, nxt); } else {
#pragma unroll
            for (int h = 0; h < 2; ++h)
#pragma unroll
                for (int i = 0; i < 2; ++i) rawN[h][i] = 0u; } }
    unsigned cA = AMap::GATHER ? 0u : (unsigned)cur.pm * tstep + (SEG2 ? (unsigned)cur.e * 1024u : 0u), nA = cA;
    unsigned cB = (unsigned)cur.e * (SEG2 ? 1024u : (unsigned)(bstride * 2)) + (unsigned)cur.pn * tstep;
    PG8_STAGE(PG8_SB(0, 0), cB, voffB); PG8_STAGE(PG8_SB(0, 1), cB + hstep, voffB); PG8_STAGE_A(PG8_SA(0, 0), 0, 0, false); PG8_STAGE_A(PG8_SA(0, 1), 1, 0, false);
    if (wr == 1) PG8_BAR;
    PG8_WAIT_V(2); PG8_BAR;
    PG8_STAGE(PG8_SB(1, 0), cB + kstep, voffB); PG8_STAGE_A(PG8_SA(1, 0), 0, kstep, false); PG8_STAGE(PG8_SB(1, 1), cB + hstep + kstep, voffB);
    PG8_WAIT_V(6); PG8_BAR;
    for (;;) {
        if constexpr (!AMap::GATHER) has_next = S.next(ui + 1, nxt);
        if constexpr (AMap::GATHER) {
            if (has_next) { PG8_CONV(offN, rawN); }
            else {
#pragma unroll
                for (int h = 0; h < 2; ++h)
#pragma unroll
                    for (int i = 0; i < 2; ++i) offN[h][i] = offC[h][i];
            }
            has_nn = has_next && S.next(ui + 2, nn);
            if (has_nn) { PG8_RAW(rawN, nn); }
        } else { nA = has_next ? (unsigned)nxt.pm * tstep + (SEG2 ? (unsigned)nxt.e * 1024u : 0u) : cA; }
        const unsigned nB = has_next ? (unsigned)nxt.e * (SEG2 ? 1024u : (unsigned)(bstride * 2)) + (unsigned)nxt.pn * tstep : cB;
        const int ntc = SEG2 ? (cur.e ? 4 : 8) : nt;
#pragma nounroll
        for (int t = 0; t < ntc; t += 2) {
            const bool last = (t == ntc - 2);
            const unsigned k1 = (unsigned)(t + 1) * kstep, k2 = last ? 0u : (unsigned)(t + 2) * kstep, k3 = k2 + kstep;
            const unsigned b2 = last ? nB : cB + (unsigned)(t + 2) * kstep, b3 = b2 + kstep;
            PG8_XLDB(0, 0, 0); PG8_XLDB(1, 0, 1); PG8_SCHED; PG8_XLDA(0, 0); PG8_STAGE_A(PG8_SA(1, 1), 1, k1, false);
            PG8_WAIT_V(8); PG8_WAIT_L(0); PG8_BAR; PG8_XMMA(0, 0, 0); PG8_XMMA(0, 1, 1); PG8_BAR; PG8_SCHED;
            PG8_XLDA(0, 1); PG8_STAGE(PG8_SB(0, 0), b2, voffB); PG8_STAGE(PG8_SB(0, 1), b2 + hstep, voffB); PG8_STAGE_A(PG8_SA(0, 0), 0, k2, last);
            PG8_WAIT_V(8); PG8_WAIT_L(0); PG8_BAR; PG8_XMMA(1, 0, 0); PG8_XMMA(1, 1, 1); PG8_BAR; PG8_SCHED;
            PG8_XLDB(0, 1, 0); PG8_XLDB(1, 1, 1); PG8_SCHED; PG8_XLDA(1, 0); PG8_STAGE_A(PG8_SA(0, 1), 1, k2, last);
            PG8_WAIT_V(8); PG8_WAIT_L(0); PG8_BAR; PG8_XMMA(0, 0, 0); PG8_XMMA(0, 1, 1); PG8_BAR; PG8_SCHED;
            PG8_XLDA(1, 1); PG8_STAGE(PG8_SB(1, 0), b3, voffB); PG8_STAGE(PG8_SB(1, 1), b3 + hstep, voffB); PG8_STAGE_A(PG8_SA(1, 0), 0, k3, last);
            PG8_WAIT_V(8); PG8_WAIT_L(0); PG8_BAR; PG8_XMMA(1, 0, 0); PG8_XMMA(1, 1, 1); PG8_BAR; PG8_SCHED;
        }
#ifdef PROBE_EPI
        unsigned long long pe_t0 = 0; if (tid == 0) pe_t0 = __builtin_amdgcn_s_memrealtime();
#endif
        if constexpr (ALIGN_EPI) { if (wr == 0) PG8_BAR; }
        if constexpr (F8) asm volatile("s_nop 15\n\ts_nop 15" ::: "memory");
        E(acc, cur, wr, wc, fr, fq);
#ifdef PROBE_EPI
        if (tid == 0) { asm volatile("s_waitcnt vmcnt(0)" ::: "memory"); volatile LAS unsigned long long* pb_ = (volatile LAS unsigned long long*)(lds + MISC_OFF + 8192); pb_[1] = pb_[1] + (__builtin_amdgcn_s_memrealtime() - pe_t0); }
#endif
        if (!has_next) break;
        if (!(SEG2 && cur.e == 0))
#pragma unroll
        for (int a = 0; a < 2; ++a)
#pragma unroll
            for (int b = 0; b < 2; ++b)
#pragma unroll
                for (int m = 0; m < 4; ++m)
#pragma unroll
                    for (int n = 0; n < 2; ++n) acc[a][b][m][n] = (f32x4){0.f, 0.f, 0.f, 0.f};
        cur = nxt; cB = nB; cA = nA; ++ui;
        if constexpr (AMap::GATHER) { nxt = nn; has_next = has_nn;
#pragma unroll
            for (int h = 0; h < 2; ++h)
#pragma unroll
                for (int i = 0; i < 2; ++i) offC[h][i] = offN[h][i];
        }
        if constexpr (ALIGN_EPI) { if (wr == 1) PG8_BAR; }
    }
    PG8_WAIT_V(0);
    if constexpr (!ALIGN_EPI) { if (wr == 0) PG8_BAR; }
    PG8_BAR;
#undef PG8_STAGE_A
#undef PG8_LD8
#undef PG8_LDA8
#undef PG8_LDB8
#undef PG8_MMA8
#undef PG8_XLDA
#undef PG8_XLDB
#undef PG8_XMMA
#undef PG8_SA
#undef PG8_SB
#undef PG8_STAGE
#undef PG8_LDA
#undef PG8_LDB
#undef PG8_MMA
#undef PG8_WAIT_V
#undef PG8_WAIT_L
#undef PG8_BAR
#undef PG8_SCHED
#undef PG8_OFFS
#undef PG8_RAW
#undef PG8_CONV
}

#define EPI_PIN(x) asm volatile("" : "+v"(x))
#define LPIN(x) asm volatile("" : "+v"(x))
#define EPI_ROWSTEP(m) (((m) == 3) ? 80 : 16)
struct EpiProj {
    static constexpr bool PERM = true;
    bf16_t* O; const float* cs; const float* sn; float* alow; float scale;
    __device__ __forceinline__ void operator()(const f32x4 (&acc)[2][2][4][2], const Unit& u, int wr, int wc, int fr, int fq) const {
        const int row0 = u.pm * BM + wr * 64 + fr, col0 = u.pn * BM + wc * 32 + 8 * fq;
        unsigned off = (unsigned)(row0 * NP + col0) * 2u;
        if (u.pn < 12) {
            unsigned toff = (unsigned)((row0 & (SEQ - 1)) * 64 + wc * 16 + fq * 4) * 4u;
            f32x4 ct[2][4], st[2][4];
#pragma unroll
            for (int ai = 0; ai < 2; ++ai)
#pragma unroll
                for (int m = 0; m < 4; ++m) { ct[ai][m] = *(const f32x4*)((const char*)cs + toff + (ai * HALF + m * 16) * 64 * 4); st[ai][m] = *(const f32x4*)((const char*)sn + toff + (ai * HALF + m * 16) * 64 * 4); }
#pragma unroll
            for (int ai = 0; ai < 2; ++ai)
#pragma unroll
                for (int m = 0; m < 4; ++m) {
                    const f32x4 c4 = ct[ai][m], s4 = st[ai][m];
#pragma unroll
                    for (int bj = 0; bj < 2; ++bj) { const f32x4 v0 = acc[ai][bj][m][0] * scale, v1 = acc[ai][bj][m][1] * scale; u32x4 w;
                        w.x = pk2(v0[0] * c4[0] - v0[1] * s4[0], v0[1] * c4[0] + v0[0] * s4[0]);
                        w.y = pk2(v0[2] * c4[1] - v0[3] * s4[1], v0[3] * c4[1] + v0[2] * s4[1]);
                        w.z = pk2(v1[0] * c4[2] - v1[1] * s4[2], v1[1] * c4[2] + v1[0] * s4[2]);
                        w.w = pk2(v1[2] * c4[3] - v1[3] * s4[3], v1[3] * c4[3] + v1[2] * s4[3]);
                        *(u32x4*)((char*)O + off + bj * HALF * 2) = w; }
                    off += EPI_ROWSTEP(m) * NP * 2; EPI_PIN(off);
                }
        } else if (GATE_F8 && u.pn >= RB / 256 && u.pn < 46) {
            unsigned off8 = (unsigned)(row0 * NP) * 2u + (unsigned)(G8_BYTE0 + col0 - RB);
#pragma unroll
            for (int ai = 0; ai < 2; ++ai)
#pragma unroll
                for (int m = 0; m < 4; ++m) {
#pragma unroll
                    for (int bj = 0; bj < 2; ++bj) { const f32x4 v0 = acc[ai][bj][m][0] * scale, v1 = acc[ai][bj][m][1] * scale; u32x2 w;
                        w.x = pk_fp8x4(v0[0], v0[1], v0[2], v0[3]); w.y = pk_fp8x4(v1[0], v1[1], v1[2], v1[3]);
                        *(u32x2*)((char*)O + off8 + bj * HALF) = w; }
                    off8 += EPI_ROWSTEP(m) * NP * 2; EPI_PIN(off8); }
        } else if (u.pn < 46) {
#pragma unroll
            for (int ai = 0; ai < 2; ++ai)
#pragma unroll
                for (int m = 0; m < 4; ++m) {
#pragma unroll
                    for (int bj = 0; bj < 2; ++bj) { const f32x4 v0 = acc[ai][bj][m][0] * scale, v1 = acc[ai][bj][m][1] * scale; u32x4 w;
                        w.x = pk2(v0[0], v0[1]); w.y = pk2(v0[2], v0[3]); w.z = pk2(v1[0], v1[1]); w.w = pk2(v1[2], v1[3]);
                        *(u32x4*)((char*)O + off + bj * HALF * 2) = w; }
                    off += EPI_ROWSTEP(m) * NP * 2; EPI_PIN(off); }
        } else {
            if (wc == 0 && fq < 2) {
                unsigned aoff_ = (unsigned)(row0 * 16 + 8 * fq) * 4u;
#pragma unroll
                for (int ai = 0; ai < 2; ++ai)
#pragma unroll
                    for (int m = 0; m < 4; ++m) { float* rp = (float*)((char*)alow + aoff_);
                        *(f32x4*)rp = acc[ai][0][m][0] * scale; *(f32x4*)(rp + 4) = acc[ai][0][m][1] * scale;
                        aoff_ += EPI_ROWSTEP(m) * 16 * 4; EPI_PIN(aoff_); }
            }
        }
    }
};
template <bool FIRST> struct EpiGate {
    static constexpr bool PERM = true;
    bf16_t* O; const bf16_t* proj; int goff; float scale; unsigned char* O8;
    __device__ __forceinline__ void operator()(const f32x4 (&acc)[2][2][4][2], const Unit& u, int wr, int wc, int fr, int fq) const {
        const int row0 = u.pm * BM + wr * 64 + fr, col0 = u.pn * BM + wc * 32 + 8 * fq;
        const unsigned goffb = GATE_F8 ? (unsigned)(row0 * NP) * 2u + (unsigned)(G8_BYTE0 + goff - RB + col0) : (unsigned)(row0 * NP + goff + col0) * 2u, ooff = (unsigned)(row0 * D + col0) * 2u;
        u32x4 gA[2][2], gB[2][2], pA[2][2], pB[2][2];
#define EG_ROW(r) ((((r) >> 2) * 128) + (((r) & 3) * 16))
#define EG_LOAD(G, P, b) do { _Pragma("unroll") for (int rr = 0; rr < 2; ++rr) { const unsigned ro = EG_ROW(2 * (b) + rr); _Pragma("unroll") for (int bj = 0; bj < 2; ++bj) { \
            if (GATE_F8) { const u32x2 g8 = *(const u32x2*)((const char*)proj + goffb + ro * NP * 2 + bj * HALF); G[rr][bj] = (u32x4){g8.x, g8.y, 0u, 0u}; } \
            else G[rr][bj] = *(const u32x4*)((const char*)proj + goffb + ro * NP * 2 + bj * HALF * 2); \
            if (!FIRST) P[rr][bj] = *(const u32x4*)((const char*)O + ooff + ro * D * 2 + bj * HALF * 2); } } asm volatile("" ::: "memory"); } while (0)
#define EG_COMP(G, P, b) do { _Pragma("unroll") for (int rr = 0; rr < 2; ++rr) { const int r = 2 * (b) + rr, ai = r >> 2, m = r & 3; const unsigned ro = EG_ROW(r); _Pragma("unroll") for (int bj = 0; bj < 2; ++bj) { \
            const u32x4 gg = G[rr][bj]; const f32x4 v0 = acc[ai][bj][m][0] * scale, v1 = acc[ai][bj][m][1] * scale; float gf[8], r8[8]; \
            if (GATE_F8) unpack_fp8x8((u32x2){gg.x, gg.y}, gf); else { gf[0] = bflo(gg.x); gf[1] = bfhi(gg.x); gf[2] = bflo(gg.y); gf[3] = bfhi(gg.y); gf[4] = bflo(gg.z); gf[5] = bfhi(gg.z); gf[6] = bflo(gg.w); gf[7] = bfhi(gg.w); } \
            r8[0] = sigmoidf_(gf[0]) * v0[0]; r8[1] = sigmoidf_(gf[1]) * v0[1]; r8[2] = sigmoidf_(gf[2]) * v0[2]; r8[3] = sigmoidf_(gf[3]) * v0[3]; \
            r8[4] = sigmoidf_(gf[4]) * v1[0]; r8[5] = sigmoidf_(gf[5]) * v1[1]; r8[6] = sigmoidf_(gf[6]) * v1[2]; r8[7] = sigmoidf_(gf[7]) * v1[3]; \
            if (!FIRST) { const u32x4 pq = P[rr][bj]; r8[0] += bflo(pq.x); r8[1] += bfhi(pq.x); r8[2] += bflo(pq.y); r8[3] += bfhi(pq.y); r8[4] += bflo(pq.z); r8[5] += bfhi(pq.z); r8[6] += bflo(pq.w); r8[7] += bfhi(pq.w); } \
            if (!FIRST && O8) { u32x2 w8; w8.x = pk_fp8x4(r8[0], r8[1], r8[2], r8[3]); w8.y = pk_fp8x4(r8[4], r8[5], r8[6], r8[7]); *(u32x2*)(O8 + (ooff >> 1) + ro * D + bj * HALF) = w8; } \
            else { u32x4 w; w.x = pk2(r8[0], r8[1]); w.y = pk2(r8[2], r8[3]); w.z = pk2(r8[4], r8[5]); w.w = pk2(r8[6], r8[7]); *(u32x4*)((char*)O + ooff + ro * D * 2 + bj * HALF * 2) = w; } } } asm volatile("" ::: "memory"); } while (0)
        EG_LOAD(gA, pA, 0); EG_LOAD(gB, pB, 1); EG_COMP(gA, pA, 0); EG_LOAD(gA, pA, 2); EG_COMP(gB, pB, 1); EG_LOAD(gB, pB, 3); EG_COMP(gA, pA, 2); EG_COMP(gB, pB, 3);
#undef EG_LOAD
#undef EG_COMP
    }
};
struct EpiGate2 {
    static constexpr bool PERM = true;
    const bf16_t* proj; float scale; unsigned char* O8;
    __device__ __forceinline__ void operator()(f32x4 (&acc)[2][2][4][2], const Unit& u, int wr, int wc, int fr, int fq) const {
        const int row0 = u.pm * BM + wr * 64 + fr, col0 = u.pn * BM + wc * 32 + 8 * fq;
        const unsigned goffa = (unsigned)(row0 * NP) * 2u + (unsigned)(G8_BYTE0 + GA - RB + col0), ooff = (unsigned)(row0 * D + col0);
        u32x4 gA[2][2], gB[2][2];
#define EG_ROW(r) ((((r) >> 2) * 128) + (((r) & 3) * 16))
        if (u.e == 0) {
#define E2_LOAD(G, b) do { _Pragma("unroll") for (int rr = 0; rr < 2; ++rr) { const unsigned ro = EG_ROW(2 * (b) + rr); _Pragma("unroll") for (int bj = 0; bj < 2; ++bj) { \
            const u32x2 ga8 = *(const u32x2*)((const char*)proj + goffa + ro * NP * 2 + bj * HALF), gb8 = *(const u32x2*)((const char*)proj + goffa + (GB - GA) + ro * NP * 2 + bj * HALF); \
            G[rr][bj] = (u32x4){ga8.x, ga8.y, gb8.x, gb8.y}; } } asm volatile("" ::: "memory"); } while (0)
#define E2_COMP(G, b) do { _Pragma("unroll") for (int rr = 0; rr < 2; ++rr) { const int r = 2 * (b) + rr, ai = r >> 2, m = r & 3; _Pragma("unroll") for (int bj = 0; bj < 2; ++bj) { \
            const u32x4 gg = G[rr][bj]; float fa[8], fb[8]; unpack_fp8x8((u32x2){gg.x, gg.y}, fa); unpack_fp8x8((u32x2){gg.z, gg.w}, fb); \
            _Pragma("unroll") for (int j = 0; j < 8; ++j) { const float q = (1.0f + __expf(-fmaxf(fa[j], -30.0f))) * sigmoidf_(fb[j]); acc[ai][bj][m][j >> 2][j & 3] *= q; } } } } while (0)
            E2_LOAD(gA, 0); E2_LOAD(gB, 1); E2_COMP(gA, 0); E2_LOAD(gA, 2); E2_COMP(gB, 1); E2_LOAD(gB, 3); E2_COMP(gA, 2); E2_COMP(gB, 3);
#undef E2_LOAD
#undef E2_COMP
        } else {
#define E2_LOAD(G, b) do { _Pragma("unroll") for (int rr = 0; rr < 2; ++rr) { const unsigned ro = EG_ROW(2 * (b) + rr); _Pragma("unroll") for (int bj = 0; bj < 2; ++bj) { \
            const u32x2 ga8 = *(const u32x2*)((const char*)proj + goffa + ro * NP * 2 + bj * HALF); G[rr][bj] = (u32x4){ga8.x, ga8.y, 0u, 0u}; } } asm volatile("" ::: "memory"); } while (0)
#define E2_COMP(G, b) do { _Pragma("unroll") for (int rr = 0; rr < 2; ++rr) { const int r = 2 * (b) + rr, ai = r >> 2, m = r & 3; const unsigned ro = EG_ROW(r); _Pragma("unroll") for (int bj = 0; bj < 2; ++bj) { \
            const u32x4 gg = G[rr][bj]; float fa[8], r8[8]; unpack_fp8x8((u32x2){gg.x, gg.y}, fa); \
            _Pragma("unroll") for (int j = 0; j < 8; ++j) r8[j] = sigmoidf_(fmaxf(fa[j], -30.0f)) * (acc[ai][bj][m][j >> 2][j & 3] * scale); \
            u32x2 w8; w8.x = pk_fp8x4(r8[0], r8[1], r8[2], r8[3]); w8.y = pk_fp8x4(r8[4], r8[5], r8[6], r8[7]); *(u32x2*)(O8 + ooff + ro * D + bj * HALF) = w8; } } asm volatile("" ::: "memory"); } while (0)
            E2_LOAD(gA, 0); E2_LOAD(gB, 1); E2_COMP(gA, 0); E2_LOAD(gA, 2); E2_COMP(gB, 1); E2_LOAD(gB, 3); E2_COMP(gA, 2); E2_COMP(gB, 3);
#undef E2_LOAD
#undef E2_COMP
        }
#undef EG_ROW
    }
};
#define EG_ROW(r) ((((r) >> 2) * 128) + (((r) & 3) * 16))
template <bool XF32> struct EpiResid {
    static constexpr bool PERM = true;
    const void* xi; bf16_t* xo; const float* gate; float scale;
    __device__ __forceinline__ void operator()(const f32x4 (&acc)[2][2][4][2], const Unit& u, int wr, int wc, int fr, int fq) const {
        const int row0 = u.pm * BM + wr * 64 + fr, col0 = u.pn * BM + wc * 32 + 8 * fq;
        const int b = (u.pm * BM) / SEQ;
        f32x4 gt[2][2];
#pragma unroll
        for (int bj = 0; bj < 2; ++bj)
#pragma unroll
            for (int n = 0; n < 2; ++n) gt[bj][n] = *(const f32x4*)(gate + (size_t)b * 12288 + col0 + bj * HALF + 4 * n) * scale;
        const unsigned off = (unsigned)(row0 * D + col0);
        constexpr int RB_ = XF32 ? 1 : 2, NBAT = 8 / RB_;
        f32x4 xA[RB_][2][2], xB[RB_][2][2];
#define ER_LOAD(X, bb) do { _Pragma("unroll") for (int rr = 0; rr < RB_; ++rr) { const unsigned ro = EG_ROW(RB_ * (bb) + rr); _Pragma("unroll") for (int bj = 0; bj < 2; ++bj) { const unsigned o = off + ro * D + bj * HALF; \
            if (XF32) { X[rr][bj][0] = *(const f32x4*)((const float*)xi + o); X[rr][bj][1] = *(const f32x4*)((const float*)xi + o + 4); } \
            else { const u32x4 rw = *(const u32x4*)((const bf16_t*)xi + o); X[rr][bj][0] = (f32x4){bflo(rw.x), bfhi(rw.x), bflo(rw.y), bfhi(rw.y)}; X[rr][bj][1] = (f32x4){bflo(rw.z), bfhi(rw.z), bflo(rw.w), bfhi(rw.w)}; } } } asm volatile("" ::: "memory"); } while (0)
#define ER_COMP(X, bb) do { _Pragma("unroll") for (int rr = 0; rr < RB_; ++rr) { const int r = RB_ * (bb) + rr, ai = r >> 2, m = r & 3; const unsigned ro = EG_ROW(r); _Pragma("unroll") for (int bj = 0; bj < 2; ++bj) { const unsigned o = off + ro * D + bj * HALF; \
            const f32x4 v0 = X[rr][bj][0] + gt[bj][0] * acc[ai][bj][m][0], v1 = X[rr][bj][1] + gt[bj][1] * acc[ai][bj][m][1]; \
            u32x4 w; w.x = pk2(v0[0], v0[1]); w.y = pk2(v0[2], v0[3]); w.z = pk2(v1[0], v1[1]); w.w = pk2(v1[2], v1[3]); *(u32x4*)(xo + o) = w; } } asm volatile("" ::: "memory"); } while (0)
        ER_LOAD(xA, 0);
#pragma unroll
        for (int bb = 0; bb < NBAT; bb += 2) {
            ER_LOAD(xB, bb + 1); ER_COMP(xA, bb);
            if (bb + 2 < NBAT) ER_LOAD(xA, bb + 2);
            ER_COMP(xB, bb + 1); }
#undef ER_LOAD
#undef ER_COMP
#undef EG_ROW
    }
};
struct EpiSwiGLU {
    static constexpr bool PERM = true;
    bf16_t* O;
    __device__ __forceinline__ void operator()(const f32x4 (&acc)[2][2][4][2], const Unit& u, int wr, int wc, int fr, int fq) const {
        const int row0 = u.pm * BM + wr * 64 + fr, col0 = u.pn * HALF + wc * 32 + 8 * fq;
        unsigned off = (unsigned)(row0 * FF + col0) * 2u;
#pragma unroll
        for (int ai = 0; ai < 2; ++ai)
#pragma unroll
            for (int m = 0; m < 4; ++m) { const f32x4 g0 = acc[ai][0][m][0], g1 = acc[ai][0][m][1], u0 = acc[ai][1][m][0], u1 = acc[ai][1][m][1]; u32x4 w;
                w.x = pk2(siluf_(g0[0]) * u0[0], siluf_(g0[1]) * u0[1]); w.y = pk2(siluf_(g0[2]) * u0[2], siluf_(g0[3]) * u0[3]);
                w.z = pk2(siluf_(g1[0]) * u1[0], siluf_(g1[1]) * u1[1]); w.w = pk2(siluf_(g1[2]) * u1[2], siluf_(g1[3]) * u1[3]);
                *(u32x4*)((char*)O + off) = w;
                off += EPI_ROWSTEP(m) * FF * 2; EPI_PIN(off); }
    }
};
struct EpiPlain {
    static constexpr bool PERM = true;
    bf16_t* O;
    __device__ __forceinline__ void operator()(const f32x4 (&acc)[2][2][4][2], const Unit& u, int wr, int wc, int fr, int fq) const {
        const int row0 = u.pm * BM + wr * 64 + fr, col0 = u.pn * BM + wc * 32 + 8 * fq;
        unsigned off = (unsigned)(row0 * D + col0) * 2u;
#pragma unroll
        for (int ai = 0; ai < 2; ++ai)
#pragma unroll
            for (int m = 0; m < 4; ++m) {
#pragma unroll
                for (int bj = 0; bj < 2; ++bj) { const f32x4 v0 = acc[ai][bj][m][0], v1 = acc[ai][bj][m][1]; u32x4 w;
                    w.x = pk2(v0[0], v0[1]); w.y = pk2(v0[2], v0[3]); w.z = pk2(v1[0], v1[1]); w.w = pk2(v1[2], v1[3]);
                    *(u32x4*)((char*)O + off + bj * HALF * 2) = w; }
                off += EPI_ROWSTEP(m) * D * 2; EPI_PIN(off); }
    }
};
constexpr float W8_SCALE = 32.0f, W8_INV = 1.0f / 32.0f;
struct EpiSwiGLU8 {
    static constexpr bool PERM = true;
    unsigned char* O;
    __device__ __forceinline__ void operator()(const f32x4 (&acc)[2][2][4][2], const Unit& u, int wr, int wc, int fr, int fq) const {
        const int row0 = u.pm * BM + wr * 64 + fr, col0 = u.pn * HALF + wc * 32 + 8 * fq;
        unsigned off = (unsigned)(row0 * FF + col0);
#pragma unroll
        for (int ai = 0; ai < 2; ++ai)
#pragma unroll
            for (int m = 0; m < 4; ++m) { const f32x4 g0 = acc[ai][0][m][0] * W8_INV, g1 = acc[ai][0][m][1] * W8_INV, u0 = acc[ai][1][m][0] * W8_INV, u1 = acc[ai][1][m][1] * W8_INV; u32x2 w;
                w.x = pk_fp8x4(siluf_(g0[0]) * u0[0], siluf_(g0[1]) * u0[1], siluf_(g0[2]) * u0[2], siluf_(g0[3]) * u0[3]);
                w.y = pk_fp8x4(siluf_(g1[0]) * u1[0], siluf_(g1[1]) * u1[1], siluf_(g1[2]) * u1[2], siluf_(g1[3]) * u1[3]);
                *(u32x2*)(O + off) = w;
                off += EPI_ROWSTEP(m) * FF; EPI_PIN(off); }
    }
};
struct EpiPlainS {
    static constexpr bool PERM = true;
    bf16_t* O; float scale;
    __device__ __forceinline__ void operator()(const f32x4 (&acc)[2][2][4][2], const Unit& u, int wr, int wc, int fr, int fq) const {
        const int row0 = u.pm * BM + wr * 64 + fr, col0 = u.pn * BM + wc * 32 + 8 * fq;
        unsigned off = (unsigned)(row0 * D + col0) * (Y_F8 ? 1u : 2u);
#pragma unroll
        for (int ai = 0; ai < 2; ++ai)
#pragma unroll
            for (int m = 0; m < 4; ++m) {
#pragma unroll
                for (int bj = 0; bj < 2; ++bj) { const f32x4 v0 = acc[ai][bj][m][0] * scale, v1 = acc[ai][bj][m][1] * scale;
#if Y_F8
                    u32x2 w; w.x = pk_fp8x4(v0[0], v0[1], v0[2], v0[3]); w.y = pk_fp8x4(v1[0], v1[1], v1[2], v1[3]);
                    *(u32x2*)((char*)O + off + bj * HALF) = w;
#else
                    u32x4 w; w.x = pk2(v0[0], v0[1]); w.y = pk2(v0[2], v0[3]); w.z = pk2(v1[0], v1[1]); w.w = pk2(v1[2], v1[3]);
                    *(u32x4*)((char*)O + off + bj * HALF * 2) = w;
#endif
                }
                off += EPI_ROWSTEP(m) * D * (Y_F8 ? 1 : 2); EPI_PIN(off); }
    }
};
}

struct Args {
    const float* x; const float* c; const float* w_ada; const float* b_ada; const float* norm_mix; const float* norm_ffn; const float* w_in;
    const float* w_alpha2; const float* b_alpha2; const float* gla_gain; const float* w_out_a; const float* w_out_b; const float* w_out;
    const float* w_router; const float* b_router; const float* w_gate_e; const float* w_up_e; const float* w_down_e; const float* final_norm;
    float* out; unsigned char* ws; int ph_lo, ph_hi;
};

__device__ __forceinline__ int proj_src_col(int n) {
    if (n < 3072) { const int blk = n >> 7, w = n & 127; return (blk << 7) + (w >> 1) + ((w & 1) << 6); }
    if (n < 7680) return n;
    if (n < 11776) return n + 16;
    if (n < 11792) return n - 4096;
    return -1;
}
struct TrDesc { const float* src; unsigned char* dst; int ldw, K, zero, rope, f8; };
__device__ __forceinline__ void tr_load(const TrDesc& d, f32x4 (&v)[16]) {
#pragma unroll
    for (int i = 0; i < 16; ++i) v[i] = *(const f32x4*)(d.src + (size_t)(4 * i) * d.ldw);
}
__device__ __forceinline__ void tr_finish(const TrDesc& d, f32x4 (&v)[16], LAS float* scr, int lane) {
    const int kk = lane >> 4, q4 = lane & 15;
    if (d.zero) {
#pragma unroll
        for (int i = 0; i < 16; ++i) v[i] = (f32x4){0.f, 0.f, 0.f, 0.f}; }
    const int d0 = d.rope ? 8 * (q4 & 7) + (q4 >> 3) : 4 * q4, ds = d.rope ? 2 : 1;
    { LAS float* rp = scr + kk * 65 + d0;
#pragma unroll
        for (int i = 0; i < 16; ++i) { rp[4 * i * 65] = v[i][0]; rp[4 * i * 65 + ds] = v[i][1]; rp[4 * i * 65 + 2 * ds] = v[i][2]; rp[4 * i * 65 + 3 * ds] = v[i][3]; } }
    LDS_WAIT(); asm volatile("" ::: "memory");
    if (d.f8) {
        const int c = lane & 3, nl = lane >> 2; const LAS float* sp = scr + (16 * c) * 65 + nl; unsigned char* dp = d.dst + (size_t)nl * d.K + 16 * c;
#pragma unroll
        for (int j = 0; j < 4; ++j) { u32x4 o;
            o.x = pk_fp8x4(sp[0 * 65 + 16 * j] * 32.0f, sp[1 * 65 + 16 * j] * 32.0f, sp[2 * 65 + 16 * j] * 32.0f, sp[3 * 65 + 16 * j] * 32.0f);
            o.y = pk_fp8x4(sp[4 * 65 + 16 * j] * 32.0f, sp[5 * 65 + 16 * j] * 32.0f, sp[6 * 65 + 16 * j] * 32.0f, sp[7 * 65 + 16 * j] * 32.0f);
            o.z = pk_fp8x4(sp[8 * 65 + 16 * j] * 32.0f, sp[9 * 65 + 16 * j] * 32.0f, sp[10 * 65 + 16 * j] * 32.0f, sp[11 * 65 + 16 * j] * 32.0f);
            o.w = pk_fp8x4(sp[12 * 65 + 16 * j] * 32.0f, sp[13 * 65 + 16 * j] * 32.0f, sp[14 * 65 + 16 * j] * 32.0f, sp[15 * 65 + 16 * j] * 32.0f);
            *(GAS u32x4*)(dp + (size_t)(16 * j) * d.K) = o; }
    } else {
        const int c = lane & 7, nl = lane >> 3; const LAS float* sp = scr + (8 * c) * 65 + nl; unsigned char* dp = d.dst + ((size_t)nl * d.K + 8 * c) * 2;
#pragma unroll
        for (int j = 0; j < 8; ++j) { u32x4 o;
            o.x = pk2(sp[0 * 65 + 8 * j], sp[1 * 65 + 8 * j]); o.y = pk2(sp[2 * 65 + 8 * j], sp[3 * 65 + 8 * j]); o.z = pk2(sp[4 * 65 + 8 * j], sp[5 * 65 + 8 * j]); o.w = pk2(sp[6 * 65 + 8 * j], sp[7 * 65 + 8 * j]);
            *(GAS u32x4*)(dp + (size_t)(8 * j) * d.K * 2) = o; }
    }
    LDS_WAIT(); asm volatile("" ::: "memory");
}

typedef const __attribute__((address_space(4))) Args CArgsP;
__device__ __forceinline__ void prologue_phase(CArgsP* ap_, LAS unsigned char* lds, int vcu, int G, int tid, int wave, int lane, int parts = 7) {
#define a (*ap_)
    unsigned char* ws = a.ws;
    if (parts & 1) {
        LAS float* cact = (LAS float*)lds;
        LAS float* red = (LAS float*)(lds + 65536);
        for (int i = tid; i < NB * D; i += NTHREADS) { const int b = i >> 11, k = i & 2047; cact[k * 8 + b] = siluf_(a.c[i]); }
        __syncthreads();
        float* ada = (float*)(ws + WS_ADA);
        const int q = tid & 7, kg = tid >> 3;
        for (int u = vcu; u < DEPTH * 384; u += G) {
            const int l = u / 384, n0 = (u % 384) * 32;
            const float* W = a.w_ada + (size_t)l * D * 12288 + n0 + 4 * q;
            f32x4 acc[8];
#pragma unroll
            for (int b = 0; b < 8; ++b) acc[b] = (f32x4){0.f, 0.f, 0.f, 0.f};
#pragma unroll 8
            for (int kk = 0; kk < 32; ++kk) { const int k = kg * 32 + kk; const f32x4 w = *(const f32x4*)(W + (size_t)k * 12288);
                const f32x4 c0 = *(const LAS f32x4*)(cact + k * 8), c1 = *(const LAS f32x4*)(cact + k * 8 + 4);
                acc[0] += w * c0[0]; acc[1] += w * c0[1]; acc[2] += w * c0[2]; acc[3] += w * c0[3];
                acc[4] += w * c1[0]; acc[5] += w * c1[1]; acc[6] += w * c1[2]; acc[7] += w * c1[3]; }
#pragma unroll
            for (int b = 0; b < 8; ++b) *(LAS f32x4*)(red + (kg * 8 + b) * 32 + 4 * q) = acc[b];
            __syncthreads();
            if (tid < 256) { const int b = tid >> 5, col = tid & 31; float s = a.b_ada[(size_t)l * 12288 + n0 + col];
                for (int g = 0; g < 64; ++g) s += red[(g * 8 + b) * 32 + col];
                const int n = n0 + col;
                if (n >= 2048 && n < 4096) s = (1.0f + s) * a.norm_mix[(size_t)l * D + n - 2048]; else if (n >= 8192 && n < 10240) s = (1.0f + s) * a.norm_ffn[(size_t)l * D + n - 8192];
                ada[((size_t)l * NB + b) * 12288 + n] = s; }
            __syncthreads();
        }
    }
    if (parts & 2) {
        float* cs = (float*)(ws + WS_ROPE); float* sn = cs + SEQ * 64;
        for (int i = vcu * NTHREADS + tid; i < SEQ * 64; i += G * NTHREADS) {
            const int pos = i >> 6, fi = i & 63;
            double f = 1.0;
            if (fi & 1) f *= 0.8659643233600653; if (fi & 2) f *= 0.7498942093324558; if (fi & 4) f *= 0.5623413251903491;
            if (fi & 8) f *= 0.31622776601683794; if (fi & 16) f *= 0.09999999999999999; if (fi & 32) f *= 0.009999999999999998;
            double rev = (double)pos * f * 0.15915494309189535; rev -= __builtin_floor(rev);
            const float rv = (float)rev;
            cs[i] = __builtin_amdgcn_cosf(rv); sn[i] = __builtin_amdgcn_sinf(rv);
        }
    }
    if (parts & 4) {
        LAS float* scr = (LAS float*)(lds + wave * 16640);
        const int gw = vcu * NWAVES + wave, NGW = G * NWAVES;
        constexpr int C_IN = 32 * 188, C_OA = 8 * 32, C_OB = 16 * 32, C_O = 32 * 32, C_GU = 16 * 32 * 32, C_DN = 16 * 16 * 32, C_L = C_IN + C_OA + C_OB + C_O + C_GU + C_DN, NIT = DEPTH * C_L;
        const int q4 = lane & 15, kk = lane >> 4;
        auto decode = [&](int it) -> TrDesc {
            TrDesc d; d.zero = 0; d.rope = 0; d.f8 = 0;
            const int l = it / C_L; int r = it % C_L;
            const float* W; unsigned char* WT; int ldw, K, k0, n0, scol, esz = 2;
            if (r < C_IN) { const int kb = r / 188, nb = r % 188; n0 = 64 * nb; k0 = 64 * kb; ldw = NIN; K = D; W = a.w_in + (size_t)l * D * NIN;
                if (n0 < 3072) { d.rope = 1; scol = (n0 >> 7) * 128 + 32 * ((n0 >> 6) & 1) + 64 * (q4 >> 3) + 4 * (q4 & 7); }
                else if (n0 < 7680) scol = n0 + 4 * q4;
                else if (n0 < 11776) scol = n0 + 16 + 4 * q4;
                else if (n0 == 11776) { scol = (q4 < 4) ? 7680 + 4 * q4 : 0; d.zero = (q4 < 4) ? 0 : 1; }
                else { scol = 0; d.zero = 1; }
#if PROJ_F8
                d.f8 = 1; esz = 1; WT = ws + WS_WIN + (size_t)l * NP * D;
#else
                WT = ws + WS_WIN + (size_t)l * NP * D * 2;
#endif
            } else if ((r -= C_IN) < C_OA) { const int kb = r / 32, nb = r % 32; n0 = 64 * nb; k0 = 64 * kb; ldw = D; K = 512; scol = n0 + 4 * q4; W = a.w_out_a + (size_t)l * 512 * D; WT = ws + WS_WOA + (size_t)l * D * 512 * (MIX_F8 ? 1 : 2); if (MIX_F8) { d.f8 = 1; esz = 1; }
                if (BR_FUSE) { K = 1536; WT = ws + WS_WOA + (size_t)l * D * 1536 + 1024; }
            } else if ((r -= C_OA) < C_OB) { const int kb = r / 32, nb = r % 32; n0 = 64 * nb; k0 = 64 * kb; ldw = D; K = 1024; scol = n0 + 4 * q4; W = a.w_out_b + (size_t)l * 1024 * D; WT = ws + WS_WOB + (size_t)l * D * 1024 * (MIX_F8 ? 1 : 2); if (MIX_F8) { d.f8 = 1; esz = 1; }
                if (BR_FUSE) { K = 1536; WT = ws + WS_WOA + (size_t)l * D * 1536; }
            } else if ((r -= C_OB) < C_O) { const int kb = r / 32, nb = r % 32; n0 = 64 * nb; k0 = 64 * kb; ldw = D; K = D; scol = n0 + 4 * q4; W = a.w_out + (size_t)l * D * D; WT = ws + WS_WO + (size_t)l * D * D * (MIX_F8 ? 1 : 2); if (MIX_F8) { d.f8 = 1; esz = 1; }
            } else if ((r -= C_O) < C_GU) { const int e = r / 1024, r2 = r % 1024, kb = r2 / 32, nb = r2 % 32, pn = nb >> 2, sgu = (nb >> 1) & 1, c0 = 64 * (nb & 1);
                n0 = 64 * nb; k0 = 64 * kb; ldw = FF; K = D; scol = 128 * pn + c0 + 4 * q4; W = (sgu ? a.w_up_e : a.w_gate_e) + (size_t)(l * NE + e) * D * FF; WT = ws + WS_WGU + (size_t)(l * NE + e) * 2048 * D; d.f8 = 1; esz = 1;
            } else { r -= C_GU; const int e = r / 512, r2 = r % 512, kb = r2 / 32, nb = r2 % 32;
                n0 = 64 * nb; k0 = 64 * kb; ldw = D; K = FF; scol = n0 + 4 * q4; W = a.w_down_e + (size_t)(l * NE + e) * FF * D; WT = ws + WS_WDN + (size_t)(l * NE + e) * D * FF; d.f8 = 1; esz = 1; }
            d.src = W + (size_t)(k0 + kk) * ldw + scol; d.ldw = ldw; d.K = K; d.dst = WT + ((size_t)n0 * K + k0) * esz;
            return d; };
        int it = gw; TrDesc dA, dB; f32x4 vA[16], vB[16];
        if (it < NIT) { dA = decode(it); tr_load(dA, vA); }
        while (it < NIT) {
            const int itB = it + NGW;
            if (itB < NIT) { dB = decode(itB); tr_load(dB, vB); }
            tr_finish(dA, vA, scr, lane);
            if (itB >= NIT) break;
            const int itA = itB + NGW;
            if (itA < NIT) { dA = decode(itA); tr_load(dA, vA); }
            tr_finish(dB, vB, scr, lane);
            it = itA;
        }
    }
}
#undef a

struct MoeStarts {
    int ts[NE];
    __device__ __forceinline__ void init(const unsigned* cnt) { int acc = 0;
#pragma unroll
        for (int e = 0; e < NE; ++e) { ts[e] = acc; acc += ((int)__hip_atomic_load(cnt + 64 * e, RLX_AGENT) + 255) >> 8; } }
    __device__ __forceinline__ int row(int slot) const { const int e = slot >> 16; int t0 = 0;
#pragma unroll
        for (int j = 0; j < NE; ++j) t0 = (e == j) ? ts[j] : t0;
        return t0 * 256 + (slot & 0xffff); }
};

template <int MODE>
__device__ __forceinline__ void norm_phase(const void* xs, void* xd, bf16_t* hout, const float* gain, const float* ada_scale, const float* ada_shift, const float* ada_gate2,
                                           const bf16_t* Y, const int* tslot, const float* tw, const unsigned* cnt, int vcu, int G, int wave, int lane) {
    const int gw = vcu * NWAVES + wave, NGW = G * NWAVES, rpw = T / NGW;
    MoeStarts ms; if (MODE != 0) ms.init(cnt);
    int tsl = 0; float twl = 0.f;
    if (MODE != 0) { const int i0 = gw * rpw * 2, ii = (i0 + lane < 2 * T) ? i0 + lane : 2 * T - 1; tsl = tslot[ii]; twl = tw[ii]; }
    for (int k = 0; k < rpw; k += 2) {
        const int row = gw * rpw + k, b = row >> 11;
        f32x4 v[2][8]; u32x2 xraw[2][8];
        int s0[2], s1[2]; float w0[2], w1[2];
        if (MODE != 0) {
#pragma unroll
            for (int rr = 0; rr < 2; ++rr) { s0[rr] = __builtin_amdgcn_readlane(tsl, (k + rr) * 2); s1[rr] = __builtin_amdgcn_readlane(tsl, (k + rr) * 2 + 1);
                w0[rr] = __builtin_bit_cast(float, __builtin_amdgcn_readlane(__builtin_bit_cast(int, twl), (k + rr) * 2)); w1[rr] = __builtin_bit_cast(float, __builtin_amdgcn_readlane(__builtin_bit_cast(int, twl), (k + rr) * 2 + 1)); } }
#pragma unroll
        for (int rr = 0; rr < 2; ++rr) {
            if (MODE == 0) { const GAS f32x4* xr = (const GAS f32x4*)((const float*)xs + (size_t)(row + rr) * D) + lane;
#pragma unroll
                for (int j = 0; j < 8; ++j) v[rr][j] = xr[64 * j];
            } else { const GAS u32x2* xr = (const GAS u32x2*)((const bf16_t*)xs + (size_t)(row + rr) * D) + lane;
#pragma unroll
                for (int j = 0; j < 8; ++j) xraw[rr][j] = xr[64 * j]; } }
        f32x4 ggv[8], ssv[8], scv[8];
#define GSS_LOAD() do { const GAS f32x4* gn_ = (const GAS f32x4*)gain + lane; \
            if (MODE == 2) { _Pragma("unroll") for (int j = 0; j < 8; ++j) { ggv[j] = gn_[64 * j]; scv[j] = (f32x4){0.f, 0.f, 0.f, 0.f}; ssv[j] = (f32x4){0.f, 0.f, 0.f, 0.f}; } } \
            else { const GAS f32x4* sc_ = (const GAS f32x4*)(ada_scale + (size_t)b * 12288) + lane; const GAS f32x4* sh_ = (const GAS f32x4*)(ada_shift + (size_t)b * 12288) + lane; \
                _Pragma("unroll") for (int j = 0; j < 8; ++j) { ggv[j] = sc_[64 * j]; scv[j] = (f32x4){0.f, 0.f, 0.f, 0.f}; ssv[j] = sh_[64 * j]; } } asm volatile("" ::: "memory"); } while (0)
        if (MODE == 0) GSS_LOAD();
        if (MODE != 0) {
            const GAS f32x4* gt = (const GAS f32x4*)(ada_gate2 + (size_t)b * 12288) + lane;
#if Y_F8
            unsigned ya[2][8], yb[2][8];
#pragma unroll
            for (int rr = 0; rr < 2; ++rr) { const GAS unsigned* y0 = (const GAS unsigned*)((const unsigned char*)Y + (size_t)ms.row(s0[rr]) * D) + lane; const GAS unsigned* y1 = (const GAS unsigned*)((const unsigned char*)Y + (size_t)ms.row(s1[rr]) * D) + lane;
#pragma unroll
                for (int j = 0; j < 8; ++j) { ya[rr][j] = y0[64 * j]; yb[rr][j] = y1[64 * j]; } }
            f32x4 gtv[8];
#pragma unroll
            for (int j = 0; j < 8; ++j) gtv[j] = gt[64 * j];
            asm volatile("" ::: "memory");
#pragma unroll
            for (int rr = 0; rr < 2; ++rr)
#pragma unroll
                for (int j = 0; j < 8; ++j) { LPIN(xraw[rr][j]); LPIN(ya[rr][j]); LPIN(yb[rr][j]); }
#pragma unroll
            for (int j = 0; j < 8; ++j) LPIN(gtv[j]);
#pragma unroll
            for (int rr = 0; rr < 2; ++rr)
#pragma unroll
                for (int j = 0; j < 8; ++j) { const u32x2 r = xraw[rr][j]; v[rr][j] = (f32x4){bflo(r.x), bfhi(r.x), bflo(r.y), bfhi(r.y)}; }
#pragma unroll
            for (int j = 0; j < 8; ++j) { const f32x4 g = gtv[j];
#pragma unroll
                for (int rr = 0; rr < 2; ++rr) {
                    const f32x2_t a0l = __builtin_amdgcn_cvt_pk_f32_fp8((int)ya[rr][j], false), a0h = __builtin_amdgcn_cvt_pk_f32_fp8((int)ya[rr][j], true), a1l = __builtin_amdgcn_cvt_pk_f32_fp8((int)yb[rr][j], false), a1h = __builtin_amdgcn_cvt_pk_f32_fp8((int)yb[rr][j], true);
                    f32x4 m; m[0] = w0[rr] * a0l[0] + w1[rr] * a1l[0]; m[1] = w0[rr] * a0l[1] + w1[rr] * a1l[1]; m[2] = w0[rr] * a0h[0] + w1[rr] * a1h[0]; m[3] = w0[rr] * a0h[1] + w1[rr] * a1h[1];
                    v[rr][j] = v[rr][j] + g * m; } }
#else
            u32x2 ya[2][8], yb[2][8];
#pragma unroll
            for (int rr = 0; rr < 2; ++rr) { const GAS u32x2* y0 = (const GAS u32x2*)(Y + (size_t)ms.row(s0[rr]) * D) + lane; const GAS u32x2* y1 = (const GAS u32x2*)(Y + (size_t)ms.row(s1[rr]) * D) + lane;
#pragma unroll
                for (int j = 0; j < 8; ++j) { ya[rr][j] = y0[64 * j]; yb[rr][j] = y1[64 * j]; } }
#pragma unroll
            for (int j = 0; j < 8; ++j) { const f32x4 g = gt[64 * j];
#pragma unroll
                for (int rr = 0; rr < 2; ++rr) { const u32x2 a0 = ya[rr][j], a1 = yb[rr][j];
                    f32x4 m; m[0] = w0[rr] * bflo(a0.x) + w1[rr] * bflo(a1.x); m[1] = w0[rr] * bfhi(a0.x) + w1[rr] * bfhi(a1.x); m[2] = w0[rr] * bflo(a0.y) + w1[rr] * bflo(a1.y); m[3] = w0[rr] * bfhi(a0.y) + w1[rr] * bfhi(a1.y);
                    v[rr][j] = v[rr][j] + g * m; } }
#endif
            GSS_LOAD();
            if (MODE == 1) {
#pragma unroll
                for (int rr = 0; rr < 2; ++rr) { GAS u32x2* xw = (GAS u32x2*)((bf16_t*)xd + (size_t)(row + rr) * D) + lane;
#pragma unroll
                    for (int j = 0; j < 8; ++j) { u32x2 w; w.x = pk2(v[rr][j][0], v[rr][j][1]); w.y = pk2(v[rr][j][2], v[rr][j][3]); xw[64 * j] = w; } } }
        }
        float rstd[2];
#pragma unroll
        for (int rr = 0; rr < 2; ++rr) { float s = 0.f;
#pragma unroll
            for (int j = 0; j < 8; ++j) s += (v[rr][j][0] * v[rr][j][0] + v[rr][j][1] * v[rr][j][1]) + (v[rr][j][2] * v[rr][j][2] + v[rr][j][3] * v[rr][j][3]);
            rstd[rr] = 1.0f / sqrtf(wave_sum(s, lane) * (1.0f / D) + NORM_EPS); }
        if (MODE == 2) {
#pragma unroll
            for (int j = 0; j < 8; ++j) { const f32x4 gg = ggv[j];
#pragma unroll
                for (int rr = 0; rr < 2; ++rr) ((GAS f32x4*)((float*)xd + (size_t)(row + rr) * D) + lane)[64 * j] = v[rr][j] * rstd[rr] * gg; }
        } else {
#pragma unroll
            for (int j = 0; j < 8; ++j) { const f32x4 gg = ggv[j] * (scv[j] + 1.0f), ss = ssv[j];
#pragma unroll
                for (int rr = 0; rr < 2; ++rr) { const f32x4 hh = v[rr][j] * rstd[rr] * gg + ss;
#if PROJ_F8
                    ((GAS unsigned*)((unsigned char*)hout + (size_t)(row + rr) * D) + lane)[64 * j] = pk_fp8x4_ns(hh[0], hh[1], hh[2], hh[3]);
#else
                    u32x2 w; w.x = pk2(hh[0], hh[1]); w.y = pk2(hh[2], hh[3]); ((GAS u32x2*)(hout + (size_t)(row + rr) * D) + lane)[64 * j] = w;
#endif
                } }
        }
    }
}

__device__ __forceinline__ float reduce16(const float (&p)[NE], int lane) {
    float q[8], r[4], s2[2];
    const bool h5 = (lane & 32) != 0, h4 = (lane & 16) != 0, h3 = (lane & 8) != 0, h2 = (lane & 4) != 0;
#pragma unroll
    for (int i = 0; i < 8; ++i) q[i] = (h5 ? p[i + 8] : p[i]) + sx<32>(h5 ? p[i] : p[i + 8], lane);
#pragma unroll
    for (int i = 0; i < 4; ++i) r[i] = (h4 ? q[i + 4] : q[i]) + sx<16>(h4 ? q[i] : q[i + 4], lane);
#pragma unroll
    for (int i = 0; i < 2; ++i) s2[i] = (h3 ? r[i + 2] : r[i]) + sx<8>(h3 ? r[i] : r[i + 2], lane);
    float t = (h2 ? s2[1] : s2[0]) + sx<4>(h2 ? s2[0] : s2[1], lane);
    t += sx<2>(t, lane); t += sx<1>(t, lane);
    return t;
}
__device__ __forceinline__ void route_token(float affl, float sell, int& i0, int& i1, float& w0, float& w1) {
    float aff[NE], sel[NE];
#pragma unroll
    for (int e = 0; e < NE; ++e) { aff[e] = __builtin_bit_cast(float, __builtin_amdgcn_readlane(__builtin_bit_cast(int, affl), 4 * e)); sel[e] = __builtin_bit_cast(float, __builtin_amdgcn_readlane(__builtin_bit_cast(int, sell), 4 * e)); }
    float gs[4];
#pragma unroll
    for (int g = 0; g < 4; ++g) { const float a = sel[4 * g], b = sel[4 * g + 1], c = sel[4 * g + 2], d = sel[4 * g + 3];
        const float h1 = fmaxf(a, b), l1 = fminf(a, b), h2 = fmaxf(c, d), l2 = fminf(c, d);
        gs[g] = fmaxf(h1, h2) + fmaxf(fminf(h1, h2), fmaxf(l1, l2)); }
    int bg = 0; float best = gs[0];
#pragma unroll
    for (int g = 1; g < 4; ++g) { const bool c = gs[g] > best; best = c ? gs[g] : best; bg = c ? g : bg; }
    float s0 = -3.0e38f, s1 = -3.0e38f, a0 = 0.f, a1 = 0.f; int j0 = 0, j1 = 0;
#pragma unroll
    for (int j = 0; j < 4; ++j) {
        const float v = bg == 0 ? sel[j] : (bg == 1 ? sel[4 + j] : (bg == 2 ? sel[8 + j] : sel[12 + j]));
        const float af = bg == 0 ? aff[j] : (bg == 1 ? aff[4 + j] : (bg == 2 ? aff[8 + j] : aff[12 + j]));
        const bool gt0 = v > s0, gt1 = v > s1;
        s1 = gt0 ? s0 : (gt1 ? v : s1); j1 = gt0 ? j0 : (gt1 ? j : j1); a1 = gt0 ? a0 : (gt1 ? af : a1);
        s0 = gt0 ? v : s0; j0 = gt0 ? j : j0; a0 = gt0 ? af : a0; }
    i0 = 4 * bg + j0; i1 = 4 * bg + j1;
    const float inv = 1.0f / (a0 + a1); w0 = a0 * inv; w1 = a1 * inv;
}
__device__ __forceinline__ void router_phase(const bf16_t* xs, bf16_t* hout, const float* gain, const float* ada_scale, const float* ada_shift, const float* w_router, const float* b_router,
                                             unsigned* cnt, int* rlist, int* tslot, float* tw, LAS unsigned char* lds, int vcu, int G, int tid, int wave, int lane) {
    LAS float* wrT = (LAS float*)lds;
    LAS int* misc = (LAS int*)(lds + MISC_OFF + 64);
    LAS int* lcnt = misc; LAS int* lbase = misc + 16; LAS int* rinfo = misc + 32;
    for (int c = tid; c < D; c += NTHREADS) {
        const f32x4 w0 = *(const f32x4*)(w_router + c * 16), w1 = *(const f32x4*)(w_router + c * 16 + 4), w2 = *(const f32x4*)(w_router + c * 16 + 8), w3 = *(const f32x4*)(w_router + c * 16 + 12);
#pragma unroll
        for (int e = 0; e < 4; ++e) { wrT[e * D + c] = w0[e]; wrT[(4 + e) * D + c] = w1[e]; wrT[(8 + e) * D + c] = w2[e]; wrT[(12 + e) * D + c] = w3[e]; } }
    const int rows_per_blk = T / G;
    for (int base = vcu * rows_per_blk; base < T; base += G * rows_per_blk) {
        if (tid < 16) lcnt[tid] = 0;
        __syncthreads();
        const int rpw = rows_per_blk / NWAVES;
        for (int k = 0; k < rpw; k += 2) {
            const int lr = wave * rpw + k, row = base + lr, b = row >> 11;
            f32x4 v[2][8]; float rstd[2];
#pragma unroll
            for (int rr = 0; rr < 2; ++rr) { const GAS u32x2* xr = (const GAS u32x2*)(xs + (size_t)(row + rr) * D) + lane;
#pragma unroll
                for (int j = 0; j < 8; ++j) { const u32x2 r = xr[64 * j]; v[rr][j] = (f32x4){bflo(r.x), bfhi(r.x), bflo(r.y), bfhi(r.y)}; } }
            f32x4 ggv[8], ssv[8];
            { const GAS f32x4* sc = (const GAS f32x4*)(ada_scale + (size_t)b * 12288) + lane; const GAS f32x4* sh = (const GAS f32x4*)(ada_shift + (size_t)b * 12288) + lane;
#pragma unroll
              for (int j = 0; j < 8; ++j) { ggv[j] = sc[64 * j]; ssv[j] = sh[64 * j]; }
              asm volatile("" ::: "memory"); }
#pragma unroll
            for (int rr = 0; rr < 2; ++rr) { float s = 0.f;
#pragma unroll
                for (int j = 0; j < 8; ++j) s += (v[rr][j][0] * v[rr][j][0] + v[rr][j][1] * v[rr][j][1]) + (v[rr][j][2] * v[rr][j][2] + v[rr][j][3] * v[rr][j][3]);
                rstd[rr] = 1.0f / sqrtf(wave_sum(s, lane) * (1.0f / D) + NORM_EPS); }
#pragma unroll
            for (int jb = 0; jb < 8; jb += 4) {
#pragma unroll
                for (int jj = 0; jj < 4; ++jj) { const int j = jb + jj; const f32x4 gg = ggv[j], ss = ssv[j];
#pragma unroll
                    for (int rr = 0; rr < 2; ++rr) { v[rr][j] = v[rr][j] * rstd[rr] * gg + ss;
                        ((GAS unsigned*)((unsigned char*)hout + (size_t)(row + rr) * D) + lane)[64 * j] = pk_fp8x4_ns(v[rr][j][0], v[rr][j][1], v[rr][j][2], v[rr][j][3]); } }
                asm volatile("" ::: "memory"); }
            float p0[NE], p1[NE];
            f32x4 wA[8], wB[8];
#define RT_RD(W, e) do { _Pragma("unroll") for (int j = 0; j < 8; ++j) W[j] = *(const LAS f32x4*)(wrT + (e) * D + 4 * lane + 256 * j); asm volatile("" ::: "memory"); } while (0)
#define RT_FMA(W, e) do { f32x2 a0 = {0.f, 0.f}, a1 = {0.f, 0.f}; _Pragma("unroll") for (int j = 0; j < 8; ++j) { LPIN(W[j]); const f32x2 wl = {W[j][0], W[j][1]}, wh = {W[j][2], W[j][3]}; \
                a0 = __builtin_elementwise_fma((f32x2){v[0][j][0], v[0][j][1]}, wl, a0); a0 = __builtin_elementwise_fma((f32x2){v[0][j][2], v[0][j][3]}, wh, a0); \
                a1 = __builtin_elementwise_fma((f32x2){v[1][j][0], v[1][j][1]}, wl, a1); a1 = __builtin_elementwise_fma((f32x2){v[1][j][2], v[1][j][3]}, wh, a1); } \
                p0[e] = a0[0] + a0[1]; p1[e] = a1[0] + a1[1]; } while (0)
            RT_RD(wA, 0);
#pragma unroll
            for (int e = 0; e < NE; e += 2) { RT_RD(wB, e + 1); RT_FMA(wA, e); if (e + 2 < NE) RT_RD(wA, e + 2); RT_FMA(wB, e + 1); }
#undef RT_RD
#undef RT_FMA
            const float t0 = reduce16(p0, lane), t1 = reduce16(p1, lane);
            const float bre = b_router[lane >> 2];
#pragma unroll
            for (int rr = 0; rr < 2; ++rr) {
                const float affl = sigmoidf_(rr ? t1 : t0), sell = affl + bre;
                int i0, i1; float w0, w1; route_token(affl, sell, i0, i1, w0, w1);
                if (lane == 0) { const int r0 = atomicAdd((int*)lcnt + i0, 1), r1 = atomicAdd((int*)lcnt + i1, 1);
                    rinfo[(lr + rr) * 4 + 0] = (i0 << 16) | r0; rinfo[(lr + rr) * 4 + 1] = (i1 << 16) | r1;
                    tw[(row + rr) * 2] = w0; tw[(row + rr) * 2 + 1] = w1; } }
        }
        __syncthreads();
        if (tid < 16) lbase[tid] = (int)__hip_atomic_fetch_add(cnt + 64 * tid, (unsigned)lcnt[tid], RLX_AGENT);
        __syncthreads();
        if (tid < rows_per_blk * 2) { const int lr = tid >> 1, kk = tid & 1, info = rinfo[lr * 4 + kk], e = info >> 16, rank = lbase[e] + (info & 0xffff);
            rlist[(size_t)e * T + rank] = base + lr; tslot[(base + lr) * 2 + kk] = (e << 16) | rank; }
        __syncthreads();
    }
}

__device__ __forceinline__ int swz256(int row, int ch) { return 256 * row + 16 * (ch ^ (((row & 3) << 2) | ((row >> 2) & 3))); }
typedef short v4i16_t __attribute__((ext_vector_type(4)));
__device__ __forceinline__ s16x4 vtr(const LAS unsigned char* p) { return __builtin_bit_cast(s16x4, __builtin_amdgcn_ds_read_tr16_b64_v4i16((LAS v4i16_t*)p)); }

struct AttnPre { u32x4 kv[8]; bf16x8 qf[4]; };
__device__ __forceinline__ void attn_issue(AttnPre& R, const bf16_t* proj, int a, int tid, int wave, int lane) {
    const int sub = a & 15, bh = a >> 4, head = bh % 12, b = bh / 12, g = head >> 2;
    const int dsh = 2 * g, nbsh = 4 - 2 * g;
    const int nblk = sub & ((1 << nbsh) - 1), r = sub >> nbsh;
    const size_t tb = (size_t)b * SEQ;
    const int p0 = 128 * (nblk - 1);
#pragma unroll
    for (int it = 0; it < 8; ++it) { const int id = tid + NTHREADS * it, row = id >> 4, ch = id & 15, p = p0 + row;
        const int pc = p < 0 ? 0 : p;
        const size_t t = tb + ((size_t)pc << dsh) + r; R.kv[it] = *(const u32x4*)(proj + t * NP + KA + head * 128 + ch * 8); }
    const int fr = lane & 15, fq = lane >> 4, qi = 16 * wave + fr;
    const size_t tq = tb + ((size_t)(128 * nblk + qi) << dsh) + r;
    const bf16_t* qsrc = proj + tq * NP + QA + head * 128 + fq * 8;
#pragma unroll
    for (int ks = 0; ks < 4; ++ks) R.qf[ks] = *(const bf16x8*)(qsrc + 32 * ks);
}
__device__ __forceinline__ void attn_unit(LAS unsigned char* lds, AttnPre& R, const bf16_t* proj, bf16_t* atto, float* lse, int a, int a_next, int tid, int wave, int lane) {
    const int sub = a & 15, bh = a >> 4, head = bh % 12, b = bh / 12, g = head >> 2, hj = head & 3;
    const int dsh = 2 * g, nbsh = 4 - 2 * g;
    const int nblk = sub & ((1 << nbsh) - 1), r = sub >> nbsh;
    const size_t tb = (size_t)b * SEQ;
    const int p0 = 128 * (nblk - 1);
    LAS unsigned char* Kl = lds; LAS unsigned char* Vl = lds + 65536;
#pragma unroll
    for (int it = 0; it < 8; ++it) { const int id = tid + NTHREADS * it, row = id >> 4, ch = id & 15; *(LAS u32x4*)(Kl + swz256(row, ch)) = R.kv[it]; }
    u32x4 vv[8];
#pragma unroll
    for (int it = 0; it < 8; ++it) { const int id = tid + NTHREADS * it, row = id >> 4, ch = id & 15, p = p0 + row;
        const int pc = p < 0 ? 0 : p;
        const size_t t = tb + ((size_t)pc << dsh) + r; vv[it] = *(const u32x4*)(proj + t * NP + VA + head * 128 + ch * 8); }
    const int fr = lane & 15, fq = lane >> 4;
    const int qi = 16 * wave + fr;
    const size_t tq = tb + ((size_t)(128 * nblk + qi) << dsh) + r;
    bf16x8 qf[4];
#pragma unroll
    for (int ks = 0; ks < 4; ++ks) qf[ks] = R.qf[ks];
    __syncthreads();
    f32x4 sacc[9];
    unsigned kbase[4];
    { const int fK = ((fr & 3) << 2) | ((fr >> 2) & 3);
#pragma unroll
        for (int ks = 0; ks < 4; ++ks) kbase[ks] = (unsigned)(256 * (16 * wave + fr) + 16 * ((4 * ks + fq) ^ fK)); }
#pragma unroll
    for (int kt = 0; kt < 9; ++kt) { f32x4 acc = (f32x4){0.f, 0.f, 0.f, 0.f};
#pragma unroll
        for (int ks = 0; ks < 4; ++ks) { const bf16x8 kf = *(const LAS bf16x8*)(Kl + kbase[ks] + 4096 * kt); acc = __builtin_amdgcn_mfma_f32_16x16x32_bf16(kf, qf[ks], acc, 0, 0, 0); }
        sacc[kt] = acc; }
    const float sc = 0.12751743082459868f;
    float mx = -3.0e38f;
#pragma unroll
    for (int kt = 0; kt < 9; ++kt)
#pragma unroll
        for (int rg = 0; rg < 4; ++rg) { const int jk = 16 * (wave + kt) + 4 * fq + rg; const bool valid = (jk >= qi) && (jk <= qi + 128) && (p0 + jk >= 0);
            const float s = valid ? sacc[kt][rg] * sc : -3.0e38f; sacc[kt][rg] = s; mx = fmaxf(mx, s); }
    mx = fmaxf(mx, sx<16>(mx, lane)); mx = fmaxf(mx, sx<32>(mx, lane));
    float sum = 0.f;
#pragma unroll
    for (int kt = 0; kt < 9; ++kt)
#pragma unroll
        for (int rg = 0; rg < 4; ++rg) { const float p = __builtin_amdgcn_exp2f(sacc[kt][rg] - mx); sacc[kt][rg] = p; sum += p; }
    sum += sx<16>(sum, lane); sum += sx<32>(sum, lane);
#pragma unroll
    for (int it = 0; it < 8; ++it) { const int id = tid + NTHREADS * it, row = id >> 4, ch = id & 15; *(LAS u32x4*)(Vl + swz256(row, ch)) = vv[it]; }
    __syncthreads();
    if (a_next >= 0) attn_issue(R, proj, a_next, tid, wave, lane);
    f32x4 oacc[8];
#pragma unroll
    for (int dt = 0; dt < 8; ++dt) oacc[dt] = (f32x4){0.f, 0.f, 0.f, 0.f};
    const int li = lane & 15, qq = li >> 2, pp = li & 3;
    unsigned vbase[8];
    { const int fV = (qq << 2) | fq;
#pragma unroll
        for (int dt = 0; dt < 8; ++dt) vbase[dt] = (unsigned)(256 * (16 * wave + 4 * fq + qq) + 16 * ((2 * dt + (pp >> 1)) ^ fV) + 8 * (pp & 1)); }
#pragma unroll
    for (int s5 = 0; s5 < 5; ++s5) {
        const int t0 = 2 * s5, t1 = (2 * s5 + 1 < 9) ? 2 * s5 + 1 : 2 * s5;
        u32x4 pw; pw.x = pk2(sacc[t0][0], sacc[t0][1]); pw.y = pk2(sacc[t0][2], sacc[t0][3]);
        if (2 * s5 + 1 < 9) { pw.z = pk2(sacc[t1][0], sacc[t1][1]); pw.w = pk2(sacc[t1][2], sacc[t1][3]); } else { pw.z = 0u; pw.w = 0u; }
        const bf16x8 pf = __builtin_bit_cast(bf16x8, pw);
#pragma unroll
        for (int dt = 0; dt < 8; ++dt) {
            const s16x4 v0 = vtr(Vl + vbase[dt] + 4096 * t0);
            const s16x4 v1 = vtr(Vl + vbase[dt] + 4096 * t1);
            bf16x8 vf; vf[0] = v0[0]; vf[1] = v0[1]; vf[2] = v0[2]; vf[3] = v0[3]; vf[4] = v1[0]; vf[5] = v1[1]; vf[6] = v1[2]; vf[7] = v1[3];
            oacc[dt] = __builtin_amdgcn_mfma_f32_16x16x32_bf16(vf, pf, oacc[dt], 0, 0, 0);
        }
    }
    const float inv = 1.0f / sum;
    bf16_t* op = atto + ((size_t)g * T + tq) * 512 + hj * 128 + 4 * fq;
#pragma unroll
    for (int dt = 0; dt < 8; ++dt) { u32x2 w; w.x = pk2(oacc[dt][0] * inv, oacc[dt][1] * inv); w.y = pk2(oacc[dt][2] * inv, oacc[dt][3] * inv); *(u32x2*)(op + 16 * dt) = w; }
    if (fq == 0) lse[((size_t)g * T + tq) * 4 + hj] = mx * 0.6931471805599453f + __logf(sum);
    __syncthreads();
}

__device__ __forceinline__ int swz512(int row, int ch) { return 512 * row + 16 * (ch ^ (((row & 3) << 2) | ((row >> 2) & 3))); }

struct GlaPre { float al0, al1; u32x4 q[2], k[2], v[4]; };
__device__ __forceinline__ void gla_local_issue(GlaPre& R, const bf16_t* proj, const float* alow, int u, int tid) {
    const int n = u & 31, h = (u >> 5) & 3, b = u >> 7;
    const size_t t0 = (size_t)b * SEQ + 64 * n;
    R.al0 = alow[t0 * 16 + tid]; R.al1 = alow[t0 * 16 + 512 + tid];
#pragma unroll
    for (int it = 0; it < 2; ++it) { const int id = tid + NTHREADS * it, row = id >> 4, ch = id & 15; const bf16_t* src = proj + (t0 + row) * NP + h * 128 + ch * 8; R.q[it] = *(const u32x4*)(src + QB); R.k[it] = *(const u32x4*)(src + KB); }
#pragma unroll
    for (int it = 0; it < 4; ++it) { const int id = tid + NTHREADS * it, row = id >> 5, ch = id & 31; R.v[it] = *(const u32x4*)(proj + (t0 + row) * NP + VB + h * 256 + ch * 8); }
}
__device__ __forceinline__ void gla_local_unit(LAS unsigned char* lds, GlaPre& R, const bf16_t* proj, const float* alow, const float (&w2)[16], const float bias,
                                               bf16_t* qdg, bf16_t* oig, bf16_t* dstg, float* decg, int u, int u_next, int tid, int wave, int lane) {
    const int n = u & 31, h = (u >> 5) & 3, b = u >> 7;
    const int d = tid & 127, ig = tid >> 7;
    const int fr = lane & 15, fq = lane >> 4;
    LAS unsigned char* QD = lds; LAS unsigned char* KI = lds + 17408; LAS unsigned char* KET = lds + 34816; LAS unsigned char* VL = lds + 53248;
    LAS unsigned char* AT = lds + 86016;
    LAS float* CS = (LAS float*)(lds + 95232); LAS float* ALs = (LAS float*)(lds + 97280);
    const size_t t0 = (size_t)b * SEQ + 64 * n;
#pragma unroll
    for (int it = 0; it < 2; ++it) { const int id = tid + NTHREADS * it, row = id >> 4, ch = id & 15; *(LAS u32x4*)(QD + row * 272 + ch * 16) = R.q[it]; *(LAS u32x4*)(KI + row * 272 + ch * 16) = R.k[it]; }
    ALs[tid] = R.al0; ALs[512 + tid] = R.al1;
#pragma unroll
    for (int it = 0; it < 4; ++it) { const int id = tid + NTHREADS * it, row = id >> 5, ch = id & 31; *(LAS u32x4*)(VL + swz512(row, ch)) = R.v[it]; }
    __syncthreads();
    if (u_next >= 0) gla_local_issue(R, proj, alow, u_next, tid);
    float bl[16]; float run = 0.f;
#pragma unroll
    for (int ii = 0; ii < 16; ++ii) { float z = bias; const LAS f32x4* ap = (const LAS f32x4*)(ALs + (16 * ig + ii) * 16);
#pragma unroll
        for (int r4 = 0; r4 < 4; ++r4) { const f32x4 av = ap[r4]; z = fmaf(av[0], w2[4 * r4], z); z = fmaf(av[1], w2[4 * r4 + 1], z); z = fmaf(av[2], w2[4 * r4 + 2], z); z = fmaf(av[3], w2[4 * r4 + 3], z); }
        const float la = (fminf(z, 0.f) - __logf(1.0f + __expf(-fabsf(z)))) * 0.0625f; run += la; bl[ii] = run; }
    CS[ig * 128 + d] = run;
    __syncthreads();
    float pre = 0.f, tot = 0.f;
#pragma unroll
    for (int g2 = 0; g2 < 4; ++g2) { const float cv = CS[g2 * 128 + d]; tot += cv; pre += (g2 < ig) ? cv : 0.f; }
    const float qscale = 0.08838834764831845f; const float etot = __expf(tot);
    unsigned ke[8];
#pragma unroll
    for (int ii = 0; ii < 16; ++ii) { const float bb = pre + bl[ii];
        LAS bf16_t* qp = (LAS bf16_t*)(QD + (16 * ig + ii) * 272 + 2 * d); LAS bf16_t* kp = (LAS bf16_t*)(KI + (16 * ig + ii) * 272 + 2 * d);
        const float qf_ = bf2f(*qp), kf_ = bf2f(*kp);
        const float eb = __expf(bb), einv = __builtin_amdgcn_rcpf(eb);
        const float qd = qf_ * qscale * eb, ki = kf_ * einv, kend = kf_ * (etot * einv);
        *qp = (bf16_t)f2bf(qd); *kp = (bf16_t)f2bf(ki);
        if (ii & 1) ke[ii >> 1] |= f2bf(kend) << 16; else ke[ii >> 1] = f2bf(kend); }
    *(LAS u32x4*)(KET + d * 144 + 32 * ig) = (u32x4){ke[0], ke[1], ke[2], ke[3]}; *(LAS u32x4*)(KET + d * 144 + 32 * ig + 16) = (u32x4){ke[4], ke[5], ke[6], ke[7]};
    if (ig == 0) decg[(size_t)u * 128 + d] = etot;
    __syncthreads();
#pragma unroll
    for (int it = 0; it < 2; ++it) { const int id = tid + NTHREADS * it, row = id >> 4, ch = id & 15; *(u32x4*)(qdg + ((size_t)(b * 4 + h) * 32 + n) * 8192 + (size_t)((((row >> 4) * 4 + (ch >> 2)) * 64 + (row & 15) * 4 + (ch & 3)) * 8)) = *(const LAS u32x4*)(QD + row * 272 + ch * 16); }
#pragma unroll
    for (int x = 0; x < 2; ++x) { const int id = 2 * wave + x, ti = id >> 2, tj = id & 3; f32x4 acc = (f32x4){0.f, 0.f, 0.f, 0.f};
        if (tj <= ti) {
#pragma unroll
            for (int ks = 0; ks < 4; ++ks) { const bf16x8 af = *(const LAS bf16x8*)(QD + (16 * ti + fr) * 272 + (32 * ks + 8 * fq) * 2); const bf16x8 bfr = *(const LAS bf16x8*)(KI + (16 * tj + fr) * 272 + (32 * ks + 8 * fq) * 2);
                acc = __builtin_amdgcn_mfma_f32_16x16x32_bf16(af, bfr, acc, 0, 0, 0); } }
#pragma unroll
        for (int rg = 0; rg < 4; ++rg) { const int i = 16 * ti + 4 * fq + rg, j = 16 * tj + fr; const float vv = (i >= j) ? acc[rg] : 0.f; *(LAS bf16_t*)(AT + i * 144 + 2 * j) = (bf16_t)f2bf(vv); } }
    bf16x8 vfr[2][2];
    { const int li = lane & 15, qq = li >> 2, pp = li & 3;
#pragma unroll
        for (int tv = 0; tv < 2; ++tv)
#pragma unroll
            for (int ks = 0; ks < 2; ++ks) { const int vt = 2 * wave + tv;
                const int r0 = 32 * ks + 8 * fq + qq, r1 = r0 + 4;
                const s16x4 a0 = vtr(VL + swz512(r0, 2 * vt + (pp >> 1)) + 8 * (pp & 1)), a1 = vtr(VL + swz512(r1, 2 * vt + (pp >> 1)) + 8 * (pp & 1));
                bf16x8 f; f[0] = a0[0]; f[1] = a0[1]; f[2] = a0[2]; f[3] = a0[3]; f[4] = a1[0]; f[5] = a1[1]; f[6] = a1[2]; f[7] = a1[3]; vfr[tv][ks] = f; } }
#pragma unroll
    for (int dt = 0; dt < 8; ++dt) {
        bf16x8 kf[2];
#pragma unroll
        for (int ks = 0; ks < 2; ++ks) kf[ks] = *(const LAS bf16x8*)(KET + (16 * dt + fr) * 144 + (32 * ks + 8 * fq) * 2);
#pragma unroll
        for (int tv = 0; tv < 2; ++tv) { f32x4 acc = (f32x4){0.f, 0.f, 0.f, 0.f};
#pragma unroll
            for (int ks = 0; ks < 2; ++ks) acc = __builtin_amdgcn_mfma_f32_16x16x32_bf16(kf[ks], vfr[tv][ks], acc, 0, 0, 0);
            u32x2 w; w.x = pk2(acc[0], acc[1]); w.y = pk2(acc[2], acc[3]);
            *(u32x2*)(dstg + (((size_t)(b * 4 + h) * 8 + wave) * 32 + n) * 4096 + (size_t)(((dt * 2 + tv) * 64 + fr * 4 + fq) * 4)) = w; } }
    __syncthreads();
#pragma unroll
    for (int ti = 0; ti < 4; ++ti) {
        bf16x8 af[2];
#pragma unroll
        for (int ks = 0; ks < 2; ++ks) af[ks] = *(const LAS bf16x8*)(AT + (16 * ti + fr) * 144 + (32 * ks + 8 * fq) * 2);
#pragma unroll
        for (int tv = 0; tv < 2; ++tv) { f32x4 acc = (f32x4){0.f, 0.f, 0.f, 0.f};
#pragma unroll
            for (int ks = 0; ks < 2; ++ks) acc = __builtin_amdgcn_mfma_f32_16x16x32_bf16(vfr[tv][ks], af[ks], acc, 0, 0, 0);
            u32x2 w; w.x = pk2(acc[0], acc[1]); w.y = pk2(acc[2], acc[3]);
            *(u32x2*)(oig + (((size_t)(b * 4 + h) * 8 + wave) * 32 + n) * 2048 + (size_t)(((ti * 2 + tv) * 64 + fr * 4 + fq) * 4)) = w; } }
    __syncthreads();
}

template <bool FAKE>
__device__ __forceinline__ void gla_scan_unit(LAS unsigned char* lds, const bf16_t* qdg, const bf16_t* oig, const bf16_t* dstg, const float* decg, bf16_t* ob, float* ssq,
                                              int u, int tid, int wave, int lane) {
    const int vs = u & 7, h = (u >> 3) & 3, b = u >> 5;
    const int fr = lane & 15, fq = lane >> 4;
    const int ti = wave >> 1, tv = wave & 1;
    LAS unsigned char* STb = lds;
    LAS unsigned char* OBL = lds + 20480;
    LAS float* SQL = (LAS float*)(lds + 53248);
    f32x4 sst[2]; sst[0] = (f32x4){0.f, 0.f, 0.f, 0.f}; sst[1] = sst[0];
    { unsigned z0 = 0u; asm volatile("" : "+v"(z0)); *(LAS u32x4*)(STb + tid * 16) = (u32x4){z0, z0, z0, z0}; if (tid < 32) *(LAS u32x4*)(STb + 8192 + tid * 16) = (u32x4){z0, z0, z0, z0}; }
    const int ub = (b * 4 + h) * 32;
    struct StepOps { bf16x8 q[4]; u32x2 o; u32x2 ds[2]; f32x4 dc; };
    const unsigned qoff = (unsigned)((ti * 4 * 64 + fr * 4 + fq) * 16), ooff = (unsigned)(((ti * 2 + tv) * 64 + fr * 4 + fq) * 8);
    const unsigned dsoff = (unsigned)(((wave * 2) * 64 + fr * 4 + fq) * 8), dcoff = (unsigned)(16 * wave + 4 * fq) * 4u;
    const char* qbase = (const char*)(qdg + (size_t)(b * 4 + h) * SEQ * 128);
    const char* obase = (const char*)(oig + ((size_t)(b * 4 + h) * 8 + vs) * SEQ * 32);
    const char* dsbase = (const char*)(dstg + ((size_t)(b * 4 + h) * 8 + vs) * 32 * 32 * 128);
    const char* dcbase = (const char*)(decg + (size_t)ub * 128);
#define GLA_LOAD(R, nn_) do { const int nn = FAKE ? 0 : ((nn_) < 32 ? (nn_) : 31); \
        const char* qs_ = qbase + (size_t)nn * 16384; _Pragma("unroll") for (int ks = 0; ks < 4; ++ks) R.q[ks] = *(const bf16x8*)(qs_ + qoff + 1024 * ks); \
        R.o = *(const u32x2*)(obase + (size_t)nn * 4096 + ooff); \
        _Pragma("unroll") for (int t2 = 0; t2 < 2; ++t2) R.ds[t2] = *(const u32x2*)(dsbase + (size_t)nn * 8192 + 512 * t2 + dsoff); \
        R.dc = *(const f32x4*)(dcbase + (size_t)nn * 512 + dcoff); } while (0)
#define GLA_STEP(R, n_) do { const int n = (n_); const size_t t0 = (size_t)b * SEQ + 64 * n; \
        LAS unsigned char* STc = STb + (n & 1) * 8704; LAS unsigned char* STn = STb + ((n + 1) & 1) * 8704; \
        f32x4 acc; acc[0] = bflo(R.o.x); acc[1] = bfhi(R.o.x); acc[2] = bflo(R.o.y); acc[3] = bfhi(R.o.y); \
        _Pragma("unroll") for (int ks = 0; ks < 4; ++ks) { const bf16x8 sfr = *(const LAS bf16x8*)(STc + (16 * tv + fr) * 272 + (32 * ks + 8 * fq) * 2); acc = __builtin_amdgcn_mfma_f32_16x16x32_bf16(sfr, R.q[ks], acc, 0, 0, 0); } \
        { u32x2 w; w.x = pk2(acc[0], acc[1]); w.y = pk2(acc[2], acc[3]);              \
            *(LAS u32x2*)(OBL + (n & 7) * 4096 + (16 * ti + fr) * 64 + (16 * tv + 4 * fq) * 2) = w; \
            float q2 = (acc[0] * acc[0] + acc[1] * acc[1]) + (acc[2] * acc[2] + acc[3] * acc[3]); q2 += sx<16>(q2, lane); q2 += sx<32>(q2, lane); \
            if (fq == 0) SQL[(n & 7) * 128 + (16 * ti + fr) * 2 + tv] = q2; } \
        _Pragma("unroll") for (int t2 = 0; t2 < 2; ++t2) { \
            sst[t2][0] = sst[t2][0] * R.dc[0] + bflo(R.ds[t2].x); sst[t2][1] = sst[t2][1] * R.dc[1] + bfhi(R.ds[t2].x); \
            sst[t2][2] = sst[t2][2] * R.dc[2] + bflo(R.ds[t2].y); sst[t2][3] = sst[t2][3] * R.dc[3] + bfhi(R.ds[t2].y); \
            u32x2 w; w.x = pk2(sst[t2][0], sst[t2][1]); w.y = pk2(sst[t2][2], sst[t2][3]); \
            *(LAS u32x2*)(STn + (16 * t2 + fr) * 272 + (16 * wave + 4 * fq) * 2) = w; } \
        __syncthreads(); \
        if (!FAKE && (n & 7) == 7) { const size_t tf = (size_t)b * SEQ + 64 * (n - 7); \
            _Pragma("unroll") for (int it = 0; it < 4; ++it) { const int id = tid + NTHREADS * it, sf = id >> 8, row = (id >> 2) & 63, c = id & 3; \
                *(u32x4*)(ob + (tf + 64 * sf + row) * 1024 + h * 256 + 32 * vs + 8 * c) = *(const LAS u32x4*)(OBL + id * 16); } \
            _Pragma("unroll") for (int it = 0; it < 2; ++it) { const int id = tid + NTHREADS * it, sf = id >> 7, row = (id >> 1) & 63, tq = id & 1; \
                ssq[((tf + 64 * sf + row) * 4 + h) * 16 + vs * 2 + tq] = SQL[id]; } \
            __syncthreads(); } } while (0)
    StepOps r0, r1, r2, r3;
    GLA_LOAD(r0, 0); GLA_LOAD(r1, 1); GLA_LOAD(r2, 2);
    __syncthreads();
    for (int n4 = 0; n4 < 32; n4 += 4) {
        GLA_LOAD(r3, n4 + 3); GLA_STEP(r0, n4);
        GLA_LOAD(r0, n4 + 4); GLA_STEP(r1, n4 + 1);
        GLA_LOAD(r1, n4 + 5); GLA_STEP(r2, n4 + 2);
        GLA_LOAD(r2, n4 + 6); GLA_STEP(r3, n4 + 3);
    }
#undef GLA_STEP
#undef GLA_LOAD
}

__device__ __forceinline__ void merge_phase(const bf16_t* atto, const float* lse, const bf16_t* ob, const float* ssq, const bf16_t* proj, const float* gla_gain, bf16_t* ya, bf16_t* yb,
                                            int vcu, int G, int wave, int lane) {
    const int gw = vcu * NWAVES + wave, NGW = G * NWAVES;
    const int hj = lane >> 4;
    f32x4 g0[2], g1[2];
#pragma unroll
    for (int c = 0; c < 2; ++c) { const int col = 8 * lane + 512 * c; g0[c] = *(const f32x4*)(gla_gain + col); g1[c] = *(const f32x4*)(gla_gain + col + 4); }
    for (int row0 = 2 * gw; row0 < T; row0 += 2 * NGW) {
        float l0[2], l1[2], l2[2]; u32x4 a0[2], a1[2], a2[2], o[2][2], rr_[2][2]; f32x4 sq[2][2][4];
#pragma unroll
        for (int r = 0; r < 2; ++r) { const int row = row0 + r;
            l0[r] = lse[((size_t)0 * T + row) * 4 + hj]; l1[r] = lse[((size_t)1 * T + row) * 4 + hj]; l2[r] = lse[((size_t)2 * T + row) * 4 + hj];
            a0[r] = *(const u32x4*)(atto + ((size_t)0 * T + row) * 512 + 8 * lane); a1[r] = *(const u32x4*)(atto + ((size_t)1 * T + row) * 512 + 8 * lane); a2[r] = *(const u32x4*)(atto + ((size_t)2 * T + row) * 512 + 8 * lane);
#pragma unroll
            for (int c = 0; c < 2; ++c) { const int col = 8 * lane + 512 * c, hh = col >> 8;
                const f32x4* sp = (const f32x4*)(ssq + ((size_t)row * 4 + hh) * 16); sq[r][c][0] = sp[0]; sq[r][c][1] = sp[1]; sq[r][c][2] = sp[2]; sq[r][c][3] = sp[3];
                o[r][c] = *(const u32x4*)(ob + (size_t)row * 1024 + col);
#if GATE_F8
                { const u32x2 r8 = *(const u32x2*)((const unsigned char*)proj + (size_t)row * NP * 2 + G8_BYTE0 + col); rr_[r][c] = (u32x4){r8.x, r8.y, 0u, 0u}; }
#else
                rr_[r][c] = *(const u32x4*)(proj + (size_t)row * NP + RB + col);
#endif
            } }
#pragma unroll
        for (int r = 0; r < 2; ++r) { const int row = row0 + r;
            const float m = fmaxf(l0[r], fmaxf(l1[r], l2[r])); float e0 = __expf(l0[r] - m), e1 = __expf(l1[r] - m), e2 = __expf(l2[r] - m); const float inv = 1.0f / (e0 + e1 + e2); e0 *= inv; e1 *= inv; e2 *= inv;
            u32x4 w;
            w.x = pk2(e0 * bflo(a0[r].x) + e1 * bflo(a1[r].x) + e2 * bflo(a2[r].x), e0 * bfhi(a0[r].x) + e1 * bfhi(a1[r].x) + e2 * bfhi(a2[r].x));
            w.y = pk2(e0 * bflo(a0[r].y) + e1 * bflo(a1[r].y) + e2 * bflo(a2[r].y), e0 * bfhi(a0[r].y) + e1 * bfhi(a1[r].y) + e2 * bfhi(a2[r].y));
            w.z = pk2(e0 * bflo(a0[r].z) + e1 * bflo(a1[r].z) + e2 * bflo(a2[r].z), e0 * bfhi(a0[r].z) + e1 * bfhi(a1[r].z) + e2 * bfhi(a2[r].z));
            w.w = pk2(e0 * bflo(a0[r].w) + e1 * bflo(a1[r].w) + e2 * bflo(a2[r].w), e0 * bfhi(a0[r].w) + e1 * bfhi(a1[r].w) + e2 * bfhi(a2[r].w));
#if MIX_F8
            { u32x2 w8; w8.x = pk_fp8x4(bflo(w.x), bfhi(w.x), bflo(w.y), bfhi(w.y)); w8.y = pk_fp8x4(bflo(w.z), bfhi(w.z), bflo(w.w), bfhi(w.w)); *(u32x2*)((unsigned char*)ya + (BR_FUSE ? (size_t)row * 1536 + 1024 : (size_t)row * 512) + 8 * lane) = w8; }
#else
            *(u32x4*)(ya + (size_t)row * 512 + 8 * lane) = w;
#endif
#pragma unroll
            for (int c = 0; c < 2; ++c) { const int col = 8 * lane + 512 * c;
                const f32x4 s0 = sq[r][c][0], s1 = sq[r][c][1], s2 = sq[r][c][2], s3 = sq[r][c][3];
                const float tot = ((s0[0] + s0[1]) + (s0[2] + s0[3])) + ((s1[0] + s1[1]) + (s1[2] + s1[3])) + ((s2[0] + s2[1]) + (s2[2] + s2[3])) + ((s3[0] + s3[1]) + (s3[2] + s3[3]));
                const float rstd = 1.0f / sqrtf(tot * (1.0f / 256.0f) + NORM_EPS);
                const u32x4 ov = o[r][c], rv = rr_[r][c]; u32x4 y; float rf[8];
#if GATE_F8
                unpack_fp8x8((u32x2){rv.x, rv.y}, rf);
#else
                rf[0] = bflo(rv.x); rf[1] = bfhi(rv.x); rf[2] = bflo(rv.y); rf[3] = bfhi(rv.y); rf[4] = bflo(rv.z); rf[5] = bfhi(rv.z); rf[6] = bflo(rv.w); rf[7] = bfhi(rv.w);
#endif
                y.x = pk2(bflo(ov.x) * rstd * g0[c][0] * siluf_(rf[0]), bfhi(ov.x) * rstd * g0[c][1] * siluf_(rf[1]));
                y.y = pk2(bflo(ov.y) * rstd * g0[c][2] * siluf_(rf[2]), bfhi(ov.y) * rstd * g0[c][3] * siluf_(rf[3]));
                y.z = pk2(bflo(ov.z) * rstd * g1[c][0] * siluf_(rf[4]), bfhi(ov.z) * rstd * g1[c][1] * siluf_(rf[5]));
                y.w = pk2(bflo(ov.w) * rstd * g1[c][2] * siluf_(rf[6]), bfhi(ov.w) * rstd * g1[c][3] * siluf_(rf[7]));
#if MIX_F8
                { u32x2 y8; y8.x = pk_fp8x4(bflo(y.x), bfhi(y.x), bflo(y.y), bfhi(y.y)); y8.y = pk_fp8x4(bflo(y.z), bfhi(y.z), bflo(y.w), bfhi(y.w)); *(u32x2*)((unsigned char*)(BR_FUSE ? ya : yb) + (size_t)row * (BR_FUSE ? 1536 : 1024) + col) = y8; }
#else
                *(u32x4*)(yb + (size_t)row * 1024 + col) = y;
#endif
            } }
    }
}

constexpr int LS = 10;
__host__ __device__ constexpr int phase_kind(int k) { return k == 0 ? 0 : (k == 1 + DEPTH * LS ? LS + 1 : ((k - 1) % LS) + 1); }
constexpr int N_PHASES = 2 + DEPTH * LS;
typedef const __attribute__((address_space(4))) Args CArgs;
__device__ __forceinline__ CArgs* fresh_args() {
    unsigned long long v = (unsigned long long)__builtin_amdgcn_kernarg_segment_ptr();
    unsigned lo = (unsigned)v, hi = (unsigned)(v >> 32);
    asm volatile("" : "+s"(lo), "+s"(hi));
    lo = __builtin_amdgcn_readfirstlane(lo); hi = __builtin_amdgcn_readfirstlane(hi);
    return (CArgs*)(((unsigned long long)hi << 32) | lo);
}
template <unsigned MASK, bool ONE>
__global__ void __launch_bounds__(NTHREADS, 2) fwd_kernel(Args a_unused) {
    extern __shared__ __attribute__((aligned(16))) unsigned char lds_raw[];
    LAS unsigned char* lds = (LAS unsigned char*)lds_raw;
    const int wave0 = __builtin_amdgcn_readfirstlane((int)threadIdx.x >> 6);
    int lane = (int)__builtin_amdgcn_mbcnt_hi(~0u, __builtin_amdgcn_mbcnt_lo(~0u, 0u)), wave = wave0, tid = wave0 * 64 + lane;
    CArgs* ap = fresh_args();
    unsigned char* ws = ap->ws;
#define a (*ap)
#define FRESH_TID() do { ap = fresh_args(); ws = ap->ws; unsigned m1_ = ~0u; asm volatile("" : "+s"(m1_)); lane = (int)__builtin_amdgcn_mbcnt_hi(m1_, __builtin_amdgcn_mbcnt_lo(m1_, 0u)); asm volatile("" : "+v"(lane)); wave = wave0; tid = wave0 * 64 + lane; } while (0)
    const int G = gridDim.x; const int bx = blockIdx.x; const int vcu = (G % 8 == 0) ? (bx % 8) * (G / 8) + bx / 8 : bx;
    volatile LAS unsigned* MISC = (volatile LAS unsigned*)(lds + MISC_OFF);
    for (int u = tid; u < (LDS_BYTES - MISC_OFF) / 4; u += NTHREADS) ((LAS unsigned*)(lds + MISC_OFF))[u] = 0u;
    __syncthreads();
    if (ONE) (void)xcd_barrier_post((unsigned*)(ws + WS_CTL) + CW_BAR, MISC + 8);
    const int lo = ONE ? 0 : a.ph_lo, hi = ONE ? N_PHASES : a.ph_hi;
#define IN(k, kind) (((MASK >> (kind)) & 1u) && (ONE || (lo <= (k) && (k) < hi)))
#if defined(PROBE_EPI) && !defined(PROBE_MASK)
#endif
#ifdef PROBE_MASK
#define PB_ON(k) ((PROBE_MASK >> phase_kind(k)) & 1u)
#define PB_START(k) do { if (PB_ON(k) && threadIdx.x == 0) *(volatile LAS unsigned long long*)(lds + MISC_OFF + 8192) = __builtin_amdgcn_s_memrealtime(); } while (0)
#define PB_END(k) do { if (PB_ON(k) && threadIdx.x == 0) { volatile LAS unsigned long long* pb_ = (volatile LAS unsigned long long*)(lds + MISC_OFF + 8192); pb_[1] = pb_[1] + (__builtin_amdgcn_s_memrealtime() - pb_[0]); } } while (0)
#else
#define PB_START(k) do { } while (0)
#define PB_END(k) do { } while (0)
#endif
#define SEAM(k) do { if (ONE) { XcdBarrier bar_; bar_.bar = (unsigned*)(((CArgs*)fresh_args())->ws + WS_CTL) + CW_BAR; bar_.x = xb_xcc_id(); bar_.st = (volatile LAS unsigned*)(lds + MISC_OFF) + 8; xcd_barrier(bar_); } } while (0)

#define ada ((float*)(ws + WS_ADA))
#define ropec ((const float*)(ws + WS_ROPE))
#define ropes (((const float*)(ws + WS_ROPE)) + SEQ * 64)
#define alow ((float*)(ws + WS_ALOW))
#define lse ((float*)(ws + WS_LSE))
#define ssq ((float*)(ws + WS_SSQ))
#define rlist ((int*)(ws + WS_RLIST))
#define tslot ((int*)(ws + WS_TSLOT))
#define tw ((float*)(ws + WS_TW))
#define hbuf ((bf16_t*)(ws + WS_H))
#define ya ((bf16_t*)(ws + WS_YA))
#define yb ((bf16_t*)(ws + WS_YB))
#define mrg ((bf16_t*)(ws + WS_MRG))
#define atto ((bf16_t*)(ws + WS_ATTO))
#define obuf ((bf16_t*)(ws + WS_OB))
#define proj ((bf16_t*)(ws + WS_PROJ))
#define act ((bf16_t*)(ws + WS_ACT))
#define Y ((bf16_t*)(ws + WS_Y))
#define ctl ((unsigned*)(ws + WS_CTL))
#define xb_ ((bf16_t*)(ws + WS_XB))
#define qdb_ ((bf16_t*)(ws + WS_QD))
#define oib_ ((bf16_t*)(ws + WS_OI))
#define dstb_ ((bf16_t*)(ws + WS_DST))
#define decb_ ((float*)(ws + WS_DEC))

    PB_START(0);
    if (IN(0, 0)) { FRESH_TID(); prologue_phase(ap, lds, vcu, G, tid, wave, lane); }
#ifdef PROBE_DUP_PRO
    __syncthreads(); if (IN(0, 0)) { FRESH_TID(); prologue_phase(ap, lds, vcu, G, tid, wave, lane, PROBE_DUP_PRO); }
#endif
    SEAM(0); PB_END(0);

    for (int l = 0; l < DEPTH; ++l) {
        const int P = 1 + LS * l;
#define adal (ada + (size_t)l * NB * 12288)
#define cntl (ctl + CW_CNT + l * 1024)
#define cntp (ctl + CW_CNT + (l > 0 ? (l - 1) * 1024 : 0))
#define xsrc ((l == 0) ? a.x : a.out)
        PB_START(P);
        if (IN(P, 1)) { FRESH_TID();
            if (l == 0) norm_phase<0>(xsrc, nullptr, hbuf, a.norm_mix, adal + 2048, adal, nullptr, nullptr, nullptr, nullptr, nullptr, vcu, G, wave, lane);
            else norm_phase<1>(xb_, xb_, hbuf, a.norm_mix + (size_t)l * D, adal + 2048, adal, ada + (size_t)(l - 1) * NB * 12288 + 10240, Y, tslot, tw, cntp, vcu, G, wave, lane);
        }
        SEAM(P); PB_END(P); PB_START(P + 1);
        if (IN(P + 1, 2)) { FRESH_TID();
#if PROJ_F8
            pg8::StaticOrderP S{T / 256, NP / 256, G, bx}; pg8::RowsContig AM; pg8::EpiProj E{proj, ropec, ropes, alow, pg8::W8_INV};
            pg8::gemm_phase<pg8::EpiProj, pg8::StaticOrderP, pg8::RowsContig, true, true>(lds, tid, hbuf, (const bf16_t*)(ws + WS_WIN + (size_t)l * NP * D), 0, D / 2, S, AM, E);
#else
            pg8::StaticOrderP S{T / 256, NP / 256, G, bx}; pg8::RowsContig AM; pg8::EpiProj E{proj, ropec, ropes, alow, 1.0f};
            pg8::gemm_phase<pg8::EpiProj, pg8::StaticOrderP, pg8::RowsContig, true>(lds, tid, hbuf, (const bf16_t*)(ws + WS_WIN) + (size_t)l * NP * D, 0, D, S, AM, E);
#endif
        }
        SEAM(P + 1); PB_END(P + 1); PB_START(P + 2);
        if (IN(P + 2, 3)) { FRESH_TID();
            {
                const int hw = (vcu >> 5) & 3, dw = tid & 127; float w2[16];
#pragma unroll
                for (int r = 0; r < 16; ++r) w2[r] = (a.w_alpha2 + (size_t)l * 16 * 512)[r * 512 + hw * 128 + dw];
                const float bias = (a.b_alpha2 + (size_t)l * 512)[hw * 128 + dw];
                for (int u = vcu; u < NB * 4 * 32; u += G) { GlaPre R; gla_local_issue(R, proj, alow, u, tid);
                    gla_local_unit(lds, R, proj, alow, w2, bias, qdb_, oib_, dstb_, decb_, u, -1, tid, wave, lane); } }
            FRESH_TID();
            for (int u = vcu; u < NB * 12 * 16; u += G) { AttnPre R; attn_issue(R, proj, u, tid, wave, lane); attn_unit(lds, R, proj, atto, lse, u, -1, tid, wave, lane); }
#ifdef PROBE_DUP_ATTN
            for (int u = vcu; u < NB * 12 * 16; u += G) { AttnPre R; attn_issue(R, proj, u, tid, wave, lane); attn_unit(lds, R, proj, atto, lse, u, -1, tid, wave, lane); }
#endif
        }
        SEAM(P + 2); PB_END(P + 2); PB_START(P + 3);
        if (IN(P + 3, 4)) { FRESH_TID();
            for (int u = vcu; u < 256; u += G) gla_scan_unit<false>(lds, qdb_, oib_, dstb_, decb_, obuf, ssq, u, tid, wave, lane);
#ifdef PROBE_FAKESCAN
            __syncthreads(); for (int u = vcu; u < 256; u += G) gla_scan_unit<true>(lds, qdb_, oib_, dstb_, decb_, obuf, ssq, u, tid, wave, lane);
#endif
        }
        SEAM(P + 3); PB_END(P + 3); PB_START(P + 4);
        if (IN(P + 4, 5)) { FRESH_TID(); merge_phase(atto, lse, obuf, ssq, proj, a.gla_gain + (size_t)l * 1024, ya, yb, vcu, G, wave, lane); }
        SEAM(P + 4); PB_END(P + 4); PB_START(P + 5);
        if (IN(P + 5, 6)) { FRESH_TID();
#if BR_FUSE
            { pg8::SegOrder S2{T / 256, D / 256, G, bx}; pg8::RowsContig AM2; pg8::EpiGate2 E{proj, pg8::W8_INV, ws + WS_MRG8};
              pg8::gemm_phase<pg8::EpiGate2, pg8::SegOrder, pg8::RowsContig, true, true, true>(lds, tid, ya, (const bf16_t*)(ws + WS_WOA + (size_t)l * D * 1536), 0, 768, S2, AM2, E); }
#else
            pg8::StaticOrder S{T / 256, D / 256, G, bx}; pg8::RowsContig AM;
#if MIX_F8
            { pg8::EpiGate<true> E{mrg, proj, GA, pg8::W8_INV, nullptr}; pg8::gemm_phase<pg8::EpiGate<true>, pg8::StaticOrder, pg8::RowsContig, true, true>(lds, tid, ya, (const bf16_t*)(ws + WS_WOA + (size_t)l * D * 512), 0, 256, S, AM, E); }
#else
            { pg8::EpiGate<true> E{mrg, proj, GA, 1.0f, nullptr}; pg8::gemm_phase<pg8::EpiGate<true>, pg8::StaticOrder, pg8::RowsContig, true>(lds, tid, ya, (const bf16_t*)(ws + WS_WOA) + (size_t)l * D * 512, 0, 512, S, AM, E); }
#endif
            FRESH_TID();
#if MIX_F8
            { pg8::EpiGate<false> E{mrg, proj, GB, pg8::W8_INV, ws + WS_MRG8}; pg8::gemm_phase<pg8::EpiGate<false>, pg8::StaticOrder, pg8::RowsContig, true, true>(lds, tid, yb, (const bf16_t*)(ws + WS_WOB + (size_t)l * D * 1024), 0, 512, S, AM, E); }
#else
            { pg8::EpiGate<false> E{mrg, proj, GB, 1.0f, nullptr}; pg8::gemm_phase<pg8::EpiGate<false>, pg8::StaticOrder, pg8::RowsContig, true>(lds, tid, yb, (const bf16_t*)(ws + WS_WOB) + (size_t)l * D * 1024, 0, 1024, S, AM, E); }
#endif
#endif
        }
        SEAM(P + 5); PB_END(P + 5); PB_START(P + 6);
        if (IN(P + 6, 7)) { FRESH_TID();
            pg8::StaticOrder S{T / 256, D / 256, G, bx}; pg8::RowsContig AM;
#if MIX_F8
            if (l == 0) { pg8::EpiResid<true> E{a.x, xb_, adal + 4096, pg8::W8_INV}; pg8::gemm_phase<pg8::EpiResid<true>, pg8::StaticOrder, pg8::RowsContig, true, true>(lds, tid, (const bf16_t*)(ws + WS_MRG8), (const bf16_t*)(ws + WS_WO + (size_t)l * D * D), 0, D / 2, S, AM, E); }
            else { pg8::EpiResid<false> E{xb_, xb_, adal + 4096, pg8::W8_INV}; pg8::gemm_phase<pg8::EpiResid<false>, pg8::StaticOrder, pg8::RowsContig, true, true>(lds, tid, (const bf16_t*)(ws + WS_MRG8), (const bf16_t*)(ws + WS_WO + (size_t)l * D * D), 0, D / 2, S, AM, E); }
#else
            if (l == 0) { pg8::EpiResid<true> E{a.x, xb_, adal + 4096, 1.0f}; pg8::gemm_phase<pg8::EpiResid<true>, pg8::StaticOrder, pg8::RowsContig, true>(lds, tid, mrg, (const bf16_t*)(ws + WS_WO) + (size_t)l * D * D, 0, D, S, AM, E); }
            else { pg8::EpiResid<false> E{xb_, xb_, adal + 4096, 1.0f}; pg8::gemm_phase<pg8::EpiResid<false>, pg8::StaticOrder, pg8::RowsContig, true>(lds, tid, mrg, (const bf16_t*)(ws + WS_WO) + (size_t)l * D * D, 0, D, S, AM, E); }
#endif
        }
        SEAM(P + 6); PB_END(P + 6); PB_START(P + 7);
        if (IN(P + 7, 8)) { FRESH_TID(); router_phase(xb_, hbuf, a.norm_ffn + (size_t)l * D, adal + 8192, adal + 6144, a.w_router, a.b_router, cntl, rlist, tslot, tw, lds, vcu, G, tid, wave, lane); }
        SEAM(P + 7); PB_END(P + 7); PB_START(P + 8);
        if (IN(P + 8, 9)) { FRESH_TID();
            pg8::moe_table_build(lds, cntl, tid);
            pg8::MoeOrder S; S.init(lds, 8, G, bx); pg8::RowsGather AM{rlist, lds}; pg8::EpiSwiGLU8 E{(unsigned char*)act};
            pg8::gemm_phase<pg8::EpiSwiGLU8, pg8::MoeOrder, pg8::RowsGather, true, true>(lds, tid, hbuf, (const bf16_t*)(ws + WS_WGU + (size_t)l * NE * 2048 * D), (size_t)2048 * D / 2, D / 2, S, AM, E);
        }
        SEAM(P + 8); PB_END(P + 8); PB_START(P + 9);
        if (IN(P + 9, 10)) { FRESH_TID();
            pg8::moe_table_build(lds, cntl, tid);
            pg8::MoeOrder S; S.init(lds, 8, G, bx); pg8::RowsContig AM; pg8::EpiPlainS E{Y, pg8::W8_INV};
            pg8::gemm_phase<pg8::EpiPlainS, pg8::MoeOrder, pg8::RowsContig, true, true>(lds, tid, act, (const bf16_t*)(ws + WS_WDN + (size_t)l * NE * D * FF), (size_t)D * FF / 2, FF / 2, S, AM, E);
        }
        SEAM(P + 9); PB_END(P + 9);
    }
    PB_START(1 + DEPTH * LS);
    if (IN(1 + DEPTH * LS, LS + 1)) { FRESH_TID(); norm_phase<2>(xb_, a.out, nullptr, a.final_norm, nullptr, nullptr, ada + (size_t)(DEPTH - 1) * NB * 12288 + 10240, Y, tslot, tw, ctl + CW_CNT + (DEPTH - 1) * 1024, vcu, G, wave, lane); }
#ifdef PROBE_MASK
    __syncthreads(); PB_END(1 + DEPTH * LS);
    if (threadIdx.x == 0) { const unsigned long long t0_ = __builtin_amdgcn_s_memrealtime(), d_ = ((volatile LAS unsigned long long*)(lds + MISC_OFF + 8192))[1];
        while (__builtin_amdgcn_s_memrealtime() - t0_ < d_) __builtin_amdgcn_s_sleep(8); }
    __syncthreads();
#endif
#undef a
#undef IN
#undef SEAM
}

template <unsigned MASK, bool ONE>
static void launch_one(const Args& a, int grid, hipStream_t stream) {
    static bool attr_done = false;
    if (!attr_done) { (void)hipFuncSetAttribute((const void*)fwd_kernel<MASK, ONE>, hipFuncAttributeMaxDynamicSharedMemorySize, LDS_BYTES); attr_done = true; }
    hipLaunchKernelGGL((fwd_kernel<MASK, ONE>), dim3(grid), dim3(NTHREADS), LDS_BYTES, stream, a);
}
extern "C" void kernel_launch(void* const* d_in, const int* in_sizes, int n_in, void* d_out, int out_size, void* d_ws, size_t ws_size, hipStream_t stream) {
    static int grid = 0;
    if (grid == 0) {
        if (n_in != 19 || out_size != T * D || ws_size < WS_END) { fprintf(stderr, "kernel_launch: unexpected shapes (n_in %d, out %d, ws %zu < %zu); nothing launched\n", n_in, out_size, ws_size, (size_t)WS_END); grid = -1; return; }
        int dev = 0, cus = 0;
        if (hipGetDevice(&dev) != hipSuccess || hipDeviceGetAttribute(&cus, hipDeviceAttributeMultiprocessorCount, dev) != hipSuccess) { grid = -1; return; }
        grid = cus;
        if (grid != 256) fprintf(stderr, "kernel_launch: note: %d CUs (built for 256)\n", grid);
    }
    if (grid < 0) return;
    (void)hipMemsetAsync((char*)d_ws + WS_CTL, 0, CTL_ZERO_BYTES, stream);
    Args a{};
    a.x = (const float*)d_in[0]; a.c = (const float*)d_in[1]; a.w_ada = (const float*)d_in[2]; a.b_ada = (const float*)d_in[3]; a.norm_mix = (const float*)d_in[4]; a.norm_ffn = (const float*)d_in[5];
    a.w_in = (const float*)d_in[6]; a.w_alpha2 = (const float*)d_in[7]; a.b_alpha2 = (const float*)d_in[8]; a.gla_gain = (const float*)d_in[9]; a.w_out_a = (const float*)d_in[10];
    a.w_out_b = (const float*)d_in[11]; a.w_out = (const float*)d_in[12]; a.w_router = (const float*)d_in[13]; a.b_router = (const float*)d_in[14]; a.w_gate_e = (const float*)d_in[15];
    a.w_up_e = (const float*)d_in[16]; a.w_down_e = (const float*)d_in[17]; a.final_norm = (const float*)d_in[18];
    a.out = (float*)d_out; a.ws = (unsigned char*)d_ws;
#if MK_PER_PHASE
    for (int p = 0; p < N_PHASES; ++p) { a.ph_lo = p; a.ph_hi = p + 1;
        const int kind = phase_kind(p);
        switch (kind) {
            case 0: launch_one<1u << 0, false>(a, grid, stream); break; case 1: launch_one<1u << 1, false>(a, grid, stream); break;
            case 2: launch_one<1u << 2, false>(a, grid, stream); break; case 3: launch_one<1u << 3, false>(a, grid, stream); break;
            case 4: launch_one<1u << 4, false>(a, grid, stream); break; case 5: launch_one<1u << 5, false>(a, grid, stream); break;
            case 6: launch_one<1u << 6, false>(a, grid, stream); break; case 7: launch_one<1u << 7, false>(a, grid, stream); break;
            case 8: launch_one<1u << 8, false>(a, grid, stream); break; case 9: launch_one<1u << 9, false>(a, grid, stream); break;
            case 10: launch_one<1u << 10, false>(a, grid, stream); break;
            default: launch_one<1u << 11, false>(a, grid, stream); break; } }
#else
    a.ph_lo = 0; a.ph_hi = N_PHASES; launch_one<0xFFFFFu, true>(a, grid, stream);
#endif
    const hipError_t le = hipPeekAtLastError();
    if (le != hipSuccess) fprintf(stderr, "kernel_launch: launch failed: %s\n", hipGetErrorName(le));
}
```

```cpp
#include <hip/hip_runtime.h>
#include <cstdio>
#include <cstdint>

#ifndef PROJ_F8
#define PROJ_F8 1
#endif
#ifndef MIX_F8
#define MIX_F8 1
#endif
#ifndef GATE_F8
#define GATE_F8 1
#endif
#ifndef Y_F8
#define Y_F8 1
#endif
#ifndef BR_FUSE
#define BR_FUSE 1
#endif
#ifndef MK_PER_PHASE
#define MK_PER_PHASE 0
#endif

#define LAS __attribute__((address_space(3)))
#define GAS __attribute__((address_space(1)))
typedef unsigned short bf16_t;
typedef short bf16x8 __attribute__((ext_vector_type(8)));
typedef short s16x4 __attribute__((ext_vector_type(4)));
typedef float f32x4 __attribute__((ext_vector_type(4)));
typedef float f32x2 __attribute__((ext_vector_type(2)));
typedef unsigned u32x4 __attribute__((ext_vector_type(4)));
typedef unsigned u32x2 __attribute__((ext_vector_type(2)));
typedef GAS unsigned gu32;

constexpr int NB = 8, SEQ = 2048, T = NB * SEQ, D = 2048, DEPTH = 2;
constexpr int NIN = 11792;
constexpr int NP = 12032;
constexpr int QA = 0, KA = 1536, VA = 3072, QB = 4608, KB = 5120, VB = 5632, RB = 6656, GA = 7680, GB = 9728, AL = 11776;
constexpr int NE = 16, FF = 1024;
constexpr int MAXTILES = 144, MAXROWS = MAXTILES * 256;
constexpr float NORM_EPS = 1e-6f;
constexpr int NWAVES = 8, NTHREADS = 512;

constexpr size_t MiB = 1u << 20;
constexpr size_t WS_CTL = 0, CTL_ZERO_BYTES = 80 * 1024;
constexpr size_t WS_ADA = 1 * MiB;
constexpr size_t WS_ROPE = 2 * MiB;
constexpr size_t WS_ALOW = 3 * MiB;
constexpr size_t WS_LSE = 4 * MiB;
constexpr size_t WS_SSQ = 5 * MiB;
constexpr size_t WS_RLIST = 9 * MiB;
constexpr size_t WS_TSLOT = 10 * MiB;
constexpr size_t WS_TW = 10 * MiB + 512 * 1024;
constexpr size_t WS_WIN = 12 * MiB;
constexpr size_t WS_MRG8 = 60 * MiB;
constexpr size_t WS_WOA = 106 * MiB;
constexpr size_t WS_WOB = 110 * MiB;
constexpr size_t WS_WO = 118 * MiB;
constexpr size_t WS_WGU = 134 * MiB;
constexpr size_t WS_XB = 262 * MiB;
constexpr size_t WS_WDN = 390 * MiB;
constexpr size_t WS_H = 518 * MiB;
constexpr size_t WS_YA = 582 * MiB;
constexpr size_t WS_YB = 598 * MiB;
constexpr size_t WS_MRG = 630 * MiB;
constexpr size_t WS_ATTO = 694 * MiB;
constexpr size_t WS_OB = 742 * MiB;
constexpr size_t WS_PROJ = 774 * MiB;
constexpr size_t WS_ACT = WS_PROJ;
constexpr size_t WS_Y = WS_PROJ + 72 * MiB;
constexpr size_t WS_QD = 1150 * MiB;
constexpr size_t WS_OI = 1166 * MiB;
constexpr size_t WS_DST = 1198 * MiB;
constexpr size_t WS_DEC = 1262 * MiB;
constexpr size_t WS_END = 1263 * MiB;
constexpr int CW_BAR = 4096;
constexpr int CW_CNT = 16384;

constexpr int RING_BYTES = 131072;
constexpr int MISC_OFF = 135168;
constexpr int LDS_BYTES = 151552;

#define LDS_WAIT() asm volatile("s_waitcnt lgkmcnt(0)" ::: "memory")
#define VM_WAIT() asm volatile("s_waitcnt vmcnt(0)" ::: "memory")
#define RLX_AGENT __ATOMIC_RELAXED, __HIP_MEMORY_SCOPE_AGENT
__device__ __forceinline__ unsigned f2bf(float f) { unsigned u = __builtin_bit_cast(unsigned, f); return (u + 0x7fffu + ((u >> 16) & 1u)) >> 16; }
typedef float f32x2_t __attribute__((ext_vector_type(2)));
typedef __bf16 bf16x2_t __attribute__((ext_vector_type(2)));
__device__ __forceinline__ unsigned pk2(float lo, float hi) { const f32x2_t v = {lo, hi}; const bf16x2_t b = __builtin_convertvector(v, bf16x2_t); return __builtin_bit_cast(unsigned, b); }
__device__ __forceinline__ float sat8(float x) { return __builtin_amdgcn_fmed3f(x, -448.0f, 448.0f); }
__device__ __forceinline__ unsigned pk_fp8x4(float a, float b, float c, float d) { int p = __builtin_amdgcn_cvt_pk_fp8_f32(sat8(a), sat8(b), 0, false); p = __builtin_amdgcn_cvt_pk_fp8_f32(sat8(c), sat8(d), p, true); return (unsigned)p; }
constexpr int G8_BYTE0 = RB * 2;
__device__ __forceinline__ void unpack_fp8x8(u32x2 v, float (&f)[8]) { const f32x2_t a = __builtin_amdgcn_cvt_pk_f32_fp8((int)v.x, false), b = __builtin_amdgcn_cvt_pk_f32_fp8((int)v.x, true), c = __builtin_amdgcn_cvt_pk_f32_fp8((int)v.y, false), d = __builtin_amdgcn_cvt_pk_f32_fp8((int)v.y, true);
    f[0] = a[0]; f[1] = a[1]; f[2] = b[0]; f[3] = b[1]; f[4] = c[0]; f[5] = c[1]; f[6] = d[0]; f[7] = d[1]; }
__device__ __forceinline__ unsigned pk_fp8x4_ns(float a, float b, float c, float d) { int p = __builtin_amdgcn_cvt_pk_fp8_f32(a, b, 0, false); p = __builtin_amdgcn_cvt_pk_fp8_f32(c, d, p, true); return (unsigned)p; }
__device__ __forceinline__ float bflo(unsigned u) { return __builtin_bit_cast(float, u << 16); }
__device__ __forceinline__ float bfhi(unsigned u) { return __builtin_bit_cast(float, u & 0xffff0000u); }
__device__ __forceinline__ float bf2f(bf16_t h) { return __builtin_bit_cast(float, (unsigned)h << 16); }
template <int M> __device__ __forceinline__ float sx(float v, int lane) {
    if constexpr (M < 32) return __builtin_bit_cast(float, __builtin_amdgcn_ds_swizzle(__builtin_bit_cast(int, v), (M << 10) | 0x1F));
    else return __builtin_bit_cast(float, __builtin_amdgcn_ds_bpermute((lane ^ 32) << 2, __builtin_bit_cast(int, v)));
}
__device__ __forceinline__ float wave_sum(float v, int lane) {
    v += sx<1>(v, lane); v += sx<2>(v, lane); v += sx<4>(v, lane); v += sx<8>(v, lane); v += sx<16>(v, lane); v += sx<32>(v, lane);
    return v;
}
__device__ __forceinline__ float sigmoidf_(float x) { return __builtin_amdgcn_rcpf(1.0f + __expf(-x)); }
__device__ __forceinline__ float siluf_(float x) { return x * __builtin_amdgcn_rcpf(1.0f + __expf(-x)); }

#define XB_TMO      128
#define XB_XCNT(j)  (256  + 64 * (j))
#define XB_XSUB(j)  (1280 + 64 * (j))
#define XB_XGEN(j)  (2304 + 64 * (j))
#define XB_TOP      3328
#define XB_TOPGEN   3392
#define XCD_BAR_WORDS 3456
#define XB_SPIN_CAP (1u << 18)
__device__ __forceinline__ unsigned xb_ld(unsigned* p)              { return __hip_atomic_load(p, __ATOMIC_RELAXED, __HIP_MEMORY_SCOPE_AGENT); }
__device__ __forceinline__ unsigned xb_add(unsigned* p, unsigned v) { return __hip_atomic_fetch_add(p, v, __ATOMIC_RELAXED, __HIP_MEMORY_SCOPE_AGENT); }
__device__ __forceinline__ unsigned xb_xcc_id() { return (unsigned)__builtin_amdgcn_s_getreg((3 << 11) | 20) & 0xFu; }
#define XB_SPIN(cond, bar) do { unsigned _sp = 0; while (cond) { __builtin_amdgcn_s_sleep(1); \
    if ((++_sp & 255u) == 0u) { if (xb_ld(&(bar)[XB_TMO])) break; if (_sp > XB_SPIN_CAP) { atomicAdd(&(bar)[XB_TMO], 1u); break; } } } } while (0)
struct XcdBarrier { unsigned* bar; unsigned x; volatile LAS unsigned* st; };
__device__ __forceinline__ XcdBarrier xcd_barrier_post(unsigned* bar, volatile LAS unsigned* st) {
    XcdBarrier b; b.bar = bar; b.x = xb_xcc_id(); b.st = st;
    if (threadIdx.x == 0) (void)xb_add(&bar[XB_XCNT(b.x)], 1u);
    return b;
}
__device__ __forceinline__ void xcd_barrier_complete(unsigned* bar, unsigned x, unsigned& nloc, unsigned& nx) {
    const unsigned G = gridDim.x * gridDim.y * gridDim.z;
    unsigned sum, cnt, mine, sp = 0u;
    for (;;) {
        sum = 0u; cnt = 0u; mine = 0u;
#pragma unroll
        for (unsigned j = 0; j < 16; ++j) { const unsigned c = xb_ld(&bar[XB_XCNT(j)]); sum += c; cnt += (c > 0u) ? 1u : 0u; mine = (j == x) ? c : mine; }
        if (sum == G) break;
        __builtin_amdgcn_s_sleep(1);
        if ((++sp & 255u) == 0u) { if (xb_ld(&bar[XB_TMO])) break; if (sp > XB_SPIN_CAP) { atomicAdd(&bar[XB_TMO], 1u); break; } }
    }
    nloc = mine > 0u ? mine : 1u; nx = cnt > 0u ? cnt : 1u;
}
__device__ __forceinline__ void xcd_barrier(const XcdBarrier& b) {
    asm volatile("s_waitcnt vmcnt(0)" ::: "memory");
    __syncthreads();
    if (threadIdx.x == 0) {
        unsigned* bar = b.bar;
        __builtin_amdgcn_s_waitcnt(0);
        unsigned nloc = b.st[0], nx = b.st[1];
        if (nloc == 0u) { xcd_barrier_complete(bar, b.x, nloc, nx); b.st[0] = nloc; b.st[1] = nx; }
        const unsigned old = xb_add(&bar[XB_XSUB(b.x)], 1u);
        const unsigned gen = old / nloc;
        if (old + 1u == (gen + 1u) * nloc) {
            __builtin_amdgcn_fence(__ATOMIC_RELEASE, "agent");
            asm volatile("s_waitcnt vmcnt(0)" ::: "memory");
            const unsigned og = xb_add(&bar[XB_TOP], 1u);
            const unsigned tg = og / nx;
            if (og + 1u == (tg + 1u) * nx) xb_add(&bar[XB_TOPGEN], 1u);
            else XB_SPIN(xb_ld(&bar[XB_TOPGEN]) == tg, bar);
            __builtin_amdgcn_fence(__ATOMIC_ACQUIRE, "agent");
            xb_add(&bar[XB_XGEN(b.x)], 1u);
            asm volatile("s_waitcnt vmcnt(0)" ::: "memory");
        } else {
            XB_SPIN(xb_ld(&bar[XB_XGEN(b.x)]) == gen, bar);
            __builtin_amdgcn_fence(__ATOMIC_ACQUIRE, "agent");
            asm volatile("s_waitcnt vmcnt(0)" ::: "memory");
        }
    }
    __syncthreads();
}

namespace pg8 {
constexpr int BM = 256, BK = 64, HALF = 128, HTB = HALF * BK * 2, NXCD = 8;
#ifndef WGM_PROJ
#define WGM_PROJ 4
#endif
#ifndef WGM_MIX
#define WGM_MIX 8
#endif
#ifndef WGM_MOE
#define WGM_MOE 4
#endif
__device__ __forceinline__ int lds_byte(int r, int c) { const int st = (r >> 4) * 2 + (c >> 5), rr = r & 15, cc = c & 31, ob = rr * 64 + cc * 2; return st * 1024 + (ob ^ (((ob >> 9) & 1) << 5)); }
__device__ __forceinline__ void stage_rc(int b, int& R, int& C) { const int st = b / 1024, sb = b % 1024, swz = sb ^ (((sb >> 9) & 1) << 5); R = (st >> 1) * 16 + swz / 64; C = (st & 1) * 32 + (swz % 64) / 2; }
__device__ __forceinline__ int perm32(int rho) { const int n = rho >> 4, i = rho & 15; return 8 * (i >> 2) + 4 * n + (i & 3); }

struct Unit { int pm, pn, e, ti; };

template <int WGM, int ROT = 0>
__device__ __forceinline__ bool grid_order(int nM, int nN, int G, int c, int i, int& pm, int& pn) {
    const int nwg = nM * nN; const long L = (long)i * G + c; if (L >= nwg) return false;
    int wgid = (int)L; const int xcd = wgid % NXCD; { const int q = nwg / NXCD, r = nwg % NXCD, off = wgid / NXCD; wgid = (xcd < r ? xcd * (q + 1) : r * (q + 1) + (xcd - r) * q) + off; }
    const int nig = WGM * nN, gid = wgid / nig, fm = gid * WGM, gsz = (nM - fm) < WGM ? (nM - fm) : WGM;
    pm = fm + ((wgid % nig) % gsz); pn = (wgid % nig) / gsz;
    if (ROT != 0 && (nwg % NXCD) == 0 && ((nwg / NXCD) % nig) == 0) pn = (pn + ROT * xcd) % nN;
    return true;
}
template <int WGM, int ROT = 0> struct StaticOrderT {
    int nM, nN, G, c;
    __device__ __forceinline__ bool next(int i, Unit& u) const { u.e = 0; u.ti = 0; return grid_order<WGM, ROT>(nM, nN, G, c, i, u.pm, u.pn); }
};
#ifndef ROT_PROJ
#define ROT_PROJ 6
#endif
#ifndef ROT_MIX
#define ROT_MIX 1
#endif
typedef StaticOrderT<WGM_PROJ, ROT_PROJ> StaticOrderP; typedef StaticOrderT<WGM_MIX, ROT_MIX> StaticOrder;
struct SegOrder {
    int nM, nN, G, c;
    __device__ __forceinline__ bool next(int i, Unit& u) const { u.e = i & 1; u.ti = 0; return grid_order<WGM_MIX, ROT_MIX>(nM, nN, G, c, i >> 1, u.pm, u.pn); }
};
constexpr int MOE_TAB_OFF = MISC_OFF + 4096;
__device__ __forceinline__ void moe_table_build(LAS unsigned char* lds, const unsigned* cnt, int tid) {
    if (tid < NE) { const int n = (int)__hip_atomic_load(cnt + 64 * tid, RLX_AGENT); ((LAS int*)(lds + MOE_TAB_OFF))[16 + tid] = n; }
    __syncthreads();
    if (tid == 0) { int acc = 0; for (int e = 0; e < NE; ++e) { acc += (((LAS int*)(lds + MOE_TAB_OFF))[16 + e] + 255) >> 8; ((LAS int*)(lds + MOE_TAB_OFF))[e] = acc; } }
    __syncthreads();
}
typedef int i32x4 __attribute__((ext_vector_type(4)));
struct MoeOrder {
    LAS unsigned char* lds; int NT, nN, G, c;
    __device__ __forceinline__ void init(LAS unsigned char* lds_, int nN_, int G_, int c_) {
        lds = lds_; NT = __builtin_amdgcn_readfirstlane(((LAS int*)(lds + MOE_TAB_OFF))[15]); nN = nN_; G = G_; c = c_; }
    __device__ __forceinline__ bool next(int i, Unit& u) const {
        if (!grid_order<WGM_MOE>(NT, nN, G, c, i, u.pm, u.pn)) return false;
        int e = 0, ts = 0;
#pragma unroll
        for (int q = 0; q < 4; ++q) { const i32x4 t = ((const LAS i32x4*)(lds + MOE_TAB_OFF))[q];
#pragma unroll
            for (int j = 0; j < 4; ++j) { const bool ge = u.pm >= t[j]; e += ge ? 1 : 0; ts = ge ? t[j] : ts; } }
        u.e = __builtin_amdgcn_readfirstlane(e); u.ti = u.pm - __builtin_amdgcn_readfirstlane(ts); return true;
    }
};
struct RowsContig { static constexpr bool GATHER = false; __device__ __forceinline__ unsigned row(const Unit& u, int rr) const { return (unsigned)(u.pm * 256 + rr); } };
struct RowsGather {
    static constexpr bool GATHER = true;
    const int* rlist; LAS unsigned char* lds;
    __device__ __forceinline__ unsigned row(const Unit& u, int rr) const {
        const int n = ((LAS int*)(lds + MOE_TAB_OFF))[16 + u.e]; const int rank = u.ti * 256 + rr; const bool ok = rank < n;
        return (unsigned)rlist[(size_t)u.e * T + (ok ? rank : 0)];
    }
};

typedef int i32x4v __attribute__((ext_vector_type(4)));
typedef int i32x8 __attribute__((ext_vector_type(8)));
template <class Epi, class Sched, class AMap, bool ALIGN_EPI, bool F8 = false, bool SEG2 = false>
__device__ __forceinline__ void gemm_phase(LAS unsigned char* lds, const int tid, const bf16_t* A, const bf16_t* Bt, size_t bstride, int K, const Sched& S, const AMap& AM, const Epi& E) {
    const int wid = __builtin_amdgcn_readfirstlane(tid >> 6), lane = tid & 63, wr = wid >> 2, wc = wid & 3, fr = lane & 15, fq = lane >> 4;
    const int nt = K / BK;
    unsigned voffA[2], voffB[2];
#pragma unroll
    for (int i = 0; i < 2; ++i) { int R, C; stage_rc(tid * 16 + i * 8192, R, C); const int Rb = Epi::PERM ? ((R & ~31) + perm32(R & 31)) : R; voffA[i] = (unsigned)(R * K + C) * 2u; voffB[i] = (unsigned)(Rb * K + C) * 2u; }
    const unsigned kstep = (unsigned)(BK * 2);
    const unsigned hstep = (unsigned)HALF * (unsigned)K * 2u;
    const unsigned tstep = 2u * hstep;
    const __amdgpu_buffer_rsrc_t rsA = __builtin_amdgcn_make_buffer_rsrc((void*)A, 0, -1, 0x00020000), rsB = __builtin_amdgcn_make_buffer_rsrc((void*)Bt, 0, -1, 0x00020000);
    const unsigned ldsw = (unsigned)wid * 1024u;
    const int aoff = lds_byte(wr * 64 + fr, fq * 8), boff = lds_byte(wc * 32 + fr, fq * 8);
#define PG8_SA(b, h) (((b) * 2 + (h)) * HTB)
#define PG8_SB(b, h) ((4 + (b) * 2 + (h)) * HTB)
#define PG8_STAGE(bufoff, soffB, voff) do { _Pragma("unroll") for (int _i = 0; _i < 2; ++_i) \
        __builtin_amdgcn_raw_ptr_buffer_load_lds(rsB, (LAS unsigned*)(lds + (bufoff) + ldsw + _i * 8192), 16, (int)(voff)[_i], (int)(soffB), 0, 0); } while (0)
#define PG8_LDA(dst, b, h) do { _Pragma("unroll") for (int m = 0; m < 4; ++m) _Pragma("unroll") for (int k = 0; k < 2; ++k) dst[m][k] = *(const LAS bf16x8*)(lds + PG8_SA(b, h) + aoff + m * 2048 + k * 1024); } while (0)
#define PG8_LDB(dst, b, h) do { _Pragma("unroll") for (int n = 0; n < 2; ++n) _Pragma("unroll") for (int k = 0; k < 2; ++k) dst[n][k] = *(const LAS bf16x8*)(lds + PG8_SB(b, h) + boff + n * 2048 + k * 1024); } while (0)
#define PG8_MMA(ai, bj, At, Bt_) do { __builtin_amdgcn_s_setprio(1); _Pragma("unroll") for (int m = 0; m < 4; ++m) _Pragma("unroll") for (int n = 0; n < 2; ++n) _Pragma("unroll") for (int k = 0; k < 2; ++k) \
        acc[ai][bj][m][n] = __builtin_amdgcn_mfma_f32_16x16x32_bf16(Bt_[n][k], At[m][k], acc[ai][bj][m][n], 0, 0, 0); __builtin_amdgcn_s_setprio(0); } while (0)
#define PG8_LD8(dst, base) do { const i32x4v lo_ = *(const LAS i32x4v*)(lds + (base)); const i32x4v hi_ = *(const LAS i32x4v*)(lds + (base) + 1024); dst = __builtin_shufflevector(lo_, hi_, 0, 1, 2, 3, 4, 5, 6, 7); } while (0)
#define PG8_LDA8(dst, b, h) do { _Pragma("unroll") for (int m = 0; m < 4; ++m) PG8_LD8(dst[m], PG8_SA(b, h) + aoff + m * 2048); } while (0)
#define PG8_LDB8(dst, b, h) do { _Pragma("unroll") for (int n = 0; n < 2; ++n) PG8_LD8(dst[n], PG8_SB(b, h) + boff + n * 2048); } while (0)
#define PG8_MMA8(ai, bj, At, Bt_) do { __builtin_amdgcn_s_setprio(1); _Pragma("unroll") for (int m = 0; m < 4; ++m) _Pragma("unroll") for (int n = 0; n < 2; ++n) \
        asm volatile("v_mfma_f32_16x16x128_f8f6f4 %0, %1, %2, %0" : "+v"(acc[ai][bj][m][n]) : "v"(Bt_[n]), "v"(At[m])); __builtin_amdgcn_s_setprio(0); } while (0)
#define PG8_XLDA(b, h) do { if constexpr (F8) PG8_LDA8(At8, b, h); else PG8_LDA(At, b, h); } while (0)
#define PG8_XLDB(w, b, h) do { if constexpr (F8) { if (w == 0) PG8_LDB8(B08, b, h); else PG8_LDB8(B18, b, h); } else { if (w == 0) PG8_LDB(B0, b, h); else PG8_LDB(B1, b, h); } } while (0)
#define PG8_XMMA(ai, bj, w) do { if constexpr (F8) { if (w == 0) PG8_MMA8(ai, bj, At8, B08); else PG8_MMA8(ai, bj, At8, B18); } else { if (w == 0) PG8_MMA(ai, bj, At, B0); else PG8_MMA(ai, bj, At, B1); } } while (0)
#define PG8_WAIT_V(n) asm volatile("s_waitcnt vmcnt(" #n ")" ::: "memory")
#define PG8_WAIT_L(n) asm volatile("s_waitcnt lgkmcnt(" #n ")" ::: "memory")
#define PG8_BAR __builtin_amdgcn_s_barrier()
#define PG8_SCHED __builtin_amdgcn_sched_barrier(0)
#define PG8_OFFS(dst, u) do { _Pragma("unroll") for (int _h = 0; _h < 2; ++_h) _Pragma("unroll") for (int _i = 0; _i < 2; ++_i) { int _R, _C; stage_rc(tid * 16 + _i * 8192, _R, _C); \
        dst[_h][_i] = (AM.row(u, _h * HALF + _R) * (unsigned)K + (unsigned)_C) * 2u; } } while (0)
#define PG8_STAGE_A(bufoff, h, kb, NXT) do { if constexpr (AMap::GATHER) { _Pragma("unroll") for (int _i = 0; _i < 2; ++_i) { const unsigned _o = (NXT) ? offN[h][_i] : offC[h][_i]; \
            __builtin_amdgcn_raw_ptr_buffer_load_lds(rsA, (LAS unsigned*)(lds + (bufoff) + ldsw + _i * 8192), 16, (int)_o, (int)(kb), 0, 0); } } \
        else { const unsigned _g = ((NXT) ? nA : cA) + (h) * hstep + (kb); _Pragma("unroll") for (int _i = 0; _i < 2; ++_i) \
            __builtin_amdgcn_raw_ptr_buffer_load_lds(rsA, (LAS unsigned*)(lds + (bufoff) + ldsw + _i * 8192), 16, (int)voffA[_i], (int)_g, 0, 0); } } while (0)
    Unit cur, nxt, nn; int ui = 0; bool has_next = false, has_nn = false;
    if (!S.next(0, cur)) return;
    f32x4 acc[2][2][4][2];
#pragma unroll
    for (int a = 0; a < 2; ++a)
#pragma unroll
        for (int b = 0; b < 2; ++b)
#pragma unroll
            for (int m = 0; m < 4; ++m)
#pragma unroll
                for (int n = 0; n < 2; ++n) acc[a][b][m][n] = (f32x4){0.f, 0.f, 0.f, 0.f};
    bf16x8 At[4][2], B0[2][2], B1[2][2]; i32x8 At8[4], B08[2], B18[2];
    int sc8 = 0x7F7F7F7F; if constexpr (F8) asm volatile("" : "+v"(sc8));
#define PG8_RAW(dst, u) do { _Pragma("unroll") for (int _h = 0; _h < 2; ++_h) _Pragma("unroll") for (int _i = 0; _i < 2; ++_i) { int _R, _C; stage_rc(tid * 16 + _i * 8192, _R, _C); dst[_h][_i] = AM.row(u, _h * HALF + _R); } } while (0)
#define PG8_CONV(dst, raw) do { _Pragma("unroll") for (int _h = 0; _h < 2; ++_h) _Pragma("unroll") for (int _i = 0; _i < 2; ++_i) { int _R, _C; stage_rc(tid * 16 + _i * 8192, _R, _C); dst[_h][_i] = (raw[_h][_i] * (unsigned)K + (unsigned)_C) * 2u; } } while (0)
    unsigned offC[2][2], offN[2][2], rawN[2][2];
    if constexpr (AMap::GATHER) { PG8_OFFS(offC, cur); has_next = S.next(1, nxt);
        if (has_next) { PG8_RAW(rawN, nxt); } else {
#pragma unroll
            for (int h = 0; h < 2; ++h)
#pragma unroll
                for (int i = 0; i < 2; ++i) rawN[h][i] = 0u; } }
    unsigned cA = AMap::GATHER ? 0u : (unsigned)cur.pm * tstep + (SEG2 ? (unsigned)cur.e * 1024u : 0u), nA = cA;
    unsigned cB = (unsigned)cur.e * (SEG2 ? 1024u : (unsigned)(bstride * 2)) + (unsigned)cur.pn * tstep;
    PG8_STAGE(PG8_SB(0, 0), cB, voffB); PG8_STAGE(PG8_SB(0, 1), cB + hstep, voffB); PG8_STAGE_A(PG8_SA(0, 0), 0, 0, false); PG8_STAGE_A(PG8_SA(0, 1), 1, 0, false);
    if (wr == 1) PG8_BAR;
    PG8_WAIT_V(2); PG8_BAR;
    PG8_STAGE(PG8_SB(1, 0), cB + kstep, voffB); PG8_STAGE_A(PG8_SA(1, 0), 0, kstep, false); PG8_STAGE(PG8_SB(1, 1), cB + hstep + kstep, voffB);
    PG8_WAIT_V(6); PG8_BAR;
    for (;;) {
        if constexpr (!AMap::GATHER) has_next = S.next(ui + 1, nxt);
        if constexpr (AMap::GATHER) {
            if (has_next) { PG8_CONV(offN, rawN); }
            else {
#pragma unroll
                for (int h = 0; h < 2; ++h)
#pragma unroll
                    for (int i = 0; i < 2; ++i) offN[h][i] = offC[h][i];
            }
            has_nn = has_next && S.next(ui + 2, nn);
            if (has_nn) { PG8_RAW(rawN, nn); }
        } else { nA = has_next ? (unsigned)nxt.pm * tstep + (SEG2 ? (unsigned)nxt.e * 1024u : 0u) : cA; }
        const unsigned nB = has_next ? (unsigned)nxt.e * (SEG2 ? 1024u : (unsigned)(bstride * 2)) + (unsigned)nxt.pn * tstep : cB;
        const int ntc = SEG2 ? (cur.e ? 4 : 8) : nt;
#pragma nounroll
        for (int t = 0; t < ntc; t += 2) {
            const bool last = (t == ntc - 2);
            const unsigned k1 = (unsigned)(t + 1) * kstep, k2 = last ? 0u : (unsigned)(t + 2) * kstep, k3 = k2 + kstep;
            const unsigned b2 = last ? nB : cB + (unsigned)(t + 2) * kstep, b3 = b2 + kstep;
            PG8_XLDB(0, 0, 0); PG8_XLDB(1, 0, 1); PG8_SCHED; PG8_XLDA(0, 0); PG8_STAGE_A(PG8_SA(1, 1), 1, k1, false);
            PG8_WAIT_V(8); PG8_WAIT_L(0); PG8_BAR; PG8_XMMA(0, 0, 0); PG8_XMMA(0, 1, 1); PG8_BAR; PG8_SCHED;
            PG8_XLDA(0, 1); PG8_STAGE(PG8_SB(0, 0), b2, voffB); PG8_STAGE(PG8_SB(0, 1), b2 + hstep, voffB); PG8_STAGE_A(PG8_SA(0, 0), 0, k2, last);
            PG8_WAIT_V(8); PG8_WAIT_L(0); PG8_BAR; PG8_XMMA(1, 0, 0); PG8_XMMA(1, 1, 1); PG8_BAR; PG8_SCHED;
            PG8_XLDB(0, 1, 0); PG8_XLDB(1, 1, 1); PG8_SCHED; PG8_XLDA(1, 0); PG8_STAGE_A(PG8_SA(0, 1), 1, k2, last);
            PG8_WAIT_V(8); PG8_WAIT_L(0); PG8_BAR; PG8_XMMA(0, 0, 0); PG8_XMMA(0, 1, 1); PG8_BAR; PG8_SCHED;
            PG8_XLDA(1, 1); PG8_STAGE(PG8_SB(1, 0), b3, voffB); PG8_STAGE(PG8_SB(1, 1), b3 + hstep, voffB); PG8_STAGE_A(PG8_SA(1, 0), 0, k3, last);
            PG8_WAIT_V(8); PG8_WAIT_L(0); PG8_BAR; PG8_XMMA(1, 0, 0); PG8_XMMA(1, 1, 1); PG8_BAR; PG8_SCHED;
        }
#ifdef PROBE_EPI
        unsigned long long pe_t0 = 0; if (tid == 0) pe_t0 = __builtin_amdgcn_s_memrealtime();
#endif
        if constexpr (ALIGN_EPI) { if (wr == 0) PG8_BAR; }
        if constexpr (F8) asm volatile("s_nop 15\n\ts_nop 15" ::: "memory");
        E(acc, cur, wr, wc, fr, fq);
#ifdef PROBE_EPI
        if (tid == 0) { asm volatile("s_waitcnt vmcnt(0)" ::: "memory"); volatile LAS unsigned long long* pb_ = (volatile LAS unsigned long long*)(lds + MISC_OFF + 8192); pb_[1] = pb_[1] + (__builtin_amdgcn_s_memrealtime() - pe_t0); }
#endif
        if (!has_next) break;
        if (!(SEG2 && cur.e == 0))
#pragma unroll
        for (int a = 0; a < 2; ++a)
#pragma unroll
            for (int b = 0; b < 2; ++b)
#pragma unroll
                for (int m = 0; m < 4; ++m)
#pragma unroll
                    for (int n = 0; n < 2; ++n) acc[a][b][m][n] = (f32x4){0.f, 0.f, 0.f, 0.f};
        cur = nxt; cB = nB; cA = nA; ++ui;
        if constexpr (AMap::GATHER) { nxt = nn; has_next = has_nn;
#pragma unroll
            for (int h = 0; h < 2; ++h)
#pragma unroll
                for (int i = 0; i < 2; ++i) offC[h][i] = offN[h][i];
        }
        if constexpr (ALIGN_EPI) { if (wr == 1) PG8_BAR; }
    }
    PG8_WAIT_V(0);
    if constexpr (!ALIGN_EPI) { if (wr == 0) PG8_BAR; }
    PG8_BAR;
#undef PG8_STAGE_A
#undef PG8_LD8
#undef PG8_LDA8
#undef PG8_LDB8
#undef PG8_MMA8
#undef PG8_XLDA
#undef PG8_XLDB
#undef PG8_XMMA
#undef PG8_SA
#undef PG8_SB
#undef PG8_STAGE
#undef PG8_LDA
#undef PG8_LDB
#undef PG8_MMA
#undef PG8_WAIT_V
#undef PG8_WAIT_L
#undef PG8_BAR
#undef PG8_SCHED
#undef PG8_OFFS
#undef PG8_RAW
#undef PG8_CONV
}

#define EPI_PIN(x) asm volatile("" : "+v"(x))
#define LPIN(x) asm volatile("" : "+v"(x))
#define EPI_ROWSTEP(m) (((m) == 3) ? 80 : 16)
struct EpiProj {
    static constexpr bool PERM = true;
    bf16_t* O; const float* cs; const float* sn; float* alow; float scale;
    __device__ __forceinline__ void operator()(const f32x4 (&acc)[2][2][4][2], const Unit& u, int wr, int wc, int fr, int fq) const {
        const int row0 = u.pm * BM + wr * 64 + fr, col0 = u.pn * BM + wc * 32 + 8 * fq;
        unsigned off = (unsigned)(row0 * NP + col0) * 2u;
        if (u.pn < 12) {
            unsigned toff = (unsigned)((row0 & (SEQ - 1)) * 64 + wc * 16 + fq * 4) * 4u;
            f32x4 ct[2][4], st[2][4];
#pragma unroll
            for (int ai = 0; ai < 2; ++ai)
#pragma unroll
                for (int m = 0; m < 4; ++m) { ct[ai][m] = *(const f32x4*)((const char*)cs + toff + (ai * HALF + m * 16) * 64 * 4); st[ai][m] = *(const f32x4*)((const char*)sn + toff + (ai * HALF + m * 16) * 64 * 4); }
#pragma unroll
            for (int ai = 0; ai < 2; ++ai)
#pragma unroll
                for (int m = 0; m < 4; ++m) {
                    const f32x4 c4 = ct[ai][m], s4 = st[ai][m];
#pragma unroll
                    for (int bj = 0; bj < 2; ++bj) { const f32x4 v0 = acc[ai][bj][m][0] * scale, v1 = acc[ai][bj][m][1] * scale; u32x4 w;
                        w.x = pk2(v0[0] * c4[0] - v0[1] * s4[0], v0[1] * c4[0] + v0[0] * s4[0]);
                        w.y = pk2(v0[2] * c4[1] - v0[3] * s4[1], v0[3] * c4[1] + v0[2] * s4[1]);
                        w.z = pk2(v1[0] * c4[2] - v1[1] * s4[2], v1[1] * c4[2] + v1[0] * s4[2]);
                        w.w = pk2(v1[2] * c4[3] - v1[3] * s4[3], v1[3] * c4[3] + v1[2] * s4[3]);
                        *(u32x4*)((char*)O + off + bj * HALF * 2) = w; }
                    off += EPI_ROWSTEP(m) * NP * 2; EPI_PIN(off);
                }
        } else if (GATE_F8 && u.pn >= RB / 256 && u.pn < 46) {
            unsigned off8 = (unsigned)(row0 * NP) * 2u + (unsigned)(G8_BYTE0 + col0 - RB);
#pragma unroll
            for (int ai = 0; ai < 2; ++ai)
#pragma unroll
                for (int m = 0; m < 4; ++m) {
#pragma unroll
                    for (int bj = 0; bj < 2; ++bj) { const f32x4 v0 = acc[ai][bj][m][0] * scale, v1 = acc[ai][bj][m][1] * scale; u32x2 w;
                        w.x = pk_fp8x4(v0[0], v0[1], v0[2], v0[3]); w.y = pk_fp8x4(v1[0], v1[1], v1[2], v1[3]);
                        *(u32x2*)((char*)O + off8 + bj * HALF) = w; }
                    off8 += EPI_ROWSTEP(m) * NP * 2; EPI_PIN(off8); }
        } else if (u.pn < 46) {
#pragma unroll
            for (int ai = 0; ai < 2; ++ai)
#pragma unroll
                for (int m = 0; m < 4; ++m) {
#pragma unroll
                    for (int bj = 0; bj < 2; ++bj) { const f32x4 v0 = acc[ai][bj][m][0] * scale, v1 = acc[ai][bj][m][1] * scale; u32x4 w;
                        w.x = pk2(v0[0], v0[1]); w.y = pk2(v0[2], v0[3]); w.z = pk2(v1[0], v1[1]); w.w = pk2(v1[2], v1[3]);
                        *(u32x4*)((char*)O + off + bj * HALF * 2) = w; }
                    off += EPI_ROWSTEP(m) * NP * 2; EPI_PIN(off); }
        } else {
            if (wc == 0 && fq < 2) {
                unsigned aoff_ = (unsigned)(row0 * 16 + 8 * fq) * 4u;
#pragma unroll
                for (int ai = 0; ai < 2; ++ai)
#pragma unroll
                    for (int m = 0; m < 4; ++m) { float* rp = (float*)((char*)alow + aoff_);
                        *(f32x4*)rp = acc[ai][0][m][0] * scale; *(f32x4*)(rp + 4) = acc[ai][0][m][1] * scale;
                        aoff_ += EPI_ROWSTEP(m) * 16 * 4; EPI_PIN(aoff_); }
            }
        }
    }
};
template <bool FIRST> struct EpiGate {
    static constexpr bool PERM = true;
    bf16_t* O; const bf16_t* proj; int goff; float scale; unsigned char* O8;
    __device__ __forceinline__ void operator()(const f32x4 (&acc)[2][2][4][2], const Unit& u, int wr, int wc, int fr, int fq) const {
        const int row0 = u.pm * BM + wr * 64 + fr, col0 = u.pn * BM + wc * 32 + 8 * fq;
        const unsigned goffb = GATE_F8 ? (unsigned)(row0 * NP) * 2u + (unsigned)(G8_BYTE0 + goff - RB + col0) : (unsigned)(row0 * NP + goff + col0) * 2u, ooff = (unsigned)(row0 * D + col0) * 2u;
        u32x4 gA[2][2], gB[2][2], pA[2][2], pB[2][2];
#define EG_ROW(r) ((((r) >> 2) * 128) + (((r) & 3) * 16))
#define EG_LOAD(G, P, b) do { _Pragma("unroll") for (int rr = 0; rr < 2; ++rr) { const unsigned ro = EG_ROW(2 * (b) + rr); _Pragma("unroll") for (int bj = 0; bj < 2; ++bj) { \
            if (GATE_F8) { const u32x2 g8 = *(const u32x2*)((const char*)proj + goffb + ro * NP * 2 + bj * HALF); G[rr][bj] = (u32x4){g8.x, g8.y, 0u, 0u}; } \
            else G[rr][bj] = *(const u32x4*)((const char*)proj + goffb + ro * NP * 2 + bj * HALF * 2); \
            if (!FIRST) P[rr][bj] = *(const u32x4*)((const char*)O + ooff + ro * D * 2 + bj * HALF * 2); } } asm volatile("" ::: "memory"); } while (0)
#define EG_COMP(G, P, b) do { _Pragma("unroll") for (int rr = 0; rr < 2; ++rr) { const int r = 2 * (b) + rr, ai = r >> 2, m = r & 3; const unsigned ro = EG_ROW(r); _Pragma("unroll") for (int bj = 0; bj < 2; ++bj) { \
            const u32x4 gg = G[rr][bj]; const f32x4 v0 = acc[ai][bj][m][0] * scale, v1 = acc[ai][bj][m][1] * scale; float gf[8], r8[8]; \
            if (GATE_F8) unpack_fp8x8((u32x2){gg.x, gg.y}, gf); else { gf[0] = bflo(gg.x); gf[1] = bfhi(gg.x); gf[2] = bflo(gg.y); gf[3] = bfhi(gg.y); gf[4] = bflo(gg.z); gf[5] = bfhi(gg.z); gf[6] = bflo(gg.w); gf[7] = bfhi(gg.w); } \
            r8[0] = sigmoidf_(gf[0]) * v0[0]; r8[1] = sigmoidf_(gf[1]) * v0[1]; r8[2] = sigmoidf_(gf[2]) * v0[2]; r8[3] = sigmoidf_(gf[3]) * v0[3]; \
            r8[4] = sigmoidf_(gf[4]) * v1[0]; r8[5] = sigmoidf_(gf[5]) * v1[1]; r8[6] = sigmoidf_(gf[6]) * v1[2]; r8[7] = sigmoidf_(gf[7]) * v1[3]; \
            if (!FIRST) { const u32x4 pq = P[rr][bj]; r8[0] += bflo(pq.x); r8[1] += bfhi(pq.x); r8[2] += bflo(pq.y); r8[3] += bfhi(pq.y); r8[4] += bflo(pq.z); r8[5] += bfhi(pq.z); r8[6] += bflo(pq.w); r8[7] += bfhi(pq.w); } \
            if (!FIRST && O8) { u32x2 w8; w8.x = pk_fp8x4(r8[0], r8[1], r8[2], r8[3]); w8.y = pk_fp8x4(r8[4], r8[5], r8[6], r8[7]); *(u32x2*)(O8 + (ooff >> 1) + ro * D + bj * HALF) = w8; } \
            else { u32x4 w; w.x = pk2(r8[0], r8[1]); w.y = pk2(r8[2], r8[3]); w.z = pk2(r8[4], r8[5]); w.w = pk2(r8[6], r8[7]); *(u32x4*)((char*)O + ooff + ro * D * 2 + bj * HALF * 2) = w; } } } asm volatile("" ::: "memory"); } while (0)
        EG_LOAD(gA, pA, 0); EG_LOAD(gB, pB, 1); EG_COMP(gA, pA, 0); EG_LOAD(gA, pA, 2); EG_COMP(gB, pB, 1); EG_LOAD(gB, pB, 3); EG_COMP(gA, pA, 2); EG_COMP(gB, pB, 3);
#undef EG_LOAD
#undef EG_COMP
    }
};
struct EpiGate2 {
    static constexpr bool PERM = true;
    const bf16_t* proj; float scale; unsigned char* O8;
    __device__ __forceinline__ void operator()(f32x4 (&acc)[2][2][4][2], const Unit& u, int wr, int wc, int fr, int fq) const {
        const int row0 = u.pm * BM + wr * 64 + fr, col0 = u.pn * BM + wc * 32 + 8 * fq;
        const unsigned goffa = (unsigned)(row0 * NP) * 2u + (unsigned)(G8_BYTE0 + GA - RB + col0), ooff = (unsigned)(row0 * D + col0);
        u32x4 gA[2][2], gB[2][2];
#define EG_ROW(r) ((((r) >> 2) * 128) + (((r) & 3) * 16))
        if (u.e == 0) {
#define E2_LOAD(G, b) do { _Pragma("unroll") for (int rr = 0; rr < 2; ++rr) { const unsigned ro = EG_ROW(2 * (b) + rr); _Pragma("unroll") for (int bj = 0; bj < 2; ++bj) { \
            const u32x2 ga8 = *(const u32x2*)((const char*)proj + goffa + ro * NP * 2 + bj * HALF), gb8 = *(const u32x2*)((const char*)proj + goffa + (GB - GA) + ro * NP * 2 + bj * HALF); \
            G[rr][bj] = (u32x4){ga8.x, ga8.y, gb8.x, gb8.y}; } } asm volatile("" ::: "memory"); } while (0)
#define E2_COMP(G, b) do { _Pragma("unroll") for (int rr = 0; rr < 2; ++rr) { const int r = 2 * (b) + rr, ai = r >> 2, m = r & 3; _Pragma("unroll") for (int bj = 0; bj < 2; ++bj) { \
            const u32x4 gg = G[rr][bj]; float fa[8], fb[8]; unpack_fp8x8((u32x2){gg.x, gg.y}, fa); unpack_fp8x8((u32x2){gg.z, gg.w}, fb); \
            _Pragma("unroll") for (int j = 0; j < 8; ++j) { const float q = (1.0f + __expf(-fmaxf(fa[j], -30.0f))) * sigmoidf_(fb[j]); acc[ai][bj][m][j >> 2][j & 3] *= q; } } } } while (0)
            E2_LOAD(gA, 0); E2_LOAD(gB, 1); E2_COMP(gA, 0); E2_LOAD(gA, 2); E2_COMP(gB, 1); E2_LOAD(gB, 3); E2_COMP(gA, 2); E2_COMP(gB, 3);
#undef E2_LOAD
#undef E2_COMP
        } else {
#define E2_LOAD(G, b) do { _Pragma("unroll") for (int rr = 0; rr < 2; ++rr) { const unsigned ro = EG_ROW(2 * (b) + rr); _Pragma("unroll") for (int bj = 0; bj < 2; ++bj) { \
            const u32x2 ga8 = *(const u32x2*)((const char*)proj + goffa + ro * NP * 2 + bj * HALF); G[rr][bj] = (u32x4){ga8.x, ga8.y, 0u, 0u}; } } asm volatile("" ::: "memory"); } while (0)
#define E2_COMP(G, b) do { _Pragma("unroll") for (int rr = 0; rr < 2; ++rr) { const int r = 2 * (b) + rr, ai = r >> 2, m = r & 3; const unsigned ro = EG_ROW(r); _Pragma("unroll") for (int bj = 0; bj < 2; ++bj) { \
            const u32x4 gg = G[rr][bj]; float fa[8], r8[8]; unpack_fp8x8((u32x2){gg.x, gg.y}, fa); \
            _Pragma("unroll") for (int j = 0; j < 8; ++j) r8[j] = sigmoidf_(fmaxf(fa[j], -30.0f)) * (acc[ai][bj][m][j >> 2][j & 3] * scale); \
            u32x2 w8; w8.x = pk_fp8x4(r8[0], r8[1], r8[2], r8[3]); w8.y = pk_fp8x4(r8[4], r8[5], r8[6], r8[7]); *(u32x2*)(O8 + ooff + ro * D + bj * HALF) = w8; } } asm volatile("" ::: "memory"); } while (0)
            E2_LOAD(gA, 0); E2_LOAD(gB, 1); E2_COMP(gA, 0); E2_LOAD(gA, 2); E2_COMP(gB, 1); E2_LOAD(gB, 3); E2_COMP(gA, 2); E2_COMP(gB, 3);
#undef E2_LOAD
#undef E2_COMP
        }
#undef EG_ROW
    }
};
#define EG_ROW(r) ((((r) >> 2) * 128) + (((r) & 3) * 16))
template <bool XF32> struct EpiResid {
    static constexpr bool PERM = true;
    const void* xi; bf16_t* xo; const float* gate; float scale;
    __device__ __forceinline__ void operator()(const f32x4 (&acc)[2][2][4][2], const Unit& u, int wr, int wc, int fr, int fq) const {
        const int row0 = u.pm * BM + wr * 64 + fr, col0 = u.pn * BM + wc * 32 + 8 * fq;
        const int b = (u.pm * BM) / SEQ;
        f32x4 gt[2][2];
#pragma unroll
        for (int bj = 0; bj < 2; ++bj)
#pragma unroll
            for (int n = 0; n < 2; ++n) gt[bj][n] = *(const f32x4*)(gate + (size_t)b * 12288 + col0 + bj * HALF + 4 * n) * scale;
        const unsigned off = (unsigned)(row0 * D + col0);
        constexpr int RB_ = XF32 ? 1 : 2, NBAT = 8 / RB_;
        f32x4 xA[RB_][2][2], xB[RB_][2][2];
#define ER_LOAD(X, bb) do { _Pragma("unroll") for (int rr = 0; rr < RB_; ++rr) { const unsigned ro = EG_ROW(RB_ * (bb) + rr); _Pragma("unroll") for (int bj = 0; bj < 2; ++bj) { const unsigned o = off + ro * D + bj * HALF; \
            if (XF32) { X[rr][bj][0] = *(const f32x4*)((const float*)xi + o); X[rr][bj][1] = *(const f32x4*)((const float*)xi + o + 4); } \
            else { const u32x4 rw = *(const u32x4*)((const bf16_t*)xi + o); X[rr][bj][0] = (f32x4){bflo(rw.x), bfhi(rw.x), bflo(rw.y), bfhi(rw.y)}; X[rr][bj][1] = (f32x4){bflo(rw.z), bfhi(rw.z), bflo(rw.w), bfhi(rw.w)}; } } } asm volatile("" ::: "memory"); } while (0)
#define ER_COMP(X, bb) do { _Pragma("unroll") for (int rr = 0; rr < RB_; ++rr) { const int r = RB_ * (bb) + rr, ai = r >> 2, m = r & 3; const unsigned ro = EG_ROW(r); _Pragma("unroll") for (int bj = 0; bj < 2; ++bj) { const unsigned o = off + ro * D + bj * HALF; \
            const f32x4 v0 = X[rr][bj][0] + gt[bj][0] * acc[ai][bj][m][0], v1 = X[rr][bj][1] + gt[bj][1] * acc[ai][bj][m][1]; \
            u32x4 w; w.x = pk2(v0[0], v0[1]); w.y = pk2(v0[2], v0[3]); w.z = pk2(v1[0], v1[1]); w.w = pk2(v1[2], v1[3]); *(u32x4*)(xo + o) = w; } } asm volatile("" ::: "memory"); } while (0)
        ER_LOAD(xA, 0);
#pragma unroll
        for (int bb = 0; bb < NBAT; bb += 2) {
            ER_LOAD(xB, bb + 1); ER_COMP(xA, bb);
            if (bb + 2 < NBAT) ER_LOAD(xA, bb + 2);
            ER_COMP(xB, bb + 1); }
#undef ER_LOAD
#undef ER_COMP
#undef EG_ROW
    }
};
struct EpiSwiGLU {
    static constexpr bool PERM = true;
    bf16_t* O;
    __device__ __forceinline__ void operator()(const f32x4 (&acc)[2][2][4][2], const Unit& u, int wr, int wc, int fr, int fq) const {
        const int row0 = u.pm * BM + wr * 64 + fr, col0 = u.pn * HALF + wc * 32 + 8 * fq;
        unsigned off = (unsigned)(row0 * FF + col0) * 2u;
#pragma unroll
        for (int ai = 0; ai < 2; ++ai)
#pragma unroll
            for (int m = 0; m < 4; ++m) { const f32x4 g0 = acc[ai][0][m][0], g1 = acc[ai][0][m][1], u0 = acc[ai][1][m][0], u1 = acc[ai][1][m][1]; u32x4 w;
                w.x = pk2(siluf_(g0[0]) * u0[0], siluf_(g0[1]) * u0[1]); w.y = pk2(siluf_(g0[2]) * u0[2], siluf_(g0[3]) * u0[3]);
                w.z = pk2(siluf_(g1[0]) * u1[0], siluf_(g1[1]) * u1[1]); w.w = pk2(siluf_(g1[2]) * u1[2], siluf_(g1[3]) * u1[3]);
                *(u32x4*)((char*)O + off) = w;
                off += EPI_ROWSTEP(m) * FF * 2; EPI_PIN(off); }
    }
};
struct EpiPlain {
    static constexpr bool PERM = true;
    bf16_t* O;
    __device__ __forceinline__ void operator()(const f32x4 (&acc)[2][2][4][2], const Unit& u, int wr, int wc, int fr, int fq) const {
        const int row0 = u.pm * BM + wr * 64 + fr, col0 = u.pn * BM + wc * 32 + 8 * fq;
        unsigned off = (unsigned)(row0 * D + col0) * 2u;
#pragma unroll
        for (int ai = 0; ai < 2; ++ai)
#pragma unroll
            for (int m = 0; m < 4; ++m) {
#pragma unroll
                for (int bj = 0; bj < 2; ++bj) { const f32x4 v0 = acc[ai][bj][m][0], v1 = acc[ai][bj][m][1]; u32x4 w;
                    w.x = pk2(v0[0], v0[1]); w.y = pk2(v0[2], v0[3]); w.z = pk2(v1[0], v1[1]); w.w = pk2(v1[2], v1[3]);
                    *(u32x4*)((char*)O + off + bj * HALF * 2) = w; }
                off += EPI_ROWSTEP(m) * D * 2; EPI_PIN(off); }
    }
};
constexpr float W8_SCALE = 32.0f, W8_INV = 1.0f / 32.0f;
struct EpiSwiGLU8 {
    static constexpr bool PERM = true;
    unsigned char* O;
    __device__ __forceinline__ void operator()(const f32x4 (&acc)[2][2][4][2], const Unit& u, int wr, int wc, int fr, int fq) const {
        const int row0 = u.pm * BM + wr * 64 + fr, col0 = u.pn * HALF + wc * 32 + 8 * fq;
        unsigned off = (unsigned)(row0 * FF + col0);
#pragma unroll
        for (int ai = 0; ai < 2; ++ai)
#pragma unroll
            for (int m = 0; m < 4; ++m) { const f32x4 g0 = acc[ai][0][m][0] * W8_INV, g1 = acc[ai][0][m][1] * W8_INV, u0 = acc[ai][1][m][0] * W8_INV, u1 = acc[ai][1][m][1] * W8_INV; u32x2 w;
                w.x = pk_fp8x4(siluf_(g0[0]) * u0[0], siluf_(g0[1]) * u0[1], siluf_(g0[2]) * u0[2], siluf_(g0[3]) * u0[3]);
                w.y = pk_fp8x4(siluf_(g1[0]) * u1[0], siluf_(g1[1]) * u1[1], siluf_(g1[2]) * u1[2], siluf_(g1[3]) * u1[3]);
                *(u32x2*)(O + off) = w;
                off += EPI_ROWSTEP(m) * FF; EPI_PIN(off); }
    }
};
struct EpiPlainS {
    static constexpr bool PERM = true;
    bf16_t* O; float scale;
    __device__ __forceinline__ void operator()(const f32x4 (&acc)[2][2][4][2], const Unit& u, int wr, int wc, int fr, int fq) const {
        const int row0 = u.pm * BM + wr * 64 + fr, col0 = u.pn * BM + wc * 32 + 8 * fq;
        unsigned off = (unsigned)(row0 * D + col0) * (Y_F8 ? 1u : 2u);
#pragma unroll
        for (int ai = 0; ai < 2; ++ai)
#pragma unroll
            for (int m = 0; m < 4; ++m) {
#pragma unroll
                for (int bj = 0; bj < 2; ++bj) { const f32x4 v0 = acc[ai][bj][m][0] * scale, v1 = acc[ai][bj][m][1] * scale;
#if Y_F8
                    u32x2 w; w.x = pk_fp8x4(v0[0], v0[1], v0[2], v0[3]); w.y = pk_fp8x4(v1[0], v1[1], v1[2], v1[3]);
                    *(u32x2*)((char*)O + off + bj * HALF) = w;
#else
                    u32x4 w; w.x = pk2(v0[0], v0[1]); w.y = pk2(v0[2], v0[3]); w.z = pk2(v1[0], v1[1]); w.w = pk2(v1[2], v1[3]);
                    *(u32x4*)((char*)O + off + bj * HALF * 2) = w;
#endif
                }
                off += EPI_ROWSTEP(m) * D * (Y_F8 ? 1 : 2); EPI_PIN(off); }
    }
};
}

struct Args {
    const float* x; const float* c; const float* w_ada; const float* b_ada; const float* norm_mix; const float* norm_ffn; const float* w_in;
    const float* w_alpha2; const float* b_alpha2; const float* gla_gain; const float* w_out_a; const float* w_out_b; const float* w_out;
    const float* w_router; const float* b_router; const float* w_gate_e; const float* w_up_e; const float* w_down_e; const float* final_norm;
    float* out; unsigned char* ws; int ph_lo, ph_hi;
};

__device__ __forceinline__ int proj_src_col(int n) {
    if (n < 3072) { const int blk = n >> 7, w = n & 127; return (blk << 7) + (w >> 1) + ((w & 1) << 6); }
    if (n < 7680) return n;
    if (n < 11776) return n + 16;
    if (n < 11792) return n - 4096;
    return -1;
}
struct TrDesc { const float* src; unsigned char* dst; int ldw, K, zero, rope, f8; };
__device__ __forceinline__ void tr_load(const TrDesc& d, f32x4 (&v)[16]) {
#pragma unroll
    for (int i = 0; i < 16; ++i) v[i] = *(const f32x4*)(d.src + (size_t)(4 * i) * d.ldw);
}
__device__ __forceinline__ void tr_finish(const TrDesc& d, f32x4 (&v)[16], LAS float* scr, int lane) {
    const int kk = lane >> 4, q4 = lane & 15;
    if (d.zero) {
#pragma unroll
        for (int i = 0; i < 16; ++i) v[i] = (f32x4){0.f, 0.f, 0.f, 0.f}; }
    const int d0 = d.rope ? 8 * (q4 & 7) + (q4 >> 3) : 4 * q4, ds = d.rope ? 2 : 1;
    { LAS float* rp = scr + kk * 65 + d0;
#pragma unroll
        for (int i = 0; i < 16; ++i) { rp[4 * i * 65] = v[i][0]; rp[4 * i * 65 + ds] = v[i][1]; rp[4 * i * 65 + 2 * ds] = v[i][2]; rp[4 * i * 65 + 3 * ds] = v[i][3]; } }
    LDS_WAIT(); asm volatile("" ::: "memory");
    if (d.f8) {
        const int c = lane & 3, nl = lane >> 2; const LAS float* sp = scr + (16 * c) * 65 + nl; unsigned char* dp = d.dst + (size_t)nl * d.K + 16 * c;
#pragma unroll
        for (int j = 0; j < 4; ++j) { u32x4 o;
            o.x = pk_fp8x4(sp[0 * 65 + 16 * j] * 32.0f, sp[1 * 65 + 16 * j] * 32.0f, sp[2 * 65 + 16 * j] * 32.0f, sp[3 * 65 + 16 * j] * 32.0f);
            o.y = pk_fp8x4(sp[4 * 65 + 16 * j] * 32.0f, sp[5 * 65 + 16 * j] * 32.0f, sp[6 * 65 + 16 * j] * 32.0f, sp[7 * 65 + 16 * j] * 32.0f);
            o.z = pk_fp8x4(sp[8 * 65 + 16 * j] * 32.0f, sp[9 * 65 + 16 * j] * 32.0f, sp[10 * 65 + 16 * j] * 32.0f, sp[11 * 65 + 16 * j] * 32.0f);
            o.w = pk_fp8x4(sp[12 * 65 + 16 * j] * 32.0f, sp[13 * 65 + 16 * j] * 32.0f, sp[14 * 65 + 16 * j] * 32.0f, sp[15 * 65 + 16 * j] * 32.0f);
            *(GAS u32x4*)(dp + (size_t)(16 * j) * d.K) = o; }
    } else {
        const int c = lane & 7, nl = lane >> 3; const LAS float* sp = scr + (8 * c) * 65 + nl; unsigned char* dp = d.dst + ((size_t)nl * d.K + 8 * c) * 2;
#pragma unroll
        for (int j = 0; j < 8; ++j) { u32x4 o;
            o.x = pk2(sp[0 * 65 + 8 * j], sp[1 * 65 + 8 * j]); o.y = pk2(sp[2 * 65 + 8 * j], sp[3 * 65 + 8 * j]); o.z = pk2(sp[4 * 65 + 8 * j], sp[5 * 65 + 8 * j]); o.w = pk2(sp[6 * 65 + 8 * j], sp[7 * 65 + 8 * j]);
            *(GAS u32x4*)(dp + (size_t)(8 * j) * d.K * 2) = o; }
    }
    LDS_WAIT(); asm volatile("" ::: "memory");
}

typedef const __attribute__((address_space(4))) Args CArgsP;
__device__ __forceinline__ void prologue_phase(CArgsP* ap_, LAS unsigned char* lds, int vcu, int G, int tid, int wave, int lane, int parts = 7) {
#define a (*ap_)
    unsigned char* ws = a.ws;
    if (parts & 1) {
        LAS float* cact = (LAS float*)lds;
        LAS float* red = (LAS float*)(lds + 65536);
        for (int i = tid; i < NB * D; i += NTHREADS) { const int b = i >> 11, k = i & 2047; cact[k * 8 + b] = siluf_(a.c[i]); }
        __syncthreads();
        float* ada = (float*)(ws + WS_ADA);
        const int q = tid & 7, kg = tid >> 3;
        for (int u = vcu; u < DEPTH * 384; u += G) {
            const int l = u / 384, n0 = (u % 384) * 32;
            const float* W = a.w_ada + (size_t)l * D * 12288 + n0 + 4 * q;
            f32x4 acc[8];
#pragma unroll
            for (int b = 0; b < 8; ++b) acc[b] = (f32x4){0.f, 0.f, 0.f, 0.f};
#pragma unroll 8
            for (int kk = 0; kk < 32; ++kk) { const int k = kg * 32 + kk; const f32x4 w = *(const f32x4*)(W + (size_t)k * 12288);
                const f32x4 c0 = *(const LAS f32x4*)(cact + k * 8), c1 = *(const LAS f32x4*)(cact + k * 8 + 4);
                acc[0] += w * c0[0]; acc[1] += w * c0[1]; acc[2] += w * c0[2]; acc[3] += w * c0[3];
                acc[4] += w * c1[0]; acc[5] += w * c1[1]; acc[6] += w * c1[2]; acc[7] += w * c1[3]; }
#pragma unroll
            for (int b = 0; b < 8; ++b) *(LAS f32x4*)(red + (kg * 8 + b) * 32 + 4 * q) = acc[b];
            __syncthreads();
            if (tid < 256) { const int b = tid >> 5, col = tid & 31; float s = a.b_ada[(size_t)l * 12288 + n0 + col];
                for (int g = 0; g < 64; ++g) s += red[(g * 8 + b) * 32 + col];
                const int n = n0 + col;
                if (n >= 2048 && n < 4096) s = (1.0f + s) * a.norm_mix[(size_t)l * D + n - 2048]; else if (n >= 8192 && n < 10240) s = (1.0f + s) * a.norm_ffn[(size_t)l * D + n - 8192];
                ada[((size_t)l * NB + b) * 12288 + n] = s; }
            __syncthreads();
        }
    }
    if (parts & 2) {
        float* cs = (float*)(ws + WS_ROPE); float* sn = cs + SEQ * 64;
        for (int i = vcu * NTHREADS + tid; i < SEQ * 64; i += G * NTHREADS) {
            const int pos = i >> 6, fi = i & 63;
            double f = 1.0;
            if (fi & 1) f *= 0.8659643233600653; if (fi & 2) f *= 0.7498942093324558; if (fi & 4) f *= 0.5623413251903491;
            if (fi & 8) f *= 0.31622776601683794; if (fi & 16) f *= 0.09999999999999999; if (fi & 32) f *= 0.009999999999999998;
            double rev = (double)pos * f * 0.15915494309189535; rev -= __builtin_floor(rev);
            const float rv = (float)rev;
            cs[i] = __builtin_amdgcn_cosf(rv); sn[i] = __builtin_amdgcn_sinf(rv);
        }
    }
    if (parts & 4) {
        LAS float* scr = (LAS float*)(lds + wave * 16640);
        const int gw = vcu * NWAVES + wave, NGW = G * NWAVES;
        constexpr int C_IN = 32 * 188, C_OA = 8 * 32, C_OB = 16 * 32, C_O = 32 * 32, C_GU = 16 * 32 * 32, C_DN = 16 * 16 * 32, C_L = C_IN + C_OA + C_OB + C_O + C_GU + C_DN, NIT = DEPTH * C_L;
        const int q4 = lane & 15, kk = lane >> 4;
        auto decode = [&](int it) -> TrDesc {
            TrDesc d; d.zero = 0; d.rope = 0; d.f8 = 0;
            const int l = it / C_L; int r = it % C_L;
            const float* W; unsigned char* WT; int ldw, K, k0, n0, scol, esz = 2;
            if (r < C_IN) { const int kb = r / 188, nb = r % 188; n0 = 64 * nb; k0 = 64 * kb; ldw = NIN; K = D; W = a.w_in + (size_t)l * D * NIN;
                if (n0 < 3072) { d.rope = 1; scol = (n0 >> 7) * 128 + 32 * ((n0 >> 6) & 1) + 64 * (q4 >> 3) + 4 * (q4 & 7); }
                else if (n0 < 7680) scol = n0 + 4 * q4;
                else if (n0 < 11776) scol = n0 + 16 + 4 * q4;
                else if (n0 == 11776) { scol = (q4 < 4) ? 7680 + 4 * q4 : 0; d.zero = (q4 < 4) ? 0 : 1; }
                else { scol = 0; d.zero = 1; }
#if PROJ_F8
                d.f8 = 1; esz = 1; WT = ws + WS_WIN + (size_t)l * NP * D;
#else
                WT = ws + WS_WIN + (size_t)l * NP * D * 2;
#endif
            } else if ((r -= C_IN) < C_OA) { const int kb = r / 32, nb = r % 32; n0 = 64 * nb; k0 = 64 * kb; ldw = D; K = 512; scol = n0 + 4 * q4; W = a.w_out_a + (size_t)l * 512 * D; WT = ws + WS_WOA + (size_t)l * D * 512 * (MIX_F8 ? 1 : 2); if (MIX_F8) { d.f8 = 1; esz = 1; }
                if (BR_FUSE) { K = 1536; WT = ws + WS_WOA + (size_t)l * D * 1536 + 1024; }
            } else if ((r -= C_OA) < C_OB) { const int kb = r / 32, nb = r % 32; n0 = 64 * nb; k0 = 64 * kb; ldw = D; K = 1024; scol = n0 + 4 * q4; W = a.w_out_b + (size_t)l * 1024 * D; WT = ws + WS_WOB + (size_t)l * D * 1024 * (MIX_F8 ? 1 : 2); if (MIX_F8) { d.f8 = 1; esz = 1; }
                if (BR_FUSE) { K = 1536; WT = ws + WS_WOA + (size_t)l * D * 1536; }
            } else if ((r -= C_OB) < C_O) { const int kb = r / 32, nb = r % 32; n0 = 64 * nb; k0 = 64 * kb; ldw = D; K = D; scol = n0 + 4 * q4; W = a.w_out + (size_t)l * D * D; WT = ws + WS_WO + (size_t)l * D * D * (MIX_F8 ? 1 : 2); if (MIX_F8) { d.f8 = 1; esz = 1; }
            } else if ((r -= C_O) < C_GU) { const int e = r / 1024, r2 = r % 1024, kb = r2 / 32, nb = r2 % 32, pn = nb >> 2, sgu = (nb >> 1) & 1, c0 = 64 * (nb & 1);
                n0 = 64 * nb; k0 = 64 * kb; ldw = FF; K = D; scol = 128 * pn + c0 + 4 * q4; W = (sgu ? a.w_up_e : a.w_gate_e) + (size_t)(l * NE + e) * D * FF; WT = ws + WS_WGU + (size_t)(l * NE + e) * 2048 * D; d.f8 = 1; esz = 1;
            } else { r -= C_GU; const int e = r / 512, r2 = r % 512, kb = r2 / 32, nb = r2 % 32;
                n0 = 64 * nb; k0 = 64 * kb; ldw = D; K = FF; scol = n0 + 4 * q4; W = a.w_down_e + (size_t)(l * NE + e) * FF * D; WT = ws + WS_WDN + (size_t)(l * NE + e) * D * FF; d.f8 = 1; esz = 1; }
            d.src = W + (size_t)(k0 + kk) * ldw + scol; d.ldw = ldw; d.K = K; d.dst = WT + ((size_t)n0 * K + k0) * esz;
            return d; };
        int it = gw; TrDesc dA, dB; f32x4 vA[16], vB[16];
        if (it < NIT) { dA = decode(it); tr_load(dA, vA); }
        while (it < NIT) {
            const int itB = it + NGW;
            if (itB < NIT) { dB = decode(itB); tr_load(dB, vB); }
            tr_finish(dA, vA, scr, lane);
            if (itB >= NIT) break;
            const int itA = itB + NGW;
            if (itA < NIT) { dA = decode(itA); tr_load(dA, vA); }
            tr_finish(dB, vB, scr, lane);
            it = itA;
        }
    }
}
#undef a

struct MoeStarts {
    int ts[NE];
    __device__ __forceinline__ void init(const unsigned* cnt) { int acc = 0;
#pragma unroll
        for (int e = 0; e < NE; ++e) { ts[e] = acc; acc += ((int)__hip_atomic_load(cnt + 64 * e, RLX_AGENT) + 255) >> 8; } }
    __device__ __forceinline__ int row(int slot) const { const int e = slot >> 16; int t0 = 0;
#pragma unroll
        for (int j = 0; j < NE; ++j) t0 = (e == j) ? ts[j] : t0;
        return t0 * 256 + (slot & 0xffff); }
};

template <int MODE>
__device__ __forceinline__ void norm_phase(const void* xs, void* xd, bf16_t* hout, const float* gain, const float* ada_scale, const float* ada_shift, const float* ada_gate2,
                                           const bf16_t* Y, const int* tslot, const float* tw, const unsigned* cnt, int vcu, int G, int wave, int lane) {
    const int gw = vcu * NWAVES + wave, NGW = G * NWAVES, rpw = T / NGW;
    MoeStarts ms; if (MODE != 0) ms.init(cnt);
    int tsl = 0; float twl = 0.f;
    if (MODE != 0) { const int i0 = gw * rpw * 2, ii = (i0 + lane < 2 * T) ? i0 + lane : 2 * T - 1; tsl = tslot[ii]; twl = tw[ii]; }
    for (int k = 0; k < rpw; k += 2) {
        const int row = gw * rpw + k, b = row >> 11;
        f32x4 v[2][8]; u32x2 xraw[2][8];
        int s0[2], s1[2]; float w0[2], w1[2];
        if (MODE != 0) {
#pragma unroll
            for (int rr = 0; rr < 2; ++rr) { s0[rr] = __builtin_amdgcn_readlane(tsl, (k + rr) * 2); s1[rr] = __builtin_amdgcn_readlane(tsl, (k + rr) * 2 + 1);
                w0[rr] = __builtin_bit_cast(float, __builtin_amdgcn_readlane(__builtin_bit_cast(int, twl), (k + rr) * 2)); w1[rr] = __builtin_bit_cast(float, __builtin_amdgcn_readlane(__builtin_bit_cast(int, twl), (k + rr) * 2 + 1)); } }
#pragma unroll
        for (int rr = 0; rr < 2; ++rr) {
            if (MODE == 0) { const GAS f32x4* xr = (const GAS f32x4*)((const float*)xs + (size_t)(row + rr) * D) + lane;
#pragma unroll
                for (int j = 0; j < 8; ++j) v[rr][j] = xr[64 * j];
            } else { const GAS u32x2* xr = (const GAS u32x2*)((const bf16_t*)xs + (size_t)(row + rr) * D) + lane;
#pragma unroll
                for (int j = 0; j < 8; ++j) xraw[rr][j] = xr[64 * j]; } }
        f32x4 ggv[8], ssv[8], scv[8];
#define GSS_LOAD() do { const GAS f32x4* gn_ = (const GAS f32x4*)gain + lane; \
            if (MODE == 2) { _Pragma("unroll") for (int j = 0; j < 8; ++j) { ggv[j] = gn_[64 * j]; scv[j] = (f32x4){0.f, 0.f, 0.f, 0.f}; ssv[j] = (f32x4){0.f, 0.f, 0.f, 0.f}; } } \
            else { const GAS f32x4* sc_ = (const GAS f32x4*)(ada_scale + (size_t)b * 12288) + lane; const GAS f32x4* sh_ = (const GAS f32x4*)(ada_shift + (size_t)b * 12288) + lane; \
                _Pragma("unroll") for (int j = 0; j < 8; ++j) { ggv[j] = sc_[64 * j]; scv[j] = (f32x4){0.f, 0.f, 0.f, 0.f}; ssv[j] = sh_[64 * j]; } } asm volatile("" ::: "memory"); } while (0)
        if (MODE == 0) GSS_LOAD();
        if (MODE != 0) {
            const GAS f32x4* gt = (const GAS f32x4*)(ada_gate2 + (size_t)b * 12288) + lane;
#if Y_F8
            unsigned ya[2][8], yb[2][8];
#pragma unroll
            for (int rr = 0; rr < 2; ++rr) { const GAS unsigned* y0 = (const GAS unsigned*)((const unsigned char*)Y + (size_t)ms.row(s0[rr]) * D) + lane; const GAS unsigned* y1 = (const GAS unsigned*)((const unsigned char*)Y + (size_t)ms.row(s1[rr]) * D) + lane;
#pragma unroll
                for (int j = 0; j < 8; ++j) { ya[rr][j] = y0[64 * j]; yb[rr][j] = y1[64 * j]; } }
            f32x4 gtv[8];
#pragma unroll
            for (int j = 0; j < 8; ++j) gtv[j] = gt[64 * j];
            asm volatile("" ::: "memory");
#pragma unroll
            for (int rr = 0; rr < 2; ++rr)
#pragma unroll
                for (int j = 0; j < 8; ++j) { LPIN(xraw[rr][j]); LPIN(ya[rr][j]); LPIN(yb[rr][j]); }
#pragma unroll
            for (int j = 0; j < 8; ++j) LPIN(gtv[j]);
#pragma unroll
            for (int rr = 0; rr < 2; ++rr)
#pragma unroll
                for (int j = 0; j < 8; ++j) { const u32x2 r = xraw[rr][j]; v[rr][j] = (f32x4){bflo(r.x), bfhi(r.x), bflo(r.y), bfhi(r.y)}; }
#pragma unroll
            for (int j = 0; j < 8; ++j) { const f32x4 g = gtv[j];
#pragma unroll
                for (int rr = 0; rr < 2; ++rr) {
                    const f32x2_t a0l = __builtin_amdgcn_cvt_pk_f32_fp8((int)ya[rr][j], false), a0h = __builtin_amdgcn_cvt_pk_f32_fp8((int)ya[rr][j], true), a1l = __builtin_amdgcn_cvt_pk_f32_fp8((int)yb[rr][j], false), a1h = __builtin_amdgcn_cvt_pk_f32_fp8((int)yb[rr][j], true);
                    f32x4 m; m[0] = w0[rr] * a0l[0] + w1[rr] * a1l[0]; m[1] = w0[rr] * a0l[1] + w1[rr] * a1l[1]; m[2] = w0[rr] * a0h[0] + w1[rr] * a1h[0]; m[3] = w0[rr] * a0h[1] + w1[rr] * a1h[1];
                    v[rr][j] = v[rr][j] + g * m; } }
#else
            u32x2 ya[2][8], yb[2][8];
#pragma unroll
            for (int rr = 0; rr < 2; ++rr) { const GAS u32x2* y0 = (const GAS u32x2*)(Y + (size_t)ms.row(s0[rr]) * D) + lane; const GAS u32x2* y1 = (const GAS u32x2*)(Y + (size_t)ms.row(s1[rr]) * D) + lane;
#pragma unroll
                for (int j = 0; j < 8; ++j) { ya[rr][j] = y0[64 * j]; yb[rr][j] = y1[64 * j]; } }
#pragma unroll
            for (int j = 0; j < 8; ++j) { const f32x4 g = gt[64 * j];
#pragma unroll
                for (int rr = 0; rr < 2; ++rr) { const u32x2 a0 = ya[rr][j], a1 = yb[rr][j];
                    f32x4 m; m[0] = w0[rr] * bflo(a0.x) + w1[rr] * bflo(a1.x); m[1] = w0[rr] * bfhi(a0.x) + w1[rr] * bfhi(a1.x); m[2] = w0[rr] * bflo(a0.y) + w1[rr] * bflo(a1.y); m[3] = w0[rr] * bfhi(a0.y) + w1[rr] * bfhi(a1.y);
                    v[rr][j] = v[rr][j] + g * m; } }
#endif
            GSS_LOAD();
            if (MODE == 1) {
#pragma unroll
                for (int rr = 0; rr < 2; ++rr) { GAS u32x2* xw = (GAS u32x2*)((bf16_t*)xd + (size_t)(row + rr) * D) + lane;
#pragma unroll
                    for (int j = 0; j < 8; ++j) { u32x2 w; w.x = pk2(v[rr][j][0], v[rr][j][1]); w.y = pk2(v[rr][j][2], v[rr][j][3]); xw[64 * j] = w; } } }
        }
        float rstd[2];
#pragma unroll
        for (int rr = 0; rr < 2; ++rr) { float s = 0.f;
#pragma unroll
            for (int j = 0; j < 8; ++j) s += (v[rr][j][0] * v[rr][j][0] + v[rr][j][1] * v[rr][j][1]) + (v[rr][j][2] * v[rr][j][2] + v[rr][j][3] * v[rr][j][3]);
            rstd[rr] = 1.0f / sqrtf(wave_sum(s, lane) * (1.0f / D) + NORM_EPS); }
        if (MODE == 2) {
#pragma unroll
            for (int j = 0; j < 8; ++j) { const f32x4 gg = ggv[j];
#pragma unroll
                for (int rr = 0; rr < 2; ++rr) ((GAS f32x4*)((float*)xd + (size_t)(row + rr) * D) + lane)[64 * j] = v[rr][j] * rstd[rr] * gg; }
        } else {
#pragma unroll
            for (int j = 0; j < 8; ++j) { const f32x4 gg = ggv[j] * (scv[j] + 1.0f), ss = ssv[j];
#pragma unroll
                for (int rr = 0; rr < 2; ++rr) { const f32x4 hh = v[rr][j] * rstd[rr] * gg + ss;
#if PROJ_F8
                    ((GAS unsigned*)((unsigned char*)hout + (size_t)(row + rr) * D) + lane)[64 * j] = pk_fp8x4_ns(hh[0], hh[1], hh[2], hh[3]);
#else
                    u32x2 w; w.x = pk2(hh[0], hh[1]); w.y = pk2(hh[2], hh[3]); ((GAS u32x2*)(hout + (size_t)(row + rr) * D) + lane)[64 * j] = w;
#endif
                } }
        }
    }
}

__device__ __forceinline__ float reduce16(const float (&p)[NE], int lane) {
    float q[8], r[4], s2[2];
    const bool h5 = (lane & 32) != 0, h4 = (lane & 16) != 0, h3 = (lane & 8) != 0, h2 = (lane & 4) != 0;
#pragma unroll
    for (int i = 0; i < 8; ++i) q[i] = (h5 ? p[i + 8] : p[i]) + sx<32>(h5 ? p[i] : p[i + 8], lane);
#pragma unroll
    for (int i = 0; i < 4; ++i) r[i] = (h4 ? q[i + 4] : q[i]) + sx<16>(h4 ? q[i] : q[i + 4], lane);
#pragma unroll
    for (int i = 0; i < 2; ++i) s2[i] = (h3 ? r[i + 2] : r[i]) + sx<8>(h3 ? r[i] : r[i + 2], lane);
    float t = (h2 ? s2[1] : s2[0]) + sx<4>(h2 ? s2[0] : s2[1], lane);
    t += sx<2>(t, lane); t += sx<1>(t, lane);
    return t;
}
__device__ __forceinline__ void route_token(float affl, float sell, int& i0, int& i1, float& w0, float& w1) {
    float aff[NE], sel[NE];
#pragma unroll
    for (int e = 0; e < NE; ++e) { aff[e] = __builtin_bit_cast(float, __builtin_amdgcn_readlane(__builtin_bit_cast(int, affl), 4 * e)); sel[e] = __builtin_bit_cast(float, __builtin_amdgcn_readlane(__builtin_bit_cast(int, sell), 4 * e)); }
    float gs[4];
#pragma unroll
    for (int g = 0; g < 4; ++g) { const float a = sel[4 * g], b = sel[4 * g + 1], c = sel[4 * g + 2], d = sel[4 * g + 3];
        const float h1 = fmaxf(a, b), l1 = fminf(a, b), h2 = fmaxf(c, d), l2 = fminf(c, d);
        gs[g] = fmaxf(h1, h2) + fmaxf(fminf(h1, h2), fmaxf(l1, l2)); }
    int bg = 0; float best = gs[0];
#pragma unroll
    for (int g = 1; g < 4; ++g) { const bool c = gs[g] > best; best = c ? gs[g] : best; bg = c ? g : bg; }
    float s0 = -3.0e38f, s1 = -3.0e38f, a0 = 0.f, a1 = 0.f; int j0 = 0, j1 = 0;
#pragma unroll
    for (int j = 0; j < 4; ++j) {
        const float v = bg == 0 ? sel[j] : (bg == 1 ? sel[4 + j] : (bg == 2 ? sel[8 + j] : sel[12 + j]));
        const float af = bg == 0 ? aff[j] : (bg == 1 ? aff[4 + j] : (bg == 2 ? aff[8 + j] : aff[12 + j]));
        const bool gt0 = v > s0, gt1 = v > s1;
        s1 = gt0 ? s0 : (gt1 ? v : s1); j1 = gt0 ? j0 : (gt1 ? j : j1); a1 = gt0 ? a0 : (gt1 ? af : a1);
        s0 = gt0 ? v : s0; j0 = gt0 ? j : j0; a0 = gt0 ? af : a0; }
    i0 = 4 * bg + j0; i1 = 4 * bg + j1;
    const float inv = 1.0f / (a0 + a1); w0 = a0 * inv; w1 = a1 * inv;
}
__device__ __forceinline__ void router_phase(const bf16_t* xs, bf16_t* hout, const float* gain, const float* ada_scale, const float* ada_shift, const float* w_router, const float* b_router,
                                             unsigned* cnt, int* rlist, int* tslot, float* tw, LAS unsigned char* lds, int vcu, int G, int tid, int wave, int lane) {
    LAS float* wrT = (LAS float*)lds;
    LAS int* misc = (LAS int*)(lds + MISC_OFF + 64);
    LAS int* lcnt = misc; LAS int* lbase = misc + 16; LAS int* rinfo = misc + 32;
    for (int c = tid; c < D; c += NTHREADS) {
        const f32x4 w0 = *(const f32x4*)(w_router + c * 16), w1 = *(const f32x4*)(w_router + c * 16 + 4), w2 = *(const f32x4*)(w_router + c * 16 + 8), w3 = *(const f32x4*)(w_router + c * 16 + 12);
#pragma unroll
        for (int e = 0; e < 4; ++e) { wrT[e * D + c] = w0[e]; wrT[(4 + e) * D + c] = w1[e]; wrT[(8 + e) * D + c] = w2[e]; wrT[(12 + e) * D + c] = w3[e]; } }
    const int rows_per_blk = T / G;
    for (int base = vcu * rows_per_blk; base < T; base += G * rows_per_blk) {
        if (tid < 16) lcnt[tid] = 0;
        __syncthreads();
        const int rpw = rows_per_blk / NWAVES;
        for (int k = 0; k < rpw; k += 2) {
            const int lr = wave * rpw + k, row = base + lr, b = row >> 11;
            f32x4 v[2][8]; float rstd[2];
#pragma unroll
            for (int rr = 0; rr < 2; ++rr) { const GAS u32x2* xr = (const GAS u32x2*)(xs + (size_t)(row + rr) * D) + lane;
#pragma unroll
                for (int j = 0; j < 8; ++j) { const u32x2 r = xr[64 * j]; v[rr][j] = (f32x4){bflo(r.x), bfhi(r.x), bflo(r.y), bfhi(r.y)}; } }
            f32x4 ggv[8], ssv[8];
            { const GAS f32x4* sc = (const GAS f32x4*)(ada_scale + (size_t)b * 12288) + lane; const GAS f32x4* sh = (const GAS f32x4*)(ada_shift + (size_t)b * 12288) + lane;
#pragma unroll
              for (int j = 0; j < 8; ++j) { ggv[j] = sc[64 * j]; ssv[j] = sh[64 * j]; }
              asm volatile("" ::: "memory"); }
#pragma unroll
            for (int rr = 0; rr < 2; ++rr) { float s = 0.f;
#pragma unroll
                for (int j = 0; j < 8; ++j) s += (v[rr][j][0] * v[rr][j][0] + v[rr][j][1] * v[rr][j][1]) + (v[rr][j][2] * v[rr][j][2] + v[rr][j][3] * v[rr][j][3]);
                rstd[rr] = 1.0f / sqrtf(wave_sum(s, lane) * (1.0f / D) + NORM_EPS); }
#pragma unroll
            for (int jb = 0; jb < 8; jb += 4) {
#pragma unroll
                for (int jj = 0; jj < 4; ++jj) { const int j = jb + jj; const f32x4 gg = ggv[j], ss = ssv[j];
#pragma unroll
                    for (int rr = 0; rr < 2; ++rr) { v[rr][j] = v[rr][j] * rstd[rr] * gg + ss;
                        ((GAS unsigned*)((unsigned char*)hout + (size_t)(row + rr) * D) + lane)[64 * j] = pk_fp8x4_ns(v[rr][j][0], v[rr][j][1], v[rr][j][2], v[rr][j][3]); } }
                asm volatile("" ::: "memory"); }
            float p0[NE], p1[NE];
            f32x4 wA[8], wB[8];
#define RT_RD(W, e) do { _Pragma("unroll") for (int j = 0; j < 8; ++j) W[j] = *(const LAS f32x4*)(wrT + (e) * D + 4 * lane + 256 * j); asm volatile("" ::: "memory"); } while (0)
#define RT_FMA(W, e) do { f32x2 a0 = {0.f, 0.f}, a1 = {0.f, 0.f}; _Pragma("unroll") for (int j = 0; j < 8; ++j) { LPIN(W[j]); const f32x2 wl = {W[j][0], W[j][1]}, wh = {W[j][2], W[j][3]}; \
                a0 = __builtin_elementwise_fma((f32x2){v[0][j][0], v[0][j][1]}, wl, a0); a0 = __builtin_elementwise_fma((f32x2){v[0][j][2], v[0][j][3]}, wh, a0); \
                a1 = __builtin_elementwise_fma((f32x2){v[1][j][0], v[1][j][1]}, wl, a1); a1 = __builtin_elementwise_fma((f32x2){v[1][j][2], v[1][j][3]}, wh, a1); } \
                p0[e] = a0[0] + a0[1]; p1[e] = a1[0] + a1[1]; } while (0)
            RT_RD(wA, 0);
#pragma unroll
            for (int e = 0; e < NE; e += 2) { RT_RD(wB, e + 1); RT_FMA(wA, e); if (e + 2 < NE) RT_RD(wA, e + 2); RT_FMA(wB, e + 1); }
#undef RT_RD
#undef RT_FMA
            const float t0 = reduce16(p0, lane), t1 = reduce16(p1, lane);
            const float bre = b_router[lane >> 2];
#pragma unroll
            for (int rr = 0; rr < 2; ++rr) {
                const float affl = sigmoidf_(rr ? t1 : t0), sell = affl + bre;
                int i0, i1; float w0, w1; route_token(affl, sell, i0, i1, w0, w1);
                if (lane == 0) { const int r0 = atomicAdd((int*)lcnt + i0, 1), r1 = atomicAdd((int*)lcnt + i1, 1);
                    rinfo[(lr + rr) * 4 + 0] = (i0 << 16) | r0; rinfo[(lr + rr) * 4 + 1] = (i1 << 16) | r1;
                    tw[(row + rr) * 2] = w0; tw[(row + rr) * 2 + 1] = w1; } }
        }
        __syncthreads();
        if (tid < 16) lbase[tid] = (int)__hip_atomic_fetch_add(cnt + 64 * tid, (unsigned)lcnt[tid], RLX_AGENT);
        __syncthreads();
        if (tid < rows_per_blk * 2) { const int lr = tid >> 1, kk = tid & 1, info = rinfo[lr * 4 + kk], e = info >> 16, rank = lbase[e] + (info & 0xffff);
            rlist[(size_t)e * T + rank] = base + lr; tslot[(base + lr) * 2 + kk] = (e << 16) | rank; }
        __syncthreads();
    }
}

__device__ __forceinline__ int swz256(int row, int ch) { return 256 * row + 16 * (ch ^ (((row & 3) << 2) | ((row >> 2) & 3))); }
typedef short v4i16_t __attribute__((ext_vector_type(4)));
__device__ __forceinline__ s16x4 vtr(const LAS unsigned char* p) { return __builtin_bit_cast(s16x4, __builtin_amdgcn_ds_read_tr16_b64_v4i16((LAS v4i16_t*)p)); }

struct AttnPre { u32x4 kv[8]; bf16x8 qf[4]; };
__device__ __forceinline__ void attn_issue(AttnPre& R, const bf16_t* proj, int a, int tid, int wave, int lane) {
    const int sub = a & 15, bh = a >> 4, head = bh % 12, b = bh / 12, g = head >> 2;
    const int dsh = 2 * g, nbsh = 4 - 2 * g;
    const int nblk = sub & ((1 << nbsh) - 1), r = sub >> nbsh;
    const size_t tb = (size_t)b * SEQ;
    const int p0 = 128 * (nblk - 1);
#pragma unroll
    for (int it = 0; it < 8; ++it) { const int id = tid + NTHREADS * it, row = id >> 4, ch = id & 15, p = p0 + row;
        const int pc = p < 0 ? 0 : p;
        const size_t t = tb + ((size_t)pc << dsh) + r; R.kv[it] = *(const u32x4*)(proj + t * NP + KA + head * 128 + ch * 8); }
    const int fr = lane & 15, fq = lane >> 4, qi = 16 * wave + fr;
    const size_t tq = tb + ((size_t)(128 * nblk + qi) << dsh) + r;
    const bf16_t* qsrc = proj + tq * NP + QA + head * 128 + fq * 8;
#pragma unroll
    for (int ks = 0; ks < 4; ++ks) R.qf[ks] = *(const bf16x8*)(qsrc + 32 * ks);
}
__device__ __forceinline__ void attn_unit(LAS unsigned char* lds, AttnPre& R, const bf16_t* proj, bf16_t* atto, float* lse, int a, int a_next, int tid, int wave, int lane) {
    const int sub = a & 15, bh = a >> 4, head = bh % 12, b = bh / 12, g = head >> 2, hj = head & 3;
    const int dsh = 2 * g, nbsh = 4 - 2 * g;
    const int nblk = sub & ((1 << nbsh) - 1), r = sub >> nbsh;
    const size_t tb = (size_t)b * SEQ;
    const int p0 = 128 * (nblk - 1);
    LAS unsigned char* Kl = lds; LAS unsigned char* Vl = lds + 65536;
#pragma unroll
    for (int it = 0; it < 8; ++it) { const int id = tid + NTHREADS * it, row = id >> 4, ch = id & 15; *(LAS u32x4*)(Kl + swz256(row, ch)) = R.kv[it]; }
    u32x4 vv[8];
#pragma unroll
    for (int it = 0; it < 8; ++it) { const int id = tid + NTHREADS * it, row = id >> 4, ch = id & 15, p = p0 + row;
        const int pc = p < 0 ? 0 : p;
        const size_t t = tb + ((size_t)pc << dsh) + r; vv[it] = *(const u32x4*)(proj + t * NP + VA + head * 128 + ch * 8); }
    const int fr = lane & 15, fq = lane >> 4;
    const int qi = 16 * wave + fr;
    const size_t tq = tb + ((size_t)(128 * nblk + qi) << dsh) + r;
    bf16x8 qf[4];
#pragma unroll
    for (int ks = 0; ks < 4; ++ks) qf[ks] = R.qf[ks];
    __syncthreads();
    f32x4 sacc[9];
    unsigned kbase[4];
    { const int fK = ((fr & 3) << 2) | ((fr >> 2) & 3);
#pragma unroll
        for (int ks = 0; ks < 4; ++ks) kbase[ks] = (unsigned)(256 * (16 * wave + fr) + 16 * ((4 * ks + fq) ^ fK)); }
#pragma unroll
    for (int kt = 0; kt < 9; ++kt) { f32x4 acc = (f32x4){0.f, 0.f, 0.f, 0.f};
#pragma unroll
        for (int ks = 0; ks < 4; ++ks) { const bf16x8 kf = *(const LAS bf16x8*)(Kl + kbase[ks] + 4096 * kt); acc = __builtin_amdgcn_mfma_f32_16x16x32_bf16(kf, qf[ks], acc, 0, 0, 0); }
        sacc[kt] = acc; }
    const float sc = 0.12751743082459868f;
    float mx = -3.0e38f;
#pragma unroll
    for (int kt = 0; kt < 9; ++kt)
#pragma unroll
        for (int rg = 0; rg < 4; ++rg) { const int jk = 16 * (wave + kt) + 4 * fq + rg; const bool valid = (jk >= qi) && (jk <= qi + 128) && (p0 + jk >= 0);
            const float s = valid ? sacc[kt][rg] * sc : -3.0e38f; sacc[kt][rg] = s; mx = fmaxf(mx, s); }
    mx = fmaxf(mx, sx<16>(mx, lane)); mx = fmaxf(mx, sx<32>(mx, lane));
    float sum = 0.f;
#pragma unroll
    for (int kt = 0; kt < 9; ++kt)
#pragma unroll
        for (int rg = 0; rg < 4; ++rg) { const float p = __builtin_amdgcn_exp2f(sacc[kt][rg] - mx); sacc[kt][rg] = p; sum += p; }
    sum += sx<16>(sum, lane); sum += sx<32>(sum, lane);
#pragma unroll
    for (int it = 0; it < 8; ++it) { const int id = tid + NTHREADS * it, row = id >> 4, ch = id & 15; *(LAS u32x4*)(Vl + swz256(row, ch)) = vv[it]; }
    __syncthreads();
    if (a_next >= 0) attn_issue(R, proj, a_next, tid, wave, lane);
    f32x4 oacc[8];
#pragma unroll
    for (int dt = 0; dt < 8; ++dt) oacc[dt] = (f32x4){0.f, 0.f, 0.f, 0.f};
    const int li = lane & 15, qq = li >> 2, pp = li & 3;
    unsigned vbase[8];
    { const int fV = (qq << 2) | fq;
#pragma unroll
        for (int dt = 0; dt < 8; ++dt) vbase[dt] = (unsigned)(256 * (16 * wave + 4 * fq + qq) + 16 * ((2 * dt + (pp >> 1)) ^ fV) + 8 * (pp & 1)); }
#pragma unroll
    for (int s5 = 0; s5 < 5; ++s5) {
        const int t0 = 2 * s5, t1 = (2 * s5 + 1 < 9) ? 2 * s5 + 1 : 2 * s5;
        u32x4 pw; pw.x = pk2(sacc[t0][0], sacc[t0][1]); pw.y = pk2(sacc[t0][2], sacc[t0][3]);
        if (2 * s5 + 1 < 9) { pw.z = pk2(sacc[t1][0], sacc[t1][1]); pw.w = pk2(sacc[t1][2], sacc[t1][3]); } else { pw.z = 0u; pw.w = 0u; }
        const bf16x8 pf = __builtin_bit_cast(bf16x8, pw);
#pragma unroll
        for (int dt = 0; dt < 8; ++dt) {
            const s16x4 v0 = vtr(Vl + vbase[dt] + 4096 * t0);
            const s16x4 v1 = vtr(Vl + vbase[dt] + 4096 * t1);
            bf16x8 vf; vf[0] = v0[0]; vf[1] = v0[1]; vf[2] = v0[2]; vf[3] = v0[3]; vf[4] = v1[0]; vf[5] = v1[1]; vf[6] = v1[2]; vf[7] = v1[3];
            oacc[dt] = __builtin_amdgcn_mfma_f32_16x16x32_bf16(vf, pf, oacc[dt], 0, 0, 0);
        }
    }
    const float inv = 1.0f / sum;
    bf16_t* op = atto + ((size_t)g * T + tq) * 512 + hj * 128 + 4 * fq;
#pragma unroll
    for (int dt = 0; dt < 8; ++dt) { u32x2 w; w.x = pk2(oacc[dt][0] * inv, oacc[dt][1] * inv); w.y = pk2(oacc[dt][2] * inv, oacc[dt][3] * inv); *(u32x2*)(op + 16 * dt) = w; }
    if (fq == 0) lse[((size_t)g * T + tq) * 4 + hj] = mx * 0.6931471805599453f + __logf(sum);
    __syncthreads();
}

__device__ __forceinline__ int swz512(int row, int ch) { return 512 * row + 16 * (ch ^ (((row & 3) << 2) | ((row >> 2) & 3))); }

struct GlaPre { float al0, al1; u32x4 q[2], k[2], v[4]; };
__device__ __forceinline__ void gla_local_issue(GlaPre& R, const bf16_t* proj, const float* alow, int u, int tid) {
    const int n = u & 31, h = (u >> 5) & 3, b = u >> 7;
    const size_t t0 = (size_t)b * SEQ + 64 * n;
    R.al0 = alow[t0 * 16 + tid]; R.al1 = alow[t0 * 16 + 512 + tid];
#pragma unroll
    for (int it = 0; it < 2; ++it) { const int id = tid + NTHREADS * it, row = id >> 4, ch = id & 15; const bf16_t* src = proj + (t0 + row) * NP + h * 128 + ch * 8; R.q[it] = *(const u32x4*)(src + QB); R.k[it] = *(const u32x4*)(src + KB); }
#pragma unroll
    for (int it = 0; it < 4; ++it) { const int id = tid + NTHREADS * it, row = id >> 5, ch = id & 31; R.v[it] = *(const u32x4*)(proj + (t0 + row) * NP + VB + h * 256 + ch * 8); }
}
__device__ __forceinline__ void gla_local_unit(LAS unsigned char* lds, GlaPre& R, const bf16_t* proj, const float* alow, const float (&w2)[16], const float bias,
                                               bf16_t* qdg, bf16_t* oig, bf16_t* dstg, float* decg, int u, int u_next, int tid, int wave, int lane) {
    const int n = u & 31, h = (u >> 5) & 3, b = u >> 7;
    const int d = tid & 127, ig = tid >> 7;
    const int fr = lane & 15, fq = lane >> 4;
    LAS unsigned char* QD = lds; LAS unsigned char* KI = lds + 17408; LAS unsigned char* KET = lds + 34816; LAS unsigned char* VL = lds + 53248;
    LAS unsigned char* AT = lds + 86016;
    LAS float* CS = (LAS float*)(lds + 95232); LAS float* ALs = (LAS float*)(lds + 97280);
    const size_t t0 = (size_t)b * SEQ + 64 * n;
#pragma unroll
    for (int it = 0; it < 2; ++it) { const int id = tid + NTHREADS * it, row = id >> 4, ch = id & 15; *(LAS u32x4*)(QD + row * 272 + ch * 16) = R.q[it]; *(LAS u32x4*)(KI + row * 272 + ch * 16) = R.k[it]; }
    ALs[tid] = R.al0; ALs[512 + tid] = R.al1;
#pragma unroll
    for (int it = 0; it < 4; ++it) { const int id = tid + NTHREADS * it, row = id >> 5, ch = id & 31; *(LAS u32x4*)(VL + swz512(row, ch)) = R.v[it]; }
    __syncthreads();
    if (u_next >= 0) gla_local_issue(R, proj, alow, u_next, tid);
    float bl[16]; float run = 0.f;
#pragma unroll
    for (int ii = 0; ii < 16; ++ii) { float z = bias; const LAS f32x4* ap = (const LAS f32x4*)(ALs + (16 * ig + ii) * 16);
#pragma unroll
        for (int r4 = 0; r4 < 4; ++r4) { const f32x4 av = ap[r4]; z = fmaf(av[0], w2[4 * r4], z); z = fmaf(av[1], w2[4 * r4 + 1], z); z = fmaf(av[2], w2[4 * r4 + 2], z); z = fmaf(av[3], w2[4 * r4 + 3], z); }
        const float la = (fminf(z, 0.f) - __logf(1.0f + __expf(-fabsf(z)))) * 0.0625f; run += la; bl[ii] = run; }
    CS[ig * 128 + d] = run;
    __syncthreads();
    float pre = 0.f, tot = 0.f;
#pragma unroll
    for (int g2 = 0; g2 < 4; ++g2) { const float cv = CS[g2 * 128 + d]; tot += cv; pre += (g2 < ig) ? cv : 0.f; }
    const float qscale = 0.08838834764831845f; const float etot = __expf(tot);
    unsigned ke[8];
#pragma unroll
    for (int ii = 0; ii < 16; ++ii) { const float bb = pre + bl[ii];
        LAS bf16_t* qp = (LAS bf16_t*)(QD + (16 * ig + ii) * 272 + 2 * d); LAS bf16_t* kp = (LAS bf16_t*)(KI + (16 * ig + ii) * 272 + 2 * d);
        const float qf_ = bf2f(*qp), kf_ = bf2f(*kp);
        const float eb = __expf(bb), einv = __builtin_amdgcn_rcpf(eb);
        const float qd = qf_ * qscale * eb, ki = kf_ * einv, kend = kf_ * (etot * einv);
        *qp = (bf16_t)f2bf(qd); *kp = (bf16_t)f2bf(ki);
        if (ii & 1) ke[ii >> 1] |= f2bf(kend) << 16; else ke[ii >> 1] = f2bf(kend); }
    *(LAS u32x4*)(KET + d * 144 + 32 * ig) = (u32x4){ke[0], ke[1], ke[2], ke[3]}; *(LAS u32x4*)(KET + d * 144 + 32 * ig + 16) = (u32x4){ke[4], ke[5], ke[6], ke[7]};
    if (ig == 0) decg[(size_t)u * 128 + d] = etot;
    __syncthreads();
#pragma unroll
    for (int it = 0; it < 2; ++it) { const int id = tid + NTHREADS * it, row = id >> 4, ch = id & 15; *(u32x4*)(qdg + ((size_t)(b * 4 + h) * 32 + n) * 8192 + (size_t)((((row >> 4) * 4 + (ch >> 2)) * 64 + (row & 15) * 4 + (ch & 3)) * 8)) = *(const LAS u32x4*)(QD + row * 272 + ch * 16); }
#pragma unroll
    for (int x = 0; x < 2; ++x) { const int id = 2 * wave + x, ti = id >> 2, tj = id & 3; f32x4 acc = (f32x4){0.f, 0.f, 0.f, 0.f};
        if (tj <= ti) {
#pragma unroll
            for (int ks = 0; ks < 4; ++ks) { const bf16x8 af = *(const LAS bf16x8*)(QD + (16 * ti + fr) * 272 + (32 * ks + 8 * fq) * 2); const bf16x8 bfr = *(const LAS bf16x8*)(KI + (16 * tj + fr) * 272 + (32 * ks + 8 * fq) * 2);
                acc = __builtin_amdgcn_mfma_f32_16x16x32_bf16(af, bfr, acc, 0, 0, 0); } }
#pragma unroll
        for (int rg = 0; rg < 4; ++rg) { const int i = 16 * ti + 4 * fq + rg, j = 16 * tj + fr; const float vv = (i >= j) ? acc[rg] : 0.f; *(LAS bf16_t*)(AT + i * 144 + 2 * j) = (bf16_t)f2bf(vv); } }
    bf16x8 vfr[2][2];
    { const int li = lane & 15, qq = li >> 2, pp = li & 3;
#pragma unroll
        for (int tv = 0; tv < 2; ++tv)
#pragma unroll
            for (int ks = 0; ks < 2; ++ks) { const int vt = 2 * wave + tv;
                const int r0 = 32 * ks + 8 * fq + qq, r1 = r0 + 4;
                const s16x4 a0 = vtr(VL + swz512(r0, 2 * vt + (pp >> 1)) + 8 * (pp & 1)), a1 = vtr(VL + swz512(r1, 2 * vt + (pp >> 1)) + 8 * (pp & 1));
                bf16x8 f; f[0] = a0[0]; f[1] = a0[1]; f[2] = a0[2]; f[3] = a0[3]; f[4] = a1[0]; f[5] = a1[1]; f[6] = a1[2]; f[7] = a1[3]; vfr[tv][ks] = f; } }
#pragma unroll
    for (int dt = 0; dt < 8; ++dt) {
        bf16x8 kf[2];
#pragma unroll
        for (int ks = 0; ks < 2; ++ks) kf[ks] = *(const LAS bf16x8*)(KET + (16 * dt + fr) * 144 + (32 * ks + 8 * fq) * 2);
#pragma unroll
        for (int tv = 0; tv < 2; ++tv) { f32x4 acc = (f32x4){0.f, 0.f, 0.f, 0.f};
#pragma unroll
            for (int ks = 0; ks < 2; ++ks) acc = __builtin_amdgcn_mfma_f32_16x16x32_bf16(kf[ks], vfr[tv][ks], acc, 0, 0, 0);
            u32x2 w; w.x = pk2(acc[0], acc[1]); w.y = pk2(acc[2], acc[3]);
            *(u32x2*)(dstg + (((size_t)(b * 4 + h) * 8 + wave) * 32 + n) * 4096 + (size_t)(((dt * 2 + tv) * 64 + fr * 4 + fq) * 4)) = w; } }
    __syncthreads();
#pragma unroll
    for (int ti = 0; ti < 4; ++ti) {
        bf16x8 af[2];
#pragma unroll
        for (int ks = 0; ks < 2; ++ks) af[ks] = *(const LAS bf16x8*)(AT + (16 * ti + fr) * 144 + (32 * ks + 8 * fq) * 2);
#pragma unroll
        for (int tv = 0; tv < 2; ++tv) { f32x4 acc = (f32x4){0.f, 0.f, 0.f, 0.f};
#pragma unroll
            for (int ks = 0; ks < 2; ++ks) acc = __builtin_amdgcn_mfma_f32_16x16x32_bf16(vfr[tv][ks], af[ks], acc, 0, 0, 0);
            u32x2 w; w.x = pk2(acc[0], acc[1]); w.y = pk2(acc[2], acc[3]);
            *(u32x2*)(oig + (((size_t)(b * 4 + h) * 8 + wave) * 32 + n) * 2048 + (size_t)(((ti * 2 + tv) * 64 + fr * 4 + fq) * 4)) = w; } }
    __syncthreads();
}

template <bool FAKE>
__device__ __forceinline__ void gla_scan_unit(LAS unsigned char* lds, const bf16_t* qdg, const bf16_t* oig, const bf16_t* dstg, const float* decg, bf16_t* ob, float* ssq,
                                              int u, int tid, int wave, int lane) {
    const int vs = u & 7, h = (u >> 3) & 3, b = u >> 5;
    const int fr = lane & 15, fq = lane >> 4;
    const int ti = wave >> 1, tv = wave & 1;
    LAS unsigned char* STb = lds;
    LAS unsigned char* OBL = lds + 20480;
    LAS float* SQL = (LAS float*)(lds + 53248);
    f32x4 sst[2]; sst[0] = (f32x4){0.f, 0.f, 0.f, 0.f}; sst[1] = sst[0];
    { unsigned z0 = 0u; asm volatile("" : "+v"(z0)); *(LAS u32x4*)(STb + tid * 16) = (u32x4){z0, z0, z0, z0}; if (tid < 32) *(LAS u32x4*)(STb + 8192 + tid * 16) = (u32x4){z0, z0, z0, z0}; }
    const int ub = (b * 4 + h) * 32;
    struct StepOps { bf16x8 q[4]; u32x2 o; u32x2 ds[2]; f32x4 dc; };
    const unsigned qoff = (unsigned)((ti * 4 * 64 + fr * 4 + fq) * 16), ooff = (unsigned)(((ti * 2 + tv) * 64 + fr * 4 + fq) * 8);
    const unsigned dsoff = (unsigned)(((wave * 2) * 64 + fr * 4 + fq) * 8), dcoff = (unsigned)(16 * wave + 4 * fq) * 4u;
    const char* qbase = (const char*)(qdg + (size_t)(b * 4 + h) * SEQ * 128);
    const char* obase = (const char*)(oig + ((size_t)(b * 4 + h) * 8 + vs) * SEQ * 32);
    const char* dsbase = (const char*)(dstg + ((size_t)(b * 4 + h) * 8 + vs) * 32 * 32 * 128);
    const char* dcbase = (const char*)(decg + (size_t)ub * 128);
#define GLA_LOAD(R, nn_) do { const int nn = FAKE ? 0 : ((nn_) < 32 ? (nn_) : 31); \
        const char* qs_ = qbase + (size_t)nn * 16384; _Pragma("unroll") for (int ks = 0; ks < 4; ++ks) R.q[ks] = *(const bf16x8*)(qs_ + qoff + 1024 * ks); \
        R.o = *(const u32x2*)(obase + (size_t)nn * 4096 + ooff); \
        _Pragma("unroll") for (int t2 = 0; t2 < 2; ++t2) R.ds[t2] = *(const u32x2*)(dsbase + (size_t)nn * 8192 + 512 * t2 + dsoff); \
        R.dc = *(const f32x4*)(dcbase + (size_t)nn * 512 + dcoff); } while (0)
#define GLA_STEP(R, n_) do { const int n = (n_); const size_t t0 = (size_t)b * SEQ + 64 * n; \
        LAS unsigned char* STc = STb + (n & 1) * 8704; LAS unsigned char* STn = STb + ((n + 1) & 1) * 8704; \
        f32x4 acc; acc[0] = bflo(R.o.x); acc[1] = bfhi(R.o.x); acc[2] = bflo(R.o.y); acc[3] = bfhi(R.o.y); \
        _Pragma("unroll") for (int ks = 0; ks < 4; ++ks) { const bf16x8 sfr = *(const LAS bf16x8*)(STc + (16 * tv + fr) * 272 + (32 * ks + 8 * fq) * 2); acc = __builtin_amdgcn_mfma_f32_16x16x32_bf16(sfr, R.q[ks], acc, 0, 0, 0); } \
        { u32x2 w; w.x = pk2(acc[0], acc[1]); w.y = pk2(acc[2], acc[3]);              \
            *(LAS u32x2*)(OBL + (n & 7) * 4096 + (16 * ti + fr) * 64 + (16 * tv + 4 * fq) * 2) = w; \
            float q2 = (acc[0] * acc[0] + acc[1] * acc[1]) + (acc[2] * acc[2] + acc[3] * acc[3]); q2 += sx<16>(q2, lane); q2 += sx<32>(q2, lane); \
            if (fq == 0) SQL[(n & 7) * 128 + (16 * ti + fr) * 2 + tv] = q2; } \
        _Pragma("unroll") for (int t2 = 0; t2 < 2; ++t2) { \
            sst[t2][0] = sst[t2][0] * R.dc[0] + bflo(R.ds[t2].x); sst[t2][1] = sst[t2][1] * R.dc[1] + bfhi(R.ds[t2].x); \
            sst[t2][2] = sst[t2][2] * R.dc[2] + bflo(R.ds[t2].y); sst[t2][3] = sst[t2][3] * R.dc[3] + bfhi(R.ds[t2].y); \
            u32x2 w; w.x = pk2(sst[t2][0], sst[t2][1]); w.y = pk2(sst[t2][2], sst[t2][3]); \
            *(LAS u32x2*)(STn + (16 * t2 + fr) * 272 + (16 * wave + 4 * fq) * 2) = w; } \
        __syncthreads(); \
        if (!FAKE && (n & 7) == 7) { const size_t tf = (size_t)b * SEQ + 64 * (n - 7); \
            _Pragma("unroll") for (int it = 0; it < 4; ++it) { const int id = tid + NTHREADS * it, sf = id >> 8, row = (id >> 2) & 63, c = id & 3; \
                *(u32x4*)(ob + (tf + 64 * sf + row) * 1024 + h * 256 + 32 * vs + 8 * c) = *(const LAS u32x4*)(OBL + id * 16); } \
            _Pragma("unroll") for (int it = 0; it < 2; ++it) { const int id = tid + NTHREADS * it, sf = id >> 7, row = (id >> 1) & 63, tq = id & 1; \
                ssq[((tf + 64 * sf + row) * 4 + h) * 16 + vs * 2 + tq] = SQL[id]; } \
            __syncthreads(); } } while (0)
    StepOps r0, r1, r2, r3;
    GLA_LOAD(r0, 0); GLA_LOAD(r1, 1); GLA_LOAD(r2, 2);
    __syncthreads();
    for (int n4 = 0; n4 < 32; n4 += 4) {
        GLA_LOAD(r3, n4 + 3); GLA_STEP(r0, n4);
        GLA_LOAD(r0, n4 + 4); GLA_STEP(r1, n4 + 1);
        GLA_LOAD(r1, n4 + 5); GLA_STEP(r2, n4 + 2);
        GLA_LOAD(r2, n4 + 6); GLA_STEP(r3, n4 + 3);
    }
#undef GLA_STEP
#undef GLA_LOAD
}

__device__ __forceinline__ void merge_phase(const bf16_t* atto, const float* lse, const bf16_t* ob, const float* ssq, const bf16_t* proj, const float* gla_gain, bf16_t* ya, bf16_t* yb,
                                            int vcu, int G, int wave, int lane) {
    const int gw = vcu * NWAVES + wave, NGW = G * NWAVES;
    const int hj = lane >> 4;
    f32x4 g0[2], g1[2];
#pragma unroll
    for (int c = 0; c < 2; ++c) { const int col = 8 * lane + 512 * c; g0[c] = *(const f32x4*)(gla_gain + col); g1[c] = *(const f32x4*)(gla_gain + col + 4); }
    for (int row0 = 2 * gw; row0 < T; row0 += 2 * NGW) {
        float l0[2], l1[2], l2[2]; u32x4 a0[2], a1[2], a2[2], o[2][2], rr_[2][2]; f32x4 sq[2][2][4];
#pragma unroll
        for (int r = 0; r < 2; ++r) { const int row = row0 + r;
            l0[r] = lse[((size_t)0 * T + row) * 4 + hj]; l1[r] = lse[((size_t)1 * T + row) * 4 + hj]; l2[r] = lse[((size_t)2 * T + row) * 4 + hj];
            a0[r] = *(const u32x4*)(atto + ((size_t)0 * T + row) * 512 + 8 * lane); a1[r] = *(const u32x4*)(atto + ((size_t)1 * T + row) * 512 + 8 * lane); a2[r] = *(const u32x4*)(atto + ((size_t)2 * T + row) * 512 + 8 * lane);
#pragma unroll
            for (int c = 0; c < 2; ++c) { const int col = 8 * lane + 512 * c, hh = col >> 8;
                const f32x4* sp = (const f32x4*)(ssq + ((size_t)row * 4 + hh) * 16); sq[r][c][0] = sp[0]; sq[r][c][1] = sp[1]; sq[r][c][2] = sp[2]; sq[r][c][3] = sp[3];
                o[r][c] = *(const u32x4*)(ob + (size_t)row * 1024 + col);
#if GATE_F8
                { const u32x2 r8 = *(const u32x2*)((const unsigned char*)proj + (size_t)row * NP * 2 + G8_BYTE0 + col); rr_[r][c] = (u32x4){r8.x, r8.y, 0u, 0u}; }
#else
                rr_[r][c] = *(const u32x4*)(proj + (size_t)row * NP + RB + col);
#endif
            } }
#pragma unroll
        for (int r = 0; r < 2; ++r) { const int row = row0 + r;
            const float m = fmaxf(l0[r], fmaxf(l1[r], l2[r])); float e0 = __expf(l0[r] - m), e1 = __expf(l1[r] - m), e2 = __expf(l2[r] - m); const float inv = 1.0f / (e0 + e1 + e2); e0 *= inv; e1 *= inv; e2 *= inv;
            u32x4 w;
            w.x = pk2(e0 * bflo(a0[r].x) + e1 * bflo(a1[r].x) + e2 * bflo(a2[r].x), e0 * bfhi(a0[r].x) + e1 * bfhi(a1[r].x) + e2 * bfhi(a2[r].x));
            w.y = pk2(e0 * bflo(a0[r].y) + e1 * bflo(a1[r].y) + e2 * bflo(a2[r].y), e0 * bfhi(a0[r].y) + e1 * bfhi(a1[r].y) + e2 * bfhi(a2[r].y));
            w.z = pk2(e0 * bflo(a0[r].z) + e1 * bflo(a1[r].z) + e2 * bflo(a2[r].z), e0 * bfhi(a0[r].z) + e1 * bfhi(a1[r].z) + e2 * bfhi(a2[r].z));
            w.w = pk2(e0 * bflo(a0[r].w) + e1 * bflo(a1[r].w) + e2 * bflo(a2[r].w), e0 * bfhi(a0[r].w) + e1 * bfhi(a1[r].w) + e2 * bfhi(a2[r].w));
#if MIX_F8
            { u32x2 w8; w8.x = pk_fp8x4(bflo(w.x), bfhi(w.x), bflo(w.y), bfhi(w.y)); w8.y = pk_fp8x4(bflo(w.z), bfhi(w.z), bflo(w.w), bfhi(w.w)); *(u32x2*)((unsigned char*)ya + (BR_FUSE ? (size_t)row * 1536 + 1024 : (size_t)row * 512) + 8 * lane) = w8; }
#else
            *(u32x4*)(ya + (size_t)row * 512 + 8 * lane) = w;
#endif
#pragma unroll
            for (int c = 0; c < 2; ++c) { const int col = 8 * lane + 512 * c;
                const f32x4 s0 = sq[r][c][0], s1 = sq[r][c][1], s2 = sq[r][c][2], s3 = sq[r][c][3];
                const float tot = ((s0[0] + s0[1]) + (s0[2] + s0[3])) + ((s1[0] + s1[1]) + (s1[2] + s1[3])) + ((s2[0] + s2[1]) + (s2[2] + s2[3])) + ((s3[0] + s3[1]) + (s3[2] + s3[3]));
                const float rstd = 1.0f / sqrtf(tot * (1.0f / 256.0f) + NORM_EPS);
                const u32x4 ov = o[r][c], rv = rr_[r][c]; u32x4 y; float rf[8];
#if GATE_F8
                unpack_fp8x8((u32x2){rv.x, rv.y}, rf);
#else
                rf[0] = bflo(rv.x); rf[1] = bfhi(rv.x); rf[2] = bflo(rv.y); rf[3] = bfhi(rv.y); rf[4] = bflo(rv.z); rf[5] = bfhi(rv.z); rf[6] = bflo(rv.w); rf[7] = bfhi(rv.w);
#endif
                y.x = pk2(bflo(ov.x) * rstd * g0[c][0] * siluf_(rf[0]), bfhi(ov.x) * rstd * g0[c][1] * siluf_(rf[1]));
                y.y = pk2(bflo(ov.y) * rstd * g0[c][2] * siluf_(rf[2]), bfhi(ov.y) * rstd * g0[c][3] * siluf_(rf[3]));
                y.z = pk2(bflo(ov.z) * rstd * g1[c][0] * siluf_(rf[4]), bfhi(ov.z) * rstd * g1[c][1] * siluf_(rf[5]));
                y.w = pk2(bflo(ov.w) * rstd * g1[c][2] * siluf_(rf[6]), bfhi(ov.w) * rstd * g1[c][3] * siluf_(rf[7]));
#if MIX_F8
                { u32x2 y8; y8.x = pk_fp8x4(bflo(y.x), bfhi(y.x), bflo(y.y), bfhi(y.y)); y8.y = pk_fp8x4(bflo(y.z), bfhi(y.z), bflo(y.w), bfhi(y.w)); *(u32x2*)((unsigned char*)(BR_FUSE ? ya : yb) + (size_t)row * (BR_FUSE ? 1536 : 1024) + col) = y8; }
#else
                *(u32x4*)(yb + (size_t)row * 1024 + col) = y;
#endif
            } }
    }
}

constexpr int LS = 10;
__host__ __device__ constexpr int phase_kind(int k) { return k == 0 ? 0 : (k == 1 + DEPTH * LS ? LS + 1 : ((k - 1) % LS) + 1); }
constexpr int N_PHASES = 2 + DEPTH * LS;
typedef const __attribute__((address_space(4))) Args CArgs;
__device__ __forceinline__ CArgs* fresh_args() {
    unsigned long long v = (unsigned long long)__builtin_amdgcn_kernarg_segment_ptr();
    unsigned lo = (unsigned)v, hi = (unsigned)(v >> 32);
    asm volatile("" : "+s"(lo), "+s"(hi));
    lo = __builtin_amdgcn_readfirstlane(lo); hi = __builtin_amdgcn_readfirstlane(hi);
    return (CArgs*)(((unsigned long long)hi << 32) | lo);
}
template <unsigned MASK, bool ONE>
__global__ void __launch_bounds__(NTHREADS, 2) fwd_kernel(Args a_unused) {
    extern __shared__ __attribute__((aligned(16))) unsigned char lds_raw[];
    LAS unsigned char* lds = (LAS unsigned char*)lds_raw;
    const int wave0 = __builtin_amdgcn_readfirstlane((int)threadIdx.x >> 6);
    int lane = (int)__builtin_amdgcn_mbcnt_hi(~0u, __builtin_amdgcn_mbcnt_lo(~0u, 0u)), wave = wave0, tid = wave0 * 64 + lane;
    CArgs* ap = fresh_args();
    unsigned char* ws = ap->ws;
#define a (*ap)
#define FRESH_TID() do { ap = fresh_args(); ws = ap->ws; unsigned m1_ = ~0u; asm volatile("" : "+s"(m1_)); lane = (int)__builtin_amdgcn_mbcnt_hi(m1_, __builtin_amdgcn_mbcnt_lo(m1_, 0u)); asm volatile("" : "+v"(lane)); wave = wave0; tid = wave0 * 64 + lane; } while (0)
    const int G = gridDim.x; const int bx = blockIdx.x; const int vcu = (G % 8 == 0) ? (bx % 8) * (G / 8) + bx / 8 : bx;
    volatile LAS unsigned* MISC = (volatile LAS unsigned*)(lds + MISC_OFF);
    for (int u = tid; u < (LDS_BYTES - MISC_OFF) / 4; u += NTHREADS) ((LAS unsigned*)(lds + MISC_OFF))[u] = 0u;
    __syncthreads();
    if (ONE) (void)xcd_barrier_post((unsigned*)(ws + WS_CTL) + CW_BAR, MISC + 8);
    const int lo = ONE ? 0 : a.ph_lo, hi = ONE ? N_PHASES : a.ph_hi;
#define IN(k, kind) (((MASK >> (kind)) & 1u) && (ONE || (lo <= (k) && (k) < hi)))
#if defined(PROBE_EPI) && !defined(PROBE_MASK)
#endif
#ifdef PROBE_MASK
#define PB_ON(k) ((PROBE_MASK >> phase_kind(k)) & 1u)
#define PB_START(k) do { if (PB_ON(k) && threadIdx.x == 0) *(volatile LAS unsigned long long*)(lds + MISC_OFF + 8192) = __builtin_amdgcn_s_memrealtime(); } while (0)
#define PB_END(k) do { if (PB_ON(k) && threadIdx.x == 0) { volatile LAS unsigned long long* pb_ = (volatile LAS unsigned long long*)(lds + MISC_OFF + 8192); pb_[1] = pb_[1] + (__builtin_amdgcn_s_memrealtime() - pb_[0]); } } while (0)
#else
#define PB_START(k) do { } while (0)
#define PB_END(k) do { } while (0)
#endif
#define SEAM(k) do { if (ONE) { XcdBarrier bar_; bar_.bar = (unsigned*)(((CArgs*)fresh_args())->ws + WS_CTL) + CW_BAR; bar_.x = xb_xcc_id(); bar_.st = (volatile LAS unsigned*)(lds + MISC_OFF) + 8; xcd_barrier(bar_); } } while (0)

#define ada ((float*)(ws + WS_ADA))
#define ropec ((const float*)(ws + WS_ROPE))
#define ropes (((const float*)(ws + WS_ROPE)) + SEQ * 64)
#define alow ((float*)(ws + WS_ALOW))
#define lse ((float*)(ws + WS_LSE))
#define ssq ((float*)(ws + WS_SSQ))
#define rlist ((int*)(ws + WS_RLIST))
#define tslot ((int*)(ws + WS_TSLOT))
#define tw ((float*)(ws + WS_TW))
#define hbuf ((bf16_t*)(ws + WS_H))
#define ya ((bf16_t*)(ws + WS_YA))
#define yb ((bf16_t*)(ws + WS_YB))
#define mrg ((bf16_t*)(ws + WS_MRG))
#define atto ((bf16_t*)(ws + WS_ATTO))
#define obuf ((bf16_t*)(ws + WS_OB))
#define proj ((bf16_t*)(ws + WS_PROJ))
#define act ((bf16_t*)(ws + WS_ACT))
#define Y ((bf16_t*)(ws + WS_Y))
#define ctl ((unsigned*)(ws + WS_CTL))
#define xb_ ((bf16_t*)(ws + WS_XB))
#define qdb_ ((bf16_t*)(ws + WS_QD))
#define oib_ ((bf16_t*)(ws + WS_OI))
#define dstb_ ((bf16_t*)(ws + WS_DST))
#define decb_ ((float*)(ws + WS_DEC))

    PB_START(0);
    if (IN(0, 0)) { FRESH_TID(); prologue_phase(ap, lds, vcu, G, tid, wave, lane); }
#ifdef PROBE_DUP_PRO
    __syncthreads(); if (IN(0, 0)) { FRESH_TID(); prologue_phase(ap, lds, vcu, G, tid, wave, lane, PROBE_DUP_PRO); }
#endif
    SEAM(0); PB_END(0);

    for (int l = 0; l < DEPTH; ++l) {
        const int P = 1 + LS * l;
#define adal (ada + (size_t)l * NB * 12288)
#define cntl (ctl + CW_CNT + l * 1024)
#define cntp (ctl + CW_CNT + (l > 0 ? (l - 1) * 1024 : 0))
#define xsrc ((l == 0) ? a.x : a.out)
        PB_START(P);
        if (IN(P, 1)) { FRESH_TID();
            if (l == 0) norm_phase<0>(xsrc, nullptr, hbuf, a.norm_mix, adal + 2048, adal, nullptr, nullptr, nullptr, nullptr, nullptr, vcu, G, wave, lane);
            else norm_phase<1>(xb_, xb_, hbuf, a.norm_mix + (size_t)l * D, adal + 2048, adal, ada + (size_t)(l - 1) * NB * 12288 + 10240, Y, tslot, tw, cntp, vcu, G, wave, lane);
        }
        SEAM(P); PB_END(P); PB_START(P + 1);
        if (IN(P + 1, 2)) { FRESH_TID();
#if PROJ_F8
            pg8::StaticOrderP S{T / 256, NP / 256, G, bx}; pg8::RowsContig AM; pg8::EpiProj E{proj, ropec, ropes, alow, pg8::W8_INV};
            pg8::gemm_phase<pg8::EpiProj, pg8::StaticOrderP, pg8::RowsContig, true, true>(lds, tid, hbuf, (const bf16_t*)(ws + WS_WIN + (size_t)l * NP * D), 0, D / 2, S, AM, E);
#else
            pg8::StaticOrderP S{T / 256, NP / 256, G, bx}; pg8::RowsContig AM; pg8::EpiProj E{proj, ropec, ropes, alow, 1.0f};
            pg8::gemm_phase<pg8::EpiProj, pg8::StaticOrderP, pg8::RowsContig, true>(lds, tid, hbuf, (const bf16_t*)(ws + WS_WIN) + (size_t)l * NP * D, 0, D, S, AM, E);
#endif
        }
        SEAM(P + 1); PB_END(P + 1); PB_START(P + 2);
        if (IN(P + 2, 3)) { FRESH_TID();
            {
                const int hw = (vcu >> 5) & 3, dw = tid & 127; float w2[16];
#pragma unroll
                for (int r = 0; r < 16; ++r) w2[r] = (a.w_alpha2 + (size_t)l * 16 * 512)[r * 512 + hw * 128 + dw];
                const float bias = (a.b_alpha2 + (size_t)l * 512)[hw * 128 + dw];
                for (int u = vcu; u < NB * 4 * 32; u += G) { GlaPre R; gla_local_issue(R, proj, alow, u, tid);
                    gla_local_unit(lds, R, proj, alow, w2, bias, qdb_, oib_, dstb_, decb_, u, -1, tid, wave, lane); } }
            FRESH_TID();
            for (int u = vcu; u < NB * 12 * 16; u += G) { AttnPre R; attn_issue(R, proj, u, tid, wave, lane); attn_unit(lds, R, proj, atto, lse, u, -1, tid, wave, lane); }
#ifdef PROBE_DUP_ATTN
            for (int u = vcu; u < NB * 12 * 16; u += G) { AttnPre R; attn_issue(R, proj, u, tid, wave, lane); attn_unit(lds, R, proj, atto, lse, u, -1, tid, wave, lane); }
#endif
        }
        SEAM(P + 2); PB_END(P + 2); PB_START(P + 3);
        if (IN(P + 3, 4)) { FRESH_TID();
            for (int u = vcu; u < 256; u += G) gla_scan_unit<false>(lds, qdb_, oib_, dstb_, decb_, obuf, ssq, u, tid, wave, lane);
#ifdef PROBE_FAKESCAN
            __syncthreads(); for (int u = vcu; u < 256; u += G) gla_scan_unit<true>(lds, qdb_, oib_, dstb_, decb_, obuf, ssq, u, tid, wave, lane);
#endif
        }
        SEAM(P + 3); PB_END(P + 3); PB_START(P + 4);
        if (IN(P + 4, 5)) { FRESH_TID(); merge_phase(atto, lse, obuf, ssq, proj, a.gla_gain + (size_t)l * 1024, ya, yb, vcu, G, wave, lane); }
        SEAM(P + 4); PB_END(P + 4); PB_START(P + 5);
        if (IN(P + 5, 6)) { FRESH_TID();
#if BR_FUSE
            { pg8::SegOrder S2{T / 256, D / 256, G, bx}; pg8::RowsContig AM2; pg8::EpiGate2 E{proj, pg8::W8_INV, ws + WS_MRG8};
              pg8::gemm_phase<pg8::EpiGate2, pg8::SegOrder, pg8::RowsContig, true, true, true>(lds, tid, ya, (const bf16_t*)(ws + WS_WOA + (size_t)l * D * 1536), 0, 768, S2, AM2, E); }
#else
            pg8::StaticOrder S{T / 256, D / 256, G, bx}; pg8::RowsContig AM;
#if MIX_F8
            { pg8::EpiGate<true> E{mrg, proj, GA, pg8::W8_INV, nullptr}; pg8::gemm_phase<pg8::EpiGate<true>, pg8::StaticOrder, pg8::RowsContig, true, true>(lds, tid, ya, (const bf16_t*)(ws + WS_WOA + (size_t)l * D * 512), 0, 256, S, AM, E); }
#else
            { pg8::EpiGate<true> E{mrg, proj, GA, 1.0f, nullptr}; pg8::gemm_phase<pg8::EpiGate<true>, pg8::StaticOrder, pg8::RowsContig, true>(lds, tid, ya, (const bf16_t*)(ws + WS_WOA) + (size_t)l * D * 512, 0, 512, S, AM, E); }
#endif
            FRESH_TID();
#if MIX_F8
            { pg8::EpiGate<false> E{mrg, proj, GB, pg8::W8_INV, ws + WS_MRG8}; pg8::gemm_phase<pg8::EpiGate<false>, pg8::StaticOrder, pg8::RowsContig, true, true>(lds, tid, yb, (const bf16_t*)(ws + WS_WOB + (size_t)l * D * 1024), 0, 512, S, AM, E); }
#else
            { pg8::EpiGate<false> E{mrg, proj, GB, 1.0f, nullptr}; pg8::gemm_phase<pg8::EpiGate<false>, pg8::StaticOrder, pg8::RowsContig, true>(lds, tid, yb, (const bf16_t*)(ws + WS_WOB) + (size_t)l * D * 1024, 0, 1024, S, AM, E); }
#endif
#endif
        }
        SEAM(P + 5); PB_END(P + 5); PB_START(P + 6);
        if (IN(P + 6, 7)) { FRESH_TID();
            pg8::StaticOrder S{T / 256, D / 256, G, bx}; pg8::RowsContig AM;
#if MIX_F8
            if (l == 0) { pg8::EpiResid<true> E{a.x, xb_, adal + 4096, pg8::W8_INV}; pg8::gemm_phase<pg8::EpiResid<true>, pg8::StaticOrder, pg8::RowsContig, true, true>(lds, tid, (const bf16_t*)(ws + WS_MRG8), (const bf16_t*)(ws + WS_WO + (size_t)l * D * D), 0, D / 2, S, AM, E); }
            else { pg8::EpiResid<false> E{xb_, xb_, adal + 4096, pg8::W8_INV}; pg8::gemm_phase<pg8::EpiResid<false>, pg8::StaticOrder, pg8::RowsContig, true, true>(lds, tid, (const bf16_t*)(ws + WS_MRG8), (const bf16_t*)(ws + WS_WO + (size_t)l * D * D), 0, D / 2, S, AM, E); }
#else
            if (l == 0) { pg8::EpiResid<true> E{a.x, xb_, adal + 4096, 1.0f}; pg8::gemm_phase<pg8::EpiResid<true>, pg8::StaticOrder, pg8::RowsContig, true>(lds, tid, mrg, (const bf16_t*)(ws + WS_WO) + (size_t)l * D * D, 0, D, S, AM, E); }
            else { pg8::EpiResid<false> E{xb_, xb_, adal + 4096, 1.0f}; pg8::gemm_phase<pg8::EpiResid<false>, pg8::StaticOrder, pg8::RowsContig, true>(lds, tid, mrg, (const bf16_t*)(ws + WS_WO) + (size_t)l * D * D, 0, D, S, AM, E); }
#endif
        }
        SEAM(P + 6); PB_END(P + 6); PB_START(P + 7);
        if (IN(P + 7, 8)) { FRESH_TID(); router_phase(xb_, hbuf, a.norm_ffn + (size_t)l * D, adal + 8192, adal + 6144, a.w_router, a.b_router, cntl, rlist, tslot, tw, lds, vcu, G, tid, wave, lane); }
        SEAM(P + 7); PB_END(P + 7); PB_START(P + 8);
        if (IN(P + 8, 9)) { FRESH_TID();
            pg8::moe_table_build(lds, cntl, tid);
            pg8::MoeOrder S; S.init(lds, 8, G, bx); pg8::RowsGather AM{rlist, lds}; pg8::EpiSwiGLU8 E{(unsigned char*)act};
            pg8::gemm_phase<pg8::EpiSwiGLU8, pg8::MoeOrder, pg8::RowsGather, true, true>(lds, tid, hbuf, (const bf16_t*)(ws + WS_WGU + (size_t)l * NE * 2048 * D), (size_t)2048 * D / 2, D / 2, S, AM, E);
        }
        SEAM(P + 8); PB_END(P + 8); PB_START(P + 9);
        if (IN(P + 9, 10)) { FRESH_TID();
            pg8::moe_table_build(lds, cntl, tid);
            pg8::MoeOrder S; S.init(lds, 8, G, bx); pg8::RowsContig AM; pg8::EpiPlainS E{Y, pg8::W8_INV};
            pg8::gemm_phase<pg8::EpiPlainS, pg8::MoeOrder, pg8::RowsContig, true, true>(lds, tid, act, (const bf16_t*)(ws + WS_WDN + (size_t)l * NE * D * FF), (size_t)D * FF / 2, FF / 2, S, AM, E);
        }
        SEAM(P + 9); PB_END(P + 9);
    }
    PB_START(1 + DEPTH * LS);
    if (IN(1 + DEPTH * LS, LS + 1)) { FRESH_TID(); norm_phase<2>(xb_, a.out, nullptr, a.final_norm, nullptr, nullptr, ada + (size_t)(DEPTH - 1) * NB * 12288 + 10240, Y, tslot, tw, ctl + CW_CNT + (DEPTH - 1) * 1024, vcu, G, wave, lane); }
#ifdef PROBE_MASK
    __syncthreads(); PB_END(1 + DEPTH * LS);
    if (threadIdx.x == 0) { const unsigned long long t0_ = __builtin_amdgcn_s_memrealtime(), d_ = ((volatile LAS unsigned long long*)(lds + MISC_OFF + 8192))[1];
        while (__builtin_amdgcn_s_memrealtime() - t0_ < d_) __builtin_amdgcn_s_sleep(8); }
    __syncthreads();
#endif
#undef a
#undef IN
#undef SEAM
}

template <unsigned MASK, bool ONE>
static void launch_one(const Args& a, int grid, hipStream_t stream) {
    static bool attr_done = false;
    if (!attr_done) { (void)hipFuncSetAttribute((const void*)fwd_kernel<MASK, ONE>, hipFuncAttributeMaxDynamicSharedMemorySize, LDS_BYTES); attr_done = true; }
    hipLaunchKernelGGL((fwd_kernel<MASK, ONE>), dim3(grid), dim3(NTHREADS), LDS_BYTES, stream, a);
}
extern "C" void kernel_launch(void* const* d_in, const int* in_sizes, int n_in, void* d_out, int out_size, void* d_ws, size_t ws_size, hipStream_t stream) {
    static int grid = 0;
    if (grid == 0) {
        if (n_in != 19 || out_size != T * D || ws_size < WS_END) { fprintf(stderr, "kernel_launch: unexpected shapes (n_in %d, out %d, ws %zu < %zu); nothing launched\n", n_in, out_size, ws_size, (size_t)WS_END); grid = -1; return; }
        int dev = 0, cus = 0;
        if (hipGetDevice(&dev) != hipSuccess || hipDeviceGetAttribute(&cus, hipDeviceAttributeMultiprocessorCount, dev) != hipSuccess) { grid = -1; return; }
        grid = cus;
        if (grid != 256) fprintf(stderr, "kernel_launch: note: %d CUs (built for 256)\n", grid);
    }
    if (grid < 0) return;
    (void)hipMemsetAsync((char*)d_ws + WS_CTL, 0, CTL_ZERO_BYTES, stream);
    Args a{};
    a.x = (const float*)d_in[0]; a.c = (const float*)d_in[1]; a.w_ada = (const float*)d_in[2]; a.b_ada = (const float*)d_in[3]; a.norm_mix = (const float*)d_in[4]; a.norm_ffn = (const float*)d_in[5];
    a.w_in = (const float*)d_in[6]; a.w_alpha2 = (const float*)d_in[7]; a.b_alpha2 = (const float*)d_in[8]; a.gla_gain = (const float*)d_in[9]; a.w_out_a = (const float*)d_in[10];
    a.w_out_b = (const float*)d_in[11]; a.w_out = (const float*)d_in[12]; a.w_router = (const float*)d_in[13]; a.b_router = (const float*)d_in[14]; a.w_gate_e = (const float*)d_in[15];
    a.w_up_e = (const float*)d_in[16]; a.w_down_e = (const float*)d_in[17]; a.final_norm = (const float*)d_in[18];
    a.out = (float*)d_out; a.ws = (unsigned char*)d_ws;
#if MK_PER_PHASE
    for (int p = 0; p < N_PHASES; ++p) { a.ph_lo = p; a.ph_hi = p + 1;
        const int kind = phase_kind(p);
        switch (kind) {
            case 0: launch_one<1u << 0, false>(a, grid, stream); break; case 1: launch_one<1u << 1, false>(a, grid, stream); break;
            case 2: launch_one<1u << 2, false>(a, grid, stream); break; case 3: launch_one<1u << 3, false>(a, grid, stream); break;
            case 4: launch_one<1u << 4, false>(a, grid, stream); break; case 5: launch_one<1u << 5, false>(a, grid, stream); break;
            case 6: launch_one<1u << 6, false>(a, grid, stream); break; case 7: launch_one<1u << 7, false>(a, grid, stream); break;
            case 8: launch_one<1u << 8, false>(a, grid, stream); break; case 9: launch_one<1u << 9, false>(a, grid, stream); break;
            case 10: launch_one<1u << 10, false>(a, grid, stream); break;
            default: launch_one<1u << 11, false>(a, grid, stream); break; } }
#else
    a.ph_lo = 0; a.ph_hi = N_PHASES; launch_one<0xFFFFFu, true>(a, grid, stream);
#endif
    const hipError_t le = hipPeekAtLastError();
    if (le != hipSuccess) fprintf(stderr, "kernel_launch: launch failed: %s\n", hipGetErrorName(le));
}
```

```cpp
#include <hip/hip_runtime.h>
#include <cstdio>
#include <cstdint>

#ifndef PROJ_F8
#define PROJ_F8 1
#endif
#ifndef MIX_F8
#define MIX_F8 1
#endif
#ifndef GATE_F8
#define GATE_F8 1
#endif
#ifndef Y_F8
#define Y_F8 1
#endif
#ifndef BR_FUSE
#define BR_FUSE 1
#endif
#ifndef MK_PER_PHASE
#define MK_PER_PHASE 0
#endif

#define LAS __attribute__((address_space(3)))
#define GAS __attribute__((address_space(1)))
typedef unsigned short bf16_t;
typedef short bf16x8 __attribute__((ext_vector_type(8)));
typedef short s16x4 __attribute__((ext_vector_type(4)));
typedef float f32x4 __attribute__((ext_vector_type(4)));
typedef float f32x2 __attribute__((ext_vector_type(2)));
typedef unsigned u32x4 __attribute__((ext_vector_type(4)));
typedef unsigned u32x2 __attribute__((ext_vector_type(2)));
typedef GAS unsigned gu32;

constexpr int NB = 8, SEQ = 2048, T = NB * SEQ, D = 2048, DEPTH = 2;
constexpr int NIN = 11792;
constexpr int NP = 12032;
constexpr int QA = 0, KA = 1536, VA = 3072, QB = 4608, KB = 5120, VB = 5632, RB = 6656, GA = 7680, GB = 9728, AL = 11776;
constexpr int NE = 16, FF = 1024;
constexpr int MAXTILES = 144, MAXROWS = MAXTILES * 256;
constexpr float NORM_EPS = 1e-6f;
constexpr int NWAVES = 8, NTHREADS = 512;

constexpr size_t MiB = 1u << 20;
constexpr size_t WS_CTL = 0, CTL_ZERO_BYTES = 80 * 1024;
constexpr size_t WS_ADA = 1 * MiB;
constexpr size_t WS_ROPE = 2 * MiB;
constexpr size_t WS_ALOW = 3 * MiB;
constexpr size_t WS_LSE = 4 * MiB;
constexpr size_t WS_SSQ = 5 * MiB;
constexpr size_t WS_RLIST = 9 * MiB;
constexpr size_t WS_TSLOT = 10 * MiB;
constexpr size_t WS_TW = 10 * MiB + 512 * 1024;
constexpr size_t WS_WIN = 12 * MiB;
constexpr size_t WS_MRG8 = 60 * MiB;
constexpr size_t WS_WOA = 106 * MiB;
constexpr size_t WS_WOB = 110 * MiB;
constexpr size_t WS_WO = 118 * MiB;
constexpr size_t WS_WGU = 134 * MiB;
constexpr size_t WS_XB = 262 * MiB;
constexpr size_t WS_WDN = 390 * MiB;
constexpr size_t WS_H = 518 * MiB;
constexpr size_t WS_YA = 582 * MiB;
constexpr size_t WS_YB = 598 * MiB;
constexpr size_t WS_MRG = 630 * MiB;
constexpr size_t WS_ATTO = 694 * MiB;
constexpr size_t WS_OB = 742 * MiB;
constexpr size_t WS_PROJ = 774 * MiB;
constexpr size_t WS_ACT = WS_PROJ;
constexpr size_t WS_Y = WS_PROJ + 72 * MiB;
constexpr size_t WS_QD = 1150 * MiB;
constexpr size_t WS_OI = 1166 * MiB;
constexpr size_t WS_DST = 1198 * MiB;
constexpr size_t WS_DEC = 1262 * MiB;
constexpr size_t WS_END = 1263 * MiB;
constexpr int CW_BAR = 4096;
constexpr int CW_CNT = 16384;

constexpr int RING_BYTES = 131072;
constexpr int MISC_OFF = 135168;
constexpr int LDS_BYTES = 151552;

#define LDS_WAIT() asm volatile("s_waitcnt lgkmcnt(0)" ::: "memory")
#define VM_WAIT() asm volatile("s_waitcnt vmcnt(0)" ::: "memory")
#define RLX_AGENT __ATOMIC_RELAXED, __HIP_MEMORY_SCOPE_AGENT
__device__ __forceinline__ unsigned f2bf(float f) { unsigned u = __builtin_bit_cast(unsigned, f); return (u + 0x7fffu + ((u >> 16) & 1u)) >> 16; }
typedef float f32x2_t __attribute__((ext_vector_type(2)));
typedef __bf16 bf16x2_t __attribute__((ext_vector_type(2)));
__device__ __forceinline__ unsigned pk2(float lo, float hi) { const f32x2_t v = {lo, hi}; const bf16x2_t b = __builtin_convertvector(v, bf16x2_t); return __builtin_bit_cast(unsigned, b); }
__device__ __forceinline__ float sat8(float x) { return __builtin_amdgcn_fmed3f(x, -448.0f, 448.0f); }
__device__ __forceinline__ unsigned pk_fp8x4(float a, float b, float c, float d) { int p = __builtin_amdgcn_cvt_pk_fp8_f32(sat8(a), sat8(b), 0, false); p = __builtin_amdgcn_cvt_pk_fp8_f32(sat8(c), sat8(d), p, true); return (unsigned)p; }
constexpr int G8_BYTE0 = RB * 2;
__device__ __forceinline__ void unpack_fp8x8(u32x2 v, float (&f)[8]) { const f32x2_t a = __builtin_amdgcn_cvt_pk_f32_fp8((int)v.x, false), b = __builtin_amdgcn_cvt_pk_f32_fp8((int)v.x, true), c = __builtin_amdgcn_cvt_pk_f32_fp8((int)v.y, false), d = __builtin_amdgcn_cvt_pk_f32_fp8((int)v.y, true);
    f[0] = a[0]; f[1] = a[1]; f[2] = b[0]; f[3] = b[1]; f[4] = c[0]; f[5] = c[1]; f[6] = d[0]; f[7] = d[1]; }
__device__ __forceinline__ unsigned pk_fp8x4_ns(float a, float b, float c, float d) { int p = __builtin_amdgcn_cvt_pk_fp8_f32(a, b, 0, false); p = __builtin_amdgcn_cvt_pk_fp8_f32(c, d, p, true); return (unsigned)p; }
__device__ __forceinline__ float bflo(unsigned u) { return __builtin_bit_cast(float, u << 16); }
__device__ __forceinline__ float bfhi(unsigned u) { return __builtin_bit_cast(float, u & 0xffff0000u); }
__device__ __forceinline__ float bf2f(bf16_t h) { return __builtin_bit_cast(float, (unsigned)h << 16); }
template <int M> __device__ __forceinline__ float sx(float v, int lane) {
    if constexpr (M < 32) return __builtin_bit_cast(float, __builtin_amdgcn_ds_swizzle(__builtin_bit_cast(int, v), (M << 10) | 0x1F));
    else return __builtin_bit_cast(float, __builtin_amdgcn_ds_bpermute((lane ^ 32) << 2, __builtin_bit_cast(int, v)));
}
__device__ __forceinline__ float wave_sum(float v, int lane) {
    v += sx<1>(v, lane); v += sx<2>(v, lane); v += sx<4>(v, lane); v += sx<8>(v, lane); v += sx<16>(v, lane); v += sx<32>(v, lane);
    return v;
}
__device__ __forceinline__ float sigmoidf_(float x) { return __builtin_amdgcn_rcpf(1.0f + __expf(-x)); }
__device__ __forceinline__ float siluf_(float x) { return x * __builtin_amdgcn_rcpf(1.0f + __expf(-x)); }

#define XB_TMO      128
#define XB_XCNT(j)  (256  + 64 * (j))
#define XB_XSUB(j)  (1280 + 64 * (j))
#define XB_XGEN(j)  (2304 + 64 * (j))
#define XB_TOP      3328
#define XB_TOPGEN   3392
#define XCD_BAR_WORDS 3456
#define XB_SPIN_CAP (1u << 18)
__device__ __forceinline__ unsigned xb_ld(unsigned* p)              { return __hip_atomic_load(p, __ATOMIC_RELAXED, __HIP_MEMORY_SCOPE_AGENT); }
__device__ __forceinline__ unsigned xb_add(unsigned* p, unsigned v) { return __hip_atomic_fetch_add(p, v, __ATOMIC_RELAXED, __HIP_MEMORY_SCOPE_AGENT); }
__device__ __forceinline__ unsigned xb_xcc_id() { return (unsigned)__builtin_amdgcn_s_getreg((3 << 11) | 20) & 0xFu; }
#define XB_SPIN(cond, bar) do { unsigned _sp = 0; while (cond) { __builtin_amdgcn_s_sleep(1); \
    if ((++_sp & 255u) == 0u) { if (xb_ld(&(bar)[XB_TMO])) break; if (_sp > XB_SPIN_CAP) { atomicAdd(&(bar)[XB_TMO], 1u); break; } } } } while (0)
struct XcdBarrier { unsigned* bar; unsigned x; volatile LAS unsigned* st; };
__device__ __forceinline__ XcdBarrier xcd_barrier_post(unsigned* bar, volatile LAS unsigned* st) {
    XcdBarrier b; b.bar = bar; b.x = xb_xcc_id(); b.st = st;
    if (threadIdx.x == 0) (void)xb_add(&bar[XB_XCNT(b.x)], 1u);
    return b;
}
__device__ __forceinline__ void xcd_barrier_complete(unsigned* bar, unsigned x, unsigned& nloc, unsigned& nx) {
    const unsigned G = gridDim.x * gridDim.y * gridDim.z;
    unsigned sum, cnt, mine, sp = 0u;
    for (;;) {
        sum = 0u; cnt = 0u; mine = 0u;
#pragma unroll
        for (unsigned j = 0; j < 16; ++j) { const unsigned c = xb_ld(&bar[XB_XCNT(j)]); sum += c; cnt += (c > 0u) ? 1u : 0u; mine = (j == x) ? c : mine; }
        if (sum == G) break;
        __builtin_amdgcn_s_sleep(1);
        if ((++sp & 255u) == 0u) { if (xb_ld(&bar[XB_TMO])) break; if (sp > XB_SPIN_CAP) { atomicAdd(&bar[XB_TMO], 1u); break; } }
    }
    nloc = mine > 0u ? mine : 1u; nx = cnt > 0u ? cnt : 1u;
}
__device__ __forceinline__ void xcd_barrier(const XcdBarrier& b) {
    asm volatile("s_waitcnt vmcnt(0)" ::: "memory");
    __syncthreads();
    if (threadIdx.x == 0) {
        unsigned* bar = b.bar;
        __builtin_amdgcn_s_waitcnt(0);
        unsigned nloc = b.st[0], nx = b.st[1];
        if (nloc == 0u) { xcd_barrier_complete(bar, b.x, nloc, nx); b.st[0] = nloc; b.st[1] = nx; }
        const unsigned old = xb_add(&bar[XB_XSUB(b.x)], 1u);
        const unsigned gen = old / nloc;
        if (old + 1u == (gen + 1u) * nloc) {
            __builtin_amdgcn_fence(__ATOMIC_RELEASE, "agent");
            asm volatile("s_waitcnt vmcnt(0)" ::: "memory");
            const unsigned og = xb_add(&bar[XB_TOP], 1u);
            const unsigned tg = og / nx;
            if (og + 1u == (tg + 1u) * nx) xb_add(&bar[XB_TOPGEN], 1u);
            else XB_SPIN(xb_ld(&bar[XB_TOPGEN]) == tg, bar);
            __builtin_amdgcn_fence(__ATOMIC_ACQUIRE, "agent");
            xb_add(&bar[XB_XGEN(b.x)], 1u);
            asm volatile("s_waitcnt vmcnt(0)" ::: "memory");
        } else {
            XB_SPIN(xb_ld(&bar[XB_XGEN(b.x)]) == gen, bar);
            __builtin_amdgcn_fence(__ATOMIC_ACQUIRE, "agent");
            asm volatile("s_waitcnt vmcnt(0)" ::: "memory");
        }
    }
    __syncthreads();
}

namespace pg8 {
constexpr int BM = 256, BK = 64, HALF = 128, HTB = HALF * BK * 2, NXCD = 8;
#ifndef WGM_PROJ
#define WGM_PROJ 4
#endif
#ifndef WGM_MIX
#define WGM_MIX 8
#endif
#ifndef WGM_MOE
#define WGM_MOE 4
#endif
__device__ __forceinline__ int lds_byte(int r, int c) { const int st = (r >> 4) * 2 + (c >> 5), rr = r & 15, cc = c & 31, ob = rr * 64 + cc * 2; return st * 1024 + (ob ^ (((ob >> 9) & 1) << 5)); }
__device__ __forceinline__ void stage_rc(int b, int& R, int& C) { const int st = b / 1024, sb = b % 1024, swz = sb ^ (((sb >> 9) & 1) << 5); R = (st >> 1) * 16 + swz / 64; C = (st & 1) * 32 + (swz % 64) / 2; }
__device__ __forceinline__ int perm32(int rho) { const int n = rho >> 4, i = rho & 15; return 8 * (i >> 2) + 4 * n + (i & 3); }

struct Unit { int pm, pn, e, ti; };

template <int WGM, int ROT = 0>
__device__ __forceinline__ bool grid_order(int nM, int nN, int G, int c, int i, int& pm, int& pn) {
    const int nwg = nM * nN; const long L = (long)i * G + c; if (L >= nwg) return false;
    int wgid = (int)L; const int xcd = wgid % NXCD; { const int q = nwg / NXCD, r = nwg % NXCD, off = wgid / NXCD; wgid = (xcd < r ? xcd * (q + 1) : r * (q + 1) + (xcd - r) * q) + off; }
    const int nig = WGM * nN, gid = wgid / nig, fm = gid * WGM, gsz = (nM - fm) < WGM ? (nM - fm) : WGM;
    pm = fm + ((wgid % nig) % gsz); pn = (wgid % nig) / gsz;
    if (ROT != 0 && (nwg % NXCD) == 0 && ((nwg / NXCD) % nig) == 0) pn = (pn + ROT * xcd) % nN;
    return true;
}
template <int WGM, int ROT = 0> struct StaticOrderT {
    int nM, nN, G, c;
    __device__ __forceinline__ bool next(int i, Unit& u) const { u.e = 0; u.ti = 0; return grid_order<WGM, ROT>(nM, nN, G, c, i, u.pm, u.pn); }
};
#ifndef ROT_PROJ
#define ROT_PROJ 6
#endif
#ifndef ROT_MIX
#define ROT_MIX 1
#endif
typedef StaticOrderT<WGM_PROJ, ROT_PROJ> StaticOrderP; typedef StaticOrderT<WGM_MIX, ROT_MIX> StaticOrder;
struct SegOrder {
    int nM, nN, G, c;
    __device__ __forceinline__ bool next(int i, Unit& u) const { u.e = i & 1; u.ti = 0; return grid_order<WGM_MIX, ROT_MIX>(nM, nN, G, c, i >> 1, u.pm, u.pn); }
};
constexpr int MOE_TAB_OFF = MISC_OFF + 4096;
__device__ __forceinline__ void moe_table_build(LAS unsigned char* lds, const unsigned* cnt, int tid) {
    if (tid < NE) { const int n = (int)__hip_atomic_load(cnt + 64 * tid, RLX_AGENT); ((LAS int*)(lds + MOE_TAB_OFF))[16 + tid] = n; }
    __syncthreads();
    if (tid == 0) { int acc = 0; for (int e = 0; e < NE; ++e) { acc += (((LAS int*)(lds + MOE_TAB_OFF))[16 + e] + 255) >> 8; ((LAS int*)(lds + MOE_TAB_OFF))[e] = acc; } }
    __syncthreads();
}
typedef int i32x4 __attribute__((ext_vector_type(4)));
struct MoeOrder {
    LAS unsigned char* lds; int NT, nN, G, c;
    __device__ __forceinline__ void init(LAS unsigned char* lds_, int nN_, int G_, int c_) {
        lds = lds_; NT = __builtin_amdgcn_readfirstlane(((LAS int*)(lds + MOE_TAB_OFF))[15]); nN = nN_; G = G_; c = c_; }
    __device__ __forceinline__ bool next(int i, Unit& u) const {
        if (!grid_order<WGM_MOE>(NT, nN, G, c, i, u.pm, u.pn)) return false;
        int e = 0, ts = 0;
#pragma unroll
        for (int q = 0; q < 4; ++q) { const i32x4 t = ((const LAS i32x4*)(lds + MOE_TAB_OFF))[q];
#pragma unroll
            for (int j = 0; j < 4; ++j) { const bool ge = u.pm >= t[j]; e += ge ? 1 : 0; ts = ge ? t[j] : ts; } }
        u.e = __builtin_amdgcn_readfirstlane(e); u.ti = u.pm - __builtin_amdgcn_readfirstlane(ts); return true;
    }
};
struct RowsContig { static constexpr bool GATHER = false; __device__ __forceinline__ unsigned row(const Unit& u, int rr) const { return (unsigned)(u.pm * 256 + rr); } };
struct RowsGather {
    static constexpr bool GATHER = true;
    const int* rlist; LAS unsigned char* lds;
    __device__ __forceinline__ unsigned row(const Unit& u, int rr) const {
        const int n = ((LAS int*)(lds + MOE_TAB_OFF))[16 + u.e]; const int rank = u.ti * 256 + rr; const bool ok = rank < n;
        return (unsigned)rlist[(size_t)u.e * T + (ok ? rank : 0)];
    }
};

typedef int i32x4v __attribute__((ext_vector_type(4)));
typedef int i32x8 __attribute__((ext_vector_type(8)));
template <class Epi, class Sched, class AMap, bool ALIGN_EPI, bool F8 = false, bool SEG2 = false>
__device__ __forceinline__ void gemm_phase(LAS unsigned char* lds, const int tid, const bf16_t* A, const bf16_t* Bt, size_t bstride, int K, const Sched& S, const AMap& AM, const Epi& E) {
    const int wid = __builtin_amdgcn_readfirstlane(tid >> 6), lane = tid & 63, wr = wid >> 2, wc = wid & 3, fr = lane & 15, fq = lane >> 4;
    const int nt = K / BK;
    unsigned voffA[2], voffB[2];
#pragma unroll
    for (int i = 0; i < 2; ++i) { int R, C; stage_rc(tid * 16 + i * 8192, R, C); const int Rb = Epi::PERM ? ((R & ~31) + perm32(R & 31)) : R; voffA[i] = (unsigned)(R * K + C) * 2u; voffB[i] = (unsigned)(Rb * K + C) * 2u; }
    const unsigned kstep = (unsigned)(BK * 2);
    const unsigned hstep = (unsigned)HALF * (unsigned)K * 2u;
    const unsigned tstep = 2u * hstep;
    const __amdgpu_buffer_rsrc_t rsA = __builtin_amdgcn_make_buffer_rsrc((void*)A, 0, -1, 0x00020000), rsB = __builtin_amdgcn_make_buffer_rsrc((void*)Bt, 0, -1, 0x00020000);
    const unsigned ldsw = (unsigned)wid * 1024u;
    const int aoff = lds_byte(wr * 64 + fr, fq * 8), boff = lds_byte(wc * 32 + fr, fq * 8);
#define PG8_SA(b, h) (((b) * 2 + (h)) * HTB)
#define PG8_SB(b, h) ((4 + (b) * 2 + (h)) * HTB)
#define PG8_STAGE(bufoff, soffB, voff) do { _Pragma("unroll") for (int _i = 0; _i < 2; ++_i) \
        __builtin_amdgcn_raw_ptr_buffer_load_lds(rsB, (LAS unsigned*)(lds + (bufoff) + ldsw + _i * 8192), 16, (int)(voff)[_i], (int)(soffB), 0, 0); } while (0)
#define PG8_LDA(dst, b, h) do { _Pragma("unroll") for (int m = 0; m < 4; ++m) _Pragma("unroll") for (int k = 0; k < 2; ++k) dst[m][k] = *(const LAS bf16x8*)(lds + PG8_SA(b, h) + aoff + m * 2048 + k * 1024); } while (0)
#define PG8_LDB(dst, b, h) do { _Pragma("unroll") for (int n = 0; n < 2; ++n) _Pragma("unroll") for (int k = 0; k < 2; ++k) dst[n][k] = *(const LAS bf16x8*)(lds + PG8_SB(b, h) + boff + n * 2048 + k * 1024); } while (0)
#define PG8_MMA(ai, bj, At, Bt_) do { __builtin_amdgcn_s_setprio(1); _Pragma("unroll") for (int m = 0; m < 4; ++m) _Pragma("unroll") for (int n = 0; n < 2; ++n) _Pragma("unroll") for (int k = 0; k < 2; ++k) \
        acc[ai][bj][m][n] = __builtin_amdgcn_mfma_f32_16x16x32_bf16(Bt_[n][k], At[m][k], acc[ai][bj][m][n], 0, 0, 0); __builtin_amdgcn_s_setprio(0); } while (0)
#define PG8_LD8(dst, base) do { const i32x4v lo_ = *(const LAS i32x4v*)(lds + (base)); const i32x4v hi_ = *(const LAS i32x4v*)(lds + (base) + 1024); dst = __builtin_shufflevector(lo_, hi_, 0, 1, 2, 3, 4, 5, 6, 7); } while (0)
#define PG8_LDA8(dst, b, h) do { _Pragma("unroll") for (int m = 0; m < 4; ++m) PG8_LD8(dst[m], PG8_SA(b, h) + aoff + m * 2048); } while (0)
#define PG8_LDB8(dst, b, h) do { _Pragma("unroll") for (int n = 0; n < 2; ++n) PG8_LD8(dst[n], PG8_SB(b, h) + boff + n * 2048); } while (0)
#define PG8_MMA8(ai, bj, At, Bt_) do { __builtin_amdgcn_s_setprio(1); _Pragma("unroll") for (int m = 0; m < 4; ++m) _Pragma("unroll") for (int n = 0; n < 2; ++n) \
        asm volatile("v_mfma_f32_16x16x128_f8f6f4 %0, %1, %2, %0" : "+v"(acc[ai][bj][m][n]) : "v"(Bt_[n]), "v"(At[m])); __builtin_amdgcn_s_setprio(0); } while (0)
#define PG8_XLDA(b, h) do { if constexpr (F8) PG8_LDA8(At8, b, h); else PG8_LDA(At, b, h); } while (0)
#define PG8_XLDB(w, b, h) do { if constexpr (F8) { if (w == 0) PG8_LDB8(B08, b, h); else PG8_LDB8(B18, b, h); } else { if (w == 0) PG8_LDB(B0, b, h); else PG8_LDB(B1, b, h); } } while (0)
#define PG8_XMMA(ai, bj, w) do { if constexpr (F8) { if (w == 0) PG8_MMA8(ai, bj, At8, B08); else PG8_MMA8(ai, bj, At8, B18); } else { if (w == 0) PG8_MMA(ai, bj, At, B0); else PG8_MMA(ai, bj, At, B1); } } while (0)
#define PG8_WAIT_V(n) asm volatile("s_waitcnt vmcnt(" #n ")" ::: "memory")
#define PG8_WAIT_L(n) asm volatile("s_waitcnt lgkmcnt(" #n ")" ::: "memory")
#define PG8_BAR __builtin_amdgcn_s_barrier()
#define PG8_SCHED __builtin_amdgcn_sched_barrier(0)
#define PG8_OFFS(dst, u) do { _Pragma("unroll") for (int _h = 0; _h < 2; ++_h) _Pragma("unroll") for (int _i = 0; _i < 2; ++_i) { int _R, _C; stage_rc(tid * 16 + _i * 8192, _R, _C); \
        dst[_h][_i] = (AM.row(u, _h * HALF + _R) * (unsigned)K + (unsigned)_C) * 2u; } } while (0)
#define PG8_STAGE_A(bufoff, h, kb, NXT) do { if constexpr (AMap::GATHER) { _Pragma("unroll") for (int _i = 0; _i < 2; ++_i) { const unsigned _o = (NXT) ? offN[h][_i] : offC[h][_i]; \
            __builtin_amdgcn_raw_ptr_buffer_load_lds(rsA, (LAS unsigned*)(lds + (bufoff) + ldsw + _i * 8192), 16, (int)_o, (int)(kb), 0, 0); } } \
        else { const unsigned _g = ((NXT) ? nA : cA) + (h) * hstep + (kb); _Pragma("unroll") for (int _i = 0; _i < 2; ++_i) \
            __builtin_amdgcn_raw_ptr_buffer_load_lds(rsA, (LAS unsigned*)(lds + (bufoff) + ldsw + _i * 8192), 16, (int)voffA[_i], (int)_g, 0, 0); } } while (0)
    Unit cur, nxt, nn; int ui = 0; bool has_next = false, has_nn = false;
    if (!S.next(0, cur)) return;
    f32x4 acc[2][2][4][2];
#pragma unroll
    for (int a = 0; a < 2; ++a)
#pragma unroll
        for (int b = 0; b < 2; ++b)
#pragma unroll
            for (int m = 0; m < 4; ++m)
#pragma unroll
                for (int n = 0; n < 2; ++n) acc[a][b][m][n] = (f32x4){0.f, 0.f, 0.f, 0.f};
    bf16x8 At[4][2], B0[2][2], B1[2][2]; i32x8 At8[4], B08[2], B18[2];
    int sc8 = 0x7F7F7F7F; if constexpr (F8) asm volatile("" : "+v"(sc8));
#define PG8_RAW(dst, u) do { _Pragma("unroll") for (int _h = 0; _h < 2; ++_h) _Pragma("unroll") for (int _i = 0; _i < 2; ++_i) { int _R, _C; stage_rc(tid * 16 + _i * 8192, _R, _C); dst[_h][_i] = AM.row(u, _h * HALF + _R); } } while (0)
#define PG8_CONV(dst, raw) do { _Pragma("unroll") for (int _h = 0; _h < 2; ++_h) _Pragma("unroll") for (int _i = 0; _i < 2; ++_i) { int _R, _C; stage_rc(tid * 16 + _i * 8192, _R, _C); dst[_h][_i] = (raw[_h][_i] * (unsigned)K + (unsigned)_C) * 2u; } } while (0)
    unsigned offC[2][2], offN[2][2], rawN[2][2];
    if constexpr (AMap::GATHER) { PG8_OFFS(offC, cur); has_next = S.next(1, nxt);
        if (has_next) { PG8_RAW(rawN, nxt); } else {
#pragma unroll
            for (int h = 0; h < 2; ++h)
#pragma unroll
                for (int i = 0; i < 2; ++i) rawN[h][i] = 0u; } }
    unsigned cA = AMap::GATHER ? 0u : (unsigned)cur.pm * tstep + (SEG2 ? (unsigned)cur.e * 1024u : 0u), nA = cA;
    unsigned cB = (unsigned)cur.e * (SEG2 ? 1024u : (unsigned)(bstride * 2)) + (unsigned)cur.pn * tstep;
    PG8_STAGE(PG8_SB(0, 0), cB, voffB); PG8_STAGE(PG8_SB(0, 1), cB + hstep, voffB); PG8_STAGE_A(PG8_SA(0, 0), 0, 0, false); PG8_STAGE_A(PG8_SA(0, 1), 1, 0, false);
    if (wr == 1) PG8_BAR;
    PG8_WAIT_V(2); PG8_BAR;
    PG8_STAGE(PG8_SB(1, 0), cB + kstep, voffB); PG8_STAGE_A(PG8_SA(1, 0), 0, kstep, false); PG8_STAGE(PG8_SB(1, 1), cB + hstep + kstep, voffB);
    PG8_WAIT_V(6); PG8_BAR;
    for (;;) {
        if constexpr (!AMap::GATHER) has_next = S.next(ui + 1, nxt);
        if constexpr (AMap::GATHER) {
            if (has_next) { PG8_CONV(offN, rawN); }
            else {
#pragma unroll
                for (int h = 0; h < 2; ++h)
#pragma unroll
                    for (int i = 0; i < 2; ++i) offN[h][i] = offC[h][i];
            }
            has_nn = has_next && S.next(ui + 2, nn);
            if (has_nn) { PG8_RAW(rawN, nn); }
        } else { nA = has_next ? (unsigned)nxt.pm * tstep + (SEG2 ? (unsigned)nxt.e * 1024u : 0u) : cA; }
        const unsigned nB = has_next ? (unsigned)nxt.e * (SEG2 ? 1024u : (unsigned)(bstride * 2)) + (unsigned)nxt.pn * tstep : cB;
        const int ntc = SEG2 ? (cur.e ? 4 : 8) : nt;
#pragma nounroll
        for (int t = 0; t < ntc; t += 2) {
            const bool last = (t == ntc - 2);
            const unsigned k1 = (unsigned)(t + 1) * kstep, k2 = last ? 0u : (unsigned)(t + 2) * kstep, k3 = k2 + kstep;
            const unsigned b2 = last ? nB : cB + (unsigned)(t + 2) * kstep, b3 = b2 + kstep;
            PG8_XLDB(0, 0, 0); PG8_XLDB(1, 0, 1); PG8_SCHED; PG8_XLDA(0, 0); PG8_STAGE_A(PG8_SA(1, 1), 1, k1, false);
            PG8_WAIT_V(8); PG8_WAIT_L(0); PG8_BAR; PG8_XMMA(0, 0, 0); PG8_XMMA(0, 1, 1); PG8_BAR; PG8_SCHED;
            PG8_XLDA(0, 1); PG8_STAGE(PG8_SB(0, 0), b2, voffB); PG8_STAGE(PG8_SB(0, 1), b2 + hstep, voffB); PG8_STAGE_A(PG8_SA(0, 0), 0, k2, last);
            PG8_WAIT_V(8); PG8_WAIT_L(0); PG8_BAR; PG8_XMMA(1, 0, 0); PG8_XMMA(1, 1, 1); PG8_BAR; PG8_SCHED;
            PG8_XLDB(0, 1, 0); PG8_XLDB(1, 1, 1); PG8_SCHED; PG8_XLDA(1, 0); PG8_STAGE_A(PG8_SA(0, 1), 1, k2, last);
            PG8_WAIT_V(8); PG8_WAIT_L(0); PG8_BAR; PG8_XMMA(0, 0, 0); PG8_XMMA(0, 1, 1); PG8_BAR; PG8_SCHED;
            PG8_XLDA(1, 1); PG8_STAGE(PG8_SB(1, 0), b3, voffB); PG8_STAGE(PG8_SB(1, 1), b3 + hstep, voffB); PG8_STAGE_A(PG8_SA(1, 0), 0, k3, last);
            PG8_WAIT_V(8); PG8_WAIT_L(0); PG8_BAR; PG8_XMMA(1, 0, 0); PG8_XMMA(1, 1, 1); PG8_BAR; PG8_SCHED;
        }
#ifdef PROBE_EPI
        unsigned long long pe_t0 = 0; if (tid == 0) pe_t0 = __builtin_amdgcn_s_memrealtime();
#endif
        if constexpr (ALIGN_EPI) { if (wr == 0) PG8_BAR; }
        if constexpr (F8) asm volatile("s_nop 15\n\ts_nop 15" ::: "memory");
        E(acc, cur, wr, wc, fr, fq);
#ifdef PROBE_EPI
        if (tid == 0) { asm volatile("s_waitcnt vmcnt(0)" ::: "memory"); volatile LAS unsigned long long* pb_ = (volatile LAS unsigned long long*)(lds + MISC_OFF + 8192); pb_[1] = pb_[1] + (__builtin_amdgcn_s_memrealtime() - pe_t0); }
#endif
        if (!has_next) break;
        if (!(SEG2 && cur.e == 0))
#pragma unroll
        for (int a = 0; a < 2; ++a)
#pragma unroll
            for (int b = 0; b < 2; ++b)
#pragma unroll
                for (int m = 0; m < 4; ++m)
#pragma unroll
                    for (int n = 0; n < 2; ++n) acc[a][b][m][n] = (f32x4){0.f, 0.f, 0.f, 0.f};
        cur = nxt; cB = nB; cA = nA; ++ui;
        if constexpr (AMap::GATHER) { nxt = nn; has_next = has_nn;
#pragma unroll
            for (int h = 0; h < 2; ++h)
#pragma unroll
                for (int i = 0; i < 2; ++i) offC[h][i] = offN[h][i];
        }
        if constexpr (ALIGN_EPI) { if (wr == 1) PG8_BAR; }
    }
    PG8_WAIT_V(0);
    if constexpr (!ALIGN_EPI) { if (wr == 0) PG8_BAR; }
    PG8_BAR;
#undef PG8_STAGE_A
#undef PG8_LD8
#undef PG8_LDA8
#undef PG8_LDB8
#undef PG8_MMA8
#undef PG8_XLDA
#undef PG8_XLDB
#undef PG8_XMMA
#undef PG8_SA
#undef PG8_SB
#undef PG8_STAGE
#undef PG8_LDA
#undef PG8_LDB
#undef PG8_MMA
#undef PG8_WAIT_V
#undef PG8_WAIT_L
#undef PG8_BAR
#undef PG8_SCHED
#undef PG8_OFFS
#undef PG8_RAW
#undef PG8_CONV
}

#define EPI_PIN(x) asm volatile("" : "+v"(x))
#define LPIN(x) asm volatile("" : "+v"(x))
#define EPI_ROWSTEP(m) (((m) == 3) ? 80 : 16)
struct EpiProj {
    static constexpr bool PERM = true;
    bf16_t* O; const float* cs; const float* sn; float* alow; float scale;
    __device__ __forceinline__ void operator()(const f32x4 (&acc)[2][2][4][2], const Unit& u, int wr, int wc, int fr, int fq) const {
        const int row0 = u.pm * BM + wr * 64 + fr, col0 = u.pn * BM + wc * 32 + 8 * fq;
        unsigned off = (unsigned)(row0 * NP + col0) * 2u;
        if (u.pn < 12) {
            unsigned toff = (unsigned)((row0 & (SEQ - 1)) * 64 + wc * 16 + fq * 4) * 4u;
            f32x4 ct[2][4], st[2][4];
#pragma unroll
            for (int ai = 0; ai < 2; ++ai)
#pragma unroll
                for (int m = 0; m < 4; ++m) { ct[ai][m] = *(const f32x4*)((const char*)cs + toff + (ai * HALF + m * 16) * 64 * 4); st[ai][m] = *(const f32x4*)((const char*)sn + toff + (ai * HALF + m * 16) * 64 * 4); }
#pragma unroll
            for (int ai = 0; ai < 2; ++ai)
#pragma unroll
                for (int m = 0; m < 4; ++m) {
                    const f32x4 c4 = ct[ai][m], s4 = st[ai][m];
#pragma unroll
                    for (int bj = 0; bj < 2; ++bj) { const f32x4 v0 = acc[ai][bj][m][0] * scale, v1 = acc[ai][bj][m][1] * scale; u32x4 w;
                        w.x = pk2(v0[0] * c4[0] - v0[1] * s4[0], v0[1] * c4[0] + v0[0] * s4[0]);
                        w.y = pk2(v0[2] * c4[1] - v0[3] * s4[1], v0[3] * c4[1] + v0[2] * s4[1]);
                        w.z = pk2(v1[0] * c4[2] - v1[1] * s4[2], v1[1] * c4[2] + v1[0] * s4[2]);
                        w.w = pk2(v1[2] * c4[3] - v1[3] * s4[3], v1[3] * c4[3] + v1[2] * s4[3]);
                        *(u32x4*)((char*)O + off + bj * HALF * 2) = w; }
                    off += EPI_ROWSTEP(m) * NP * 2; EPI_PIN(off);
                }
        } else if (GATE_F8 && u.pn >= RB / 256 && u.pn < 46) {
            unsigned off8 = (unsigned)(row0 * NP) * 2u + (unsigned)(G8_BYTE0 + col0 - RB);
#pragma unroll
            for (int ai = 0; ai < 2; ++ai)
#pragma unroll
                for (int m = 0; m < 4; ++m) {
#pragma unroll
                    for (int bj = 0; bj < 2; ++bj) { const f32x4 v0 = acc[ai][bj][m][0] * scale, v1 = acc[ai][bj][m][1] * scale; u32x2 w;
                        w.x = pk_fp8x4(v0[0], v0[1], v0[2], v0[3]); w.y = pk_fp8x4(v1[0], v1[1], v1[2], v1[3]);
                        *(u32x2*)((char*)O + off8 + bj * HALF) = w; }
                    off8 += EPI_ROWSTEP(m) * NP * 2; EPI_PIN(off8); }
        } else if (u.pn < 46) {
#pragma unroll
            for (int ai = 0; ai < 2; ++ai)
#pragma unroll
                for (int m = 0; m < 4; ++m) {
#pragma unroll
                    for (int bj = 0; bj < 2; ++bj) { const f32x4 v0 = acc[ai][bj][m][0] * scale, v1 = acc[ai][bj][m][1] * scale; u32x4 w;
                        w.x = pk2(v0[0], v0[1]); w.y = pk2(v0[2], v0[3]); w.z = pk2(v1[0], v1[1]); w.w = pk2(v1[2], v1[3]);
                        *(u32x4*)((char*)O + off + bj * HALF * 2) = w; }
                    off += EPI_ROWSTEP(m) * NP * 2; EPI_PIN(off); }
        } else {
            if (wc == 0 && fq < 2) {
                unsigned aoff_ = (unsigned)(row0 * 16 + 8 * fq) * 4u;
#pragma unroll
                for (int ai = 0; ai < 2; ++ai)
#pragma unroll
                    for (int m = 0; m < 4; ++m) { float* rp = (float*)((char*)alow + aoff_);
                        *(f32x4*)rp = acc[ai][0][m][0] * scale; *(f32x4*)(rp + 4) = acc[ai][0][m][1] * scale;
                        aoff_ += EPI_ROWSTEP(m) * 16 * 4; EPI_PIN(aoff_); }
            }
        }
    }
};
template <bool FIRST> struct EpiGate {
    static constexpr bool PERM = true;
    bf16_t* O; const bf16_t* proj; int goff; float scale; unsigned char* O8;
    __device__ __forceinline__ void operator()(const f32x4 (&acc)[2][2][4][2], const Unit& u, int wr, int wc, int fr, int fq) const {
        const int row0 = u.pm * BM + wr * 64 + fr, col0 = u.pn * BM + wc * 32 + 8 * fq;
        const unsigned goffb = GATE_F8 ? (unsigned)(row0 * NP) * 2u + (unsigned)(G8_BYTE0 + goff - RB + col0) : (unsigned)(row0 * NP + goff + col0) * 2u, ooff = (unsigned)(row0 * D + col0) * 2u;
        u32x4 gA[2][2], gB[2][2], pA[2][2], pB[2][2];
#define EG_ROW(r) ((((r) >> 2) * 128) + (((r) & 3) * 16))
#define EG_LOAD(G, P, b) do { _Pragma("unroll") for (int rr = 0; rr < 2; ++rr) { const unsigned ro = EG_ROW(2 * (b) + rr); _Pragma("unroll") for (int bj = 0; bj < 2; ++bj) { \
            if (GATE_F8) { const u32x2 g8 = *(const u32x2*)((const char*)proj + goffb + ro * NP * 2 + bj * HALF); G[rr][bj] = (u32x4){g8.x, g8.y, 0u, 0u}; } \
            else G[rr][bj] = *(const u32x4*)((const char*)proj + goffb + ro * NP * 2 + bj * HALF * 2); \
            if (!FIRST) P[rr][bj] = *(const u32x4*)((const char*)O + ooff + ro * D * 2 + bj * HALF * 2); } } asm volatile("" ::: "memory"); } while (0)
#define EG_COMP(G, P, b) do { _Pragma("unroll") for (int rr = 0; rr < 2; ++rr) { const int r = 2 * (b) + rr, ai = r >> 2, m = r & 3; const unsigned ro = EG_ROW(r); _Pragma("unroll") for (int bj = 0; bj < 2; ++bj) { \
            const u32x4 gg = G[rr][bj]; const f32x4 v0 = acc[ai][bj][m][0] * scale, v1 = acc[ai][bj][m][1] * scale; float gf[8], r8[8]; \
            if (GATE_F8) unpack_fp8x8((u32x2){gg.x, gg.y}, gf); else { gf[0] = bflo(gg.x); gf[1] = bfhi(gg.x); gf[2] = bflo(gg.y); gf[3] = bfhi(gg.y); gf[4] = bflo(gg.z); gf[5] = bfhi(gg.z); gf[6] = bflo(gg.w); gf[7] = bfhi(gg.w); } \
            r8[0] = sigmoidf_(gf[0]) * v0[0]; r8[1] = sigmoidf_(gf[1]) * v0[1]; r8[2] = sigmoidf_(gf[2]) * v0[2]; r8[3] = sigmoidf_(gf[3]) * v0[3]; \
            r8[4] = sigmoidf_(gf[4]) * v1[0]; r8[5] = sigmoidf_(gf[5]) * v1[1]; r8[6] = sigmoidf_(gf[6]) * v1[2]; r8[7] = sigmoidf_(gf[7]) * v1[3]; \
            if (!FIRST) { const u32x4 pq = P[rr][bj]; r8[0] += bflo(pq.x); r8[1] += bfhi(pq.x); r8[2] += bflo(pq.y); r8[3] += bfhi(pq.y); r8[4] += bflo(pq.z); r8[5] += bfhi(pq.z); r8[6] += bflo(pq.w); r8[7] += bfhi(pq.w); } \
            if (!FIRST && O8) { u32x2 w8; w8.x = pk_fp8x4(r8[0], r8[1], r8[2], r8[3]); w8.y = pk_fp8x4(r8[4], r8[5], r8[6], r8[7]); *(u32x2*)(O8 + (ooff >> 1) + ro * D + bj * HALF) = w8; } \
            else { u32x4 w; w.x = pk2(r8[0], r8[1]); w.y = pk2(r8[2], r8[3]); w.z = pk2(r8[4], r8[5]); w.w = pk2(r8[6], r8[7]); *(u32x4*)((char*)O + ooff + ro * D * 2 + bj * HALF * 2) = w; } } } asm volatile("" ::: "memory"); } while (0)
        EG_LOAD(gA, pA, 0); EG_LOAD(gB, pB, 1); EG_COMP(gA, pA, 0); EG_LOAD(gA, pA, 2); EG_COMP(gB, pB, 1); EG_LOAD(gB, pB, 3); EG_COMP(gA, pA, 2); EG_COMP(gB, pB, 3);
#undef EG_LOAD
#undef EG_COMP
    }
};
struct EpiGate2 {
    static constexpr bool PERM = true;
    const bf16_t* proj; float scale; unsigned char* O8;
    __device__ __forceinline__ void operator()(f32x4 (&acc)[2][2][4][2], const Unit& u, int wr, int wc, int fr, int fq) const {
        const int row0 = u.pm * BM + wr * 64 + fr, col0 = u.pn * BM + wc * 32 + 8 * fq;
        const unsigned goffa = (unsigned)(row0 * NP) * 2u + (unsigned)(G8_BYTE0 + GA - RB + col0), ooff = (unsigned)(row0 * D + col0);
        u32x4 gA[2][2], gB[2][2];
#define EG_ROW(r) ((((r) >> 2) * 128) + (((r) & 3) * 16))
        if (u.e == 0) {
#define E2_LOAD(G, b) do { _Pragma("unroll") for (int rr = 0; rr < 2; ++rr) { const unsigned ro = EG_ROW(2 * (b) + rr); _Pragma("unroll") for (int bj = 0; bj < 2; ++bj) { \
            const u32x2 ga8 = *(const u32x2*)((const char*)proj + goffa + ro * NP * 2 + bj * HALF), gb8 = *(const u32x2*)((const char*)proj + goffa + (GB - GA) + ro * NP * 2 + bj * HALF); \
            G[rr][bj] = (u32x4){ga8.x, ga8.y, gb8.x, gb8.y}; } } asm volatile("" ::: "memory"); } while (0)
#define E2_COMP(G, b) do { _Pragma("unroll") for (int rr = 0; rr < 2; ++rr) { const int r = 2 * (b) + rr, ai = r >> 2, m = r & 3; _Pragma("unroll") for (int bj = 0; bj < 2; ++bj) { \
            const u32x4 gg = G[rr][bj]; float fa[8], fb[8]; unpack_fp8x8((u32x2){gg.x, gg.y}, fa); unpack_fp8x8((u32x2){gg.z, gg.w}, fb); \
            _Pragma("unroll") for (int j = 0; j < 8; ++j) { const float q = (1.0f + __expf(-fmaxf(fa[j], -30.0f))) * sigmoidf_(fb[j]); acc[ai][bj][m][j >> 2][j & 3] *= q; } } } } while (0)
            E2_LOAD(gA, 0); E2_LOAD(gB, 1); E2_COMP(gA, 0); E2_LOAD(gA, 2); E2_COMP(gB, 1); E2_LOAD(gB, 3); E2_COMP(gA, 2); E2_COMP(gB, 3);
#undef E2_LOAD
#undef E2_COMP
        } else {
#define E2_LOAD(G, b) do { _Pragma("unroll") for (int rr = 0; rr < 2; ++rr) { const unsigned ro = EG_ROW(2 * (b) + rr); _Pragma("unroll") for (int bj = 0; bj < 2; ++bj) { \
            const u32x2 ga8 = *(const u32x2*)((const char*)proj + goffa + ro * NP * 2 + bj * HALF); G[rr][bj] = (u32x4){ga8.x, ga8.y, 0u, 0u}; } } asm volatile("" ::: "memory"); } while (0)
#define E2_COMP(G, b) do { _Pragma("unroll") for (int rr = 0; rr < 2; ++rr) { const int r = 2 * (b) + rr, ai = r >> 2, m = r & 3; const unsigned ro = EG_ROW(r); _Pragma("unroll") for (int bj = 0; bj < 2; ++bj) { \
            const u32x4 gg = G[rr][bj]; float fa[8], r8[8]; unpack_fp8x8((u32x2){gg.x, gg.y}, fa); \
            _Pragma("unroll") for (int j = 0; j < 8; ++j) r8[j] = sigmoidf_(fmaxf(fa[j], -30.0f)) * (acc[ai][bj][m][j >> 2][j & 3] * scale); \
            u32x2 w8; w8.x = pk_fp8x4(r8[0], r8[1], r8[2], r8[3]); w8.y = pk_fp8x4(r8[4], r8[5], r8[6], r8[7]); *(u32x2*)(O8 + ooff + ro * D + bj * HALF) = w8; } } asm volatile("" ::: "memory"); } while (0)
            E2_LOAD(gA, 0); E2_LOAD(gB, 1); E2_COMP(gA, 0); E2_LOAD(gA, 2); E2_COMP(gB, 1); E2_LOAD(gB, 3); E2_COMP(gA, 2); E2_COMP(gB, 3);
#undef E2_LOAD
#undef E2_COMP
        }
#undef EG_ROW
    }
};
#define EG_ROW(r) ((((r) >> 2) * 128) + (((r) & 3) * 16))
template <bool XF32> struct EpiResid {
    static constexpr bool PERM = true;
    const void* xi; bf16_t* xo; const float* gate; float scale;
    __device__ __forceinline__ void operator()(const f32x4 (&acc)[2][2][4][2], const Unit& u, int wr, int wc, int fr, int fq) const {
        const int row0 = u.pm * BM + wr * 64 + fr, col0 = u.pn * BM + wc * 32 + 8 * fq;
        const int b = (u.pm * BM) / SEQ;
        f32x4 gt[2][2];
#pragma unroll
        for (int bj = 0; bj < 2; ++bj)
#pragma unroll
            for (int n = 0; n < 2; ++n) gt[bj][n] = *(const f32x4*)(gate + (size_t)b * 12288 + col0 + bj * HALF + 4 * n) * scale;
        const unsigned off = (unsigned)(row0 * D + col0);
        constexpr int RB_ = XF32 ? 1 : 2, NBAT = 8 / RB_;
        f32x4 xA[RB_][2][2], xB[RB_][2][2];
#define ER_LOAD(X, bb) do { _Pragma("unroll") for (int rr = 0; rr < RB_; ++rr) { const unsigned ro = EG_ROW(RB_ * (bb) + rr); _Pragma("unroll") for (int bj = 0; bj < 2; ++bj) { const unsigned o = off + ro * D + bj * HALF; \
            if (XF32) { X[rr][bj][0] = *(const f32x4*)((const float*)xi + o); X[rr][bj][1] = *(const f32x4*)((const float*)xi + o + 4); } \
            else { const u32x4 rw = *(const u32x4*)((const bf16_t*)xi + o); X[rr][bj][0] = (f32x4){bflo(rw.x), bfhi(rw.x), bflo(rw.y), bfhi(rw.y)}; X[rr][bj][1] = (f32x4){bflo(rw.z), bfhi(rw.z), bflo(rw.w), bfhi(rw.w)}; } } } asm volatile("" ::: "memory"); } while (0)
#define ER_COMP(X, bb) do { _Pragma("unroll") for (int rr = 0; rr < RB_; ++rr) { const int r = RB_ * (bb) + rr, ai = r >> 2, m = r & 3; const unsigned ro = EG_ROW(r); _Pragma("unroll") for (int bj = 0; bj < 2; ++bj) { const unsigned o = off + ro * D + bj * HALF; \
            const f32x4 v0 = X[rr][bj][0] + gt[bj][0] * acc[ai][bj][m][0], v1 = X[rr][bj][1] + gt[bj][1] * acc[ai][bj][m][1]; \
            u32x4 w; w.x = pk2(v0[0], v0[1]); w.y = pk2(v0[2], v0[3]); w.z = pk2(v1[0], v1[1]); w.w = pk2(v1[2], v1[3]); *(u32x4*)(xo + o) = w; } } asm volatile("" ::: "memory"); } while (0)
        ER_LOAD(xA, 0);
#pragma unroll
        for (int bb = 0; bb < NBAT; bb += 2) {
            ER_LOAD(xB, bb + 1); ER_COMP(xA, bb);
            if (bb + 2 < NBAT) ER_LOAD(xA, bb + 2);
            ER_COMP(xB, bb + 1); }
#undef ER_LOAD
#undef ER_COMP
#undef EG_ROW
    }
};
struct EpiSwiGLU {
    static constexpr bool PERM = true;
    bf16_t* O;
    __device__ __forceinline__ void operator()(const f32x4 (&acc)[2][2][4][2], const Unit& u, int wr, int wc, int fr, int fq) const {
        const int row0 = u.pm * BM + wr * 64 + fr, col0 = u.pn * HALF + wc * 32 + 8 * fq;
        unsigned off = (unsigned)(row0 * FF + col0) * 2u;
#pragma unroll
        for (int ai = 0; ai < 2; ++ai)
#pragma unroll
            for (int m = 0; m < 4; ++m) { const f32x4 g0 = acc[ai][0][m][0], g1 = acc[ai][0][m][1], u0 = acc[ai][1][m][0], u1 = acc[ai][1][m][1]; u32x4 w;
                w.x = pk2(siluf_(g0[0]) * u0[0], siluf_(g0[1]) * u0[1]); w.y = pk2(siluf_(g0[2]) * u0[2], siluf_(g0[3]) * u0[3]);
                w.z = pk2(siluf_(g1[0]) * u1[0], siluf_(g1[1]) * u1[1]); w.w = pk2(siluf_(g1[2]) * u1[2], siluf_(g1[3]) * u1[3]);
                *(u32x4*)((char*)O + off) = w;
                off += EPI_ROWSTEP(m) * FF * 2; EPI_PIN(off); }
    }
};
struct EpiPlain {
    static constexpr bool PERM = true;
    bf16_t* O;
    __device__ __forceinline__ void operator()(const f32x4 (&acc)[2][2][4][2], const Unit& u, int wr, int wc, int fr, int fq) const {
        const int row0 = u.pm * BM + wr * 64 + fr, col0 = u.pn * BM + wc * 32 + 8 * fq;
        unsigned off = (unsigned)(row0 * D + col0) * 2u;
#pragma unroll
        for (int ai = 0; ai < 2; ++ai)
#pragma unroll
            for (int m = 0; m < 4; ++m) {
#pragma unroll
                for (int bj = 0; bj < 2; ++bj) { const f32x4 v0 = acc[ai][bj][m][0], v1 = acc[ai][bj][m][1]; u32x4 w;
                    w.x = pk2(v0[0], v0[1]); w.y = pk2(v0[2], v0[3]); w.z = pk2(v1[0], v1[1]); w.w = pk2(v1[2], v1[3]);
                    *(u32x4*)((char*)O + off + bj * HALF * 2) = w; }
                off += EPI_ROWSTEP(m) * D * 2; EPI_PIN(off); }
    }
};
constexpr float W8_SCALE = 32.0f, W8_INV = 1.0f / 32.0f;
struct EpiSwiGLU8 {
    static constexpr bool PERM = true;
    unsigned char* O;
    __device__ __forceinline__ void operator()(const f32x4 (&acc)[2][2][4][2], const Unit& u, int wr, int wc, int fr, int fq) const {
        const int row0 = u.pm * BM + wr * 64 + fr, col0 = u.pn * HALF + wc * 32 + 8 * fq;
        unsigned off = (unsigned)(row0 * FF + col0);
#pragma unroll
        for (int ai = 0; ai < 2; ++ai)
#pragma unroll
            for (int m = 0; m < 4; ++m) { const f32x4 g0 = acc[ai][0][m][0] * W8_INV, g1 = acc[ai][0][m][1] * W8_INV, u0 = acc[ai][1][m][0] * W8_INV, u1 = acc[ai][1][m][1] * W8_INV; u32x2 w;
                w.x = pk_fp8x4(siluf_(g0[0]) * u0[0], siluf_(g0[1]) * u0[1], siluf_(g0[2]) * u0[2], siluf_(g0[3]) * u0[3]);
                w.y = pk_fp8x4(siluf_(g1[0]) * u1[0], siluf_(g1[1]) * u1[1], siluf_(g1[2]) * u1[2], siluf_(g1[3]) * u1[3]);
                *(u32x2*)(O + off) = w;
                off += EPI_ROWSTEP(m) * FF; EPI_PIN(off); }
    }
};
struct EpiPlainS {
    static constexpr bool PERM = true;
    bf16_t* O; float scale;
    __device__ __forceinline__ void operator()(const f32x4 (&acc)[2][2][4][2], const Unit& u, int wr, int wc, int fr, int fq) const {
        const int row0 = u.pm * BM + wr * 64 + fr, col0 = u.pn * BM + wc * 32 + 8 * fq;
        unsigned off = (unsigned)(row0 * D + col0) * (Y_F8 ? 1u : 2u);
#pragma unroll
        for (int ai = 0; ai < 2; ++ai)
#pragma unroll
            for (int m = 0; m < 4; ++m) {
#pragma unroll
                for (int bj = 0; bj < 2; ++bj) { const f32x4 v0 = acc[ai][bj][m][0] * scale, v1 = acc[ai][bj][m][1] * scale;
#if Y_F8
                    u32x2 w; w.x = pk_fp8x4(v0[0], v0[1], v0[2], v0[3]); w.y = pk_fp8x4(v1[0], v1[1], v1[2], v1[3]);
                    *(u32x2*)((char*)O + off + bj * HALF) = w;
#else
                    u32x4 w; w.x = pk2(v0[0], v0[1]); w.y = pk2(v0[2], v0[3]); w.z = pk2(v1[0], v1[1]); w.w = pk2(v1[2], v1[3]);
                    *(u32x4*)((char*)O + off + bj * HALF * 2) = w;
#endif
                }
                off += EPI_ROWSTEP(m) * D * (Y_F8 ? 1 : 2); EPI_PIN(off); }
    }
};
}

struct Args {
    const float* x; const float* c; const float* w_ada; const float* b_ada; const float* norm_mix; const float* norm_ffn; const float* w_in;
    const float* w_alpha2; const float* b_alpha2; const float* gla_gain; const float* w_out_a; const float* w_out_b; const float* w_out;
    const float* w_router; const float* b_router; const float* w_gate_e; const float* w_up_e; const float* w_down_e; const float* final_norm;
    float* out; unsigned char* ws; int ph_lo, ph_hi;
};

__device__ __forceinline__ int proj_src_col(int n) {
    if (n < 3072) { const int blk = n >> 7, w = n & 127; return (blk << 7) + (w >> 1) + ((w & 1) << 6); }
    if (n < 7680) return n;
    if (n < 11776) return n + 16;
    if (n < 11792) return n - 4096;
    return -1;
}
struct TrDesc { const float* src; unsigned char* dst; int ldw, K, zero, rope, f8; };
__device__ __forceinline__ void tr_load(const TrDesc& d, f32x4 (&v)[16]) {
#pragma unroll
    for (int i = 0; i < 16; ++i) v[i] = __builtin_nontemporal_load((const f32x4*)(d.src + (size_t)(4 * i) * d.ldw));
}
__device__ __forceinline__ void tr_finish(const TrDesc& d, f32x4 (&v)[16], LAS float* scr, int lane) {
    const int kk = lane >> 4, q4 = lane & 15;
    if (d.zero) {
#pragma unroll
        for (int i = 0; i < 16; ++i) v[i] = (f32x4){0.f, 0.f, 0.f, 0.f}; }
    const int d0 = d.rope ? 8 * (q4 & 7) + (q4 >> 3) : 4 * q4, ds = d.rope ? 2 : 1;
    { LAS float* rp = scr + kk * 65 + d0;
#pragma unroll
        for (int i = 0; i < 16; ++i) { rp[4 * i * 65] = v[i][0]; rp[4 * i * 65 + ds] = v[i][1]; rp[4 * i * 65 + 2 * ds] = v[i][2]; rp[4 * i * 65 + 3 * ds] = v[i][3]; } }
    LDS_WAIT(); asm volatile("" ::: "memory");
    if (d.f8) {
        const int c = lane & 3, nl = lane >> 2; const LAS float* sp = scr + (16 * c) * 65 + nl; unsigned char* dp = d.dst + (size_t)nl * d.K + 16 * c;
#pragma unroll
        for (int j = 0; j < 4; ++j) { u32x4 o;
            o.x = pk_fp8x4(sp[0 * 65 + 16 * j] * 32.0f, sp[1 * 65 + 16 * j] * 32.0f, sp[2 * 65 + 16 * j] * 32.0f, sp[3 * 65 + 16 * j] * 32.0f);
            o.y = pk_fp8x4(sp[4 * 65 + 16 * j] * 32.0f, sp[5 * 65 + 16 * j] * 32.0f, sp[6 * 65 + 16 * j] * 32.0f, sp[7 * 65 + 16 * j] * 32.0f);
            o.z = pk_fp8x4(sp[8 * 65 + 16 * j] * 32.0f, sp[9 * 65 + 16 * j] * 32.0f, sp[10 * 65 + 16 * j] * 32.0f, sp[11 * 65 + 16 * j] * 32.0f);
            o.w = pk_fp8x4(sp[12 * 65 + 16 * j] * 32.0f, sp[13 * 65 + 16 * j] * 32.0f, sp[14 * 65 + 16 * j] * 32.0f, sp[15 * 65 + 16 * j] * 32.0f);
            *(GAS u32x4*)(dp + (size_t)(16 * j) * d.K) = o; }
    } else {
        const int c = lane & 7, nl = lane >> 3; const LAS float* sp = scr + (8 * c) * 65 + nl; unsigned char* dp = d.dst + ((size_t)nl * d.K + 8 * c) * 2;
#pragma unroll
        for (int j = 0; j < 8; ++j) { u32x4 o;
            o.x = pk2(sp[0 * 65 + 8 * j], sp[1 * 65 + 8 * j]); o.y = pk2(sp[2 * 65 + 8 * j], sp[3 * 65 + 8 * j]); o.z = pk2(sp[4 * 65 + 8 * j], sp[5 * 65 + 8 * j]); o.w = pk2(sp[6 * 65 + 8 * j], sp[7 * 65 + 8 * j]);
            *(GAS u32x4*)(dp + (size_t)(8 * j) * d.K * 2) = o; }
    }
    LDS_WAIT(); asm volatile("" ::: "memory");
}

typedef const __attribute__((address_space(4))) Args CArgsP;
__device__ __forceinline__ void prologue_phase(CArgsP* ap_, LAS unsigned char* lds, int vcu, int G, int tid, int wave, int lane, int parts = 7) {
#define a (*ap_)
    unsigned char* ws = a.ws;
    if (parts & 1) {
        LAS float* cact = (LAS float*)lds;
        LAS float* red = (LAS float*)(lds + 65536);
        for (int i = tid; i < NB * D; i += NTHREADS) { const int b = i >> 11, k = i & 2047; cact[k * 8 + b] = siluf_(a.c[i]); }
        __syncthreads();
        float* ada = (float*)(ws + WS_ADA);
        const int q = tid & 7, kg = tid >> 3;
        for (int u = vcu; u < DEPTH * 384; u += G) {
            const int l = u / 384, n0 = (u % 384) * 32;
            const float* W = a.w_ada + (size_t)l * D * 12288 + n0 + 4 * q;
            f32x4 acc[8];
#pragma unroll
            for (int b = 0; b < 8; ++b) acc[b] = (f32x4){0.f, 0.f, 0.f, 0.f};
#pragma unroll 8
            for (int kk = 0; kk < 32; ++kk) { const int k = kg * 32 + kk; const f32x4 w = __builtin_nontemporal_load((const f32x4*)(W + (size_t)k * 12288));
                const f32x4 c0 = *(const LAS f32x4*)(cact + k * 8), c1 = *(const LAS f32x4*)(cact + k * 8 + 4);
                acc[0] += w * c0[0]; acc[1] += w * c0[1]; acc[2] += w * c0[2]; acc[3] += w * c0[3];
                acc[4] += w * c1[0]; acc[5] += w * c1[1]; acc[6] += w * c1[2]; acc[7] += w * c1[3]; }
#pragma unroll
            for (int b = 0; b < 8; ++b) *(LAS f32x4*)(red + (kg * 8 + b) * 32 + 4 * q) = acc[b];
            __syncthreads();
            if (tid < 256) { const int b = tid >> 5, col = tid & 31; float s = a.b_ada[(size_t)l * 12288 + n0 + col];
                for (int g = 0; g < 64; ++g) s += red[(g * 8 + b) * 32 + col];
                const int n = n0 + col;
                if (n >= 2048 && n < 4096) s = (1.0f + s) * a.norm_mix[(size_t)l * D + n - 2048]; else if (n >= 8192 && n < 10240) s = (1.0f + s) * a.norm_ffn[(size_t)l * D + n - 8192];
                ada[((size_t)l * NB + b) * 12288 + n] = s; }
            __syncthreads();
        }
    }
    if (parts & 2) {
        float* cs = (float*)(ws + WS_ROPE); float* sn = cs + SEQ * 64;
        for (int i = vcu * NTHREADS + tid; i < SEQ * 64; i += G * NTHREADS) {
            const int pos = i >> 6, fi = i & 63;
            double f = 1.0;
            if (fi & 1) f *= 0.8659643233600653; if (fi & 2) f *= 0.7498942093324558; if (fi & 4) f *= 0.5623413251903491;
            if (fi & 8) f *= 0.31622776601683794; if (fi & 16) f *= 0.09999999999999999; if (fi & 32) f *= 0.009999999999999998;
            double rev = (double)pos * f * 0.15915494309189535; rev -= __builtin_floor(rev);
            const float rv = (float)rev;
            cs[i] = __builtin_amdgcn_cosf(rv); sn[i] = __builtin_amdgcn_sinf(rv);
        }
    }
    if (parts & 4) {
        LAS float* scr = (LAS float*)(lds + wave * 16640);
        const int gw = vcu * NWAVES + wave, NGW = G * NWAVES;
        constexpr int C_IN = 32 * 188, C_OA = 8 * 32, C_OB = 16 * 32, C_O = 32 * 32, C_GU = 16 * 32 * 32, C_DN = 16 * 16 * 32, C_L = C_IN + C_OA + C_OB + C_O + C_GU + C_DN, NIT = DEPTH * C_L;
        const int q4 = lane & 15, kk = lane >> 4;
        auto decode = [&](int it) -> TrDesc {
            TrDesc d; d.zero = 0; d.rope = 0; d.f8 = 0;
            const int l = it / C_L; int r = it % C_L;
            const float* W; unsigned char* WT; int ldw, K, k0, n0, scol, esz = 2;
            if (r < C_IN) { const int kb = r / 188, nb = r % 188; n0 = 64 * nb; k0 = 64 * kb; ldw = NIN; K = D; W = a.w_in + (size_t)l * D * NIN;
                if (n0 < 3072) { d.rope = 1; scol = (n0 >> 7) * 128 + 32 * ((n0 >> 6) & 1) + 64 * (q4 >> 3) + 4 * (q4 & 7); }
                else if (n0 < 7680) scol = n0 + 4 * q4;
                else if (n0 < 11776) scol = n0 + 16 + 4 * q4;
                else if (n0 == 11776) { scol = (q4 < 4) ? 7680 + 4 * q4 : 0; d.zero = (q4 < 4) ? 0 : 1; }
                else { scol = 0; d.zero = 1; }
#if PROJ_F8
                d.f8 = 1; esz = 1; WT = ws + WS_WIN + (size_t)l * NP * D;
#else
                WT = ws + WS_WIN + (size_t)l * NP * D * 2;
#endif
            } else if ((r -= C_IN) < C_OA) { const int kb = r / 32, nb = r % 32; n0 = 64 * nb; k0 = 64 * kb; ldw = D; K = 512; scol = n0 + 4 * q4; W = a.w_out_a + (size_t)l * 512 * D; WT = ws + WS_WOA + (size_t)l * D * 512 * (MIX_F8 ? 1 : 2); if (MIX_F8) { d.f8 = 1; esz = 1; }
                if (BR_FUSE) { K = 1536; WT = ws + WS_WOA + (size_t)l * D * 1536 + 1024; }
            } else if ((r -= C_OA) < C_OB) { const int kb = r / 32, nb = r % 32; n0 = 64 * nb; k0 = 64 * kb; ldw = D; K = 1024; scol = n0 + 4 * q4; W = a.w_out_b + (size_t)l * 1024 * D; WT = ws + WS_WOB + (size_t)l * D * 1024 * (MIX_F8 ? 1 : 2); if (MIX_F8) { d.f8 = 1; esz = 1; }
                if (BR_FUSE) { K = 1536; WT = ws + WS_WOA + (size_t)l * D * 1536; }
            } else if ((r -= C_OB) < C_O) { const int kb = r / 32, nb = r % 32; n0 = 64 * nb; k0 = 64 * kb; ldw = D; K = D; scol = n0 + 4 * q4; W = a.w_out + (size_t)l * D * D; WT = ws + WS_WO + (size_t)l * D * D * (MIX_F8 ? 1 : 2); if (MIX_F8) { d.f8 = 1; esz = 1; }
            } else if ((r -= C_O) < C_GU) { const int e = r / 1024, r2 = r % 1024, kb = r2 / 32, nb = r2 % 32, pn = nb >> 2, sgu = (nb >> 1) & 1, c0 = 64 * (nb & 1);
                n0 = 64 * nb; k0 = 64 * kb; ldw = FF; K = D; scol = 128 * pn + c0 + 4 * q4; W = (sgu ? a.w_up_e : a.w_gate_e) + (size_t)(l * NE + e) * D * FF; WT = ws + WS_WGU + (size_t)(l * NE + e) * 2048 * D; d.f8 = 1; esz = 1;
            } else { r -= C_GU; const int e = r / 512, r2 = r % 512, kb = r2 / 32, nb = r2 % 32;
                n0 = 64 * nb; k0 = 64 * kb; ldw = D; K = FF; scol = n0 + 4 * q4; W = a.w_down_e + (size_t)(l * NE + e) * FF * D; WT = ws + WS_WDN + (size_t)(l * NE + e) * D * FF; d.f8 = 1; esz = 1; }
            d.src = W + (size_t)(k0 + kk) * ldw + scol; d.ldw = ldw; d.K = K; d.dst = WT + ((size_t)n0 * K + k0) * esz;
            return d; };
        int it = gw; TrDesc dA, dB; f32x4 vA[16], vB[16];
        if (it < NIT) { dA = decode(NIT - 1 - it); tr_load(dA, vA); }
        while (it < NIT) {
            const int itB = it + NGW;
            if (itB < NIT) { dB = decode(NIT - 1 - itB); tr_load(dB, vB); }
            tr_finish(dA, vA, scr, lane);
            if (itB >= NIT) break;
            const int itA = itB + NGW;
            if (itA < NIT) { dA = decode(NIT - 1 - itA); tr_load(dA, vA); }
            tr_finish(dB, vB, scr, lane);
            it = itA;
        }
    }
}
#undef a

struct MoeStarts {
    int ts[NE];
    __device__ __forceinline__ void init(const unsigned* cnt) { int acc = 0;
#pragma unroll
        for (int e = 0; e < NE; ++e) { ts[e] = acc; acc += ((int)__hip_atomic_load(cnt + 64 * e, RLX_AGENT) + 255) >> 8; } }
    __device__ __forceinline__ int row(int slot) const { const int e = slot >> 16; int t0 = 0;
#pragma unroll
        for (int j = 0; j < NE; ++j) t0 = (e == j) ? ts[j] : t0;
        return t0 * 256 + (slot & 0xffff); }
};

template <int MODE>
__device__ __forceinline__ void norm_phase(const void* xs, void* xd, bf16_t* hout, const float* gain, const float* ada_scale, const float* ada_shift, const float* ada_gate2,
                                           const bf16_t* Y, const int* tslot, const float* tw, const unsigned* cnt, int vcu, int G, int wave, int lane) {
    const int gw = vcu * NWAVES + wave, NGW = G * NWAVES, rpw = T / NGW;
    MoeStarts ms; if (MODE != 0) ms.init(cnt);
    int tsl = 0; float twl = 0.f;
    if (MODE != 0) { const int i0 = gw * rpw * 2, ii = (i0 + lane < 2 * T) ? i0 + lane : 2 * T - 1; tsl = tslot[ii]; twl = tw[ii]; }
    for (int k = 0; k < rpw; k += 2) {
        const int row = gw * rpw + k, b = row >> 11;
        f32x4 v[2][8]; u32x2 xraw[2][8];
        int s0[2], s1[2]; float w0[2], w1[2];
        if (MODE != 0) {
#pragma unroll
            for (int rr = 0; rr < 2; ++rr) { s0[rr] = __builtin_amdgcn_readlane(tsl, (k + rr) * 2); s1[rr] = __builtin_amdgcn_readlane(tsl, (k + rr) * 2 + 1);
                w0[rr] = __builtin_bit_cast(float, __builtin_amdgcn_readlane(__builtin_bit_cast(int, twl), (k + rr) * 2)); w1[rr] = __builtin_bit_cast(float, __builtin_amdgcn_readlane(__builtin_bit_cast(int, twl), (k + rr) * 2 + 1)); } }
#pragma unroll
        for (int rr = 0; rr < 2; ++rr) {
            if (MODE == 0) { const GAS f32x4* xr = (const GAS f32x4*)((const float*)xs + (size_t)(row + rr) * D) + lane;
#pragma unroll
                for (int j = 0; j < 8; ++j) v[rr][j] = __builtin_nontemporal_load(xr + 64 * j);
            } else { const GAS u32x2* xr = (const GAS u32x2*)((const bf16_t*)xs + (size_t)(row + rr) * D) + lane;
#pragma unroll
                for (int j = 0; j < 8; ++j) xraw[rr][j] = __builtin_nontemporal_load(xr + 64 * j); } }
        f32x4 ggv[8], ssv[8], scv[8];
#define GSS_LOAD() do { const GAS f32x4* gn_ = (const GAS f32x4*)gain + lane; \
            if (MODE == 2) { _Pragma("unroll") for (int j = 0; j < 8; ++j) { ggv[j] = gn_[64 * j]; scv[j] = (f32x4){0.f, 0.f, 0.f, 0.f}; ssv[j] = (f32x4){0.f, 0.f, 0.f, 0.f}; } } \
            else { const GAS f32x4* sc_ = (const GAS f32x4*)(ada_scale + (size_t)b * 12288) + lane; const GAS f32x4* sh_ = (const GAS f32x4*)(ada_shift + (size_t)b * 12288) + lane; \
                _Pragma("unroll") for (int j = 0; j < 8; ++j) { ggv[j] = sc_[64 * j]; scv[j] = (f32x4){0.f, 0.f, 0.f, 0.f}; ssv[j] = sh_[64 * j]; } } asm volatile("" ::: "memory"); } while (0)
        if (MODE == 0) GSS_LOAD();
        if (MODE != 0) {
            const GAS f32x4* gt = (const GAS f32x4*)(ada_gate2 + (size_t)b * 12288) + lane;
#if Y_F8
            unsigned ya[2][8], yb[2][8];
#pragma unroll
            for (int rr = 0; rr < 2; ++rr) { const GAS unsigned* y0 = (const GAS unsigned*)((const unsigned char*)Y + (size_t)ms.row(s0[rr]) * D) + lane; const GAS unsigned* y1 = (const GAS unsigned*)((const unsigned char*)Y + (size_t)ms.row(s1[rr]) * D) + lane;
#pragma unroll
                for (int j = 0; j < 8; ++j) { ya[rr][j] = __builtin_nontemporal_load(y0 + 64 * j); yb[rr][j] = __builtin_nontemporal_load(y1 + 64 * j); } }
            f32x4 gtv[8];
#pragma unroll
            for (int j = 0; j < 8; ++j) gtv[j] = gt[64 * j];
            asm volatile("" ::: "memory");
#pragma unroll
            for (int rr = 0; rr < 2; ++rr)
#pragma unroll
                for (int j = 0; j < 8; ++j) { LPIN(xraw[rr][j]); LPIN(ya[rr][j]); LPIN(yb[rr][j]); }
#pragma unroll
            for (int j = 0; j < 8; ++j) LPIN(gtv[j]);
#pragma unroll
            for (int rr = 0; rr < 2; ++rr)
#pragma unroll
                for (int j = 0; j < 8; ++j) { const u32x2 r = xraw[rr][j]; v[rr][j] = (f32x4){bflo(r.x), bfhi(r.x), bflo(r.y), bfhi(r.y)}; }
#pragma unroll
            for (int j = 0; j < 8; ++j) { const f32x4 g = gtv[j];
#pragma unroll
                for (int rr = 0; rr < 2; ++rr) {
                    const f32x2_t a0l = __builtin_amdgcn_cvt_pk_f32_fp8((int)ya[rr][j], false), a0h = __builtin_amdgcn_cvt_pk_f32_fp8((int)ya[rr][j], true), a1l = __builtin_amdgcn_cvt_pk_f32_fp8((int)yb[rr][j], false), a1h = __builtin_amdgcn_cvt_pk_f32_fp8((int)yb[rr][j], true);
                    f32x4 m; m[0] = w0[rr] * a0l[0] + w1[rr] * a1l[0]; m[1] = w0[rr] * a0l[1] + w1[rr] * a1l[1]; m[2] = w0[rr] * a0h[0] + w1[rr] * a1h[0]; m[3] = w0[rr] * a0h[1] + w1[rr] * a1h[1];
                    v[rr][j] = v[rr][j] + g * m; } }
#else
            u32x2 ya[2][8], yb[2][8];
#pragma unroll
            for (int rr = 0; rr < 2; ++rr) { const GAS u32x2* y0 = (const GAS u32x2*)(Y + (size_t)ms.row(s0[rr]) * D) + lane; const GAS u32x2* y1 = (const GAS u32x2*)(Y + (size_t)ms.row(s1[rr]) * D) + lane;
#pragma unroll
                for (int j = 0; j < 8; ++j) { ya[rr][j] = y0[64 * j]; yb[rr][j] = y1[64 * j]; } }
#pragma unroll
            for (int j = 0; j < 8; ++j) { const f32x4 g = gt[64 * j];
#pragma unroll
                for (int rr = 0; rr < 2; ++rr) { const u32x2 a0 = ya[rr][j], a1 = yb[rr][j];
                    f32x4 m; m[0] = w0[rr] * bflo(a0.x) + w1[rr] * bflo(a1.x); m[1] = w0[rr] * bfhi(a0.x) + w1[rr] * bfhi(a1.x); m[2] = w0[rr] * bflo(a0.y) + w1[rr] * bflo(a1.y); m[3] = w0[rr] * bfhi(a0.y) + w1[rr] * bfhi(a1.y);
                    v[rr][j] = v[rr][j] + g * m; } }
#endif
            GSS_LOAD();
            if (MODE == 1) {
#pragma unroll
                for (int rr = 0; rr < 2; ++rr) { GAS u32x2* xw = (GAS u32x2*)((bf16_t*)xd + (size_t)(row + rr) * D) + lane;
#pragma unroll
                    for (int j = 0; j < 8; ++j) { u32x2 w; w.x = pk2(v[rr][j][0], v[rr][j][1]); w.y = pk2(v[rr][j][2], v[rr][j][3]); xw[64 * j] = w; } } }
        }
        float rstd[2];
#pragma unroll
        for (int rr = 0; rr < 2; ++rr) { float s = 0.f;
#pragma unroll
            for (int j = 0; j < 8; ++j) s += (v[rr][j][0] * v[rr][j][0] + v[rr][j][1] * v[rr][j][1]) + (v[rr][j][2] * v[rr][j][2] + v[rr][j][3] * v[rr][j][3]);
            rstd[rr] = 1.0f / sqrtf(wave_sum(s, lane) * (1.0f / D) + NORM_EPS); }
        if (MODE == 2) {
#pragma unroll
            for (int j = 0; j < 8; ++j) { const f32x4 gg = ggv[j];
#pragma unroll
                for (int rr = 0; rr < 2; ++rr) ((GAS f32x4*)((float*)xd + (size_t)(row + rr) * D) + lane)[64 * j] = v[rr][j] * rstd[rr] * gg; }
        } else {
#pragma unroll
            for (int j = 0; j < 8; ++j) { const f32x4 gg = ggv[j] * (scv[j] + 1.0f), ss = ssv[j];
#pragma unroll
                for (int rr = 0; rr < 2; ++rr) { const f32x4 hh = v[rr][j] * rstd[rr] * gg + ss;
#if PROJ_F8
                    ((GAS unsigned*)((unsigned char*)hout + (size_t)(row + rr) * D) + lane)[64 * j] = pk_fp8x4_ns(hh[0], hh[1], hh[2], hh[3]);
#else
                    u32x2 w; w.x = pk2(hh[0], hh[1]); w.y = pk2(hh[2], hh[3]); ((GAS u32x2*)(hout + (size_t)(row + rr) * D) + lane)[64 * j] = w;
#endif
                } }
        }
    }
}

__device__ __forceinline__ float reduce16(const float (&p)[NE], int lane) {
    float q[8], r[4], s2[2];
    const bool h5 = (lane & 32) != 0, h4 = (lane & 16) != 0, h3 = (lane & 8) != 0, h2 = (lane & 4) != 0;
#pragma unroll
    for (int i = 0; i < 8; ++i) q[i] = (h5 ? p[i + 8] : p[i]) + sx<32>(h5 ? p[i] : p[i + 8], lane);
#pragma unroll
    for (int i = 0; i < 4; ++i) r[i] = (h4 ? q[i + 4] : q[i]) + sx<16>(h4 ? q[i] : q[i + 4], lane);
#pragma unroll
    for (int i = 0; i < 2; ++i) s2[i] = (h3 ? r[i + 2] : r[i]) + sx<8>(h3 ? r[i] : r[i + 2], lane);
    float t = (h2 ? s2[1] : s2[0]) + sx<4>(h2 ? s2[0] : s2[1], lane);
    t += sx<2>(t, lane); t += sx<1>(t, lane);
    return t;
}
__device__ __forceinline__ void route_token(float affl, float sell, int& i0, int& i1, float& w0, float& w1) {
    float aff[NE], sel[NE];
#pragma unroll
    for (int e = 0; e < NE; ++e) { aff[e] = __builtin_bit_cast(float, __builtin_amdgcn_readlane(__builtin_bit_cast(int, affl), 4 * e)); sel[e] = __builtin_bit_cast(float, __builtin_amdgcn_readlane(__builtin_bit_cast(int, sell), 4 * e)); }
    float gs[4];
#pragma unroll
    for (int g = 0; g < 4; ++g) { const float a = sel[4 * g], b = sel[4 * g + 1], c = sel[4 * g + 2], d = sel[4 * g + 3];
        const float h1 = fmaxf(a, b), l1 = fminf(a, b), h2 = fmaxf(c, d), l2 = fminf(c, d);
        gs[g] = fmaxf(h1, h2) + fmaxf(fminf(h1, h2), fmaxf(l1, l2)); }
    int bg = 0; float best = gs[0];
#pragma unroll
    for (int g = 1; g < 4; ++g) { const bool c = gs[g] > best; best = c ? gs[g] : best; bg = c ? g : bg; }
    float s0 = -3.0e38f, s1 = -3.0e38f, a0 = 0.f, a1 = 0.f; int j0 = 0, j1 = 0;
#pragma unroll
    for (int j = 0; j < 4; ++j) {
        const float v = bg == 0 ? sel[j] : (bg == 1 ? sel[4 + j] : (bg == 2 ? sel[8 + j] : sel[12 + j]));
        const float af = bg == 0 ? aff[j] : (bg == 1 ? aff[4 + j] : (bg == 2 ? aff[8 + j] : aff[12 + j]));
        const bool gt0 = v > s0, gt1 = v > s1;
        s1 = gt0 ? s0 : (gt1 ? v : s1); j1 = gt0 ? j0 : (gt1 ? j : j1); a1 = gt0 ? a0 : (gt1 ? af : a1);
        s0 = gt0 ? v : s0; j0 = gt0 ? j : j0; a0 = gt0 ? af : a0; }
    i0 = 4 * bg + j0; i1 = 4 * bg + j1;
    const float inv = 1.0f / (a0 + a1); w0 = a0 * inv; w1 = a1 * inv;
}
__device__ __forceinline__ void router_phase(const bf16_t* xs, bf16_t* hout, const float* gain, const float* ada_scale, const float* ada_shift, const float* w_router, const float* b_router,
                                             unsigned* cnt, int* rlist, int* tslot, float* tw, LAS unsigned char* lds, int vcu, int G, int tid, int wave, int lane) {
    LAS float* wrT = (LAS float*)lds;
    LAS int* misc = (LAS int*)(lds + MISC_OFF + 64);
    LAS int* lcnt = misc; LAS int* lbase = misc + 16; LAS int* rinfo = misc + 32;
    for (int c = tid; c < D; c += NTHREADS) {
        const f32x4 w0 = *(const f32x4*)(w_router + c * 16), w1 = *(const f32x4*)(w_router + c * 16 + 4), w2 = *(const f32x4*)(w_router + c * 16 + 8), w3 = *(const f32x4*)(w_router + c * 16 + 12);
#pragma unroll
        for (int e = 0; e < 4; ++e) { wrT[e * D + c] = w0[e]; wrT[(4 + e) * D + c] = w1[e]; wrT[(8 + e) * D + c] = w2[e]; wrT[(12 + e) * D + c] = w3[e]; } }
    const int rows_per_blk = T / G;
    for (int base = vcu * rows_per_blk; base < T; base += G * rows_per_blk) {
        if (tid < 16) lcnt[tid] = 0;
        __syncthreads();
        const int rpw = rows_per_blk / NWAVES;
        for (int k = 0; k < rpw; k += 2) {
            const int lr = wave * rpw + k, row = base + lr, b = row >> 11;
            f32x4 v[2][8]; float rstd[2];
#pragma unroll
            for (int rr = 0; rr < 2; ++rr) { const GAS u32x2* xr = (const GAS u32x2*)(xs + (size_t)(row + rr) * D) + lane;
#pragma unroll
                for (int j = 0; j < 8; ++j) { const u32x2 r = __builtin_nontemporal_load(xr + 64 * j); v[rr][j] = (f32x4){bflo(r.x), bfhi(r.x), bflo(r.y), bfhi(r.y)}; } }
            f32x4 ggv[8], ssv[8];
            { const GAS f32x4* sc = (const GAS f32x4*)(ada_scale + (size_t)b * 12288) + lane; const GAS f32x4* sh = (const GAS f32x4*)(ada_shift + (size_t)b * 12288) + lane;
#pragma unroll
              for (int j = 0; j < 8; ++j) { ggv[j] = sc[64 * j]; ssv[j] = sh[64 * j]; }
              asm volatile("" ::: "memory"); }
#pragma unroll
            for (int rr = 0; rr < 2; ++rr) { float s = 0.f;
#pragma unroll
                for (int j = 0; j < 8; ++j) s += (v[rr][j][0] * v[rr][j][0] + v[rr][j][1] * v[rr][j][1]) + (v[rr][j][2] * v[rr][j][2] + v[rr][j][3] * v[rr][j][3]);
                rstd[rr] = 1.0f / sqrtf(wave_sum(s, lane) * (1.0f / D) + NORM_EPS); }
#pragma unroll
            for (int jb = 0; jb < 8; jb += 4) {
#pragma unroll
                for (int jj = 0; jj < 4; ++jj) { const int j = jb + jj; const f32x4 gg = ggv[j], ss = ssv[j];
#pragma unroll
                    for (int rr = 0; rr < 2; ++rr) { v[rr][j] = v[rr][j] * rstd[rr] * gg + ss;
                        ((GAS unsigned*)((unsigned char*)hout + (size_t)(row + rr) * D) + lane)[64 * j] = pk_fp8x4_ns(v[rr][j][0], v[rr][j][1], v[rr][j][2], v[rr][j][3]); } }
                asm volatile("" ::: "memory"); }
            float p0[NE], p1[NE];
            f32x4 wA[8], wB[8];
#define RT_RD(W, e) do { _Pragma("unroll") for (int j = 0; j < 8; ++j) W[j] = *(const LAS f32x4*)(wrT + (e) * D + 4 * lane + 256 * j); asm volatile("" ::: "memory"); } while (0)
#define RT_FMA(W, e) do { f32x2 a0 = {0.f, 0.f}, a1 = {0.f, 0.f}; _Pragma("unroll") for (int j = 0; j < 8; ++j) { LPIN(W[j]); const f32x2 wl = {W[j][0], W[j][1]}, wh = {W[j][2], W[j][3]}; \
                a0 = __builtin_elementwise_fma((f32x2){v[0][j][0], v[0][j][1]}, wl, a0); a0 = __builtin_elementwise_fma((f32x2){v[0][j][2], v[0][j][3]}, wh, a0); \
                a1 = __builtin_elementwise_fma((f32x2){v[1][j][0], v[1][j][1]}, wl, a1); a1 = __builtin_elementwise_fma((f32x2){v[1][j][2], v[1][j][3]}, wh, a1); } \
                p0[e] = a0[0] + a0[1]; p1[e] = a1[0] + a1[1]; } while (0)
            RT_RD(wA, 0);
#pragma unroll
            for (int e = 0; e < NE; e += 2) { RT_RD(wB, e + 1); RT_FMA(wA, e); if (e + 2 < NE) RT_RD(wA, e + 2); RT_FMA(wB, e + 1); }
#undef RT_RD
#undef RT_FMA
            const float t0 = reduce16(p0, lane), t1 = reduce16(p1, lane);
            const float bre = b_router[lane >> 2];
#pragma unroll
            for (int rr = 0; rr < 2; ++rr) {
                const float affl = sigmoidf_(rr ? t1 : t0), sell = affl + bre;
                int i0, i1; float w0, w1; route_token(affl, sell, i0, i1, w0, w1);
                if (lane == 0) { const int r0 = atomicAdd((int*)lcnt + i0, 1), r1 = atomicAdd((int*)lcnt + i1, 1);
                    rinfo[(lr + rr) * 4 + 0] = (i0 << 16) | r0; rinfo[(lr + rr) * 4 + 1] = (i1 << 16) | r1;
                    tw[(row + rr) * 2] = w0; tw[(row + rr) * 2 + 1] = w1; } }
        }
        __syncthreads();
        if (tid < 16) lbase[tid] = (int)__hip_atomic_fetch_add(cnt + 64 * tid, (unsigned)lcnt[tid], RLX_AGENT);
        __syncthreads();
        if (tid < rows_per_blk * 2) { const int lr = tid >> 1, kk = tid & 1, info = rinfo[lr * 4 + kk], e = info >> 16, rank = lbase[e] + (info & 0xffff);
            rlist[(size_t)e * T + rank] = base + lr; tslot[(base + lr) * 2 + kk] = (e << 16) | rank; }
        __syncthreads();
    }
}

__device__ __forceinline__ int swz256(int row, int ch) { return 256 * row + 16 * (ch ^ (((row & 3) << 2) | ((row >> 2) & 3))); }
typedef short v4i16_t __attribute__((ext_vector_type(4)));
__device__ __forceinline__ s16x4 vtr(const LAS unsigned char* p) { return __builtin_bit_cast(s16x4, __builtin_amdgcn_ds_read_tr16_b64_v4i16((LAS v4i16_t*)p)); }

struct AttnPre { u32x4 kv[8]; bf16x8 qf[4]; };
__device__ __forceinline__ void attn_issue(AttnPre& R, const bf16_t* proj, int a, int tid, int wave, int lane) {
    const int sub = a & 15, bh = a >> 4, head = bh % 12, b = bh / 12, g = head >> 2;
    const int dsh = 2 * g, nbsh = 4 - 2 * g;
    const int nblk = sub & ((1 << nbsh) - 1), r = sub >> nbsh;
    const size_t tb = (size_t)b * SEQ;
    const int p0 = 128 * (nblk - 1);
#pragma unroll
    for (int it = 0; it < 8; ++it) { const int id = tid + NTHREADS * it, row = id >> 4, ch = id & 15, p = p0 + row;
        const int pc = p < 0 ? 0 : p;
        const size_t t = tb + ((size_t)pc << dsh) + r; R.kv[it] = *(const u32x4*)(proj + t * NP + KA + head * 128 + ch * 8); }
    const int fr = lane & 15, fq = lane >> 4, qi = 16 * wave + fr;
    const size_t tq = tb + ((size_t)(128 * nblk + qi) << dsh) + r;
    const bf16_t* qsrc = proj + tq * NP + QA + head * 128 + fq * 8;
#pragma unroll
    for (int ks = 0; ks < 4; ++ks) R.qf[ks] = *(const bf16x8*)(qsrc + 32 * ks);
}
__device__ __forceinline__ void attn_unit(LAS unsigned char* lds, AttnPre& R, const bf16_t* proj, bf16_t* atto, float* lse, int a, int a_next, int tid, int wave, int lane) {
    const int sub = a & 15, bh = a >> 4, head = bh % 12, b = bh / 12, g = head >> 2, hj = head & 3;
    const int dsh = 2 * g, nbsh = 4 - 2 * g;
    const int nblk = sub & ((1 << nbsh) - 1), r = sub >> nbsh;
    const size_t tb = (size_t)b * SEQ;
    const int p0 = 128 * (nblk - 1);
    LAS unsigned char* Kl = lds; LAS unsigned char* Vl = lds + 65536;
#pragma unroll
    for (int it = 0; it < 8; ++it) { const int id = tid + NTHREADS * it, row = id >> 4, ch = id & 15; *(LAS u32x4*)(Kl + swz256(row, ch)) = R.kv[it]; }
    u32x4 vv[8];
#pragma unroll
    for (int it = 0; it < 8; ++it) { const int id = tid + NTHREADS * it, row = id >> 4, ch = id & 15, p = p0 + row;
        const int pc = p < 0 ? 0 : p;
        const size_t t = tb + ((size_t)pc << dsh) + r; vv[it] = *(const u32x4*)(proj + t * NP + VA + head * 128 + ch * 8); }
    const int fr = lane & 15, fq = lane >> 4;
    const int qi = 16 * wave + fr;
    const size_t tq = tb + ((size_t)(128 * nblk + qi) << dsh) + r;
    bf16x8 qf[4];
#pragma unroll
    for (int ks = 0; ks < 4; ++ks) qf[ks] = R.qf[ks];
    __syncthreads();
    f32x4 sacc[9];
    unsigned kbase[4];
    { const int fK = ((fr & 3) << 2) | ((fr >> 2) & 3);
#pragma unroll
        for (int ks = 0; ks < 4; ++ks) kbase[ks] = (unsigned)(256 * (16 * wave + fr) + 16 * ((4 * ks + fq) ^ fK)); }
#pragma unroll
    for (int kt = 0; kt < 9; ++kt) { f32x4 acc = (f32x4){0.f, 0.f, 0.f, 0.f};
#pragma unroll
        for (int ks = 0; ks < 4; ++ks) { const bf16x8 kf = *(const LAS bf16x8*)(Kl + kbase[ks] + 4096 * kt); acc = __builtin_amdgcn_mfma_f32_16x16x32_bf16(kf, qf[ks], acc, 0, 0, 0); }
        sacc[kt] = acc; }
    const float sc = 0.12751743082459868f;
    float mx = -3.0e38f;
#pragma unroll
    for (int kt = 0; kt < 9; ++kt)
#pragma unroll
        for (int rg = 0; rg < 4; ++rg) { const int jk = 16 * (wave + kt) + 4 * fq + rg; const bool valid = (jk >= qi) && (jk <= qi + 128) && (p0 + jk >= 0);
            const float s = valid ? sacc[kt][rg] * sc : -3.0e38f; sacc[kt][rg] = s; mx = fmaxf(mx, s); }
    mx = fmaxf(mx, sx<16>(mx, lane)); mx = fmaxf(mx, sx<32>(mx, lane));
    float sum = 0.f;
#pragma unroll
    for (int kt = 0; kt < 9; ++kt)
#pragma unroll
        for (int rg = 0; rg < 4; ++rg) { const float p = __builtin_amdgcn_exp2f(sacc[kt][rg] - mx); sacc[kt][rg] = p; sum += p; }
    sum += sx<16>(sum, lane); sum += sx<32>(sum, lane);
#pragma unroll
    for (int it = 0; it < 8; ++it) { const int id = tid + NTHREADS * it, row = id >> 4, ch = id & 15; *(LAS u32x4*)(Vl + swz256(row, ch)) = vv[it]; }
    __syncthreads();
    if (a_next >= 0) attn_issue(R, proj, a_next, tid, wave, lane);
    f32x4 oacc[8];
#pragma unroll
    for (int dt = 0; dt < 8; ++dt) oacc[dt] = (f32x4){0.f, 0.f, 0.f, 0.f};
    const int li = lane & 15, qq = li >> 2, pp = li & 3;
    unsigned vbase[8];
    { const int fV = (qq << 2) | fq;
#pragma unroll
        for (int dt = 0; dt < 8; ++dt) vbase[dt] = (unsigned)(256 * (16 * wave + 4 * fq + qq) + 16 * ((2 * dt + (pp >> 1)) ^ fV) + 8 * (pp & 1)); }
#pragma unroll
    for (int s5 = 0; s5 < 5; ++s5) {
        const int t0 = 2 * s5, t1 = (2 * s5 + 1 < 9) ? 2 * s5 + 1 : 2 * s5;
        u32x4 pw; pw.x = pk2(sacc[t0][0], sacc[t0][1]); pw.y = pk2(sacc[t0][2], sacc[t0][3]);
        if (2 * s5 + 1 < 9) { pw.z = pk2(sacc[t1][0], sacc[t1][1]); pw.w = pk2(sacc[t1][2], sacc[t1][3]); } else { pw.z = 0u; pw.w = 0u; }
        const bf16x8 pf = __builtin_bit_cast(bf16x8, pw);
#pragma unroll
        for (int dt = 0; dt < 8; ++dt) {
            const s16x4 v0 = vtr(Vl + vbase[dt] + 4096 * t0);
            const s16x4 v1 = vtr(Vl + vbase[dt] + 4096 * t1);
            bf16x8 vf; vf[0] = v0[0]; vf[1] = v0[1]; vf[2] = v0[2]; vf[3] = v0[3]; vf[4] = v1[0]; vf[5] = v1[1]; vf[6] = v1[2]; vf[7] = v1[3];
            oacc[dt] = __builtin_amdgcn_mfma_f32_16x16x32_bf16(vf, pf, oacc[dt], 0, 0, 0);
        }
    }
    const float inv = 1.0f / sum;
    bf16_t* op = atto + ((size_t)g * T + tq) * 512 + hj * 128 + 4 * fq;
#pragma unroll
    for (int dt = 0; dt < 8; ++dt) { u32x2 w; w.x = pk2(oacc[dt][0] * inv, oacc[dt][1] * inv); w.y = pk2(oacc[dt][2] * inv, oacc[dt][3] * inv); *(u32x2*)(op + 16 * dt) = w; }
    if (fq == 0) lse[((size_t)g * T + tq) * 4 + hj] = mx * 0.6931471805599453f + __logf(sum);
    __syncthreads();
}

__device__ __forceinline__ int swz512(int row, int ch) { return 512 * row + 16 * (ch ^ (((row & 3) << 2) | ((row >> 2) & 3))); }

struct GlaPre { float al0, al1; u32x4 q[2], k[2], v[4]; };
__device__ __forceinline__ void gla_local_issue(GlaPre& R, const bf16_t* proj, const float* alow, int u, int tid) {
    const int n = u & 31, h = (u >> 5) & 3, b = u >> 7;
    const size_t t0 = (size_t)b * SEQ + 64 * n;
    R.al0 = alow[t0 * 16 + tid]; R.al1 = alow[t0 * 16 + 512 + tid];
#pragma unroll
    for (int it = 0; it < 2; ++it) { const int id = tid + NTHREADS * it, row = id >> 4, ch = id & 15; const bf16_t* src = proj + (t0 + row) * NP + h * 128 + ch * 8; R.q[it] = *(const u32x4*)(src + QB); R.k[it] = *(const u32x4*)(src + KB); }
#pragma unroll
    for (int it = 0; it < 4; ++it) { const int id = tid + NTHREADS * it, row = id >> 5, ch = id & 31; R.v[it] = *(const u32x4*)(proj + (t0 + row) * NP + VB + h * 256 + ch * 8); }
}
__device__ __forceinline__ void gla_local_unit(LAS unsigned char* lds, GlaPre& R, const bf16_t* proj, const float* alow, const float (&w2)[16], const float bias,
                                               bf16_t* qdg, bf16_t* oig, bf16_t* dstg, float* decg, int u, int u_next, int tid, int wave, int lane) {
    const int n = u & 31, h = (u >> 5) & 3, b = u >> 7;
    const int d = tid & 127, ig = tid >> 7;
    const int fr = lane & 15, fq = lane >> 4;
    LAS unsigned char* QD = lds; LAS unsigned char* KI = lds + 17408; LAS unsigned char* KET = lds + 34816; LAS unsigned char* VL = lds + 53248;
    LAS unsigned char* AT = lds + 86016;
    LAS float* CS = (LAS float*)(lds + 95232); LAS float* ALs = (LAS float*)(lds + 97280);
    const size_t t0 = (size_t)b * SEQ + 64 * n;
#pragma unroll
    for (int it = 0; it < 2; ++it) { const int id = tid + NTHREADS * it, row = id >> 4, ch = id & 15; *(LAS u32x4*)(QD + row * 272 + ch * 16) = R.q[it]; *(LAS u32x4*)(KI + row * 272 + ch * 16) = R.k[it]; }
    ALs[tid] = R.al0; ALs[512 + tid] = R.al1;
#pragma unroll
    for (int it = 0; it < 4; ++it) { const int id = tid + NTHREADS * it, row = id >> 5, ch = id & 31; *(LAS u32x4*)(VL + swz512(row, ch)) = R.v[it]; }
    __syncthreads();
    if (u_next >= 0) gla_local_issue(R, proj, alow, u_next, tid);
    float bl[16]; float run = 0.f;
#pragma unroll
    for (int ii = 0; ii < 16; ++ii) { float z = bias; const LAS f32x4* ap = (const LAS f32x4*)(ALs + (16 * ig + ii) * 16);
#pragma unroll
        for (int r4 = 0; r4 < 4; ++r4) { const f32x4 av = ap[r4]; z = fmaf(av[0], w2[4 * r4], z); z = fmaf(av[1], w2[4 * r4 + 1], z); z = fmaf(av[2], w2[4 * r4 + 2], z); z = fmaf(av[3], w2[4 * r4 + 3], z); }
        const float la = (fminf(z, 0.f) - __logf(1.0f + __expf(-fabsf(z)))) * 0.0625f; run += la; bl[ii] = run; }
    CS[ig * 128 + d] = run;
    __syncthreads();
    float pre = 0.f, tot = 0.f;
#pragma unroll
    for (int g2 = 0; g2 < 4; ++g2) { const float cv = CS[g2 * 128 + d]; tot += cv; pre += (g2 < ig) ? cv : 0.f; }
    const float qscale = 0.08838834764831845f; const float etot = __expf(tot);
    unsigned ke[8];
#pragma unroll
    for (int ii = 0; ii < 16; ++ii) { const float bb = pre + bl[ii];
        LAS bf16_t* qp = (LAS bf16_t*)(QD + (16 * ig + ii) * 272 + 2 * d); LAS bf16_t* kp = (LAS bf16_t*)(KI + (16 * ig + ii) * 272 + 2 * d);
        const float qf_ = bf2f(*qp), kf_ = bf2f(*kp);
        const float eb = __expf(bb), einv = __builtin_amdgcn_rcpf(eb);
        const float qd = qf_ * qscale * eb, ki = kf_ * einv, kend = kf_ * (etot * einv);
        *qp = (bf16_t)f2bf(qd); *kp = (bf16_t)f2bf(ki);
        if (ii & 1) ke[ii >> 1] |= f2bf(kend) << 16; else ke[ii >> 1] = f2bf(kend); }
    *(LAS u32x4*)(KET + d * 144 + 32 * ig) = (u32x4){ke[0], ke[1], ke[2], ke[3]}; *(LAS u32x4*)(KET + d * 144 + 32 * ig + 16) = (u32x4){ke[4], ke[5], ke[6], ke[7]};
    if (ig == 0) decg[(size_t)u * 128 + d] = etot;
    __syncthreads();
#pragma unroll
    for (int it = 0; it < 2; ++it) { const int id = tid + NTHREADS * it, row = id >> 4, ch = id & 15; *(u32x4*)(qdg + ((size_t)(b * 4 + h) * 32 + n) * 8192 + (size_t)((((row >> 4) * 4 + (ch >> 2)) * 64 + (row & 15) * 4 + (ch & 3)) * 8)) = *(const LAS u32x4*)(QD + row * 272 + ch * 16); }
#pragma unroll
    for (int x = 0; x < 2; ++x) { const int id = 2 * wave + x, ti = id >> 2, tj = id & 3; f32x4 acc = (f32x4){0.f, 0.f, 0.f, 0.f};
        if (tj <= ti) {
#pragma unroll
            for (int ks = 0; ks < 4; ++ks) { const bf16x8 af = *(const LAS bf16x8*)(QD + (16 * ti + fr) * 272 + (32 * ks + 8 * fq) * 2); const bf16x8 bfr = *(const LAS bf16x8*)(KI + (16 * tj + fr) * 272 + (32 * ks + 8 * fq) * 2);
                acc = __builtin_amdgcn_mfma_f32_16x16x32_bf16(af, bfr, acc, 0, 0, 0); } }
#pragma unroll
        for (int rg = 0; rg < 4; ++rg) { const int i = 16 * ti + 4 * fq + rg, j = 16 * tj + fr; const float vv = (i >= j) ? acc[rg] : 0.f; *(LAS bf16_t*)(AT + i * 144 + 2 * j) = (bf16_t)f2bf(vv); } }
    bf16x8 vfr[2][2];
    { const int li = lane & 15, qq = li >> 2, pp = li & 3;
#pragma unroll
        for (int tv = 0; tv < 2; ++tv)
#pragma unroll
            for (int ks = 0; ks < 2; ++ks) { const int vt = 2 * wave + tv;
                const int r0 = 32 * ks + 8 * fq + qq, r1 = r0 + 4;
                const s16x4 a0 = vtr(VL + swz512(r0, 2 * vt + (pp >> 1)) + 8 * (pp & 1)), a1 = vtr(VL + swz512(r1, 2 * vt + (pp >> 1)) + 8 * (pp & 1));
                bf16x8 f; f[0] = a0[0]; f[1] = a0[1]; f[2] = a0[2]; f[3] = a0[3]; f[4] = a1[0]; f[5] = a1[1]; f[6] = a1[2]; f[7] = a1[3]; vfr[tv][ks] = f; } }
#pragma unroll
    for (int dt = 0; dt < 8; ++dt) {
        bf16x8 kf[2];
#pragma unroll
        for (int ks = 0; ks < 2; ++ks) kf[ks] = *(const LAS bf16x8*)(KET + (16 * dt + fr) * 144 + (32 * ks + 8 * fq) * 2);
#pragma unroll
        for (int tv = 0; tv < 2; ++tv) { f32x4 acc = (f32x4){0.f, 0.f, 0.f, 0.f};
#pragma unroll
            for (int ks = 0; ks < 2; ++ks) acc = __builtin_amdgcn_mfma_f32_16x16x32_bf16(kf[ks], vfr[tv][ks], acc, 0, 0, 0);
            u32x2 w; w.x = pk2(acc[0], acc[1]); w.y = pk2(acc[2], acc[3]);
            *(u32x2*)(dstg + (((size_t)(b * 4 + h) * 8 + wave) * 32 + n) * 4096 + (size_t)(((dt * 2 + tv) * 64 + fr * 4 + fq) * 4)) = w; } }
    __syncthreads();
#pragma unroll
    for (int ti = 0; ti < 4; ++ti) {
        bf16x8 af[2];
#pragma unroll
        for (int ks = 0; ks < 2; ++ks) af[ks] = *(const LAS bf16x8*)(AT + (16 * ti + fr) * 144 + (32 * ks + 8 * fq) * 2);
#pragma unroll
        for (int tv = 0; tv < 2; ++tv) { f32x4 acc = (f32x4){0.f, 0.f, 0.f, 0.f};
#pragma unroll
            for (int ks = 0; ks < 2; ++ks) acc = __builtin_amdgcn_mfma_f32_16x16x32_bf16(vfr[tv][ks], af[ks], acc, 0, 0, 0);
            u32x2 w; w.x = pk2(acc[0], acc[1]); w.y = pk2(acc[2], acc[3]);
            *(u32x2*)(oig + (((size_t)(b * 4 + h) * 8 + wave) * 32 + n) * 2048 + (size_t)(((ti * 2 + tv) * 64 + fr * 4 + fq) * 4)) = w; } }
    __syncthreads();
}

template <bool FAKE>
__device__ __forceinline__ void gla_scan_unit(LAS unsigned char* lds, const bf16_t* qdg, const bf16_t* oig, const bf16_t* dstg, const float* decg, bf16_t* ob, float* ssq,
                                              int u, int tid, int wave, int lane) {
    const int vs = u & 7, h = (u >> 3) & 3, b = u >> 5;
    const int fr = lane & 15, fq = lane >> 4;
    const int ti = wave >> 1, tv = wave & 1;
    LAS unsigned char* STb = lds;
    LAS unsigned char* OBL = lds + 20480;
    LAS float* SQL = (LAS float*)(lds + 53248);
    f32x4 sst[2]; sst[0] = (f32x4){0.f, 0.f, 0.f, 0.f}; sst[1] = sst[0];
    { unsigned z0 = 0u; asm volatile("" : "+v"(z0)); *(LAS u32x4*)(STb + tid * 16) = (u32x4){z0, z0, z0, z0}; if (tid < 32) *(LAS u32x4*)(STb + 8192 + tid * 16) = (u32x4){z0, z0, z0, z0}; }
    const int ub = (b * 4 + h) * 32;
    struct StepOps { bf16x8 q[4]; u32x2 o; u32x2 ds[2]; f32x4 dc; };
    const unsigned qoff = (unsigned)((ti * 4 * 64 + fr * 4 + fq) * 16), ooff = (unsigned)(((ti * 2 + tv) * 64 + fr * 4 + fq) * 8);
    const unsigned dsoff = (unsigned)(((wave * 2) * 64 + fr * 4 + fq) * 8), dcoff = (unsigned)(16 * wave + 4 * fq) * 4u;
    const char* qbase = (const char*)(qdg + (size_t)(b * 4 + h) * SEQ * 128);
    const char* obase = (const char*)(oig + ((size_t)(b * 4 + h) * 8 + vs) * SEQ * 32);
    const char* dsbase = (const char*)(dstg + ((size_t)(b * 4 + h) * 8 + vs) * 32 * 32 * 128);
    const char* dcbase = (const char*)(decg + (size_t)ub * 128);
#define GLA_LOAD(R, nn_) do { const int nn = FAKE ? 0 : ((nn_) < 32 ? (nn_) : 31); \
        const char* qs_ = qbase + (size_t)nn * 16384; _Pragma("unroll") for (int ks = 0; ks < 4; ++ks) R.q[ks] = *(const bf16x8*)(qs_ + qoff + 1024 * ks); \
        R.o = *(const u32x2*)(obase + (size_t)nn * 4096 + ooff); \
        _Pragma("unroll") for (int t2 = 0; t2 < 2; ++t2) R.ds[t2] = *(const u32x2*)(dsbase + (size_t)nn * 8192 + 512 * t2 + dsoff); \
        R.dc = *(const f32x4*)(dcbase + (size_t)nn * 512 + dcoff); } while (0)
#define GLA_STEP(R, n_) do { const int n = (n_); const size_t t0 = (size_t)b * SEQ + 64 * n; \
        LAS unsigned char* STc = STb + (n & 1) * 8704; LAS unsigned char* STn = STb + ((n + 1) & 1) * 8704; \
        f32x4 acc; acc[0] = bflo(R.o.x); acc[1] = bfhi(R.o.x); acc[2] = bflo(R.o.y); acc[3] = bfhi(R.o.y); \
        _Pragma("unroll") for (int ks = 0; ks < 4; ++ks) { const bf16x8 sfr = *(const LAS bf16x8*)(STc + (16 * tv + fr) * 272 + (32 * ks + 8 * fq) * 2); acc = __builtin_amdgcn_mfma_f32_16x16x32_bf16(sfr, R.q[ks], acc, 0, 0, 0); } \
        { u32x2 w; w.x = pk2(acc[0], acc[1]); w.y = pk2(acc[2], acc[3]);              \
            *(LAS u32x2*)(OBL + (n & 7) * 4096 + (16 * ti + fr) * 64 + (16 * tv + 4 * fq) * 2) = w; \
            float q2 = (acc[0] * acc[0] + acc[1] * acc[1]) + (acc[2] * acc[2] + acc[3] * acc[3]); q2 += sx<16>(q2, lane); q2 += sx<32>(q2, lane); \
            if (fq == 0) SQL[(n & 7) * 128 + (16 * ti + fr) * 2 + tv] = q2; } \
        _Pragma("unroll") for (int t2 = 0; t2 < 2; ++t2) { \
            sst[t2][0] = sst[t2][0] * R.dc[0] + bflo(R.ds[t2].x); sst[t2][1] = sst[t2][1] * R.dc[1] + bfhi(R.ds[t2].x); \
            sst[t2][2] = sst[t2][2] * R.dc[2] + bflo(R.ds[t2].y); sst[t2][3] = sst[t2][3] * R.dc[3] + bfhi(R.ds[t2].y); \
            u32x2 w; w.x = pk2(sst[t2][0], sst[t2][1]); w.y = pk2(sst[t2][2], sst[t2][3]); \
            *(LAS u32x2*)(STn + (16 * t2 + fr) * 272 + (16 * wave + 4 * fq) * 2) = w; } \
        __syncthreads(); \
        if (!FAKE && (n & 7) == 7) { const size_t tf = (size_t)b * SEQ + 64 * (n - 7); \
            _Pragma("unroll") for (int it = 0; it < 4; ++it) { const int id = tid + NTHREADS * it, sf = id >> 8, row = (id >> 2) & 63, c = id & 3; \
                *(u32x4*)(ob + (tf + 64 * sf + row) * 1024 + h * 256 + 32 * vs + 8 * c) = *(const LAS u32x4*)(OBL + id * 16); } \
            _Pragma("unroll") for (int it = 0; it < 2; ++it) { const int id = tid + NTHREADS * it, sf = id >> 7, row = (id >> 1) & 63, tq = id & 1; \
                ssq[((tf + 64 * sf + row) * 4 + h) * 16 + vs * 2 + tq] = SQL[id]; } \
            __syncthreads(); } } while (0)
    StepOps r0, r1, r2, r3;
    GLA_LOAD(r0, 0); GLA_LOAD(r1, 1); GLA_LOAD(r2, 2);
    __syncthreads();
    for (int n4 = 0; n4 < 32; n4 += 4) {
        GLA_LOAD(r3, n4 + 3); GLA_STEP(r0, n4);
        GLA_LOAD(r0, n4 + 4); GLA_STEP(r1, n4 + 1);
        GLA_LOAD(r1, n4 + 5); GLA_STEP(r2, n4 + 2);
        GLA_LOAD(r2, n4 + 6); GLA_STEP(r3, n4 + 3);
    }
#undef GLA_STEP
#undef GLA_LOAD
}

__device__ __forceinline__ void merge_phase(const bf16_t* atto, const float* lse, const bf16_t* ob, const float* ssq, const bf16_t* proj, const float* gla_gain, bf16_t* ya, bf16_t* yb,
                                            int vcu, int G, int wave, int lane) {
    const int gw = vcu * NWAVES + wave, NGW = G * NWAVES;
    const int hj = lane >> 4;
    f32x4 g0[2], g1[2];
#pragma unroll
    for (int c = 0; c < 2; ++c) { const int col = 8 * lane + 512 * c; g0[c] = *(const f32x4*)(gla_gain + col); g1[c] = *(const f32x4*)(gla_gain + col + 4); }
    for (int row0 = 2 * gw; row0 < T; row0 += 2 * NGW) {
        float l0[2], l1[2], l2[2]; u32x4 a0[2], a1[2], a2[2], o[2][2], rr_[2][2]; f32x4 sq[2][2][4];
#pragma unroll
        for (int r = 0; r < 2; ++r) { const int row = row0 + r;
            l0[r] = lse[((size_t)0 * T + row) * 4 + hj]; l1[r] = lse[((size_t)1 * T + row) * 4 + hj]; l2[r] = lse[((size_t)2 * T + row) * 4 + hj];
            a0[r] = __builtin_nontemporal_load((const u32x4*)(atto + ((size_t)0 * T + row) * 512 + 8 * lane)); a1[r] = __builtin_nontemporal_load((const u32x4*)(atto + ((size_t)1 * T + row) * 512 + 8 * lane)); a2[r] = __builtin_nontemporal_load((const u32x4*)(atto + ((size_t)2 * T + row) * 512 + 8 * lane));
#pragma unroll
            for (int c = 0; c < 2; ++c) { const int col = 8 * lane + 512 * c, hh = col >> 8;
                const f32x4* sp = (const f32x4*)(ssq + ((size_t)row * 4 + hh) * 16); sq[r][c][0] = sp[0]; sq[r][c][1] = sp[1]; sq[r][c][2] = sp[2]; sq[r][c][3] = sp[3];
                o[r][c] = __builtin_nontemporal_load((const u32x4*)(ob + (size_t)row * 1024 + col));
#if GATE_F8
                { const u32x2 r8 = *(const u32x2*)((const unsigned char*)proj + (size_t)row * NP * 2 + G8_BYTE0 + col); rr_[r][c] = (u32x4){r8.x, r8.y, 0u, 0u}; }
#else
                rr_[r][c] = *(const u32x4*)(proj + (size_t)row * NP + RB + col);
#endif
            } }
#pragma unroll
        for (int r = 0; r < 2; ++r) { const int row = row0 + r;
            const float m = fmaxf(l0[r], fmaxf(l1[r], l2[r])); float e0 = __expf(l0[r] - m), e1 = __expf(l1[r] - m), e2 = __expf(l2[r] - m); const float inv = 1.0f / (e0 + e1 + e2); e0 *= inv; e1 *= inv; e2 *= inv;
            u32x4 w;
            w.x = pk2(e0 * bflo(a0[r].x) + e1 * bflo(a1[r].x) + e2 * bflo(a2[r].x), e0 * bfhi(a0[r].x) + e1 * bfhi(a1[r].x) + e2 * bfhi(a2[r].x));
            w.y = pk2(e0 * bflo(a0[r].y) + e1 * bflo(a1[r].y) + e2 * bflo(a2[r].y), e0 * bfhi(a0[r].y) + e1 * bfhi(a1[r].y) + e2 * bfhi(a2[r].y));
            w.z = pk2(e0 * bflo(a0[r].z) + e1 * bflo(a1[r].z) + e2 * bflo(a2[r].z), e0 * bfhi(a0[r].z) + e1 * bfhi(a1[r].z) + e2 * bfhi(a2[r].z));
            w.w = pk2(e0 * bflo(a0[r].w) + e1 * bflo(a1[r].w) + e2 * bflo(a2[r].w), e0 * bfhi(a0[r].w) + e1 * bfhi(a1[r].w) + e2 * bfhi(a2[r].w));
#if MIX_F8
            { u32x2 w8; w8.x = pk_fp8x4(bflo(w.x), bfhi(w.x), bflo(w.y), bfhi(w.y)); w8.y = pk_fp8x4(bflo(w.z), bfhi(w.z), bflo(w.w), bfhi(w.w)); *(u32x2*)((unsigned char*)ya + (BR_FUSE ? (size_t)row * 1536 + 1024 : (size_t)row * 512) + 8 * lane) = w8; }
#else
            *(u32x4*)(ya + (size_t)row * 512 + 8 * lane) = w;
#endif
#pragma unroll
            for (int c = 0; c < 2; ++c) { const int col = 8 * lane + 512 * c;
                const f32x4 s0 = sq[r][c][0], s1 = sq[r][c][1], s2 = sq[r][c][2], s3 = sq[r][c][3];
                const float tot = ((s0[0] + s0[1]) + (s0[2] + s0[3])) + ((s1[0] + s1[1]) + (s1[2] + s1[3])) + ((s2[0] + s2[1]) + (s2[2] + s2[3])) + ((s3[0] + s3[1]) + (s3[2] + s3[3]));
                const float rstd = 1.0f / sqrtf(tot * (1.0f / 256.0f) + NORM_EPS);
                const u32x4 ov = o[r][c], rv = rr_[r][c]; u32x4 y; float rf[8];
#if GATE_F8
                unpack_fp8x8((u32x2){rv.x, rv.y}, rf);
#else
                rf[0] = bflo(rv.x); rf[1] = bfhi(rv.x); rf[2] = bflo(rv.y); rf[3] = bfhi(rv.y); rf[4] = bflo(rv.z); rf[5] = bfhi(rv.z); rf[6] = bflo(rv.w); rf[7] = bfhi(rv.w);
#endif
                y.x = pk2(bflo(ov.x) * rstd * g0[c][0] * siluf_(rf[0]), bfhi(ov.x) * rstd * g0[c][1] * siluf_(rf[1]));
                y.y = pk2(bflo(ov.y) * rstd * g0[c][2] * siluf_(rf[2]), bfhi(ov.y) * rstd * g0[c][3] * siluf_(rf[3]));
                y.z = pk2(bflo(ov.z) * rstd * g1[c][0] * siluf_(rf[4]), bfhi(ov.z) * rstd * g1[c][1] * siluf_(rf[5]));
                y.w = pk2(bflo(ov.w) * rstd * g1[c][2] * siluf_(rf[6]), bfhi(ov.w) * rstd * g1[c][3] * siluf_(rf[7]));
#if MIX_F8
                { u32x2 y8; y8.x = pk_fp8x4(bflo(y.x), bfhi(y.x), bflo(y.y), bfhi(y.y)); y8.y = pk_fp8x4(bflo(y.z), bfhi(y.z), bflo(y.w), bfhi(y.w)); *(u32x2*)((unsigned char*)(BR_FUSE ? ya : yb) + (size_t)row * (BR_FUSE ? 1536 : 1024) + col) = y8; }
#else
                *(u32x4*)(yb + (size_t)row * 1024 + col) = y;
#endif
            } }
    }
}

constexpr int LS = 10;
__host__ __device__ constexpr int phase_kind(int k) { return k == 0 ? 0 : (k == 1 + DEPTH * LS ? LS + 1 : ((k - 1) % LS) + 1); }
constexpr int N_PHASES = 2 + DEPTH * LS;
typedef const __attribute__((address_space(4))) Args CArgs;
__device__ __forceinline__ CArgs* fresh_args() {
    unsigned long long v = (unsigned long long)__builtin_amdgcn_kernarg_segment_ptr();
    unsigned lo = (unsigned)v, hi = (unsigned)(v >> 32);
    asm volatile("" : "+s"(lo), "+s"(hi));
    lo = __builtin_amdgcn_readfirstlane(lo); hi = __builtin_amdgcn_readfirstlane(hi);
    return (CArgs*)(((unsigned long long)hi << 32) | lo);
}
template <unsigned MASK, bool ONE>
__global__ void __launch_bounds__(NTHREADS, 2) fwd_kernel(Args a_unused) {
    extern __shared__ __attribute__((aligned(16))) unsigned char lds_raw[];
    LAS unsigned char* lds = (LAS unsigned char*)lds_raw;
    const int wave0 = __builtin_amdgcn_readfirstlane((int)threadIdx.x >> 6);
    int lane = (int)__builtin_amdgcn_mbcnt_hi(~0u, __builtin_amdgcn_mbcnt_lo(~0u, 0u)), wave = wave0, tid = wave0 * 64 + lane;
    CArgs* ap = fresh_args();
    unsigned char* ws = ap->ws;
#define a (*ap)
#define FRESH_TID() do { ap = fresh_args(); ws = ap->ws; unsigned m1_ = ~0u; asm volatile("" : "+s"(m1_)); lane = (int)__builtin_amdgcn_mbcnt_hi(m1_, __builtin_amdgcn_mbcnt_lo(m1_, 0u)); asm volatile("" : "+v"(lane)); wave = wave0; tid = wave0 * 64 + lane; } while (0)
    const int G = gridDim.x; const int bx = blockIdx.x; const int vcu = (G % 8 == 0) ? (bx % 8) * (G / 8) + bx / 8 : bx;
    volatile LAS unsigned* MISC = (volatile LAS unsigned*)(lds + MISC_OFF);
    for (int u = tid; u < (LDS_BYTES - MISC_OFF) / 4; u += NTHREADS) ((LAS unsigned*)(lds + MISC_OFF))[u] = 0u;
    __syncthreads();
    if (ONE) (void)xcd_barrier_post((unsigned*)(ws + WS_CTL) + CW_BAR, MISC + 8);
    const int lo = ONE ? 0 : a.ph_lo, hi = ONE ? N_PHASES : a.ph_hi;
#define IN(k, kind) (((MASK >> (kind)) & 1u) && (ONE || (lo <= (k) && (k) < hi)))
#if defined(PROBE_EPI) && !defined(PROBE_MASK)
#endif
#ifdef PROBE_MASK
#define PB_ON(k) ((PROBE_MASK >> phase_kind(k)) & 1u)
#define PB_START(k) do { if (PB_ON(k) && threadIdx.x == 0) *(volatile LAS unsigned long long*)(lds + MISC_OFF + 8192) = __builtin_amdgcn_s_memrealtime(); } while (0)
#define PB_END(k) do { if (PB_ON(k) && threadIdx.x == 0) { volatile LAS unsigned long long* pb_ = (volatile LAS unsigned long long*)(lds + MISC_OFF + 8192); pb_[1] = pb_[1] + (__builtin_amdgcn_s_memrealtime() - pb_[0]); } } while (0)
#else
#define PB_START(k) do { } while (0)
#define PB_END(k) do { } while (0)
#endif
#define SEAM(k) do { if (ONE) { XcdBarrier bar_; bar_.bar = (unsigned*)(((CArgs*)fresh_args())->ws + WS_CTL) + CW_BAR; bar_.x = xb_xcc_id(); bar_.st = (volatile LAS unsigned*)(lds + MISC_OFF) + 8; xcd_barrier(bar_); } } while (0)

#define ada ((float*)(ws + WS_ADA))
#define ropec ((const float*)(ws + WS_ROPE))
#define ropes (((const float*)(ws + WS_ROPE)) + SEQ * 64)
#define alow ((float*)(ws + WS_ALOW))
#define lse ((float*)(ws + WS_LSE))
#define ssq ((float*)(ws + WS_SSQ))
#define rlist ((int*)(ws + WS_RLIST))
#define tslot ((int*)(ws + WS_TSLOT))
#define tw ((float*)(ws + WS_TW))
#define hbuf ((bf16_t*)(ws + WS_H))
#define ya ((bf16_t*)(ws + WS_YA))
#define yb ((bf16_t*)(ws + WS_YB))
#define mrg ((bf16_t*)(ws + WS_MRG))
#define atto ((bf16_t*)(ws + WS_ATTO))
#define obuf ((bf16_t*)(ws + WS_OB))
#define proj ((bf16_t*)(ws + WS_PROJ))
#define act ((bf16_t*)(ws + WS_ACT))
#define Y ((bf16_t*)(ws + WS_Y))
#define ctl ((unsigned*)(ws + WS_CTL))
#define xb_ ((bf16_t*)(ws + WS_XB))
#define qdb_ ((bf16_t*)(ws + WS_QD))
#define oib_ ((bf16_t*)(ws + WS_OI))
#define dstb_ ((bf16_t*)(ws + WS_DST))
#define decb_ ((float*)(ws + WS_DEC))

    PB_START(0);
    if (IN(0, 0)) { FRESH_TID(); prologue_phase(ap, lds, vcu, G, tid, wave, lane); }
#ifdef PROBE_DUP_PRO
    __syncthreads(); if (IN(0, 0)) { FRESH_TID(); prologue_phase(ap, lds, vcu, G, tid, wave, lane, PROBE_DUP_PRO); }
#endif
    SEAM(0); PB_END(0);

    for (int l = 0; l < DEPTH; ++l) {
        const int P = 1 + LS * l;
#define adal (ada + (size_t)l * NB * 12288)
#define cntl (ctl + CW_CNT + l * 1024)
#define cntp (ctl + CW_CNT + (l > 0 ? (l - 1) * 1024 : 0))
#define xsrc ((l == 0) ? a.x : a.out)
        PB_START(P);
        if (IN(P, 1)) { FRESH_TID();
            if (l == 0) norm_phase<0>(xsrc, nullptr, hbuf, a.norm_mix, adal + 2048, adal, nullptr, nullptr, nullptr, nullptr, nullptr, vcu, G, wave, lane);
            else norm_phase<1>(xb_, xb_, hbuf, a.norm_mix + (size_t)l * D, adal + 2048, adal, ada + (size_t)(l - 1) * NB * 12288 + 10240, Y, tslot, tw, cntp, vcu, G, wave, lane);
        }
        SEAM(P); PB_END(P); PB_START(P + 1);
        if (IN(P + 1, 2)) { FRESH_TID();
#if PROJ_F8
            pg8::StaticOrderP S{T / 256, NP / 256, G, bx}; pg8::RowsContig AM; pg8::EpiProj E{proj, ropec, ropes, alow, pg8::W8_INV};
            pg8::gemm_phase<pg8::EpiProj, pg8::StaticOrderP, pg8::RowsContig, true, true>(lds, tid, hbuf, (const bf16_t*)(ws + WS_WIN + (size_t)l * NP * D), 0, D / 2, S, AM, E);
#else
            pg8::StaticOrderP S{T / 256, NP / 256, G, bx}; pg8::RowsContig AM; pg8::EpiProj E{proj, ropec, ropes, alow, 1.0f};
            pg8::gemm_phase<pg8::EpiProj, pg8::StaticOrderP, pg8::RowsContig, true>(lds, tid, hbuf, (const bf16_t*)(ws + WS_WIN) + (size_t)l * NP * D, 0, D, S, AM, E);
#endif
        }
        SEAM(P + 1); PB_END(P + 1); PB_START(P + 2);
        if (IN(P + 2, 3)) { FRESH_TID();
            {
                const int hw = (vcu >> 5) & 3, dw = tid & 127; float w2[16];
#pragma unroll
                for (int r = 0; r < 16; ++r) w2[r] = (a.w_alpha2 + (size_t)l * 16 * 512)[r * 512 + hw * 128 + dw];
                const float bias = (a.b_alpha2 + (size_t)l * 512)[hw * 128 + dw];
                for (int u = vcu; u < NB * 4 * 32; u += G) { GlaPre R; gla_local_issue(R, proj, alow, u, tid);
                    gla_local_unit(lds, R, proj, alow, w2, bias, qdb_, oib_, dstb_, decb_, u, -1, tid, wave, lane); } }
            FRESH_TID();
            for (int u = vcu; u < NB * 12 * 16; u += G) { AttnPre R; attn_issue(R, proj, u, tid, wave, lane); attn_unit(lds, R, proj, atto, lse, u, -1, tid, wave, lane); }
#ifdef PROBE_DUP_ATTN
            for (int u = vcu; u < NB * 12 * 16; u += G) { AttnPre R; attn_issue(R, proj, u, tid, wave, lane); attn_unit(lds, R, proj, atto, lse, u, -1, tid, wave, lane); }
#endif
        }
        SEAM(P + 2); PB_END(P + 2); PB_START(P + 3);
        if (IN(P + 3, 4)) { FRESH_TID();
            for (int u = vcu; u < 256; u += G) gla_scan_unit<false>(lds, qdb_, oib_, dstb_, decb_, obuf, ssq, u, tid, wave, lane);
#ifdef PROBE_FAKESCAN
            __syncthreads(); for (int u = vcu; u < 256; u += G) gla_scan_unit<true>(lds, qdb_, oib_, dstb_, decb_, obuf, ssq, u, tid, wave, lane);
#endif
        }
        SEAM(P + 3); PB_END(P + 3); PB_START(P + 4);
        if (IN(P + 4, 5)) { FRESH_TID(); merge_phase(atto, lse, obuf, ssq, proj, a.gla_gain + (size_t)l * 1024, ya, yb, vcu, G, wave, lane); }
        SEAM(P + 4); PB_END(P + 4); PB_START(P + 5);
        if (IN(P + 5, 6)) { FRESH_TID();
#if BR_FUSE
            { pg8::SegOrder S2{T / 256, D / 256, G, bx}; pg8::RowsContig AM2; pg8::EpiGate2 E{proj, pg8::W8_INV, ws + WS_MRG8};
              pg8::gemm_phase<pg8::EpiGate2, pg8::SegOrder, pg8::RowsContig, true, true, true>(lds, tid, ya, (const bf16_t*)(ws + WS_WOA + (size_t)l * D * 1536), 0, 768, S2, AM2, E); }
#else
            pg8::StaticOrder S{T / 256, D / 256, G, bx}; pg8::RowsContig AM;
#if MIX_F8
            { pg8::EpiGate<true> E{mrg, proj, GA, pg8::W8_INV, nullptr}; pg8::gemm_phase<pg8::EpiGate<true>, pg8::StaticOrder, pg8::RowsContig, true, true>(lds, tid, ya, (const bf16_t*)(ws + WS_WOA + (size_t)l * D * 512), 0, 256, S, AM, E); }
#else
            { pg8::EpiGate<true> E{mrg, proj, GA, 1.0f, nullptr}; pg8::gemm_phase<pg8::EpiGate<true>, pg8::StaticOrder, pg8::RowsContig, true>(lds, tid, ya, (const bf16_t*)(ws + WS_WOA) + (size_t)l * D * 512, 0, 512, S, AM, E); }
#endif
            FRESH_TID();
#if MIX_F8
            { pg8::EpiGate<false> E{mrg, proj, GB, pg8::W8_INV, ws + WS_MRG8}; pg8::gemm_phase<pg8::EpiGate<false>, pg8::StaticOrder, pg8::RowsContig, true, true>(lds, tid, yb, (const bf16_t*)(ws + WS_WOB + (size_t)l * D * 1024), 0, 512, S, AM, E); }
#else
            { pg8::EpiGate<false> E{mrg, proj, GB, 1.0f, nullptr}; pg8::gemm_phase<pg8::EpiGate<false>, pg8::StaticOrder, pg8::RowsContig, true>(lds, tid, yb, (const bf16_t*)(ws + WS_WOB) + (size_t)l * D * 1024, 0, 1024, S, AM, E); }
#endif
#endif
        }
        SEAM(P + 5); PB_END(P + 5); PB_START(P + 6);
        if (IN(P + 6, 7)) { FRESH_TID();
            pg8::StaticOrder S{T / 256, D / 256, G, bx}; pg8::RowsContig AM;
#if MIX_F8
            if (l == 0) { pg8::EpiResid<true> E{a.x, xb_, adal + 4096, pg8::W8_INV}; pg8::gemm_phase<pg8::EpiResid<true>, pg8::StaticOrder, pg8::RowsContig, true, true>(lds, tid, (const bf16_t*)(ws + WS_MRG8), (const bf16_t*)(ws + WS_WO + (size_t)l * D * D), 0, D / 2, S, AM, E); }
            else { pg8::EpiResid<false> E{xb_, xb_, adal + 4096, pg8::W8_INV}; pg8::gemm_phase<pg8::EpiResid<false>, pg8::StaticOrder, pg8::RowsContig, true, true>(lds, tid, (const bf16_t*)(ws + WS_MRG8), (const bf16_t*)(ws + WS_WO + (size_t)l * D * D), 0, D / 2, S, AM, E); }
#else
            if (l == 0) { pg8::EpiResid<true> E{a.x, xb_, adal + 4096, 1.0f}; pg8::gemm_phase<pg8::EpiResid<true>, pg8::StaticOrder, pg8::RowsContig, true>(lds, tid, mrg, (const bf16_t*)(ws + WS_WO) + (size_t)l * D * D, 0, D, S, AM, E); }
            else { pg8::EpiResid<false> E{xb_, xb_, adal + 4096, 1.0f}; pg8::gemm_phase<pg8::EpiResid<false>, pg8::StaticOrder, pg8::RowsContig, true>(lds, tid, mrg, (const bf16_t*)(ws + WS_WO) + (size_t)l * D * D, 0, D, S, AM, E); }
#endif
        }
        SEAM(P + 6); PB_END(P + 6); PB_START(P + 7);
        if (IN(P + 7, 8)) { FRESH_TID(); router_phase(xb_, hbuf, a.norm_ffn + (size_t)l * D, adal + 8192, adal + 6144, a.w_router, a.b_router, cntl, rlist, tslot, tw, lds, vcu, G, tid, wave, lane); }
        SEAM(P + 7); PB_END(P + 7); PB_START(P + 8);
        if (IN(P + 8, 9)) { FRESH_TID();
            pg8::moe_table_build(lds, cntl, tid);
            pg8::MoeOrder S; S.init(lds, 8, G, bx); pg8::RowsGather AM{rlist, lds}; pg8::EpiSwiGLU8 E{(unsigned char*)act};
            pg8::gemm_phase<pg8::EpiSwiGLU8, pg8::MoeOrder, pg8::RowsGather, true, true>(lds, tid, hbuf, (const bf16_t*)(ws + WS_WGU + (size_t)l * NE * 2048 * D), (size_t)2048 * D / 2, D / 2, S, AM, E);
        }
        SEAM(P + 8); PB_END(P + 8); PB_START(P + 9);
        if (IN(P + 9, 10)) { FRESH_TID();
            pg8::moe_table_build(lds, cntl, tid);
            pg8::MoeOrder S; S.init(lds, 8, G, bx); pg8::RowsContig AM; pg8::EpiPlainS E{Y, pg8::W8_INV};
            pg8::gemm_phase<pg8::EpiPlainS, pg8::MoeOrder, pg8::RowsContig, true, true>(lds, tid, act, (const bf16_t*)(ws + WS_WDN + (size_t)l * NE * D * FF), (size_t)D * FF / 2, FF / 2, S, AM, E);
        }
        SEAM(P + 9); PB_END(P + 9);
    }
    PB_START(1 + DEPTH * LS);
    if (IN(1 + DEPTH * LS, LS + 1)) { FRESH_TID(); norm_phase<2>(xb_, a.out, nullptr, a.final_norm, nullptr, nullptr, ada + (size_t)(DEPTH - 1) * NB * 12288 + 10240, Y, tslot, tw, ctl + CW_CNT + (DEPTH - 1) * 1024, vcu, G, wave, lane); }
#ifdef PROBE_MASK
    __syncthreads(); PB_END(1 + DEPTH * LS);
    if (threadIdx.x == 0) { const unsigned long long t0_ = __builtin_amdgcn_s_memrealtime(), d_ = ((volatile LAS unsigned long long*)(lds + MISC_OFF + 8192))[1];
        while (__builtin_amdgcn_s_memrealtime() - t0_ < d_) __builtin_amdgcn_s_sleep(8); }
    __syncthreads();
#endif
#undef a
#undef IN
#undef SEAM
}

template <unsigned MASK, bool ONE>
static void launch_one(const Args& a, int grid, hipStream_t stream) {
    static bool attr_done = false;
    if (!attr_done) { (void)hipFuncSetAttribute((const void*)fwd_kernel<MASK, ONE>, hipFuncAttributeMaxDynamicSharedMemorySize, LDS_BYTES); attr_done = true; }
    hipLaunchKernelGGL((fwd_kernel<MASK, ONE>), dim3(grid), dim3(NTHREADS), LDS_BYTES, stream, a);
}
extern "C" void kernel_launch(void* const* d_in, const int* in_sizes, int n_in, void* d_out, int out_size, void* d_ws, size_t ws_size, hipStream_t stream) {
    static int grid = 0;
    if (grid == 0) {
        if (n_in != 19 || out_size != T * D || ws_size < WS_END) { fprintf(stderr, "kernel_launch: unexpected shapes (n_in %d, out %d, ws %zu < %zu); nothing launched\n", n_in, out_size, ws_size, (size_t)WS_END); grid = -1; return; }
        int dev = 0, cus = 0;
        if (hipGetDevice(&dev) != hipSuccess || hipDeviceGetAttribute(&cus, hipDeviceAttributeMultiprocessorCount, dev) != hipSuccess) { grid = -1; return; }
        grid = cus;
        if (grid != 256) fprintf(stderr, "kernel_launch: note: %d CUs (built for 256)\n", grid);
    }
    if (grid < 0) return;
    (void)hipMemsetAsync((char*)d_ws + WS_CTL, 0, CTL_ZERO_BYTES, stream);
    Args a{};
    a.x = (const float*)d_in[0]; a.c = (const float*)d_in[1]; a.w_ada = (const float*)d_in[2]; a.b_ada = (const float*)d_in[3]; a.norm_mix = (const float*)d_in[4]; a.norm_ffn = (const float*)d_in[5];
    a.w_in = (const float*)d_in[6]; a.w_alpha2 = (const float*)d_in[7]; a.b_alpha2 = (const float*)d_in[8]; a.gla_gain = (const float*)d_in[9]; a.w_out_a = (const float*)d_in[10];
    a.w_out_b = (const float*)d_in[11]; a.w_out = (const float*)d_in[12]; a.w_router = (const float*)d_in[13]; a.b_router = (const float*)d_in[14]; a.w_gate_e = (const float*)d_in[15];
    a.w_up_e = (const float*)d_in[16]; a.w_down_e = (const float*)d_in[17]; a.final_norm = (const float*)d_in[18];
    a.out = (float*)d_out; a.ws = (unsigned char*)d_ws;
#if MK_PER_PHASE
    for (int p = 0; p < N_PHASES; ++p) { a.ph_lo = p; a.ph_hi = p + 1;
        const int kind = phase_kind(p);
        switch (kind) {
            case 0: launch_one<1u << 0, false>(a, grid, stream); break; case 1: launch_one<1u << 1, false>(a, grid, stream); break;
            case 2: launch_one<1u << 2, false>(a, grid, stream); break; case 3: launch_one<1u << 3, false>(a, grid, stream); break;
            case 4: launch_one<1u << 4, false>(a, grid, stream); break; case 5: launch_one<1u << 5, false>(a, grid, stream); break;
            case 6: launch_one<1u << 6, false>(a, grid, stream); break; case 7: launch_one<1u << 7, false>(a, grid, stream); break;
            case 8: launch_one<1u << 8, false>(a, grid, stream); break; case 9: launch_one<1u << 9, false>(a, grid, stream); break;
            case 10: launch_one<1u << 10, false>(a, grid, stream); break;
            default: launch_one<1u << 11, false>(a, grid, stream); break; } }
#else
    a.ph_lo = 0; a.ph_hi = N_PHASES; launch_one<0xFFFFFu, true>(a, grid, stream);
#endif
    const hipError_t le = hipPeekAtLastError();
    if (le != hipSuccess) fprintf(stderr, "kernel_launch: launch failed: %s\n", hipGetErrorName(le));
}
```
